# Optimizing an MI355X kernel written in HIP

```python
import jax, jax.numpy as jnp
from jax import lax
import numpy as np

D_MODEL = 1024
BATCH = 2
SEQ = 16384
DEPTH = 1

CTX_LEN = 256
GRID_W = 64
EPS = 1e-6
D_RNN = 512
RNN_BLOCKS = 8
RNN_BLOCK_W = D_RNN // RNN_BLOCKS
RNN_CONV_W = 4
RNN_CONV_LEFT = 2
LRU_C = 8.0
HEAD_DIM = 64
N_Q_HEADS = 8
N_KV_HEADS = 2
Q_PER_KV = N_Q_HEADS // N_KV_HEADS
D_ATTN = N_Q_HEADS * HEAD_DIM
D_KV = N_KV_HEADS * HEAD_DIM
D_MIX = D_RNN + D_ATTN
D_IN = 2 * D_RNN + D_ATTN + 2 * D_KV
IN_SPLITS = (D_RNN, 2 * D_RNN, 2 * D_RNN + D_ATTN, 2 * D_RNN + D_ATTN + D_KV)
WINDOW = 128
BLOCK_Q = 128
ROPE_THETA = 10000.0
NEG_INF = -1e30
D_FF = 2816
FFN_CONV_W = 3
FFN_CONV_LEFT = 1

kernel_name = "hybrid_rglru_swa_convffn_dit_layer"


def rms_norm(x, g):
    xf = x.astype(jnp.float32)
    y = xf * lax.rsqrt(jnp.mean(xf * xf, axis=-1, keepdims=True) + EPS)
    return (y * g.astype(jnp.float32)).astype(x.dtype)


def adaln(cond, w_mod, b_mod):
    m = (jax.nn.silu(cond) @ w_mod + b_mod)[..., None, :]
    return jnp.split(m, 6, axis=-1)


def modulate(h, shift, scale):
    return h * (1 + scale) + shift


def dwconv(x, w, b, left):
    k = w.shape[0]
    s = x.shape[1]
    xp = jnp.pad(x, ((0, 0), (left, k - 1 - left), (0, 0)))
    out = b
    for j in range(k):
        out = out + xp[:, j:j + s] * w[j]
    return out


def rope_1d(x, pos):
    half = x.shape[-1] // 2
    inv = ROPE_THETA ** (-jnp.arange(half, dtype=jnp.float32) / half)
    ang = pos.astype(jnp.float32)[:, None] * inv[None, :]
    cos = jnp.cos(ang)[:, None, :].astype(x.dtype)
    sin = jnp.sin(ang)[:, None, :].astype(x.dtype)
    x1, x2 = x[..., :half], x[..., half:]
    return jnp.concatenate([x1 * cos - x2 * sin, x2 * cos + x1 * sin], axis=-1)


def rope_2d(x, row, col):
    d = HEAD_DIM // 2
    return jnp.concatenate([rope_1d(x[..., :d], row), rope_1d(x[..., d:], col)], axis=-1)


def linear_scan(a, u, h0):
    def combine(l, r):
        return l[0] * r[0], r[0] * l[1] + r[1]
    a_cum, b_cum = lax.associative_scan(combine, (a, u), axis=1)
    return a_cum * h0[:, None, :] + b_cum


def rglru_coeffs(xr, w_a, b_a, w_i, b_i, lam):
    xf = xr.astype(jnp.float32)
    xb = xf.reshape(xf.shape[:-1] + (RNN_BLOCKS, RNN_BLOCK_W))
    r = jax.nn.sigmoid(jnp.einsum('bsnc,ncd->bsnd', xb, w_a.astype(jnp.float32)).reshape(xf.shape) + b_a.astype(jnp.float32))
    i = jax.nn.sigmoid(jnp.einsum('bsnc,ncd->bsnd', xb, w_i.astype(jnp.float32)).reshape(xf.shape) + b_i.astype(jnp.float32))
    log_a = -LRU_C * r * jax.nn.softplus(-lam.astype(jnp.float32))
    a = jnp.exp(log_a)
    u = jnp.sqrt(-jnp.expm1(2.0 * log_a)) * (i * xf)
    return a, u


def rglru_bidir(x_lat, x_ctx, w_a, b_a, w_i, b_i, lam, with_ctx_out):
    y_lat = jnp.zeros(x_lat.shape, jnp.float32)
    y_ctx = jnp.zeros(x_ctx.shape, jnp.float32)
    h0 = jnp.zeros((x_ctx.shape[0], D_RNN), jnp.float32)
    for d in range(2):
        a_c, u_c = rglru_coeffs(x_ctx, w_a[d], b_a[d], w_i[d], b_i[d], lam[d])
        a_l, u_l = rglru_coeffs(x_lat, w_a[d], b_a[d], w_i[d], b_i[d], lam[d])
        if d == 1:
            a_c, u_c, a_l, u_l = (jnp.flip(t, axis=1) for t in (a_c, u_c, a_l, u_l))
        h_c = linear_scan(a_c, u_c, h0)
        h_l = linear_scan(a_l, u_l, h_c[:, -1])
        if d == 1:
            h_c, h_l = jnp.flip(h_c, axis=1), jnp.flip(h_l, axis=1)
        y_lat = y_lat + h_l
        if with_ctx_out:
            y_ctx = y_ctx + h_c
    return y_lat.astype(x_lat.dtype), (y_ctx.astype(x_ctx.dtype) if with_ctx_out else None)


def windowed_attention(q, k, v, qc, kc, vc, sink, with_ctx_out):
    B, S = q.shape[:2]
    L = kc.shape[1]
    nb = S // BLOCK_Q
    scale = HEAD_DIM ** -0.5
    qb = q.reshape(B, nb, BLOCK_Q, N_KV_HEADS, Q_PER_KV, HEAD_DIM)

    def band(t):
        tp = jnp.pad(t, ((0, 0), (BLOCK_Q, BLOCK_Q), (0, 0), (0, 0)))
        tp = tp.reshape(B, nb + 2, BLOCK_Q, N_KV_HEADS, HEAD_DIM)
        return jnp.concatenate([tp[:, :-2], tp[:, 1:-1], tp[:, 2:]], axis=2)

    kb, vb = band(k), band(v)
    qpos = jnp.arange(nb)[:, None] * BLOCK_Q + jnp.arange(BLOCK_Q)[None, :]
    kpos = (jnp.arange(nb)[:, None] - 1) * BLOCK_Q + jnp.arange(3 * BLOCK_Q)[None, :]
    mask = ((jnp.abs(qpos[:, :, None] - kpos[:, None, :]) <= WINDOW)
            & (kpos[:, None, :] >= 0) & (kpos[:, None, :] < S))
    s_loc = jnp.einsum('bnqhgd,bnkhd->bnhgqk', qb, kb).astype(jnp.float32) * scale
    s_loc = jnp.where(mask[None, :, None, None], s_loc, NEG_INF)
    s_ctx = jnp.einsum('bnqhgd,blhd->bnhgql', qb, kc).astype(jnp.float32) * scale
    sink_hg = sink.astype(jnp.float32).reshape(N_KV_HEADS, Q_PER_KV)
    s_sink = jnp.broadcast_to(sink_hg[None, None, :, :, None, None], s_loc.shape[:-1] + (1,))
    p = jax.nn.softmax(jnp.concatenate([s_loc, s_ctx, s_sink], axis=-1), axis=-1)
    p_loc = p[..., :3 * BLOCK_Q].astype(v.dtype)
    p_ctx = p[..., 3 * BLOCK_Q:3 * BLOCK_Q + L].astype(v.dtype)
    o = jnp.einsum('bnhgqk,bnkhd->bnqhgd', p_loc, vb) + jnp.einsum('bnhgql,blhd->bnqhgd', p_ctx, vc)
    o_lat = o.reshape(B, S, D_ATTN)
    o_ctx = None
    if with_ctx_out:
        qcg = qc.reshape(B, L, N_KV_HEADS, Q_PER_KV, HEAD_DIM)
        sc = jnp.einsum('blhgd,bmhd->bhglm', qcg, kc).astype(jnp.float32) * scale
        sc_sink = jnp.broadcast_to(sink_hg[None, :, :, None, None], sc.shape[:-1] + (1,))
        pc = jax.nn.softmax(jnp.concatenate([sc, sc_sink], axis=-1), axis=-1)[..., :L].astype(vc.dtype)
        o_ctx = jnp.einsum('bhglm,bmhd->blhgd', pc, vc).reshape(B, L, D_ATTN)
    return o_lat, o_ctx


def token_mixer(h, hc, row, col, w_in, rnn_conv_w, rnn_conv_b, lru_w_a, lru_b_a, lru_w_i, lru_b_i,
                lru_lam, attn_sink, gn_rnn, gn_attn, w_out, with_ctx_out):
    B, S = h.shape[:2]
    L = hc.shape[1]
    xr, xg, q, k, v = jnp.split(h @ w_in, IN_SPLITS, axis=-1)
    xrc, xgc, qc, kc, vc = jnp.split(hc @ w_in, IN_SPLITS, axis=-1)
    xr = dwconv(xr, rnn_conv_w, rnn_conv_b, RNN_CONV_LEFT)
    xrc = dwconv(xrc, rnn_conv_w, rnn_conv_b, RNN_CONV_LEFT)
    y_l, y_c = rglru_bidir(xr, xrc, lru_w_a, lru_b_a, lru_w_i, lru_b_i, lru_lam, with_ctx_out)
    rnn_l = jax.nn.gelu(xg) * y_l
    q = rope_2d(q.reshape(B, S, N_Q_HEADS, HEAD_DIM), row, col)
    k = rope_2d(k.reshape(B, S, N_KV_HEADS, HEAD_DIM), row, col)
    v = v.reshape(B, S, N_KV_HEADS, HEAD_DIM)
    qc = qc.reshape(B, L, N_Q_HEADS, HEAD_DIM)
    kc = kc.reshape(B, L, N_KV_HEADS, HEAD_DIM)
    vc = vc.reshape(B, L, N_KV_HEADS, HEAD_DIM)
    a_l, a_c = windowed_attention(q, k, v, qc, kc, vc, attn_sink, with_ctx_out)
    out_l = jnp.concatenate([rms_norm(rnn_l, gn_rnn), rms_norm(a_l, gn_attn)], axis=-1) @ w_out
    out_c = None
    if with_ctx_out:
        rnn_c = jax.nn.gelu(xgc) * y_c
        out_c = jnp.concatenate([rms_norm(rnn_c, gn_rnn), rms_norm(a_c, gn_attn)], axis=-1) @ w_out
    return out_l, out_c


def conv_ffn(h, w_up, conv_w, conv_b, w_down):
    u = dwconv(h @ w_up, conv_w, conv_b, FFN_CONV_LEFT)
    gate, val = jnp.split(u, 2, axis=-1)
    return (jax.nn.silu(gate) * val) @ w_down


def setup_inputs(seed: int = 0) -> dict:
    key = jax.random.key(seed)
    ks = jax.random.split(key, 25)
    nrm = jax.random.normal
    f32 = jnp.float32
    a0 = jax.random.uniform(ks[14], (DEPTH, 2, D_RNN), f32, 0.9, 0.999)
    return {
        "x": nrm(ks[0], (BATCH, SEQ, D_MODEL), f32),
        "c": nrm(ks[1], (BATCH, D_MODEL), f32),
        "ctx": nrm(ks[2], (BATCH, CTX_LEN, D_MODEL), f32),
        "c_ctx": nrm(ks[3], (D_MODEL,), f32),
        "w_mod": nrm(ks[4], (DEPTH, D_MODEL, 6 * D_MODEL), f32) * (0.5 * D_MODEL ** -0.5),
        "b_mod": nrm(ks[5], (DEPTH, 6 * D_MODEL), f32) * 0.02,
        "norm1_g": 1.0 + 0.02 * nrm(ks[6], (DEPTH, D_MODEL), f32),
        "w_in": nrm(ks[7], (DEPTH, D_MODEL, D_IN), f32) * D_MODEL ** -0.5,
        "rnn_conv_w": nrm(ks[8], (DEPTH, RNN_CONV_W, D_RNN), f32) * RNN_CONV_W ** -0.5,
        "rnn_conv_b": nrm(ks[9], (DEPTH, D_RNN), f32) * 0.02,
        "lru_w_a": nrm(ks[10], (DEPTH, 2, RNN_BLOCKS, RNN_BLOCK_W, RNN_BLOCK_W), f32) * RNN_BLOCK_W ** -0.5,
        "lru_b_a": nrm(ks[11], (DEPTH, 2, D_RNN), f32) * 0.02,
        "lru_w_i": nrm(ks[12], (DEPTH, 2, RNN_BLOCKS, RNN_BLOCK_W, RNN_BLOCK_W), f32) * RNN_BLOCK_W ** -0.5,
        "lru_b_i": nrm(ks[13], (DEPTH, 2, D_RNN), f32) * 0.02,
        "lru_lam": jnp.log(a0) - jnp.log1p(-a0),
        "attn_sink": nrm(ks[15], (DEPTH, N_Q_HEADS), f32) * 0.5,
        "gn_rnn": 1.0 + 0.02 * nrm(ks[16], (DEPTH, D_RNN), f32),
        "gn_attn": 1.0 + 0.02 * nrm(ks[17], (DEPTH, D_ATTN), f32),
        "w_out": nrm(ks[18], (DEPTH, D_MIX, D_MODEL), f32) * D_MIX ** -0.5,
        "norm2_g": 1.0 + 0.02 * nrm(ks[19], (DEPTH, D_MODEL), f32),
        "w_up": nrm(ks[20], (DEPTH, D_MODEL, 2 * D_FF), f32) * D_MODEL ** -0.5,
        "ffn_conv_w": nrm(ks[21], (DEPTH, FFN_CONV_W, 2 * D_FF), f32) * FFN_CONV_W ** -0.5,
        "ffn_conv_b": nrm(ks[22], (DEPTH, 2 * D_FF), f32) * 0.02,
        "w_down": nrm(ks[23], (DEPTH, D_FF, D_MODEL), f32) * D_FF ** -0.5,
        "final_g": 1.0 + 0.02 * nrm(ks[24], (D_MODEL,), f32),
    }


def reference(x, c, ctx, c_ctx, w_mod, b_mod, norm1_g, w_in, rnn_conv_w, rnn_conv_b, lru_w_a, lru_b_a,
              lru_w_i, lru_b_i, lru_lam, attn_sink, gn_rnn, gn_attn, w_out, norm2_g, w_up, ffn_conv_w,
              ffn_conv_b, w_down, final_g):
    S = x.shape[1]
    rows = S // GRID_W
    row = jnp.repeat(jnp.arange(rows, dtype=jnp.int32), GRID_W)
    col = jnp.tile(jnp.arange(GRID_W, dtype=jnp.int32), rows)
    for l in range(DEPTH):
        update_ctx = l < DEPTH - 1
        sh1, sc1, g1, sh2, sc2, g2 = adaln(c, w_mod[l], b_mod[l])
        csh1, csc1, cg1, csh2, csc2, cg2 = adaln(c_ctx, w_mod[l], b_mod[l])
        h = modulate(rms_norm(x, norm1_g[l]), sh1, sc1)
        hc = modulate(rms_norm(ctx, norm1_g[l]), csh1, csc1)
        out_l, out_c = token_mixer(h, hc, row, col, w_in[l], rnn_conv_w[l], rnn_conv_b[l], lru_w_a[l],
                                   lru_b_a[l], lru_w_i[l], lru_b_i[l], lru_lam[l], attn_sink[l],
                                   gn_rnn[l], gn_attn[l], w_out[l], update_ctx)
        x = x + g1 * out_l
        x = x + g2 * conv_ffn(modulate(rms_norm(x, norm2_g[l]), sh2, sc2), w_up[l], ffn_conv_w[l],
                              ffn_conv_b[l], w_down[l])
        if update_ctx:
            ctx = ctx + cg1 * out_c
            ctx = ctx + cg2 * conv_ffn(modulate(rms_norm(ctx, norm2_g[l]), csh2, csc2), w_up[l],
                                       ffn_conv_w[l], ffn_conv_b[l], w_down[l])
    return rms_norm(x, final_g)
```

```cpp
#include <hip/hip_runtime.h>
#include <hip/hip_cooperative_groups.h>
#include <cstdio>
namespace cg = cooperative_groups;

#define LAS __attribute__((address_space(3)))
typedef unsigned short bf16_t;
typedef short bf16x8 __attribute__((ext_vector_type(8)));
typedef float f32x4 __attribute__((ext_vector_type(4)));
typedef unsigned u32x4 __attribute__((ext_vector_type(4)));
typedef unsigned u32x2 __attribute__((ext_vector_type(2)));

constexpr int D = 1024, NB = 2, S = 16384, LC = 256;
constexpr int NLAT = NB * S;
constexpr int NCTX = NB * LC;
constexpr int MROWS = NLAT + NCTX;
constexpr int DIN = 1792, DFF = 2816, DUP = 5632, DRNN = 512;
constexpr int NCHUNK = MROWS / 64;
constexpr float EPS = 1e-6f;

constexpr size_t AL(size_t x) { return (x + 255) & ~(size_t)255; }
constexpr size_t WS_WIN  = 0;
constexpr size_t WS_WOUT = WS_WIN  + AL((size_t)DIN * D * 2);
constexpr size_t WS_WUP  = WS_WOUT + AL((size_t)D * D * 2);
constexpr size_t WS_WDN  = WS_WUP  + AL((size_t)DUP * D * 2);
constexpr size_t WS_LRU  = WS_WDN  + AL((size_t)D * DFF * 2);
constexpr size_t WS_MOD  = WS_LRU  + AL((size_t)4 * 8 * 64 * 64 * 2);
constexpr size_t WS_ROPE = WS_MOD  + AL((size_t)3 * 6144 * 4);
constexpr size_t WS_SUM  = WS_ROPE + AL((size_t)2 * 256 * 16 * 4);
constexpr size_t WS_CAR  = WS_SUM  + AL((size_t)2 * NCHUNK * 2 * 512 * 4);
constexpr size_t WS_HB   = WS_CAR  + AL((size_t)2 * NCHUNK * 512 * 4);
constexpr size_t WS_R1   = WS_HB   + AL((size_t)MROWS * D * 2);
constexpr size_t WS_PROJ = WS_R1;
constexpr size_t WS_ATT  = WS_PROJ + AL((size_t)MROWS * DIN * 2);
constexpr size_t WS_YL   = WS_ATT  + AL((size_t)NLAT * 512 * 2);
constexpr size_t WS_CAF  = WS_YL   + AL((size_t)NLAT * 512 * 2);
constexpr size_t WS_CAB  = WS_CAF  + AL((size_t)NLAT * 512 * 2);
constexpr size_t WS_R1END = WS_CAB + AL((size_t)NLAT * 512 * 2);
constexpr size_t WS_ACT  = WS_R1;
constexpr size_t WS_U    = WS_ACT + AL((size_t)NLAT * DFF * 2);
constexpr size_t WS_TMP  = WS_R1END;
constexpr size_t WS_END  = WS_U + AL((size_t)S * DUP * 2);
static_assert(WS_TMP + (size_t)NLAT * 512 * 4 <= WS_END, "tmp");
static_assert(WS_U >= WS_ACT + (size_t)NLAT * DFF * 2, "u");

constexpr int LDS_BYTES = 131072 + 8192;

struct Params {
    const float *x, *c, *ctx, *c_ctx, *w_mod, *b_mod, *norm1_g, *w_in, *rnn_conv_w, *rnn_conv_b, *lru_w_a, *lru_b_a,
        *lru_w_i, *lru_b_i, *lru_lam, *attn_sink, *gn_rnn, *gn_attn, *w_out, *norm2_g, *w_up, *ffn_conv_w, *ffn_conv_b,
        *w_down, *final_g;
    float* out;
    unsigned char* ws;
};

__device__ __forceinline__ bf16_t f2bf(float f) { unsigned u = __float_as_uint(f); u += 0x7FFFu + ((u >> 16) & 1u); return (bf16_t)(u >> 16); }
__device__ __forceinline__ float bf2f(bf16_t b) { return __uint_as_float(((unsigned)b) << 16); }
__device__ __forceinline__ unsigned pk2(float lo, float hi) { return (unsigned)f2bf(lo) | ((unsigned)f2bf(hi) << 16); }
__device__ __forceinline__ float bflo(unsigned w) { return __uint_as_float(w << 16); }
__device__ __forceinline__ float bfhi(unsigned w) { return __uint_as_float(w & 0xFFFF0000u); }
__device__ __forceinline__ float wave_sum(float v) {
#pragma unroll
    for (int o = 32; o >= 1; o >>= 1) v += __shfl_xor(v, o);
    return v;
}
__device__ __forceinline__ float wave_max(float v) {
#pragma unroll
    for (int o = 32; o >= 1; o >>= 1) v = fmaxf(v, __shfl_xor(v, o));
    return v;
}
__device__ __forceinline__ float sigmoidf_(float x) { return 1.0f / (1.0f + __expf(-x)); }
__device__ __forceinline__ float silu_(float x) { return x / (1.0f + __expf(-x)); }
__device__ __forceinline__ float gelu_tanh_(float x) {
    const float u = 0.7978845608028654f * (x + 0.044715f * x * x * x);
    const float e = __expf(2.0f * u);
    const float th = 1.0f - 2.0f / (e + 1.0f);
    return 0.5f * x * (1.0f + th);
}

namespace pg8 {
constexpr int BM = 256, BK = 64, HALF = 128, HTB = HALF * BK * 2, NXCD = 8, WGM = 8;
__host__ __device__ __forceinline__ int lds_byte(int r, int c) { const int st = (r >> 4) * 2 + (c >> 5), rr = r & 15, cc = c & 31, ob = rr * 64 + cc * 2; return st * 1024 + (ob ^ (((ob >> 9) & 1) << 5)); }
__host__ __device__ __forceinline__ void stage_rc(int b, int& R, int& C) { const int st = b / 1024, sb = b % 1024, swz = sb ^ (((sb >> 9) & 1) << 5); R = (st >> 1) * 16 + swz / 64; C = (st & 1) * 32 + (swz % 64) / 2; }
struct Unit { int pm, pn; };
struct Gemm { const bf16_t* A; const bf16_t* Bt; int nM, nN, K, a_tile_rows; };
struct StaticOrder {
    int nM, nN, nwg, G, c;
    __device__ void init(int nM_, int nN_, int G_, int c_) { nM = nM_; nN = nN_; nwg = nM * nN; G = G_; c = c_; }
    __device__ bool next(int i, Unit& u) const {
        const long L = (long)i * G + c; if (L >= nwg) return false;
        int wgid = (int)L; { const int q = nwg / NXCD, r = nwg % NXCD, xcd = wgid % NXCD, off = wgid / NXCD; wgid = (xcd < r ? xcd * (q + 1) : r * (q + 1) + (xcd - r) * q) + off; }
        const int nig = WGM * nN, gid = wgid / nig, fm = gid * WGM, gsz = (nM - fm) < WGM ? (nM - fm) : WGM;
        u.pm = fm + ((wgid % nig) % gsz); u.pn = (wgid % nig) / gsz; return true;
    }
};
template <class Epi>
__device__ __forceinline__ void gemm_phase(LAS unsigned char* lds, const Gemm g, const StaticOrder& S, const Epi& E) {
    const int tid = threadIdx.x, wid = __builtin_amdgcn_readfirstlane(tid >> 6), lane = tid & 63, wr = wid >> 2, wc = wid & 3, fr = lane & 15, fq = lane >> 4;
    const int K = g.K, nt = K / BK;
    unsigned voffA[2], voffB[2];
#pragma unroll
    for (int i = 0; i < 2; ++i) { int R, C; stage_rc(tid * 16 + i * 8192, R, C); voffA[i] = (unsigned)(R * K + C) * 2u; voffB[i] = voffA[i]; }
    const size_t kstep = (size_t)(BK * 2);
    const size_t hstep = (size_t)HALF * K * 2;
    const size_t tstepA = (size_t)g.a_tile_rows * K * 2;
    const size_t tstepB = 2 * hstep;
    const unsigned ldsw = (unsigned)wid * 1024u;
    const int aoff = lds_byte(wr * 64 + fr, fq * 8), boff = lds_byte(wc * 32 + fr, fq * 8);
#define PG8_SA(b, h) (((b) * 2 + (h)) * HTB)
#define PG8_SB(b, h) ((4 + (b) * 2 + (h)) * HTB)
#define PG8_STAGE(bufoff, gbase, voff) do { _Pragma("unroll") for (int _i = 0; _i < 2; ++_i) \
        __builtin_amdgcn_global_load_lds((const unsigned*)((const char*)(gbase) + (voff)[_i]), (LAS unsigned*)(lds + (bufoff) + ldsw + _i * 8192), 16, 0, 0); } while (0)
#define PG8_LDA(dst, b, h) do { _Pragma("unroll") for (int m = 0; m < 4; ++m) _Pragma("unroll") for (int k = 0; k < 2; ++k) dst[m][k] = *(const LAS bf16x8*)(lds + PG8_SA(b, h) + aoff + m * 2048 + k * 1024); } while (0)
#define PG8_LDB(dst, b, h) do { _Pragma("unroll") for (int n = 0; n < 2; ++n) _Pragma("unroll") for (int k = 0; k < 2; ++k) dst[n][k] = *(const LAS bf16x8*)(lds + PG8_SB(b, h) + boff + n * 2048 + k * 1024); } while (0)
#define PG8_MMA(ai, bj, At, Bt) do { __builtin_amdgcn_s_setprio(1); _Pragma("unroll") for (int m = 0; m < 4; ++m) _Pragma("unroll") for (int n = 0; n < 2; ++n) _Pragma("unroll") for (int k = 0; k < 2; ++k) \
        acc[ai][bj][m][n] = __builtin_amdgcn_mfma_f32_16x16x32_bf16(Bt[n][k], At[m][k], acc[ai][bj][m][n], 0, 0, 0); __builtin_amdgcn_s_setprio(0); } while (0)
#define PG8_WAIT_V(n) asm volatile("s_waitcnt vmcnt(" #n ")" ::: "memory")
#define PG8_WAIT_L(n) asm volatile("s_waitcnt lgkmcnt(" #n ")" ::: "memory")
#define PG8_BAR __builtin_amdgcn_s_barrier()
#define PG8_SCHED __builtin_amdgcn_sched_barrier(0)
    Unit cur, nxt; int ui = 0;
    if (!S.next(0, cur)) return;
    f32x4 acc[2][2][4][2];
#pragma unroll
    for (int a = 0; a < 2; ++a)
#pragma unroll
        for (int b = 0; b < 2; ++b)
#pragma unroll
            for (int m = 0; m < 4; ++m)
#pragma unroll
                for (int n = 0; n < 2; ++n) acc[a][b][m][n] = (f32x4){0.f, 0.f, 0.f, 0.f};
    bf16x8 At[4][2], B0[2][2], B1[2][2];
    const char* cA = (const char*)g.A + (size_t)cur.pm * tstepA; const char* cB = (const char*)g.Bt + (size_t)cur.pn * tstepB;
    PG8_STAGE(PG8_SB(0, 0), cB, voffB); PG8_STAGE(PG8_SA(0, 0), cA, voffA); PG8_STAGE(PG8_SB(0, 1), cB + hstep, voffB); PG8_STAGE(PG8_SA(0, 1), cA + hstep, voffA);
    if (wr == 1) PG8_BAR;
    PG8_WAIT_V(4); PG8_BAR;
    PG8_STAGE(PG8_SB(1, 0), cB + kstep, voffB); PG8_STAGE(PG8_SA(1, 0), cA + kstep, voffA); PG8_STAGE(PG8_SB(1, 1), cB + hstep + kstep, voffB);
    PG8_WAIT_V(6); PG8_BAR;
    for (;;) {
        const bool has_next = S.next(ui + 1, nxt);
        const char* nA = has_next ? (const char*)g.A + (size_t)nxt.pm * tstepA : cA; const char* nB = has_next ? (const char*)g.Bt + (size_t)nxt.pn * tstepB : cB;
        for (int t = 0; t < nt; t += 2) {
            const bool last = (t == nt - 2);
            const char* a1 = cA + (size_t)(t + 1) * kstep;
            const char* a2 = last ? nA : cA + (size_t)(t + 2) * kstep; const char* b2 = last ? nB : cB + (size_t)(t + 2) * kstep;
            const char* a3 = a2 + kstep; const char* b3 = b2 + kstep;
            PG8_LDB(B0, 0, 0); PG8_SCHED; PG8_LDA(At, 0, 0); PG8_STAGE(PG8_SA(1, 1), a1 + hstep, voffA);
            PG8_WAIT_L(8); PG8_BAR; PG8_WAIT_L(0); PG8_MMA(0, 0, At, B0); PG8_BAR; PG8_SCHED;
            PG8_LDB(B1, 0, 1); PG8_STAGE(PG8_SB(0, 0), b2, voffB);
            PG8_BAR; PG8_WAIT_L(0); PG8_MMA(0, 1, At, B1); PG8_BAR;
            PG8_LDA(At, 0, 1); PG8_STAGE(PG8_SA(0, 0), a2, voffA);
            PG8_BAR; PG8_WAIT_L(0); PG8_MMA(1, 0, At, B0); PG8_BAR; PG8_SCHED;
            PG8_STAGE(PG8_SB(0, 1), b2 + hstep, voffB);
            PG8_WAIT_V(6); PG8_BAR; PG8_MMA(1, 1, At, B1); PG8_BAR;
            PG8_LDB(B0, 1, 0); PG8_SCHED; PG8_LDA(At, 1, 0); PG8_STAGE(PG8_SA(0, 1), a2 + hstep, voffA);
            PG8_WAIT_L(8); PG8_BAR; PG8_WAIT_L(0); PG8_MMA(0, 0, At, B0); PG8_BAR; PG8_SCHED;
            PG8_LDB(B1, 1, 1); PG8_STAGE(PG8_SB(1, 0), b3, voffB);
            PG8_BAR; PG8_WAIT_L(0); PG8_MMA(0, 1, At, B1); PG8_BAR;
            PG8_LDA(At, 1, 1); PG8_STAGE(PG8_SA(1, 0), a3, voffA);
            PG8_BAR; PG8_WAIT_L(0); PG8_MMA(1, 0, At, B0); PG8_BAR; PG8_SCHED;
            PG8_STAGE(PG8_SB(1, 1), b3 + hstep, voffB);
            PG8_WAIT_V(6); PG8_BAR; PG8_MMA(1, 1, At, B1); PG8_BAR;
        }
        E(acc, cur, wr, wc, fr, fq);
        if (!has_next) break;
#pragma unroll
        for (int a = 0; a < 2; ++a)
#pragma unroll
            for (int b = 0; b < 2; ++b)
#pragma unroll
                for (int m = 0; m < 4; ++m)
#pragma unroll
                    for (int n = 0; n < 2; ++n) acc[a][b][m][n] = (f32x4){0.f, 0.f, 0.f, 0.f};
        cur = nxt; cA = nA; cB = nB; ++ui;
    }
    PG8_WAIT_V(0);
    if (wr == 0) PG8_BAR;
    PG8_BAR;
#undef PG8_SA
#undef PG8_SB
#undef PG8_STAGE
#undef PG8_LDA
#undef PG8_LDB
#undef PG8_MMA
#undef PG8_WAIT_V
#undef PG8_WAIT_L
#undef PG8_BAR
#undef PG8_SCHED
}
}
using pg8::Unit;

struct EpiProj {
    bf16_t* O; const float* cosT; const float* sinT;
    __device__ __forceinline__ void operator()(const f32x4 (&acc)[2][2][4][2], const Unit& u, int wr, int wc, int fr, int fq) const {
        const bool latent = u.pm < 128;
#pragma unroll
        for (int ai = 0; ai < 2; ++ai)
#pragma unroll
            for (int m = 0; m < 4; ++m) {
                const int row = u.pm * 256 + ai * 128 + wr * 64 + m * 16 + fr;
                const int t = row & (S - 1);
                const int pos = (wc & 1) ? (t & 63) : (t >> 6);
#pragma unroll
                for (int bj = 0; bj < 2; ++bj) {
                    const int col = u.pn * 256 + bj * 128 + wc * 32 + 4 * fq;
                    f32x4 v0 = acc[ai][bj][m][0], v1 = acc[ai][bj][m][1];
                    const bool rope = latent && (u.pn == 4 || u.pn == 5 || (u.pn == 6 && bj == 0));
                    if (rope) {
                        const f32x4 cs = *(const f32x4*)(cosT + pos * 16 + 4 * fq), sn = *(const f32x4*)(sinT + pos * 16 + 4 * fq);
                        const f32x4 n0 = v0 * cs - v1 * sn, n1 = v1 * cs + v0 * sn; v0 = n0; v1 = n1;
                    }
                    bf16_t* p = O + (size_t)row * DIN + col;
                    u32x2 w0, w1; w0.x = pk2(v0[0], v0[1]); w0.y = pk2(v0[2], v0[3]); w1.x = pk2(v1[0], v1[1]); w1.y = pk2(v1[2], v1[3]);
                    *(u32x2*)p = w0; *(u32x2*)(p + 16) = w1;
                }
            }
    }
};
struct EpiRes {
    const float* src; float* dst; const float* gate0; const float* gate1;
    __device__ __forceinline__ void operator()(const f32x4 (&acc)[2][2][4][2], const Unit& u, int wr, int wc, int fr, int fq) const {
        const float* gate = (u.pm >= 64) ? gate1 : gate0;
        f32x4 gv[2][2];
#pragma unroll
        for (int bj = 0; bj < 2; ++bj)
#pragma unroll
            for (int n = 0; n < 2; ++n) gv[bj][n] = *(const f32x4*)(gate + u.pn * 256 + bj * 128 + wc * 32 + n * 16 + 4 * fq);
#pragma unroll
        for (int ai = 0; ai < 2; ++ai)
#pragma unroll
            for (int m = 0; m < 4; ++m) {
                const size_t row = (size_t)u.pm * 256 + ai * 128 + wr * 64 + m * 16 + fr;
#pragma unroll
                for (int bj = 0; bj < 2; ++bj)
#pragma unroll
                    for (int n = 0; n < 2; ++n) {
                        const size_t o = row * D + u.pn * 256 + bj * 128 + wc * 32 + n * 16 + 4 * fq;
                        const f32x4 s = *(const f32x4*)(src + o);
                        *(f32x4*)(dst + o) = s + gv[bj][n] * acc[ai][bj][m][n];
                    }
            }
    }
};
struct EpiU {
    bf16_t* O;
    __device__ __forceinline__ void operator()(const f32x4 (&acc)[2][2][4][2], const Unit& u, int wr, int wc, int fr, int fq) const {
#pragma unroll
        for (int ai = 0; ai < 2; ++ai)
#pragma unroll
            for (int m = 0; m < 4; ++m) {
                const size_t row = (size_t)u.pm * 256 + ai * 128 + wr * 64 + m * 16 + fr;
#pragma unroll
                for (int bj = 0; bj < 2; ++bj)
#pragma unroll
                    for (int n = 0; n < 2; ++n) {
                        const f32x4 v = acc[ai][bj][m][n];
                        u32x2 w; w.x = pk2(v[0], v[1]); w.y = pk2(v[2], v[3]);
                        *(u32x2*)(O + row * DUP + u.pn * 256 + bj * 128 + wc * 32 + n * 16 + 4 * fq) = w;
                    }
            }
    }
};

__device__ __forceinline__ void transpose_item(const float* W, int N, int k0, int n0, bf16_t* dst, int Kd, float* scr, int lane) {
#pragma unroll 8
    for (int i = 0; i < 32; ++i) { const int kk = 2 * i + (lane >> 5); scr[kk * 33 + (lane & 31)] = W[(size_t)(k0 + kk) * N + n0 + (lane & 31)]; }
    __builtin_amdgcn_wave_barrier();
    const int c = lane & 7;
#pragma unroll
    for (int j = 0; j < 4; ++j) {
        const int n = (lane >> 3) + 8 * j; const float* s = scr + (8 * c) * 33 + n;
        u32x4 o; o.x = pk2(s[0], s[33]); o.y = pk2(s[2 * 33], s[3 * 33]); o.z = pk2(s[4 * 33], s[5 * 33]); o.w = pk2(s[6 * 33], s[7 * 33]);
        *(u32x4*)(dst + (size_t)n * Kd + k0 + 8 * c) = o;
    }
    __builtin_amdgcn_wave_barrier();
}

__device__ __forceinline__ void phase0(const Params& p, unsigned char* shm) {
    const int tid = threadIdx.x, lane = tid & 63, wave = tid >> 6;
    unsigned char* ws = p.ws;
    if (blockIdx.x < 192) {
        float* sv = (float*)shm;
        float* red = sv + 3 * 1024;
        for (int i = tid; i < 3 * 1024; i += 512) {
            const int j = i >> 10, k = i & 1023;
            const float v = (j < 2) ? p.c[j * 1024 + k] : p.c_ctx[k];
            sv[i] = silu_(v);
        }
        __syncthreads();
        const int n0 = blockIdx.x * 32, col = tid & 31, ks = tid >> 5;
        float a0 = 0.f, a1 = 0.f, a2 = 0.f;
        const float* wp = p.w_mod + (size_t)(ks * 64) * 6144 + n0 + col;
#pragma unroll 8
        for (int k = 0; k < 64; ++k) {
            const float w = wp[(size_t)k * 6144];
            a0 += sv[ks * 64 + k] * w; a1 += sv[1024 + ks * 64 + k] * w; a2 += sv[2048 + ks * 64 + k] * w;
        }
        red[(ks * 3 + 0) * 32 + col] = a0; red[(ks * 3 + 1) * 32 + col] = a1; red[(ks * 3 + 2) * 32 + col] = a2;
        __syncthreads();
        if (tid < 96) {
            const int j = tid >> 5, cc = tid & 31; float s = p.b_mod[n0 + cc];
            for (int k = 0; k < 16; ++k) s += red[(k * 3 + j) * 32 + cc];
            ((float*)(ws + WS_MOD))[j * 6144 + n0 + cc] = s;
        }
        __syncthreads();
    }
    if (blockIdx.x >= 192 && blockIdx.x < 200) {
        const int idx = (blockIdx.x - 192) * 512 + tid;
        const int pos = idx >> 4, i = idx & 15;
        const float inv = powf(10000.0f, -(float)i / 16.0f);
        const float ang = (float)pos * inv;
        ((float*)(ws + WS_ROPE))[idx] = cosf(ang);
        ((float*)(ws + WS_ROPE))[4096 + idx] = sinf(ang);
    }
    float* scr = (float*)(shm + 32768) + wave * (64 * 33);
    const int gw = blockIdx.x * 8 + wave, NGW = gridDim.x * 8;
    constexpr int I_IN = (D / 64) * (DIN / 32), I_OUT = (D / 64) * (D / 32), I_UP = (D / 64) * (DUP / 32), I_DN = (DFF / 64) * (D / 32), I_LRU = 2 * 2 * 8 * 2;
    constexpr int NIT = I_IN + I_OUT + I_UP + I_DN + I_LRU;
    for (int it = gw; it < NIT; it += NGW) {
        int r = it;
        if (r < I_IN) { const int nb = DIN / 32, kb = r / nb, n0 = (r % nb) * 32; transpose_item(p.w_in, DIN, kb * 64, n0, (bf16_t*)(ws + WS_WIN) + (size_t)n0 * D, D, scr, lane); continue; } r -= I_IN;
        if (r < I_OUT) { const int nb = D / 32, kb = r / nb, n0 = (r % nb) * 32; transpose_item(p.w_out, D, kb * 64, n0, (bf16_t*)(ws + WS_WOUT) + (size_t)n0 * D, D, scr, lane); continue; } r -= I_OUT;
        if (r < I_UP) { const int nb = DUP / 32, kb = r / nb, n0 = (r % nb) * 32;
            const int isv = n0 >= DFF, nn = isv ? n0 - DFF : n0, drow = (nn / 128) * 256 + isv * 128 + (nn % 128);
            transpose_item(p.w_up, DUP, kb * 64, n0, (bf16_t*)(ws + WS_WUP) + (size_t)drow * D, D, scr, lane); continue; } r -= I_UP;
        if (r < I_DN) { const int nb = D / 32, kb = r / nb, n0 = (r % nb) * 32; transpose_item(p.w_down, D, kb * 64, n0, (bf16_t*)(ws + WS_WDN) + (size_t)n0 * DFF, DFF, scr, lane); continue; } r -= I_DN;
        {
            const int nh = r & 1, blk = (r >> 1) & 7, type = (r >> 4) & 1, dir = r >> 5;
            const float* src = (type ? p.lru_w_i : p.lru_w_a) + (size_t)(dir * 8 + blk) * 4096;
            bf16_t* dst = (bf16_t*)(ws + WS_LRU) + (size_t)((dir * 2 + type) * 8 + blk) * 4096 + (size_t)(nh * 32) * 64;
            transpose_item(src, 64, 0, nh * 32, dst, 64, scr, lane);
        }
    }
}

__device__ __forceinline__ void norm_mod_row(const float* src, const float* g, const float* sh, const float* sc, bf16_t* dst, int lane) {
    f32x4 v[4]; float ss = 0.f;
#pragma unroll
    for (int j = 0; j < 4; ++j) { v[j] = *(const f32x4*)(src + 4 * lane + 256 * j); ss += v[j][0] * v[j][0] + v[j][1] * v[j][1] + v[j][2] * v[j][2] + v[j][3] * v[j][3]; }
    const float rstd = rsqrtf(wave_sum(ss) * (1.0f / D) + EPS);
#pragma unroll
    for (int j = 0; j < 4; ++j) {
        const int c = 4 * lane + 256 * j;
        const f32x4 gg = *(const f32x4*)(g + c), s1 = *(const f32x4*)(sc + c), s0 = *(const f32x4*)(sh + c);
        const f32x4 o = (v[j] * rstd * gg) * (s1 + 1.0f) + s0;
        u32x2 w; w.x = pk2(o[0], o[1]); w.y = pk2(o[2], o[3]);
        *(u32x2*)(dst + c) = w;
    }
}
__device__ __forceinline__ void phase1(const Params& p) {
    const int lane = threadIdx.x & 63, gw = blockIdx.x * 8 + (threadIdx.x >> 6), NGW = gridDim.x * 8;
    const float* mod = (const float*)(p.ws + WS_MOD);
    bf16_t* hb = (bf16_t*)(p.ws + WS_HB);
    for (int r = gw; r < MROWS; r += NGW) {
        const int mi = r < NLAT ? (r >> 14) : 2;
        const float* src = r < NLAT ? p.x + (size_t)r * D : p.ctx + (size_t)(r - NLAT) * D;
        norm_mod_row(src, p.norm1_g, mod + mi * 6144, mod + mi * 6144 + 1024, hb + (size_t)r * D, lane);
    }
}

__device__ __forceinline__ void attn_naive(const Params& p, unsigned char* shm) {
    const int lane = threadIdx.x & 63, wave = threadIdx.x >> 6, gw = blockIdx.x * 8 + wave, NGW = gridDim.x * 8;
    float* qs = (float*)shm + wave * 640;
    float* ps = qs + 64;
    const bf16_t* proj = (const bf16_t*)(p.ws + WS_PROJ);
    bf16_t* att = (bf16_t*)(p.ws + WS_ATT);
    for (int item = gw; item < NLAT * 8; item += NGW) {
        const int r = item >> 3, hq = item & 7, hk = hq >> 2, b = r >> 14, t = r & (S - 1);
        qs[lane] = bf2f(proj[(size_t)r * DIN + 1024 + hq * 64 + lane]);
        __builtin_amdgcn_wave_barrier();
        float sc[9];
#pragma unroll
        for (int i = 0; i < 9; ++i) {
            int kp; bool valid; const bf16_t* krow;
            if (i < 5) { kp = t - 128 + lane + 64 * i; valid = kp >= 0 && kp < S && kp <= t + 128; krow = proj + (size_t)(b * S + (valid ? kp : 0)) * DIN + 1536 + hk * 64; }
            else { kp = lane + 64 * (i - 5); valid = true; krow = proj + (size_t)(NLAT + b * LC + kp) * DIN + 1536 + hk * 64; }
            float s = 0.f;
#pragma unroll
            for (int d8 = 0; d8 < 8; ++d8) {
                const u32x4 kv = *(const u32x4*)(krow + 8 * d8);
                const f32x4 q0 = *(const f32x4*)(qs + 8 * d8), q1 = *(const f32x4*)(qs + 8 * d8 + 4);
                s += q0[0] * bflo(kv.x) + q0[1] * bfhi(kv.x) + q0[2] * bflo(kv.y) + q0[3] * bfhi(kv.y)
                   + q1[0] * bflo(kv.z) + q1[1] * bfhi(kv.z) + q1[2] * bflo(kv.w) + q1[3] * bfhi(kv.w);
            }
            sc[i] = valid ? s * 0.125f : -1e30f;
        }
        const float sink = p.attn_sink[hq];
        float mx = sink;
#pragma unroll
        for (int i = 0; i < 9; ++i) mx = fmaxf(mx, sc[i]);
        mx = wave_max(mx);
        float sum = 0.f;
#pragma unroll
        for (int i = 0; i < 9; ++i) { const float e = sc[i] > -1e29f ? __expf(sc[i] - mx) : 0.f; ps[i * 64 + lane] = e; sum += e; }
        sum = wave_sum(sum) + __expf(sink - mx);
        __builtin_amdgcn_wave_barrier();
        float o = 0.f;
        const int jlo = max(0, 128 - t), jhi = min(256, S - 1 - t + 128);
        const bf16_t* vb = proj + (long)(b * S + t - 128) * DIN + 1664 + hk * 64 + lane;
        for (int j = jlo; j <= jhi; ++j) o += ps[j] * bf2f(vb[(long)j * DIN]);
        const bf16_t* vc = proj + (size_t)(NLAT + b * LC) * DIN + 1664 + hk * 64 + lane;
#pragma unroll 4
        for (int j = 0; j < 256; ++j) o += ps[320 + j] * bf2f(vc[(size_t)j * DIN]);
        att[(size_t)r * 512 + hq * 64 + lane] = f2bf(o / sum);
        __builtin_amdgcn_wave_barrier();
    }
}

__device__ __forceinline__ void scan_naive(const Params& p, unsigned char* shm) {
    const int c = threadIdx.x;
    float* xs = (float*)shm;
    const bf16_t* proj = (const bf16_t*)(p.ws + WS_PROJ);
    float* sumb = (float*)(p.ws + WS_SUM);
    float* tmp = (float*)(p.ws + WS_TMP);
    bf16_t* yl = (bf16_t*)(p.ws + WS_YL); bf16_t* caf = (bf16_t*)(p.ws + WS_CAF); bf16_t* cab = (bf16_t*)(p.ws + WS_CAB);
    for (int id = blockIdx.x; id < NCHUNK; id += gridDim.x) {
        int rowbase, t0, seqlen; bool latent;
        if (id < 512) { const int b = id >> 8, k = id & 255; t0 = 64 * k; rowbase = b * S + t0; seqlen = S; latent = true; }
        else { const int j = id - 512, b = j >> 2, k = j & 3; t0 = 64 * k; rowbase = NLAT + b * LC + t0; seqlen = LC; latent = false; }
        const int seqbase = rowbase - t0;
        {
            const float cw0 = p.rnn_conv_w[c], cw1 = p.rnn_conv_w[512 + c], cw2 = p.rnn_conv_w[1024 + c], cw3 = p.rnn_conv_w[1536 + c], cb = p.rnn_conv_b[c];
            auto ld = [&](int tt) -> float { return (tt >= 0 && tt < seqlen) ? bf2f(proj[(size_t)(seqbase + tt) * DIN + c]) : 0.f; };
            float xm2 = ld(t0 - 2), xm1 = ld(t0 - 1), x0 = ld(t0);
            for (int t = 0; t < 64; ++t) {
                const float xp1 = ld(t0 + t + 1);
                xs[t * 512 + c] = cb + cw0 * xm2 + cw1 * xm1 + cw2 * x0 + cw3 * xp1;
                xm2 = xm1; xm1 = x0; x0 = xp1;
            }
        }
        __syncthreads();
        const int n = c >> 6, dd = c & 63;
        for (int dir = 0; dir < 2; ++dir) {
            float wa[64], wi[64];
#pragma unroll
            for (int ci = 0; ci < 64; ++ci) {
                wa[ci] = p.lru_w_a[(size_t)((dir * 8 + n) * 64 + ci) * 64 + dd];
                wi[ci] = p.lru_w_i[(size_t)((dir * 8 + n) * 64 + ci) * 64 + dd];
            }
            const float ba = p.lru_b_a[dir * 512 + c], bi = p.lru_b_i[dir * 512 + c];
            const float sp = log1pf(expf(-p.lru_lam[dir * 512 + c]));
            float h = 0.f, A = 1.f;
            for (int step = 0; step < 64; ++step) {
                const int t = dir ? 63 - step : step;
                const float* xr = xs + t * 512 + n * 64;
                float ga = ba, gi = bi;
#pragma unroll
                for (int c4 = 0; c4 < 16; ++c4) {
                    const f32x4 xv = *(const f32x4*)(xr + 4 * c4);
                    ga += xv[0] * wa[4 * c4] + xv[1] * wa[4 * c4 + 1] + xv[2] * wa[4 * c4 + 2] + xv[3] * wa[4 * c4 + 3];
                    gi += xv[0] * wi[4 * c4] + xv[1] * wi[4 * c4 + 1] + xv[2] * wi[4 * c4 + 2] + xv[3] * wi[4 * c4 + 3];
                }
                const float rr = sigmoidf_(ga), ii = sigmoidf_(gi);
                const float la = -8.0f * rr * sp;
                const float a = expf(la);
                const float uu = sqrtf(-expm1f(2.0f * la)) * (ii * xs[t * 512 + c]);
                h = a * h + uu; A *= a;
                if (latent) {
                    const size_t o = (size_t)(rowbase + t) * 512 + c;
                    if (dir == 0) { tmp[o] = h; caf[o] = f2bf(A); }
                    else { yl[o] = f2bf(tmp[o] + h); cab[o] = f2bf(A); }
                }
            }
            sumb[((size_t)(dir * NCHUNK + id) * 2 + 0) * 512 + c] = A;
            sumb[((size_t)(dir * NCHUNK + id) * 2 + 1) * 512 + c] = h;
        }
        __syncthreads();
    }
}

__device__ __forceinline__ void carry_phase(const Params& p) {
    if (blockIdx.x >= 4) return;
    const int b = blockIdx.x >> 1, dir = blockIdx.x & 1, c = threadIdx.x;
    const float* sumb = (const float*)(p.ws + WS_SUM) + (size_t)dir * NCHUNK * 1024;
    float* car = (float*)(p.ws + WS_CAR) + (size_t)dir * NCHUNK * 512;
    float h = 0.f;
    for (int s = 0; s < 260; ++s) {
        int id;
        if (dir == 0) id = s < 4 ? 512 + 4 * b + s : 256 * b + (s - 4);
        else id = s < 4 ? 512 + 4 * b + (3 - s) : 256 * b + (255 - (s - 4));
        car[(size_t)id * 512 + c] = h;
        h = sumb[(size_t)id * 1024 + c] * h + sumb[(size_t)id * 1024 + 512 + c];
    }
}

__device__ __forceinline__ void mix_phase(const Params& p) {
    const int lane = threadIdx.x & 63, gw = blockIdx.x * 8 + (threadIdx.x >> 6), NGW = gridDim.x * 8;
    const bf16_t* proj = (const bf16_t*)(p.ws + WS_PROJ);
    const bf16_t* att = (const bf16_t*)(p.ws + WS_ATT);
    const bf16_t* yl = (const bf16_t*)(p.ws + WS_YL); const bf16_t* caf = (const bf16_t*)(p.ws + WS_CAF); const bf16_t* cab = (const bf16_t*)(p.ws + WS_CAB);
    const float* car = (const float*)(p.ws + WS_CAR);
    bf16_t* mix = (bf16_t*)(p.ws + WS_HB);
    const int c0 = 8 * lane;
    for (int r = gw; r < NLAT; r += NGW) {
        const int id = r >> 6;
        const u32x4 vy = *(const u32x4*)(yl + (size_t)r * 512 + c0), vf = *(const u32x4*)(caf + (size_t)r * 512 + c0), vb = *(const u32x4*)(cab + (size_t)r * 512 + c0);
        const u32x4 vg = *(const u32x4*)(proj + (size_t)r * DIN + 512 + c0), va = *(const u32x4*)(att + (size_t)r * 512 + c0);
        const float* cf = car + (size_t)id * 512 + c0; const float* cbk = car + (size_t)(NCHUNK + id) * 512 + c0;
        float rn[8], at[8]; float s1 = 0.f, s2 = 0.f;
#pragma unroll
        for (int e = 0; e < 8; ++e) {
            const unsigned wy = vy[e >> 1], wf = vf[e >> 1], wb = vb[e >> 1], wg = vg[e >> 1], wa = va[e >> 1];
            const float y = ((e & 1) ? bfhi(wy) : bflo(wy)) + ((e & 1) ? bfhi(wf) : bflo(wf)) * cf[e] + ((e & 1) ? bfhi(wb) : bflo(wb)) * cbk[e];
            const float xg = (e & 1) ? bfhi(wg) : bflo(wg);
            rn[e] = gelu_tanh_(xg) * y; s1 += rn[e] * rn[e];
            at[e] = (e & 1) ? bfhi(wa) : bflo(wa); s2 += at[e] * at[e];
        }
        const float r1 = rsqrtf(wave_sum(s1) * (1.0f / 512.0f) + EPS), r2 = rsqrtf(wave_sum(s2) * (1.0f / 512.0f) + EPS);
        u32x4 o1, o2;
#pragma unroll
        for (int e2 = 0; e2 < 4; ++e2) {
            o1[e2] = pk2(rn[2 * e2] * r1 * p.gn_rnn[c0 + 2 * e2], rn[2 * e2 + 1] * r1 * p.gn_rnn[c0 + 2 * e2 + 1]);
            o2[e2] = pk2(at[2 * e2] * r2 * p.gn_attn[c0 + 2 * e2], at[2 * e2 + 1] * r2 * p.gn_attn[c0 + 2 * e2 + 1]);
        }
        *(u32x4*)(mix + (size_t)r * D + c0) = o1; *(u32x4*)(mix + (size_t)r * D + 512 + c0) = o2;
    }
}

__device__ __forceinline__ void phase7(const Params& p) {
    const int lane = threadIdx.x & 63, gw = blockIdx.x * 8 + (threadIdx.x >> 6), NGW = gridDim.x * 8;
    const float* mod = (const float*)(p.ws + WS_MOD);
    bf16_t* hb = (bf16_t*)(p.ws + WS_HB);
    for (int r = gw; r < NLAT; r += NGW) {
        const int mi = r >> 14;
        norm_mod_row(p.out + (size_t)r * D, p.norm2_g, mod + mi * 6144 + 3072, mod + mi * 6144 + 4096, hb + (size_t)r * D, lane);
    }
}

__device__ __forceinline__ void convgate_phase(const Params& p, int hb) {
    const bf16_t* U = (const bf16_t*)(p.ws + WS_U);
    bf16_t* act = (bf16_t*)(p.ws + WS_ACT) + (size_t)hb * S * DFF;
    const size_t total = (size_t)S * (DFF / 8);
    for (size_t i = (size_t)blockIdx.x * 512 + threadIdx.x; i < total; i += (size_t)gridDim.x * 512) {
        const int t = (int)(i / (DFF / 8)), ch = (int)(i % (DFF / 8)) * 8;
        const int gcol = (ch / 128) * 256 + (ch % 128);
        const bf16_t* up = U + (size_t)t * DUP + gcol;
        const u32x4 z = {0u, 0u, 0u, 0u};
        const u32x4 g0 = t > 0 ? *(const u32x4*)(up - DUP) : z, g1 = *(const u32x4*)up, g2 = t < S - 1 ? *(const u32x4*)(up + DUP) : z;
        const u32x4 v0 = t > 0 ? *(const u32x4*)(up - DUP + 128) : z, v1 = *(const u32x4*)(up + 128), v2 = t < S - 1 ? *(const u32x4*)(up + DUP + 128) : z;
        u32x4 o;
#pragma unroll
        for (int e2 = 0; e2 < 4; ++e2) {
            float r[2];
#pragma unroll
            for (int h = 0; h < 2; ++h) {
                const int cg_ = ch + 2 * e2 + h, cv_ = cg_ + DFF;
                const float a0 = h ? bfhi(g0[e2]) : bflo(g0[e2]), a1 = h ? bfhi(g1[e2]) : bflo(g1[e2]), a2 = h ? bfhi(g2[e2]) : bflo(g2[e2]);
                const float b0 = h ? bfhi(v0[e2]) : bflo(v0[e2]), b1 = h ? bfhi(v1[e2]) : bflo(v1[e2]), b2 = h ? bfhi(v2[e2]) : bflo(v2[e2]);
                const float cg = p.ffn_conv_b[cg_] + p.ffn_conv_w[cg_] * a0 + p.ffn_conv_w[DUP + cg_] * a1 + p.ffn_conv_w[2 * DUP + cg_] * a2;
                const float cv = p.ffn_conv_b[cv_] + p.ffn_conv_w[cv_] * b0 + p.ffn_conv_w[DUP + cv_] * b1 + p.ffn_conv_w[2 * DUP + cv_] * b2;
                r[h] = silu_(cg) * cv;
            }
            o[e2] = pk2(r[0], r[1]);
        }
        *(u32x4*)(act + (size_t)t * DFF + ch) = o;
    }
}

__device__ __forceinline__ void final_phase(const Params& p) {
    const int lane = threadIdx.x & 63, gw = blockIdx.x * 8 + (threadIdx.x >> 6), NGW = gridDim.x * 8;
    for (int r = gw; r < NLAT; r += NGW) {
        float* row = p.out + (size_t)r * D;
        f32x4 v[4]; float ss = 0.f;
#pragma unroll
        for (int j = 0; j < 4; ++j) { v[j] = *(const f32x4*)(row + 4 * lane + 256 * j); ss += v[j][0] * v[j][0] + v[j][1] * v[j][1] + v[j][2] * v[j][2] + v[j][3] * v[j][3]; }
        const float rstd = rsqrtf(wave_sum(ss) * (1.0f / D) + EPS);
#pragma unroll
        for (int j = 0; j < 4; ++j) { const f32x4 gg = *(const f32x4*)(p.final_g + 4 * lane + 256 * j); *(f32x4*)(row + 4 * lane + 256 * j) = v[j] * rstd * gg; }
    }
}

__global__ void __launch_bounds__(512, 2) fwd_megakernel(Params p) {
    extern __shared__ __attribute__((aligned(16))) unsigned char shm[];
    cg::grid_group grid = cg::this_grid();
    LAS unsigned char* lds = (LAS unsigned char*)shm;
    unsigned char* ws = p.ws;
    const float* mod = (const float*)(ws + WS_MOD);
    pg8::StaticOrder so;

    phase0(p, shm);
    grid.sync();
    phase1(p);
    grid.sync();
    {
        pg8::Gemm g{(const bf16_t*)(ws + WS_HB), (const bf16_t*)(ws + WS_WIN), MROWS / 256, DIN / 256, D, 256};
        so.init(g.nM, g.nN, gridDim.x, blockIdx.x);
        EpiProj e{(bf16_t*)(ws + WS_PROJ), (const float*)(ws + WS_ROPE), (const float*)(ws + WS_ROPE) + 4096};
        pg8::gemm_phase(lds, g, so, e);
    }
    grid.sync();
    scan_naive(p, shm);
    attn_naive(p, shm);
    grid.sync();
    carry_phase(p);
    grid.sync();
    mix_phase(p);
    grid.sync();
    {
        pg8::Gemm g{(const bf16_t*)(ws + WS_HB), (const bf16_t*)(ws + WS_WOUT), NLAT / 256, D / 256, D, 256};
        so.init(g.nM, g.nN, gridDim.x, blockIdx.x);
        EpiRes e{p.x, p.out, mod + 2048, mod + 6144 + 2048};
        pg8::gemm_phase(lds, g, so, e);
    }
    grid.sync();
    phase7(p);
    grid.sync();
    for (int hb = 0; hb < 2; ++hb) {
        pg8::Gemm g{(const bf16_t*)(ws + WS_HB) + (size_t)hb * S * D, (const bf16_t*)(ws + WS_WUP), S / 256, DUP / 256, D, 256};
        so.init(g.nM, g.nN, gridDim.x, blockIdx.x);
        EpiU e{(bf16_t*)(ws + WS_U)};
        pg8::gemm_phase(lds, g, so, e);
        grid.sync();
        convgate_phase(p, hb);
        grid.sync();
    }
    {
        pg8::Gemm g{(const bf16_t*)(ws + WS_ACT), (const bf16_t*)(ws + WS_WDN), NLAT / 256, D / 256, DFF, 256};
        so.init(g.nM, g.nN, gridDim.x, blockIdx.x);
        EpiRes e{p.out, p.out, mod + 5120, mod + 6144 + 5120};
        pg8::gemm_phase(lds, g, so, e);
    }
    grid.sync();
    final_phase(p);
}

extern "C" void kernel_launch(void* const* d_in, const int* in_sizes, int n_in, void* d_out, int out_size, void* d_ws, size_t ws_size, hipStream_t stream) {
    static int grid_blocks = 0;
    if (!grid_blocks) {
        int dev = 0, cus = 0, per_cu = 0;
        hipGetDevice(&dev);
        hipDeviceGetAttribute(&cus, hipDeviceAttributeMultiprocessorCount, dev);
        hipFuncSetAttribute((const void*)fwd_megakernel, hipFuncAttributeMaxDynamicSharedMemorySize, LDS_BYTES);
        hipOccupancyMaxActiveBlocksPerMultiprocessor(&per_cu, (const void*)fwd_megakernel, 512, LDS_BYTES);
        if (per_cu < 1) per_cu = 1;
        grid_blocks = cus * per_cu;
        if (ws_size < WS_END) fprintf(stderr, "kernel_launch: workspace too small: %zu < %zu\n", ws_size, (size_t)WS_END);
    }
    Params p{};
    const float** pp = (const float**)&p;
    for (int i = 0; i < 25; ++i) pp[i] = (const float*)d_in[i];
    p.out = (float*)d_out; p.ws = (unsigned char*)d_ws;
    void* args[] = {&p};
    hipError_t e = hipLaunchCooperativeKernel((const void*)fwd_megakernel, dim3(grid_blocks), dim3(512), args, LDS_BYTES, stream);
    if (e != hipSuccess) fprintf(stderr, "cooperative launch failed: %s (grid %d)\n", hipGetErrorString(e), grid_blocks);
}
```

```cpp
#include <hip/hip_runtime.h>
#include <hip/hip_cooperative_groups.h>
#include <cstdio>
namespace cg = cooperative_groups;

#define LAS __attribute__((address_space(3)))
typedef unsigned short bf16_t;
typedef short bf16x8 __attribute__((ext_vector_type(8)));
typedef float f32x4 __attribute__((ext_vector_type(4)));
typedef unsigned u32x4 __attribute__((ext_vector_type(4)));
typedef unsigned u32x2 __attribute__((ext_vector_type(2)));

constexpr int D = 1024, NB = 2, S = 16384, LC = 256;
constexpr int NLAT = NB * S;
constexpr int NCTX = NB * LC;
constexpr int MROWS = NLAT + NCTX;
constexpr int DIN = 1792, DFF = 2816, DUP = 5632, DRNN = 512;
constexpr int NCHUNK = MROWS / 64;
constexpr float EPS = 1e-6f;

constexpr size_t AL(size_t x) { return (x + 255) & ~(size_t)255; }
constexpr size_t WS_WIN  = 0;
constexpr size_t WS_WOUT = WS_WIN  + AL((size_t)DIN * D * 2);
constexpr size_t WS_WUP  = WS_WOUT + AL((size_t)D * D * 2);
constexpr size_t WS_WDN  = WS_WUP  + AL((size_t)DUP * D * 2);
constexpr size_t WS_LRU  = WS_WDN  + AL((size_t)D * DFF * 2);
constexpr size_t WS_MOD  = WS_LRU  + AL((size_t)4 * 8 * 64 * 64 * 2);
constexpr size_t WS_ROPE = WS_MOD  + AL((size_t)3 * 6144 * 4);
constexpr size_t WS_SUM  = WS_ROPE + AL((size_t)2 * 256 * 16 * 4);
constexpr size_t WS_CAR  = WS_SUM  + AL((size_t)2 * NCHUNK * 2 * 512 * 4);
constexpr size_t WS_HB   = WS_CAR  + AL((size_t)2 * NCHUNK * 512 * 4);
constexpr size_t WS_R1   = WS_HB   + AL((size_t)MROWS * D * 2);
constexpr size_t WS_PROJ = WS_R1;
constexpr size_t WS_ATT  = WS_PROJ + AL((size_t)MROWS * DIN * 2);
constexpr size_t WS_YL   = WS_ATT  + AL((size_t)NLAT * 512 * 2);
constexpr size_t WS_CAF  = WS_YL   + AL((size_t)NLAT * 512 * 2);
constexpr size_t WS_CAB  = WS_CAF  + AL((size_t)NLAT * 512 * 2);
constexpr size_t WS_R1END = WS_CAB + AL((size_t)NLAT * 512 * 2);
constexpr size_t WS_ACT  = WS_R1;
constexpr size_t WS_U    = WS_ACT + AL((size_t)NLAT * DFF * 2);
constexpr size_t WS_TMP  = WS_R1END;
constexpr size_t WS_END  = WS_U + AL((size_t)S * DUP * 2);
static_assert(WS_TMP + (size_t)NLAT * 512 * 4 <= WS_END, "tmp");
static_assert(WS_U >= WS_ACT + (size_t)NLAT * DFF * 2, "u");

constexpr int LDS_BYTES = 131072 + 8192;

struct Params {
    const float *x, *c, *ctx, *c_ctx, *w_mod, *b_mod, *norm1_g, *w_in, *rnn_conv_w, *rnn_conv_b, *lru_w_a, *lru_b_a,
        *lru_w_i, *lru_b_i, *lru_lam, *attn_sink, *gn_rnn, *gn_attn, *w_out, *norm2_g, *w_up, *ffn_conv_w, *ffn_conv_b,
        *w_down, *final_g;
    float* out;
    unsigned char* ws;
};

__device__ __forceinline__ bf16_t f2bf(float f) { unsigned u = __float_as_uint(f); u += 0x7FFFu + ((u >> 16) & 1u); return (bf16_t)(u >> 16); }
__device__ __forceinline__ float bf2f(bf16_t b) { return __uint_as_float(((unsigned)b) << 16); }
__device__ __forceinline__ unsigned pk2(float lo, float hi) { return (unsigned)f2bf(lo) | ((unsigned)f2bf(hi) << 16); }
__device__ __forceinline__ float bflo(unsigned w) { return __uint_as_float(w << 16); }
__device__ __forceinline__ float bfhi(unsigned w) { return __uint_as_float(w & 0xFFFF0000u); }
__device__ __forceinline__ float wave_sum(float v) {
#pragma unroll
    for (int o = 32; o >= 1; o >>= 1) v += __shfl_xor(v, o);
    return v;
}
__device__ __forceinline__ float wave_max(float v) {
#pragma unroll
    for (int o = 32; o >= 1; o >>= 1) v = fmaxf(v, __shfl_xor(v, o));
    return v;
}
__device__ __forceinline__ float sigmoidf_(float x) { return 1.0f / (1.0f + __expf(-x)); }
__device__ __forceinline__ float silu_(float x) { return x / (1.0f + __expf(-x)); }
__device__ __forceinline__ float gelu_tanh_(float x) {
    const float u = 0.7978845608028654f * (x + 0.044715f * x * x * x);
    const float e = __expf(2.0f * u);
    const float th = 1.0f - 2.0f / (e + 1.0f);
    return 0.5f * x * (1.0f + th);
}

namespace pg8 {
constexpr int BM = 256, BK = 64, HALF = 128, HTB = HALF * BK * 2, NXCD = 8, WGM = 8;
__host__ __device__ __forceinline__ int lds_byte(int r, int c) { const int st = (r >> 4) * 2 + (c >> 5), rr = r & 15, cc = c & 31, ob = rr * 64 + cc * 2; return st * 1024 + (ob ^ (((ob >> 9) & 1) << 5)); }
__host__ __device__ __forceinline__ void stage_rc(int b, int& R, int& C) { const int st = b / 1024, sb = b % 1024, swz = sb ^ (((sb >> 9) & 1) << 5); R = (st >> 1) * 16 + swz / 64; C = (st & 1) * 32 + (swz % 64) / 2; }
struct Unit { int pm, pn; };
struct Gemm { const bf16_t* A; const bf16_t* Bt; int nM, nN, K, a_tile_rows; };
struct StaticOrder {
    int nM, nN, nwg, G, c;
    __device__ void init(int nM_, int nN_, int G_, int c_) { nM = nM_; nN = nN_; nwg = nM * nN; G = G_; c = c_; }
    __device__ bool next(int i, Unit& u) const {
        const long L = (long)i * G + c; if (L >= nwg) return false;
        int wgid = (int)L; { const int q = nwg / NXCD, r = nwg % NXCD, xcd = wgid % NXCD, off = wgid / NXCD; wgid = (xcd < r ? xcd * (q + 1) : r * (q + 1) + (xcd - r) * q) + off; }
        const int nig = WGM * nN, gid = wgid / nig, fm = gid * WGM, gsz = (nM - fm) < WGM ? (nM - fm) : WGM;
        u.pm = fm + ((wgid % nig) % gsz); u.pn = (wgid % nig) / gsz; return true;
    }
};
template <class Epi>
__device__ __forceinline__ void gemm_phase(LAS unsigned char* lds, const Gemm g, const StaticOrder& S, const Epi& E) {
    int tid = threadIdx.x; asm volatile("" : "+v"(tid));
    const int wid = __builtin_amdgcn_readfirstlane(tid >> 6), lane = tid & 63, wr = wid >> 2, wc = wid & 3, fr = lane & 15, fq = lane >> 4;
    const int K = g.K, nt = K / BK;
    unsigned voffA[2], voffB[2];
#pragma unroll
    for (int i = 0; i < 2; ++i) { int R, C; stage_rc(tid * 16 + i * 8192, R, C); voffA[i] = (unsigned)(R * K + C) * 2u; voffB[i] = voffA[i]; }
    const size_t kstep = (size_t)(BK * 2);
    const size_t hstep = (size_t)HALF * K * 2;
    const size_t tstepA = (size_t)g.a_tile_rows * K * 2;
    const size_t tstepB = 2 * hstep;
    const unsigned ldsw = (unsigned)wid * 1024u;
    const int aoff = lds_byte(wr * 64 + fr, fq * 8), boff = lds_byte(wc * 32 + fr, fq * 8);
#define PG8_SA(b, h) (((b) * 2 + (h)) * HTB)
#define PG8_SB(b, h) ((4 + (b) * 2 + (h)) * HTB)
#define PG8_STAGE(bufoff, gbase, voff) do { _Pragma("unroll") for (int _i = 0; _i < 2; ++_i) \
        __builtin_amdgcn_global_load_lds((const unsigned*)((const char*)(gbase) + (voff)[_i]), (LAS unsigned*)(lds + (bufoff) + ldsw + _i * 8192), 16, 0, 0); } while (0)
#define PG8_LDA(dst, b, h) do { _Pragma("unroll") for (int m = 0; m < 4; ++m) _Pragma("unroll") for (int k = 0; k < 2; ++k) dst[m][k] = *(const LAS bf16x8*)(lds + PG8_SA(b, h) + aoff + m * 2048 + k * 1024); } while (0)
#define PG8_LDB(dst, b, h) do { _Pragma("unroll") for (int n = 0; n < 2; ++n) _Pragma("unroll") for (int k = 0; k < 2; ++k) dst[n][k] = *(const LAS bf16x8*)(lds + PG8_SB(b, h) + boff + n * 2048 + k * 1024); } while (0)
#define PG8_MMA(ai, bj, At, Bt) do { __builtin_amdgcn_s_setprio(1); _Pragma("unroll") for (int m = 0; m < 4; ++m) _Pragma("unroll") for (int n = 0; n < 2; ++n) _Pragma("unroll") for (int k = 0; k < 2; ++k) \
        acc[ai][bj][m][n] = __builtin_amdgcn_mfma_f32_16x16x32_bf16(Bt[n][k], At[m][k], acc[ai][bj][m][n], 0, 0, 0); __builtin_amdgcn_s_setprio(0); } while (0)
#define PG8_WAIT_V(n) asm volatile("s_waitcnt vmcnt(" #n ")" ::: "memory")
#define PG8_WAIT_L(n) asm volatile("s_waitcnt lgkmcnt(" #n ")" ::: "memory")
#define PG8_BAR __builtin_amdgcn_s_barrier()
#define PG8_SCHED __builtin_amdgcn_sched_barrier(0)
    Unit cur, nxt; int ui = 0;
    if (!S.next(0, cur)) return;
    f32x4 acc[2][2][4][2];
#pragma unroll
    for (int a = 0; a < 2; ++a)
#pragma unroll
        for (int b = 0; b < 2; ++b)
#pragma unroll
            for (int m = 0; m < 4; ++m)
#pragma unroll
                for (int n = 0; n < 2; ++n) acc[a][b][m][n] = (f32x4){0.f, 0.f, 0.f, 0.f};
    bf16x8 At[4][2], B0[2][2], B1[2][2];
    const char* cA = (const char*)g.A + (size_t)cur.pm * tstepA; const char* cB = (const char*)g.Bt + (size_t)cur.pn * tstepB;
    PG8_STAGE(PG8_SB(0, 0), cB, voffB); PG8_STAGE(PG8_SA(0, 0), cA, voffA); PG8_STAGE(PG8_SB(0, 1), cB + hstep, voffB); PG8_STAGE(PG8_SA(0, 1), cA + hstep, voffA);
    if (wr == 1) PG8_BAR;
    PG8_WAIT_V(4); PG8_BAR;
    PG8_STAGE(PG8_SB(1, 0), cB + kstep, voffB); PG8_STAGE(PG8_SA(1, 0), cA + kstep, voffA); PG8_STAGE(PG8_SB(1, 1), cB + hstep + kstep, voffB);
    PG8_WAIT_V(6); PG8_BAR;
    for (;;) {
        const bool has_next = S.next(ui + 1, nxt);
        const char* nA = has_next ? (const char*)g.A + (size_t)nxt.pm * tstepA : cA; const char* nB = has_next ? (const char*)g.Bt + (size_t)nxt.pn * tstepB : cB;
        for (int t = 0; t < nt; t += 2) {
            const bool last = (t == nt - 2);
            const char* a1 = cA + (size_t)(t + 1) * kstep;
            const char* a2 = last ? nA : cA + (size_t)(t + 2) * kstep; const char* b2 = last ? nB : cB + (size_t)(t + 2) * kstep;
            const char* a3 = a2 + kstep; const char* b3 = b2 + kstep;
            PG8_LDB(B0, 0, 0); PG8_SCHED; PG8_LDA(At, 0, 0); PG8_STAGE(PG8_SA(1, 1), a1 + hstep, voffA);
            PG8_WAIT_L(8); PG8_BAR; PG8_WAIT_L(0); PG8_MMA(0, 0, At, B0); PG8_BAR; PG8_SCHED;
            PG8_LDB(B1, 0, 1); PG8_STAGE(PG8_SB(0, 0), b2, voffB);
            PG8_BAR; PG8_WAIT_L(0); PG8_MMA(0, 1, At, B1); PG8_BAR;
            PG8_LDA(At, 0, 1); PG8_STAGE(PG8_SA(0, 0), a2, voffA);
            PG8_BAR; PG8_WAIT_L(0); PG8_MMA(1, 0, At, B0); PG8_BAR; PG8_SCHED;
            PG8_STAGE(PG8_SB(0, 1), b2 + hstep, voffB);
            PG8_WAIT_V(6); PG8_BAR; PG8_MMA(1, 1, At, B1); PG8_BAR;
            PG8_LDB(B0, 1, 0); PG8_SCHED; PG8_LDA(At, 1, 0); PG8_STAGE(PG8_SA(0, 1), a2 + hstep, voffA);
            PG8_WAIT_L(8); PG8_BAR; PG8_WAIT_L(0); PG8_MMA(0, 0, At, B0); PG8_BAR; PG8_SCHED;
            PG8_LDB(B1, 1, 1); PG8_STAGE(PG8_SB(1, 0), b3, voffB);
            PG8_BAR; PG8_WAIT_L(0); PG8_MMA(0, 1, At, B1); PG8_BAR;
            PG8_LDA(At, 1, 1); PG8_STAGE(PG8_SA(1, 0), a3, voffA);
            PG8_BAR; PG8_WAIT_L(0); PG8_MMA(1, 0, At, B0); PG8_BAR; PG8_SCHED;
            PG8_STAGE(PG8_SB(1, 1), b3 + hstep, voffB);
            PG8_WAIT_V(6); PG8_BAR; PG8_MMA(1, 1, At, B1); PG8_BAR;
        }
        E(acc, cur, wr, wc, fr, fq);
        if (!has_next) break;
#pragma unroll
        for (int a = 0; a < 2; ++a)
#pragma unroll
            for (int b = 0; b < 2; ++b)
#pragma unroll
                for (int m = 0; m < 4; ++m)
#pragma unroll
                    for (int n = 0; n < 2; ++n) acc[a][b][m][n] = (f32x4){0.f, 0.f, 0.f, 0.f};
        cur = nxt; cA = nA; cB = nB; ++ui;
    }
    PG8_WAIT_V(0);
    if (wr == 0) PG8_BAR;
    PG8_BAR;
#undef PG8_SA
#undef PG8_SB
#undef PG8_STAGE
#undef PG8_LDA
#undef PG8_LDB
#undef PG8_MMA
#undef PG8_WAIT_V
#undef PG8_WAIT_L
#undef PG8_BAR
#undef PG8_SCHED
}
}
using pg8::Unit;

struct EpiProj {
    bf16_t* O; const float* cosT; const float* sinT;
    __device__ __forceinline__ void operator()(const f32x4 (&acc)[2][2][4][2], const Unit& u, int wr, int wc, int fr, int fq) const {
        const bool latent = u.pm < 128;
#pragma unroll
        for (int ai = 0; ai < 2; ++ai)
#pragma unroll
            for (int m = 0; m < 4; ++m) {
                const int row = u.pm * 256 + ai * 128 + wr * 64 + m * 16 + fr;
                const int t = row & (S - 1);
                const int pos = (wc & 1) ? (t & 63) : (t >> 6);
#pragma unroll
                for (int bj = 0; bj < 2; ++bj) {
                    const int col = u.pn * 256 + bj * 128 + wc * 32 + 4 * fq;
                    f32x4 v0 = acc[ai][bj][m][0], v1 = acc[ai][bj][m][1];
                    const bool rope = latent && (u.pn == 4 || u.pn == 5 || (u.pn == 6 && bj == 0));
                    if (rope) {
                        const f32x4 cs = *(const f32x4*)(cosT + pos * 16 + 4 * fq), sn = *(const f32x4*)(sinT + pos * 16 + 4 * fq);
                        const f32x4 n0 = v0 * cs - v1 * sn, n1 = v1 * cs + v0 * sn; v0 = n0; v1 = n1;
                    }
                    bf16_t* p = O + (size_t)row * DIN + col;
                    u32x2 w0, w1; w0.x = pk2(v0[0], v0[1]); w0.y = pk2(v0[2], v0[3]); w1.x = pk2(v1[0], v1[1]); w1.y = pk2(v1[2], v1[3]);
                    *(u32x2*)p = w0; *(u32x2*)(p + 16) = w1;
                }
            }
    }
};
struct EpiRes {
    const float* src; float* dst; const float* gate0; const float* gate1;
    __device__ __forceinline__ void operator()(const f32x4 (&acc)[2][2][4][2], const Unit& u, int wr, int wc, int fr, int fq) const {
        const float* gate = (u.pm >= 64) ? gate1 : gate0;
        f32x4 gv[2][2];
#pragma unroll
        for (int bj = 0; bj < 2; ++bj)
#pragma unroll
            for (int n = 0; n < 2; ++n) gv[bj][n] = *(const f32x4*)(gate + u.pn * 256 + bj * 128 + wc * 32 + n * 16 + 4 * fq);
#pragma unroll
        for (int ai = 0; ai < 2; ++ai)
#pragma unroll
            for (int m = 0; m < 4; ++m) {
                const size_t row = (size_t)u.pm * 256 + ai * 128 + wr * 64 + m * 16 + fr;
#pragma unroll
                for (int bj = 0; bj < 2; ++bj)
#pragma unroll
                    for (int n = 0; n < 2; ++n) {
                        const size_t o = row * D + u.pn * 256 + bj * 128 + wc * 32 + n * 16 + 4 * fq;
                        const f32x4 s = *(const f32x4*)(src + o);
                        *(f32x4*)(dst + o) = s + gv[bj][n] * acc[ai][bj][m][n];
                    }
            }
    }
};
struct EpiU {
    bf16_t* O;
    __device__ __forceinline__ void operator()(const f32x4 (&acc)[2][2][4][2], const Unit& u, int wr, int wc, int fr, int fq) const {
#pragma unroll
        for (int ai = 0; ai < 2; ++ai)
#pragma unroll
            for (int m = 0; m < 4; ++m) {
                const size_t row = (size_t)u.pm * 256 + ai * 128 + wr * 64 + m * 16 + fr;
#pragma unroll
                for (int bj = 0; bj < 2; ++bj)
#pragma unroll
                    for (int n = 0; n < 2; ++n) {
                        const f32x4 v = acc[ai][bj][m][n];
                        u32x2 w; w.x = pk2(v[0], v[1]); w.y = pk2(v[2], v[3]);
                        *(u32x2*)(O + row * DUP + u.pn * 256 + bj * 128 + wc * 32 + n * 16 + 4 * fq) = w;
                    }
            }
    }
};

__device__ __forceinline__ void transpose_item(const float* W, int N, int k0, int n0, bf16_t* dst, int Kd, float* scr, int lane) {
#pragma unroll 8
    for (int i = 0; i < 32; ++i) { const int kk = 2 * i + (lane >> 5); scr[kk * 33 + (lane & 31)] = W[(size_t)(k0 + kk) * N + n0 + (lane & 31)]; }
    __builtin_amdgcn_wave_barrier();
    const int c = lane & 7;
#pragma unroll
    for (int j = 0; j < 4; ++j) {
        const int n = (lane >> 3) + 8 * j; const float* s = scr + (8 * c) * 33 + n;
        u32x4 o; o.x = pk2(s[0], s[33]); o.y = pk2(s[2 * 33], s[3 * 33]); o.z = pk2(s[4 * 33], s[5 * 33]); o.w = pk2(s[6 * 33], s[7 * 33]);
        *(u32x4*)(dst + (size_t)n * Kd + k0 + 8 * c) = o;
    }
    __builtin_amdgcn_wave_barrier();
}

__device__ __forceinline__ void phase0(const Params& p, unsigned char* shm) {
    const int tid = threadIdx.x, lane = tid & 63, wave = tid >> 6;
    unsigned char* ws = p.ws;
    if (blockIdx.x < 192) {
        float* sv = (float*)shm;
        float* red = sv + 3 * 1024;
        for (int i = tid; i < 3 * 1024; i += 512) {
            const int j = i >> 10, k = i & 1023;
            const float v = (j < 2) ? p.c[j * 1024 + k] : p.c_ctx[k];
            sv[i] = silu_(v);
        }
        __syncthreads();
        const int n0 = blockIdx.x * 32, col = tid & 31, ks = tid >> 5;
        float a0 = 0.f, a1 = 0.f, a2 = 0.f;
        const float* wp = p.w_mod + (size_t)(ks * 64) * 6144 + n0 + col;
#pragma unroll 8
        for (int k = 0; k < 64; ++k) {
            const float w = wp[(size_t)k * 6144];
            a0 += sv[ks * 64 + k] * w; a1 += sv[1024 + ks * 64 + k] * w; a2 += sv[2048 + ks * 64 + k] * w;
        }
        red[(ks * 3 + 0) * 32 + col] = a0; red[(ks * 3 + 1) * 32 + col] = a1; red[(ks * 3 + 2) * 32 + col] = a2;
        __syncthreads();
        if (tid < 96) {
            const int j = tid >> 5, cc = tid & 31; float s = p.b_mod[n0 + cc];
            for (int k = 0; k < 16; ++k) s += red[(k * 3 + j) * 32 + cc];
            ((float*)(ws + WS_MOD))[j * 6144 + n0 + cc] = s;
        }
        __syncthreads();
    }
    if (blockIdx.x >= 192 && blockIdx.x < 200) {
        const int idx = (blockIdx.x - 192) * 512 + tid;
        const int pos = idx >> 4, i = idx & 15;
        const float inv = powf(10000.0f, -(float)i / 16.0f);
        const float ang = (float)pos * inv;
        ((float*)(ws + WS_ROPE))[idx] = cosf(ang);
        ((float*)(ws + WS_ROPE))[4096 + idx] = sinf(ang);
    }
    float* scr = (float*)(shm + 32768) + wave * (64 * 33);
    const int gw = blockIdx.x * 8 + wave, NGW = gridDim.x * 8;
    constexpr int I_IN = (D / 64) * (DIN / 32), I_OUT = (D / 64) * (D / 32), I_UP = (D / 64) * (DUP / 32), I_DN = (DFF / 64) * (D / 32), I_LRU = 2 * 2 * 8 * 2;
    constexpr int NIT = I_IN + I_OUT + I_UP + I_DN + I_LRU;
    for (int it = gw; it < NIT; it += NGW) {
        int r = it;
        if (r < I_IN) { const int nb = DIN / 32, kb = r / nb, n0 = (r % nb) * 32; transpose_item(p.w_in, DIN, kb * 64, n0, (bf16_t*)(ws + WS_WIN) + (size_t)n0 * D, D, scr, lane); continue; } r -= I_IN;
        if (r < I_OUT) { const int nb = D / 32, kb = r / nb, n0 = (r % nb) * 32; transpose_item(p.w_out, D, kb * 64, n0, (bf16_t*)(ws + WS_WOUT) + (size_t)n0 * D, D, scr, lane); continue; } r -= I_OUT;
        if (r < I_UP) { const int nb = DUP / 32, kb = r / nb, n0 = (r % nb) * 32;
            const int isv = n0 >= DFF, nn = isv ? n0 - DFF : n0, drow = (nn / 128) * 256 + isv * 128 + (nn % 128);
            transpose_item(p.w_up, DUP, kb * 64, n0, (bf16_t*)(ws + WS_WUP) + (size_t)drow * D, D, scr, lane); continue; } r -= I_UP;
        if (r < I_DN) { const int nb = D / 32, kb = r / nb, n0 = (r % nb) * 32; transpose_item(p.w_down, D, kb * 64, n0, (bf16_t*)(ws + WS_WDN) + (size_t)n0 * DFF, DFF, scr, lane); continue; } r -= I_DN;
        {
            const int nh = r & 1, blk = (r >> 1) & 7, type = (r >> 4) & 1, dir = r >> 5;
            const float* src = (type ? p.lru_w_i : p.lru_w_a) + (size_t)(dir * 8 + blk) * 4096;
            bf16_t* dst = (bf16_t*)(ws + WS_LRU) + (size_t)((dir * 2 + type) * 8 + blk) * 4096 + (size_t)(nh * 32) * 64;
            transpose_item(src, 64, 0, nh * 32, dst, 64, scr, lane);
        }
    }
}

__device__ __forceinline__ void norm_mod_row(const float* src, const float* g, const float* sh, const float* sc, bf16_t* dst, int lane) {
    f32x4 v[4]; float ss = 0.f;
#pragma unroll
    for (int j = 0; j < 4; ++j) { v[j] = *(const f32x4*)(src + 4 * lane + 256 * j); ss += v[j][0] * v[j][0] + v[j][1] * v[j][1] + v[j][2] * v[j][2] + v[j][3] * v[j][3]; }
    const float rstd = rsqrtf(wave_sum(ss) * (1.0f / D) + EPS);
#pragma unroll
    for (int j = 0; j < 4; ++j) {
        const int c = 4 * lane + 256 * j;
        const f32x4 gg = *(const f32x4*)(g + c), s1 = *(const f32x4*)(sc + c), s0 = *(const f32x4*)(sh + c);
        const f32x4 o = (v[j] * rstd * gg) * (s1 + 1.0f) + s0;
        u32x2 w; w.x = pk2(o[0], o[1]); w.y = pk2(o[2], o[3]);
        *(u32x2*)(dst + c) = w;
    }
}
__device__ __forceinline__ void phase1(const Params& p) {
    const int lane = threadIdx.x & 63, gw = blockIdx.x * 8 + (threadIdx.x >> 6), NGW = gridDim.x * 8;
    const float* mod = (const float*)(p.ws + WS_MOD);
    bf16_t* hb = (bf16_t*)(p.ws + WS_HB);
    for (int r = gw; r < MROWS; r += NGW) {
        const int mi = r < NLAT ? (r >> 14) : 2;
        const float* src = r < NLAT ? p.x + (size_t)r * D : p.ctx + (size_t)(r - NLAT) * D;
        norm_mod_row(src, p.norm1_g, mod + mi * 6144, mod + mi * 6144 + 1024, hb + (size_t)r * D, lane);
    }
}

__device__ __forceinline__ void attn_naive(const Params& p, unsigned char* shm) {
    const int lane = threadIdx.x & 63, wave = threadIdx.x >> 6, gw = blockIdx.x * 8 + wave, NGW = gridDim.x * 8;
    float* qs = (float*)shm + wave * 640;
    float* ps = qs + 64;
    const bf16_t* proj = (const bf16_t*)(p.ws + WS_PROJ);
    bf16_t* att = (bf16_t*)(p.ws + WS_ATT);
    for (int item = gw; item < NLAT * 8; item += NGW) {
        const int r = item >> 3, hq = item & 7, hk = hq >> 2, b = r >> 14, t = r & (S - 1);
        qs[lane] = bf2f(proj[(size_t)r * DIN + 1024 + hq * 64 + lane]);
        __builtin_amdgcn_wave_barrier();
        float sc[9];
#pragma unroll
        for (int i = 0; i < 9; ++i) {
            int kp; bool valid; const bf16_t* krow;
            if (i < 5) { kp = t - 128 + lane + 64 * i; valid = kp >= 0 && kp < S && kp <= t + 128; krow = proj + (size_t)(b * S + (valid ? kp : 0)) * DIN + 1536 + hk * 64; }
            else { kp = lane + 64 * (i - 5); valid = true; krow = proj + (size_t)(NLAT + b * LC + kp) * DIN + 1536 + hk * 64; }
            float s = 0.f;
#pragma unroll
            for (int d8 = 0; d8 < 8; ++d8) {
                const u32x4 kv = *(const u32x4*)(krow + 8 * d8);
                const f32x4 q0 = *(const f32x4*)(qs + 8 * d8), q1 = *(const f32x4*)(qs + 8 * d8 + 4);
                s += q0[0] * bflo(kv.x) + q0[1] * bfhi(kv.x) + q0[2] * bflo(kv.y) + q0[3] * bfhi(kv.y)
                   + q1[0] * bflo(kv.z) + q1[1] * bfhi(kv.z) + q1[2] * bflo(kv.w) + q1[3] * bfhi(kv.w);
            }
            sc[i] = valid ? s * 0.125f : -1e30f;
        }
        const float sink = p.attn_sink[hq];
        float mx = sink;
#pragma unroll
        for (int i = 0; i < 9; ++i) mx = fmaxf(mx, sc[i]);
        mx = wave_max(mx);
        float sum = 0.f;
#pragma unroll
        for (int i = 0; i < 9; ++i) { const float e = sc[i] > -1e29f ? __expf(sc[i] - mx) : 0.f; ps[i * 64 + lane] = e; sum += e; }
        sum = wave_sum(sum) + __expf(sink - mx);
        __builtin_amdgcn_wave_barrier();
        float o = 0.f;
        const int jlo = max(0, 128 - t), jhi = min(256, S - 1 - t + 128);
        const bf16_t* vb = proj + (long)(b * S + t - 128) * DIN + 1664 + hk * 64 + lane;
        for (int j = jlo; j <= jhi; ++j) o += ps[j] * bf2f(vb[(long)j * DIN]);
        const bf16_t* vc = proj + (size_t)(NLAT + b * LC) * DIN + 1664 + hk * 64 + lane;
#pragma unroll 4
        for (int j = 0; j < 256; ++j) o += ps[320 + j] * bf2f(vc[(size_t)j * DIN]);
        att[(size_t)r * 512 + hq * 64 + lane] = f2bf(o / sum);
        __builtin_amdgcn_wave_barrier();
    }
}


typedef float f32x16 __attribute__((ext_vector_type(16)));
__device__ __forceinline__ unsigned cvt_pk_bf16(float lo, float hi) { unsigned r; asm("v_cvt_pk_bf16_f32 %0, %1, %2" : "=v"(r) : "v"(lo), "v"(hi)); return r; }
__device__ __forceinline__ void attn_mfma(const Params& p, unsigned char* shm) {
    int tid = threadIdx.x; asm volatile("" : "+v"(tid));
    const int lane = tid & 63, wave = tid >> 6, l31 = lane & 31, hl = lane >> 5;
    bf16_t* Ks = (bf16_t*)shm;
    bf16_t* Vt = (bf16_t*)(shm + 18432);
    const bf16_t* proj = (const bf16_t*)(p.ws + WS_PROJ);
    bf16_t* att = (bf16_t*)(p.ws + WS_ATT);
    const float L2E = 1.4426950408889634f;
    const float SC2 = 0.125f * L2E;
    for (int item = blockIdx.x; item < 512; item += gridDim.x) {
        const int hk = item & 1, qb = (item >> 1) & 127, b = item >> 8;
        const int g = wave >> 1, qh = wave & 1, hq = hk * 4 + g;
        const int qrow0 = b * S + 128 * qb + 64 * qh;
        bf16x8 qf[2][4];
#pragma unroll
        for (int qi = 0; qi < 2; ++qi)
#pragma unroll
            for (int st = 0; st < 4; ++st) qf[qi][st] = *(const bf16x8*)(proj + (size_t)(qrow0 + 32 * qi + l31) * DIN + 1024 + 64 * hq + 16 * st + 8 * hl);
        const float sink2 = p.attn_sink[hq] * L2E;
        float mrun[2] = {sink2, sink2};
        float lrun[2] = {hl == 0 ? 1.f : 0.f, hl == 0 ? 1.f : 0.f};
        f32x16 oacc[2][2];
#pragma unroll
        for (int a = 0; a < 2; ++a)
#pragma unroll
            for (int c = 0; c < 2; ++c)
#pragma unroll
                for (int i = 0; i < 16; ++i) oacc[a][c][i] = 0.f;
        u32x4 kreg[2], vreg[2];
        int ci = (qb == 0) ? 1 : 0;
#define ATT_GLOAD(CI) do { const int _row0 = (CI) < 3 ? b * S + 128 * (qb - 1 + (CI)) : NLAT + b * LC + 128 * ((CI) - 3); \
        _Pragma("unroll") for (int _i = 0; _i < 2; ++_i) { const int _pi = tid + 512 * _i, _key = _pi >> 3, _part = _pi & 7; \
            const bf16_t* _src = proj + (size_t)(_row0 + _key) * DIN + 1536 + 64 * hk + 8 * _part; kreg[_i] = *(const u32x4*)_src; vreg[_i] = *(const u32x4*)(_src + 128); } } while (0)
        ATT_GLOAD(ci);
        while (ci < 5) {
            __syncthreads();
#pragma unroll
            for (int i = 0; i < 2; ++i) {
                const int pi = tid + 512 * i, key = pi >> 3, part = pi & 7;
                *(u32x4*)(Ks + key * 72 + 8 * part) = kreg[i];
#pragma unroll
                for (int e = 0; e < 8; ++e) { const unsigned w = vreg[i][e >> 1]; Vt[(8 * part + e) * 132 + key] = (bf16_t)((e & 1) ? (w >> 16) : (w & 0xFFFFu)); }
            }
            __syncthreads();
            int cn = ci + 1; if (cn == 2 && qb == 127) cn = 3;
            if (cn < 5) ATT_GLOAD(cn);
#pragma unroll 1
            for (int kt = 0; kt < 4; ++kt) {
                bf16x8 kf[4];
#pragma unroll
                for (int st = 0; st < 4; ++st) kf[st] = *(const bf16x8*)(Ks + (32 * kt + l31) * 72 + 16 * st + 8 * hl);
                bf16x8 vf[2][2];
#pragma unroll
                for (int db = 0; db < 2; ++db)
#pragma unroll
                    for (int s2 = 0; s2 < 2; ++s2) {
                        const bf16_t* vp = Vt + (32 * db + l31) * 132 + 32 * kt + 16 * s2 + 4 * hl;
                        const u32x2 lo = *(const u32x2*)vp, hi = *(const u32x2*)(vp + 8);
                        u32x4 w; w.x = lo.x; w.y = lo.y; w.z = hi.x; w.w = hi.y;
                        vf[db][s2] = __builtin_bit_cast(bf16x8, w);
                    }
#pragma unroll
                for (int qi = 0; qi < 2; ++qi) {
                    f32x16 s;
#pragma unroll
                    for (int i = 0; i < 16; ++i) s[i] = 0.f;
#pragma unroll
                    for (int st = 0; st < 4; ++st) s = __builtin_amdgcn_mfma_f32_32x32x16_bf16(kf[st], qf[qi][st], s, 0, 0, 0);
                    const int qrel = 64 * qh + 32 * qi + l31;
                    float mx = -1e30f;
#pragma unroll
                    for (int i = 0; i < 16; ++i) {
                        const int koff = 32 * kt + 8 * (i >> 2) + 4 * hl + (i & 3);
                        float v = s[i] * SC2;
                        if (ci == 0) v = (qrel <= koff) ? v : -1e30f;
                        if (ci == 2) v = (koff <= qrel) ? v : -1e30f;
                        s[i] = v; mx = fmaxf(mx, v);
                    }
                    mx = fmaxf(mx, __shfl_xor(mx, 32));
                    const float mnew = fmaxf(mrun[qi], mx);
                    const float alpha = __builtin_amdgcn_exp2f(mrun[qi] - mnew);
                    mrun[qi] = mnew;
                    float ls = 0.f;
#pragma unroll
                    for (int i = 0; i < 16; ++i) { s[i] = __builtin_amdgcn_exp2f(s[i] - mnew); ls += s[i]; }
                    lrun[qi] = lrun[qi] * alpha + ls;
                    bf16x8 pf[2];
#pragma unroll
                    for (int s2 = 0; s2 < 2; ++s2) {
                        u32x4 w; w.x = cvt_pk_bf16(s[8 * s2 + 0], s[8 * s2 + 1]); w.y = cvt_pk_bf16(s[8 * s2 + 2], s[8 * s2 + 3]);
                        w.z = cvt_pk_bf16(s[8 * s2 + 4], s[8 * s2 + 5]); w.w = cvt_pk_bf16(s[8 * s2 + 6], s[8 * s2 + 7]);
                        pf[s2] = __builtin_bit_cast(bf16x8, w);
                    }
#pragma unroll
                    for (int db = 0; db < 2; ++db) {
#pragma unroll
                        for (int i = 0; i < 16; ++i) oacc[db][qi][i] *= alpha;
#pragma unroll
                        for (int s2 = 0; s2 < 2; ++s2) oacc[db][qi] = __builtin_amdgcn_mfma_f32_32x32x16_bf16(vf[db][s2], pf[s2], oacc[db][qi], 0, 0, 0);
                    }
                }
            }
            ci = cn;
        }
#undef ATT_GLOAD
#pragma unroll
        for (int qi = 0; qi < 2; ++qi) {
            const float lt = lrun[qi] + __shfl_xor(lrun[qi], 32);
            const float inv = 1.0f / lt;
            bf16_t* orow = att + (size_t)(qrow0 + 32 * qi + l31) * 512 + hq * 64;
#pragma unroll
            for (int db = 0; db < 2; ++db)
#pragma unroll
                for (int g4 = 0; g4 < 4; ++g4) {
                    u32x2 w; w.x = cvt_pk_bf16(oacc[db][qi][4 * g4] * inv, oacc[db][qi][4 * g4 + 1] * inv); w.y = cvt_pk_bf16(oacc[db][qi][4 * g4 + 2] * inv, oacc[db][qi][4 * g4 + 3] * inv);
                    *(u32x2*)(orow + 32 * db + 8 * g4 + 4 * hl) = w;
                }
        }
    }
    __syncthreads();
}

__device__ __forceinline__ void scan_naive(const Params& p, unsigned char* shm) {
    const int c = threadIdx.x;
    float* xs = (float*)shm;
    const bf16_t* proj = (const bf16_t*)(p.ws + WS_PROJ);
    float* sumb = (float*)(p.ws + WS_SUM);
    float* tmp = (float*)(p.ws + WS_TMP);
    bf16_t* yl = (bf16_t*)(p.ws + WS_YL); bf16_t* caf = (bf16_t*)(p.ws + WS_CAF); bf16_t* cab = (bf16_t*)(p.ws + WS_CAB);
    for (int id = blockIdx.x; id < NCHUNK; id += gridDim.x) {
        int rowbase, t0, seqlen; bool latent;
        if (id < 512) { const int b = id >> 8, k = id & 255; t0 = 64 * k; rowbase = b * S + t0; seqlen = S; latent = true; }
        else { const int j = id - 512, b = j >> 2, k = j & 3; t0 = 64 * k; rowbase = NLAT + b * LC + t0; seqlen = LC; latent = false; }
        const int seqbase = rowbase - t0;
        {
            const float cw0 = p.rnn_conv_w[c], cw1 = p.rnn_conv_w[512 + c], cw2 = p.rnn_conv_w[1024 + c], cw3 = p.rnn_conv_w[1536 + c], cb = p.rnn_conv_b[c];
            auto ld = [&](int tt) -> float { return (tt >= 0 && tt < seqlen) ? bf2f(proj[(size_t)(seqbase + tt) * DIN + c]) : 0.f; };
            float xm2 = ld(t0 - 2), xm1 = ld(t0 - 1), x0 = ld(t0);
            for (int t = 0; t < 64; ++t) {
                const float xp1 = ld(t0 + t + 1);
                xs[t * 512 + c] = cb + cw0 * xm2 + cw1 * xm1 + cw2 * x0 + cw3 * xp1;
                xm2 = xm1; xm1 = x0; x0 = xp1;
            }
        }
        __syncthreads();
        const int n = c >> 6, dd = c & 63;
        for (int dir = 0; dir < 2; ++dir) {
            float wa[64], wi[64];
#pragma unroll
            for (int ci = 0; ci < 64; ++ci) {
                wa[ci] = p.lru_w_a[(size_t)((dir * 8 + n) * 64 + ci) * 64 + dd];
                wi[ci] = p.lru_w_i[(size_t)((dir * 8 + n) * 64 + ci) * 64 + dd];
            }
            const float ba = p.lru_b_a[dir * 512 + c], bi = p.lru_b_i[dir * 512 + c];
            const float sp = log1pf(expf(-p.lru_lam[dir * 512 + c]));
            float h = 0.f, A = 1.f;
            for (int step = 0; step < 64; ++step) {
                const int t = dir ? 63 - step : step;
                const float* xr = xs + t * 512 + n * 64;
                float ga = ba, gi = bi;
#pragma unroll
                for (int c4 = 0; c4 < 16; ++c4) {
                    const f32x4 xv = *(const f32x4*)(xr + 4 * c4);
                    ga += xv[0] * wa[4 * c4] + xv[1] * wa[4 * c4 + 1] + xv[2] * wa[4 * c4 + 2] + xv[3] * wa[4 * c4 + 3];
                    gi += xv[0] * wi[4 * c4] + xv[1] * wi[4 * c4 + 1] + xv[2] * wi[4 * c4 + 2] + xv[3] * wi[4 * c4 + 3];
                }
                const float rr = sigmoidf_(ga), ii = sigmoidf_(gi);
                const float la = -8.0f * rr * sp;
                const float a = expf(la);
                const float uu = sqrtf(-expm1f(2.0f * la)) * (ii * xs[t * 512 + c]);
                h = a * h + uu; A *= a;
                if (latent) {
                    const size_t o = (size_t)(rowbase + t) * 512 + c;
                    if (dir == 0) { tmp[o] = h; caf[o] = f2bf(A); }
                    else { yl[o] = f2bf(tmp[o] + h); cab[o] = f2bf(A); }
                }
            }
            sumb[((size_t)(dir * NCHUNK + id) * 2 + 0) * 512 + c] = A;
            sumb[((size_t)(dir * NCHUNK + id) * 2 + 1) * 512 + c] = h;
        }
        __syncthreads();
    }
}

__device__ __forceinline__ void carry_phase(const Params& p) {
    if (blockIdx.x >= 4) return;
    const int b = blockIdx.x >> 1, dir = blockIdx.x & 1, c = threadIdx.x;
    const float* sumb = (const float*)(p.ws + WS_SUM) + (size_t)dir * NCHUNK * 1024;
    float* car = (float*)(p.ws + WS_CAR) + (size_t)dir * NCHUNK * 512;
    float h = 0.f;
    for (int s = 0; s < 260; ++s) {
        int id;
        if (dir == 0) id = s < 4 ? 512 + 4 * b + s : 256 * b + (s - 4);
        else id = s < 4 ? 512 + 4 * b + (3 - s) : 256 * b + (255 - (s - 4));
        car[(size_t)id * 512 + c] = h;
        h = sumb[(size_t)id * 1024 + c] * h + sumb[(size_t)id * 1024 + 512 + c];
    }
}

__device__ __forceinline__ void mix_phase(const Params& p) {
    const int lane = threadIdx.x & 63, gw = blockIdx.x * 8 + (threadIdx.x >> 6), NGW = gridDim.x * 8;
    const bf16_t* proj = (const bf16_t*)(p.ws + WS_PROJ);
    const bf16_t* att = (const bf16_t*)(p.ws + WS_ATT);
    const bf16_t* yl = (const bf16_t*)(p.ws + WS_YL); const bf16_t* caf = (const bf16_t*)(p.ws + WS_CAF); const bf16_t* cab = (const bf16_t*)(p.ws + WS_CAB);
    const float* car = (const float*)(p.ws + WS_CAR);
    bf16_t* mix = (bf16_t*)(p.ws + WS_HB);
    const int c0 = 8 * lane;
    for (int r = gw; r < NLAT; r += NGW) {
        const int id = r >> 6;
        const u32x4 vy = *(const u32x4*)(yl + (size_t)r * 512 + c0), vf = *(const u32x4*)(caf + (size_t)r * 512 + c0), vb = *(const u32x4*)(cab + (size_t)r * 512 + c0);
        const u32x4 vg = *(const u32x4*)(proj + (size_t)r * DIN + 512 + c0), va = *(const u32x4*)(att + (size_t)r * 512 + c0);
        const float* cf = car + (size_t)id * 512 + c0; const float* cbk = car + (size_t)(NCHUNK + id) * 512 + c0;
        float rn[8], at[8]; float s1 = 0.f, s2 = 0.f;
#pragma unroll
        for (int e = 0; e < 8; ++e) {
            const unsigned wy = vy[e >> 1], wf = vf[e >> 1], wb = vb[e >> 1], wg = vg[e >> 1], wa = va[e >> 1];
            const float y = ((e & 1) ? bfhi(wy) : bflo(wy)) + ((e & 1) ? bfhi(wf) : bflo(wf)) * cf[e] + ((e & 1) ? bfhi(wb) : bflo(wb)) * cbk[e];
            const float xg = (e & 1) ? bfhi(wg) : bflo(wg);
            rn[e] = gelu_tanh_(xg) * y; s1 += rn[e] * rn[e];
            at[e] = (e & 1) ? bfhi(wa) : bflo(wa); s2 += at[e] * at[e];
        }
        const float r1 = rsqrtf(wave_sum(s1) * (1.0f / 512.0f) + EPS), r2 = rsqrtf(wave_sum(s2) * (1.0f / 512.0f) + EPS);
        u32x4 o1, o2;
#pragma unroll
        for (int e2 = 0; e2 < 4; ++e2) {
            o1[e2] = pk2(rn[2 * e2] * r1 * p.gn_rnn[c0 + 2 * e2], rn[2 * e2 + 1] * r1 * p.gn_rnn[c0 + 2 * e2 + 1]);
            o2[e2] = pk2(at[2 * e2] * r2 * p.gn_attn[c0 + 2 * e2], at[2 * e2 + 1] * r2 * p.gn_attn[c0 + 2 * e2 + 1]);
        }
        *(u32x4*)(mix + (size_t)r * D + c0) = o1; *(u32x4*)(mix + (size_t)r * D + 512 + c0) = o2;
    }
}

__device__ __forceinline__ void phase7(const Params& p) {
    const int lane = threadIdx.x & 63, gw = blockIdx.x * 8 + (threadIdx.x >> 6), NGW = gridDim.x * 8;
    const float* mod = (const float*)(p.ws + WS_MOD);
    bf16_t* hb = (bf16_t*)(p.ws + WS_HB);
    for (int r = gw; r < NLAT; r += NGW) {
        const int mi = r >> 14;
        norm_mod_row(p.out + (size_t)r * D, p.norm2_g, mod + mi * 6144 + 3072, mod + mi * 6144 + 4096, hb + (size_t)r * D, lane);
    }
}

__device__ __forceinline__ void convgate_phase(const Params& p, int hb) {
    const bf16_t* U = (const bf16_t*)(p.ws + WS_U);
    bf16_t* act = (bf16_t*)(p.ws + WS_ACT) + (size_t)hb * S * DFF;
    const size_t total = (size_t)S * (DFF / 8);
    for (size_t i = (size_t)blockIdx.x * 512 + threadIdx.x; i < total; i += (size_t)gridDim.x * 512) {
        const int t = (int)(i / (DFF / 8)), ch = (int)(i % (DFF / 8)) * 8;
        const int gcol = (ch / 128) * 256 + (ch % 128);
        const bf16_t* up = U + (size_t)t * DUP + gcol;
        const u32x4 z = {0u, 0u, 0u, 0u};
        const u32x4 g0 = t > 0 ? *(const u32x4*)(up - DUP) : z, g1 = *(const u32x4*)up, g2 = t < S - 1 ? *(const u32x4*)(up + DUP) : z;
        const u32x4 v0 = t > 0 ? *(const u32x4*)(up - DUP + 128) : z, v1 = *(const u32x4*)(up + 128), v2 = t < S - 1 ? *(const u32x4*)(up + DUP + 128) : z;
        u32x4 o;
#pragma unroll
        for (int e2 = 0; e2 < 4; ++e2) {
            float r[2];
#pragma unroll
            for (int h = 0; h < 2; ++h) {
                const int cg_ = ch + 2 * e2 + h, cv_ = cg_ + DFF;
                const float a0 = h ? bfhi(g0[e2]) : bflo(g0[e2]), a1 = h ? bfhi(g1[e2]) : bflo(g1[e2]), a2 = h ? bfhi(g2[e2]) : bflo(g2[e2]);
                const float b0 = h ? bfhi(v0[e2]) : bflo(v0[e2]), b1 = h ? bfhi(v1[e2]) : bflo(v1[e2]), b2 = h ? bfhi(v2[e2]) : bflo(v2[e2]);
                const float cg = p.ffn_conv_b[cg_] + p.ffn_conv_w[cg_] * a0 + p.ffn_conv_w[DUP + cg_] * a1 + p.ffn_conv_w[2 * DUP + cg_] * a2;
                const float cv = p.ffn_conv_b[cv_] + p.ffn_conv_w[cv_] * b0 + p.ffn_conv_w[DUP + cv_] * b1 + p.ffn_conv_w[2 * DUP + cv_] * b2;
                r[h] = silu_(cg) * cv;
            }
            o[e2] = pk2(r[0], r[1]);
        }
        *(u32x4*)(act + (size_t)t * DFF + ch) = o;
    }
}

__device__ __forceinline__ void final_phase(const Params& p) {
    const int lane = threadIdx.x & 63, gw = blockIdx.x * 8 + (threadIdx.x >> 6), NGW = gridDim.x * 8;
    for (int r = gw; r < NLAT; r += NGW) {
        float* row = p.out + (size_t)r * D;
        f32x4 v[4]; float ss = 0.f;
#pragma unroll
        for (int j = 0; j < 4; ++j) { v[j] = *(const f32x4*)(row + 4 * lane + 256 * j); ss += v[j][0] * v[j][0] + v[j][1] * v[j][1] + v[j][2] * v[j][2] + v[j][3] * v[j][3]; }
        const float rstd = rsqrtf(wave_sum(ss) * (1.0f / D) + EPS);
#pragma unroll
        for (int j = 0; j < 4; ++j) { const f32x4 gg = *(const f32x4*)(p.final_g + 4 * lane + 256 * j); *(f32x4*)(row + 4 * lane + 256 * j) = v[j] * rstd * gg; }
    }
}

__global__ void __launch_bounds__(512, 2) fwd_megakernel(Params p) {
    extern __shared__ __attribute__((aligned(16))) unsigned char shm[];
    cg::grid_group grid = cg::this_grid();
    LAS unsigned char* lds = (LAS unsigned char*)shm;
    unsigned char* ws = p.ws;
    const float* mod = (const float*)(ws + WS_MOD);
    pg8::StaticOrder so;

    phase0(p, shm);
    grid.sync();
    phase1(p);
    grid.sync();
    {
        pg8::Gemm g{(const bf16_t*)(ws + WS_HB), (const bf16_t*)(ws + WS_WIN), MROWS / 256, DIN / 256, D, 256};
        so.init(g.nM, g.nN, gridDim.x, blockIdx.x);
        EpiProj e{(bf16_t*)(ws + WS_PROJ), (const float*)(ws + WS_ROPE), (const float*)(ws + WS_ROPE) + 4096};
        pg8::gemm_phase(lds, g, so, e);
    }
    grid.sync();
    scan_naive(p, shm);
    attn_mfma(p, shm);
    grid.sync();
    carry_phase(p);
    grid.sync();
    mix_phase(p);
    grid.sync();
    {
        pg8::Gemm g{(const bf16_t*)(ws + WS_HB), (const bf16_t*)(ws + WS_WOUT), NLAT / 256, D / 256, D, 256};
        so.init(g.nM, g.nN, gridDim.x, blockIdx.x);
        EpiRes e{p.x, p.out, mod + 2048, mod + 6144 + 2048};
        pg8::gemm_phase(lds, g, so, e);
    }
    grid.sync();
    phase7(p);
    grid.sync();
    for (int hb = 0; hb < 2; ++hb) {
        pg8::Gemm g{(const bf16_t*)(ws + WS_HB) + (size_t)hb * S * D, (const bf16_t*)(ws + WS_WUP), S / 256, DUP / 256, D, 256};
        so.init(g.nM, g.nN, gridDim.x, blockIdx.x);
        EpiU e{(bf16_t*)(ws + WS_U)};
        pg8::gemm_phase(lds, g, so, e);
        grid.sync();
        convgate_phase(p, hb);
        grid.sync();
    }
    {
        pg8::Gemm g{(const bf16_t*)(ws + WS_ACT), (const bf16_t*)(ws + WS_WDN), NLAT / 256, D / 256, DFF, 256};
        so.init(g.nM, g.nN, gridDim.x, blockIdx.x);
        EpiRes e{p.out, p.out, mod + 5120, mod + 6144 + 5120};
        pg8::gemm_phase(lds, g, so, e);
    }
    grid.sync();
    final_phase(p);
}

extern "C" void kernel_launch(void* const* d_in, const int* in_sizes, int n_in, void* d_out, int out_size, void* d_ws, size_t ws_size, hipStream_t stream) {
    static int grid_blocks = 0;
    if (!grid_blocks) {
        int dev = 0, cus = 0, per_cu = 0;
        hipGetDevice(&dev);
        hipDeviceGetAttribute(&cus, hipDeviceAttributeMultiprocessorCount, dev);
        hipFuncSetAttribute((const void*)fwd_megakernel, hipFuncAttributeMaxDynamicSharedMemorySize, LDS_BYTES);
        hipOccupancyMaxActiveBlocksPerMultiprocessor(&per_cu, (const void*)fwd_megakernel, 512, LDS_BYTES);
        if (per_cu < 1) per_cu = 1;
        grid_blocks = cus * per_cu;
        if (ws_size < WS_END) fprintf(stderr, "kernel_launch: workspace too small: %zu < %zu\n", ws_size, (size_t)WS_END);
    }
    Params p{};
    const float** pp = (const float**)&p;
    for (int i = 0; i < 25; ++i) pp[i] = (const float*)d_in[i];
    p.out = (float*)d_out; p.ws = (unsigned char*)d_ws;
    void* args[] = {&p};
    hipError_t e = hipLaunchCooperativeKernel((const void*)fwd_megakernel, dim3(grid_blocks), dim3(512), args, LDS_BYTES, stream);
    if (e != hipSuccess) fprintf(stderr, "cooperative launch failed: %s (grid %d)\n", hipGetErrorString(e), grid_blocks);
}
```

```cpp
#include <hip/hip_runtime.h>
#include <hip/hip_cooperative_groups.h>
#include <cstdio>
namespace cg = cooperative_groups;

#define LAS __attribute__((address_space(3)))
typedef unsigned short bf16_t;
typedef short bf16x8 __attribute__((ext_vector_type(8)));
typedef float f32x4 __attribute__((ext_vector_type(4)));
typedef unsigned u32x4 __attribute__((ext_vector_type(4)));
typedef unsigned u32x2 __attribute__((ext_vector_type(2)));

constexpr int D = 1024, NB = 2, S = 16384, LC = 256;
constexpr int NLAT = NB * S;
constexpr int NCTX = NB * LC;
constexpr int MROWS = NLAT + NCTX;
constexpr int DIN = 1792, DFF = 2816, DUP = 5632, DRNN = 512;
constexpr int NCHUNK = MROWS / 64;
constexpr float EPS = 1e-6f;

constexpr size_t AL(size_t x) { return (x + 255) & ~(size_t)255; }
constexpr size_t WS_WIN  = 0;
constexpr size_t WS_WOUT = WS_WIN  + AL((size_t)DIN * D * 2);
constexpr size_t WS_WUP  = WS_WOUT + AL((size_t)D * D * 2);
constexpr size_t WS_WDN  = WS_WUP  + AL((size_t)DUP * D * 2);
constexpr size_t WS_LRU  = WS_WDN  + AL((size_t)D * DFF * 2);
constexpr size_t WS_MOD  = WS_LRU  + AL((size_t)4 * 8 * 64 * 64 * 2);
constexpr size_t WS_ROPE = WS_MOD  + AL((size_t)3 * 6144 * 4);
constexpr size_t WS_SUM  = WS_ROPE + AL((size_t)2 * 256 * 16 * 4);
constexpr size_t WS_CAR  = WS_SUM  + AL((size_t)2 * NCHUNK * 2 * 512 * 4);
constexpr size_t WS_BAR  = WS_CAR  + AL((size_t)2 * NCHUNK * 512 * 4);
constexpr size_t WS_HB   = WS_BAR  + 16384;
constexpr size_t WS_R1   = WS_HB   + AL((size_t)MROWS * D * 2);
constexpr size_t WS_PROJ = WS_R1;
constexpr size_t WS_ATT  = WS_PROJ + AL((size_t)MROWS * DIN * 2);
constexpr size_t WS_YL   = WS_ATT  + AL((size_t)NLAT * 512 * 2);
constexpr size_t WS_CAF  = WS_YL   + AL((size_t)NLAT * 512 * 2);
constexpr size_t WS_CAB  = WS_CAF  + AL((size_t)NLAT * 512 * 2);
constexpr size_t WS_R1END = WS_CAB + AL((size_t)NLAT * 512 * 2);
constexpr size_t WS_ACT  = WS_R1;
constexpr size_t WS_U    = WS_ACT + AL((size_t)NLAT * DFF * 2);
constexpr size_t WS_TMP  = WS_R1END;
constexpr size_t WS_END  = WS_U + AL((size_t)S * DUP * 2);
static_assert(WS_TMP + (size_t)NLAT * 512 * 4 <= WS_END, "tmp");
static_assert(WS_U >= WS_ACT + (size_t)NLAT * DFF * 2, "u");

constexpr int LDS_BYTES = 131072 + 8192 + 256;
constexpr int LDS_XB = 131072 + 8192;

struct Params {
    const float *x, *c, *ctx, *c_ctx, *w_mod, *b_mod, *norm1_g, *w_in, *rnn_conv_w, *rnn_conv_b, *lru_w_a, *lru_b_a,
        *lru_w_i, *lru_b_i, *lru_lam, *attn_sink, *gn_rnn, *gn_attn, *w_out, *norm2_g, *w_up, *ffn_conv_w, *ffn_conv_b,
        *w_down, *final_g;
    float* out;
    unsigned char* ws;
};

__device__ __forceinline__ bf16_t f2bf(float f) { unsigned u = __float_as_uint(f); u += 0x7FFFu + ((u >> 16) & 1u); return (bf16_t)(u >> 16); }
__device__ __forceinline__ float bf2f(bf16_t b) { return __uint_as_float(((unsigned)b) << 16); }
__device__ __forceinline__ unsigned pk2(float lo, float hi) { return (unsigned)f2bf(lo) | ((unsigned)f2bf(hi) << 16); }
__device__ __forceinline__ float bflo(unsigned w) { return __uint_as_float(w << 16); }
__device__ __forceinline__ float bfhi(unsigned w) { return __uint_as_float(w & 0xFFFF0000u); }
__device__ __forceinline__ float wave_sum(float v) {
#pragma unroll
    for (int o = 32; o >= 1; o >>= 1) v += __shfl_xor(v, o);
    return v;
}
__device__ __forceinline__ float wave_max(float v) {
#pragma unroll
    for (int o = 32; o >= 1; o >>= 1) v = fmaxf(v, __shfl_xor(v, o));
    return v;
}
__device__ __forceinline__ float sigmoidf_(float x) { return 1.0f / (1.0f + __expf(-x)); }
__device__ __forceinline__ float silu_(float x) { return x / (1.0f + __expf(-x)); }
__device__ __forceinline__ float gelu_tanh_(float x) {
    const float u = 0.7978845608028654f * (x + 0.044715f * x * x * x);
    const float e = __expf(2.0f * u);
    const float th = 1.0f - 2.0f / (e + 1.0f);
    return 0.5f * x * (1.0f + th);
}


#define XB_TMO      128
#define XB_XCNT(j)  (256  + 64 * (j))
#define XB_XSUB(j)  (1280 + 64 * (j))
#define XB_XGEN(j)  (2304 + 64 * (j))
#define XB_TOP      3328
#define XB_TOPGEN   3392
#define XCD_BAR_WORDS 3456
#define XB_SPIN_CAP (1u << 20)
__device__ __forceinline__ unsigned xb_ld(unsigned* p)              { return __hip_atomic_load(p, __ATOMIC_RELAXED, __HIP_MEMORY_SCOPE_AGENT); }
__device__ __forceinline__ unsigned xb_add(unsigned* p, unsigned v) { return __hip_atomic_fetch_add(p, v, __ATOMIC_RELAXED, __HIP_MEMORY_SCOPE_AGENT); }
__device__ __forceinline__ unsigned xb_xcc_id() { return (unsigned)__builtin_amdgcn_s_getreg((3 << 11) | 20) & 0xFu; }
#define XB_SPIN(cond, bar) do { unsigned _sp = 0; while (cond) { __builtin_amdgcn_s_sleep(1); \
    if ((++_sp & 255u) == 0u) { if (xb_ld(&(bar)[XB_TMO])) break; if (_sp > XB_SPIN_CAP) { atomicAdd(&(bar)[XB_TMO], 1u); break; } } } } while (0)
struct XcdBarrier { unsigned* bar; unsigned x; volatile LAS unsigned* st; };
__device__ __forceinline__ XcdBarrier xcd_barrier_post(unsigned* bar, volatile LAS unsigned* st) {
    XcdBarrier b; b.bar = bar; b.x = xb_xcc_id(); b.st = st;
    if (threadIdx.x == 0) (void)xb_add(&bar[XB_XCNT(b.x)], 1u);
    return b;
}
__device__ __forceinline__ void xcd_barrier_complete(unsigned* bar, unsigned x, unsigned& nloc, unsigned& nx) {
    const unsigned G = gridDim.x * gridDim.y * gridDim.z;
    unsigned sum, cnt, mine, sp = 0u;
    for (;;) {
        sum = 0u; cnt = 0u; mine = 0u;
#pragma unroll
        for (unsigned j = 0; j < 16; ++j) { const unsigned c = xb_ld(&bar[XB_XCNT(j)]); sum += c; cnt += (c > 0u) ? 1u : 0u; mine = (j == x) ? c : mine; }
        if (sum == G) break;
        __builtin_amdgcn_s_sleep(1);
        if ((++sp & 255u) == 0u) { if (xb_ld(&bar[XB_TMO])) break; if (sp > XB_SPIN_CAP) { atomicAdd(&bar[XB_TMO], 1u); break; } }
    }
    nloc = mine > 0u ? mine : 1u; nx = cnt > 0u ? cnt : 1u;
}
__device__ __forceinline__ void xcd_barrier(const XcdBarrier& b) {
    asm volatile("s_waitcnt vmcnt(0)" ::: "memory");
    __syncthreads();
    if (threadIdx.x == 0) {
        unsigned* bar = b.bar;
        __builtin_amdgcn_s_waitcnt(0);
        unsigned nloc = b.st[0], nx = b.st[1];
        if (nloc == 0u) { xcd_barrier_complete(bar, b.x, nloc, nx); b.st[0] = nloc; b.st[1] = nx; }
        const unsigned old = xb_add(&bar[XB_XSUB(b.x)], 1u);
        const unsigned gen = old / nloc;
        if (old + 1u == (gen + 1u) * nloc) {
            __builtin_amdgcn_fence(__ATOMIC_RELEASE, "agent");
            asm volatile("s_waitcnt vmcnt(0)" ::: "memory");
            const unsigned og = xb_add(&bar[XB_TOP], 1u);
            const unsigned tg = og / nx;
            if (og + 1u == (tg + 1u) * nx) xb_add(&bar[XB_TOPGEN], 1u);
            else XB_SPIN(xb_ld(&bar[XB_TOPGEN]) == tg, bar);
            __builtin_amdgcn_fence(__ATOMIC_ACQUIRE, "agent");
            xb_add(&bar[XB_XGEN(b.x)], 1u);
            asm volatile("s_waitcnt vmcnt(0)" ::: "memory");
        } else {
            XB_SPIN(xb_ld(&bar[XB_XGEN(b.x)]) == gen, bar);
            __builtin_amdgcn_fence(__ATOMIC_ACQUIRE, "agent");
            asm volatile("s_waitcnt vmcnt(0)" ::: "memory");
        }
    }
    __syncthreads();
}

namespace pg8 {
constexpr int BM = 256, BK = 64, HALF = 128, HTB = HALF * BK * 2, NXCD = 8, WGM = 8;
__host__ __device__ __forceinline__ int lds_byte(int r, int c) { const int st = (r >> 4) * 2 + (c >> 5), rr = r & 15, cc = c & 31, ob = rr * 64 + cc * 2; return st * 1024 + (ob ^ (((ob >> 9) & 1) << 5)); }
__host__ __device__ __forceinline__ void stage_rc(int b, int& R, int& C) { const int st = b / 1024, sb = b % 1024, swz = sb ^ (((sb >> 9) & 1) << 5); R = (st >> 1) * 16 + swz / 64; C = (st & 1) * 32 + (swz % 64) / 2; }
struct Unit { int pm, pn; };
struct Gemm { const bf16_t* A; const bf16_t* Bt; int nM, nN, K, a_tile_rows; };
struct StaticOrder {
    int nM, nN, nwg, G, c;
    __device__ void init(int nM_, int nN_, int G_, int c_) { nM = nM_; nN = nN_; nwg = nM * nN; G = G_; c = c_; }
    __device__ bool next(int i, Unit& u) const {
        const long L = (long)i * G + c; if (L >= nwg) return false;
        int wgid = (int)L; { const int q = nwg / NXCD, r = nwg % NXCD, xcd = wgid % NXCD, off = wgid / NXCD; wgid = (xcd < r ? xcd * (q + 1) : r * (q + 1) + (xcd - r) * q) + off; }
        const int nig = WGM * nN, gid = wgid / nig, fm = gid * WGM, gsz = (nM - fm) < WGM ? (nM - fm) : WGM;
        u.pm = fm + ((wgid % nig) % gsz); u.pn = (wgid % nig) / gsz; return true;
    }
};
template <class Epi>
__device__ __forceinline__ void gemm_phase(LAS unsigned char* lds, const Gemm g, const StaticOrder& S, const Epi& E) {
    int tid = threadIdx.x; asm volatile("" : "+v"(tid));
    const int wid = __builtin_amdgcn_readfirstlane(tid >> 6), lane = tid & 63, wr = wid >> 2, wc = wid & 3, fr = lane & 15, fq = lane >> 4;
    const int K = g.K, nt = K / BK;
    unsigned voffA[2], voffB[2];
#pragma unroll
    for (int i = 0; i < 2; ++i) { int R, C; stage_rc(tid * 16 + i * 8192, R, C); voffA[i] = (unsigned)(R * K + C) * 2u; voffB[i] = voffA[i]; }
    const size_t kstep = (size_t)(BK * 2);
    const size_t hstep = (size_t)HALF * K * 2;
    const size_t tstepA = (size_t)g.a_tile_rows * K * 2;
    const size_t tstepB = 2 * hstep;
    const unsigned ldsw = (unsigned)wid * 1024u;
    const int aoff = lds_byte(wr * 64 + fr, fq * 8), boff = lds_byte(wc * 32 + fr, fq * 8);
#define PG8_SA(b, h) (((b) * 2 + (h)) * HTB)
#define PG8_SB(b, h) ((4 + (b) * 2 + (h)) * HTB)
#define PG8_STAGE(bufoff, gbase, voff) do { _Pragma("unroll") for (int _i = 0; _i < 2; ++_i) \
        __builtin_amdgcn_global_load_lds((const unsigned*)((const char*)(gbase) + (voff)[_i]), (LAS unsigned*)(lds + (bufoff) + ldsw + _i * 8192), 16, 0, 0); } while (0)
#define PG8_LDA(dst, b, h) do { _Pragma("unroll") for (int m = 0; m < 4; ++m) _Pragma("unroll") for (int k = 0; k < 2; ++k) dst[m][k] = *(const LAS bf16x8*)(lds + PG8_SA(b, h) + aoff + m * 2048 + k * 1024); } while (0)
#define PG8_LDB(dst, b, h) do { _Pragma("unroll") for (int n = 0; n < 2; ++n) _Pragma("unroll") for (int k = 0; k < 2; ++k) dst[n][k] = *(const LAS bf16x8*)(lds + PG8_SB(b, h) + boff + n * 2048 + k * 1024); } while (0)
#define PG8_MMA(ai, bj, At, Bt) do { __builtin_amdgcn_s_setprio(1); _Pragma("unroll") for (int m = 0; m < 4; ++m) _Pragma("unroll") for (int n = 0; n < 2; ++n) _Pragma("unroll") for (int k = 0; k < 2; ++k) \
        acc[ai][bj][m][n] = __builtin_amdgcn_mfma_f32_16x16x32_bf16(Bt[n][k], At[m][k], acc[ai][bj][m][n], 0, 0, 0); __builtin_amdgcn_s_setprio(0); } while (0)
#define PG8_WAIT_V(n) asm volatile("s_waitcnt vmcnt(" #n ")" ::: "memory")
#define PG8_WAIT_L(n) asm volatile("s_waitcnt lgkmcnt(" #n ")" ::: "memory")
#define PG8_BAR __builtin_amdgcn_s_barrier()
#define PG8_SCHED __builtin_amdgcn_sched_barrier(0)
    Unit cur, nxt; int ui = 0;
    if (!S.next(0, cur)) return;
    f32x4 acc[2][2][4][2];
#pragma unroll
    for (int a = 0; a < 2; ++a)
#pragma unroll
        for (int b = 0; b < 2; ++b)
#pragma unroll
            for (int m = 0; m < 4; ++m)
#pragma unroll
                for (int n = 0; n < 2; ++n) acc[a][b][m][n] = (f32x4){0.f, 0.f, 0.f, 0.f};
    bf16x8 At[4][2], B0[2][2], B1[2][2];
    const char* cA = (const char*)g.A + (size_t)cur.pm * tstepA; const char* cB = (const char*)g.Bt + (size_t)cur.pn * tstepB;
    PG8_STAGE(PG8_SB(0, 0), cB, voffB); PG8_STAGE(PG8_SA(0, 0), cA, voffA); PG8_STAGE(PG8_SB(0, 1), cB + hstep, voffB); PG8_STAGE(PG8_SA(0, 1), cA + hstep, voffA);
    if (wr == 1) PG8_BAR;
    PG8_WAIT_V(4); PG8_BAR;
    PG8_STAGE(PG8_SB(1, 0), cB + kstep, voffB); PG8_STAGE(PG8_SA(1, 0), cA + kstep, voffA); PG8_STAGE(PG8_SB(1, 1), cB + hstep + kstep, voffB);
    PG8_WAIT_V(6); PG8_BAR;
    for (;;) {
        const bool has_next = S.next(ui + 1, nxt);
        const char* nA = has_next ? (const char*)g.A + (size_t)nxt.pm * tstepA : cA; const char* nB = has_next ? (const char*)g.Bt + (size_t)nxt.pn * tstepB : cB;
        for (int t = 0; t < nt; t += 2) {
            const bool last = (t == nt - 2);
            const char* a1 = cA + (size_t)(t + 1) * kstep;
            const char* a2 = last ? nA : cA + (size_t)(t + 2) * kstep; const char* b2 = last ? nB : cB + (size_t)(t + 2) * kstep;
            const char* a3 = a2 + kstep; const char* b3 = b2 + kstep;
            PG8_LDB(B0, 0, 0); PG8_SCHED; PG8_LDA(At, 0, 0); PG8_STAGE(PG8_SA(1, 1), a1 + hstep, voffA);
            PG8_WAIT_L(8); PG8_BAR; PG8_WAIT_L(0); PG8_MMA(0, 0, At, B0); PG8_BAR; PG8_SCHED;
            PG8_LDB(B1, 0, 1); PG8_STAGE(PG8_SB(0, 0), b2, voffB);
            PG8_BAR; PG8_WAIT_L(0); PG8_MMA(0, 1, At, B1); PG8_BAR;
            PG8_LDA(At, 0, 1); PG8_STAGE(PG8_SA(0, 0), a2, voffA);
            PG8_BAR; PG8_WAIT_L(0); PG8_MMA(1, 0, At, B0); PG8_BAR; PG8_SCHED;
            PG8_STAGE(PG8_SB(0, 1), b2 + hstep, voffB);
            PG8_WAIT_V(6); PG8_BAR; PG8_MMA(1, 1, At, B1); PG8_BAR;
            PG8_LDB(B0, 1, 0); PG8_SCHED; PG8_LDA(At, 1, 0); PG8_STAGE(PG8_SA(0, 1), a2 + hstep, voffA);
            PG8_WAIT_L(8); PG8_BAR; PG8_WAIT_L(0); PG8_MMA(0, 0, At, B0); PG8_BAR; PG8_SCHED;
            PG8_LDB(B1, 1, 1); PG8_STAGE(PG8_SB(1, 0), b3, voffB);
            PG8_BAR; PG8_WAIT_L(0); PG8_MMA(0, 1, At, B1); PG8_BAR;
            PG8_LDA(At, 1, 1); PG8_STAGE(PG8_SA(1, 0), a3, voffA);
            PG8_BAR; PG8_WAIT_L(0); PG8_MMA(1, 0, At, B0); PG8_BAR; PG8_SCHED;
            PG8_STAGE(PG8_SB(1, 1), b3 + hstep, voffB);
            PG8_WAIT_V(6); PG8_BAR; PG8_MMA(1, 1, At, B1); PG8_BAR;
        }
        E(acc, cur, wr, wc, fr, fq);
        if (!has_next) break;
#pragma unroll
        for (int a = 0; a < 2; ++a)
#pragma unroll
            for (int b = 0; b < 2; ++b)
#pragma unroll
                for (int m = 0; m < 4; ++m)
#pragma unroll
                    for (int n = 0; n < 2; ++n) acc[a][b][m][n] = (f32x4){0.f, 0.f, 0.f, 0.f};
        cur = nxt; cA = nA; cB = nB; ++ui;
    }
    PG8_WAIT_V(0);
    if (wr == 0) PG8_BAR;
    PG8_BAR;
#undef PG8_SA
#undef PG8_SB
#undef PG8_STAGE
#undef PG8_LDA
#undef PG8_LDB
#undef PG8_MMA
#undef PG8_WAIT_V
#undef PG8_WAIT_L
#undef PG8_BAR
#undef PG8_SCHED
}
}
using pg8::Unit;

struct EpiProj {
    bf16_t* O; const float* cosT; const float* sinT;
    __device__ __forceinline__ void operator()(const f32x4 (&acc)[2][2][4][2], const Unit& u, int wr, int wc, int fr, int fq) const {
        const bool latent = u.pm < 128;
#pragma unroll
        for (int ai = 0; ai < 2; ++ai)
#pragma unroll
            for (int m = 0; m < 4; ++m) {
                const int row = u.pm * 256 + ai * 128 + wr * 64 + m * 16 + fr;
                const int t = row & (S - 1);
                const int pos = (wc & 1) ? (t & 63) : (t >> 6);
#pragma unroll
                for (int bj = 0; bj < 2; ++bj) {
                    const int col = u.pn * 256 + bj * 128 + wc * 32 + 4 * fq;
                    f32x4 v0 = acc[ai][bj][m][0], v1 = acc[ai][bj][m][1];
                    const bool rope = latent && (u.pn == 4 || u.pn == 5 || (u.pn == 6 && bj == 0));
                    if (rope) {
                        const f32x4 cs = *(const f32x4*)(cosT + pos * 16 + 4 * fq), sn = *(const f32x4*)(sinT + pos * 16 + 4 * fq);
                        const f32x4 n0 = v0 * cs - v1 * sn, n1 = v1 * cs + v0 * sn; v0 = n0; v1 = n1;
                    }
                    bf16_t* p = O + (size_t)row * DIN + col;
                    u32x2 w0, w1; w0.x = pk2(v0[0], v0[1]); w0.y = pk2(v0[2], v0[3]); w1.x = pk2(v1[0], v1[1]); w1.y = pk2(v1[2], v1[3]);
                    *(u32x2*)p = w0; *(u32x2*)(p + 16) = w1;
                }
            }
    }
};
struct EpiRes {
    const float* src; float* dst; const float* gate0; const float* gate1;
    __device__ __forceinline__ void operator()(const f32x4 (&acc)[2][2][4][2], const Unit& u, int wr, int wc, int fr, int fq) const {
        const float* gate = (u.pm >= 64) ? gate1 : gate0;
        f32x4 gv[2][2];
#pragma unroll
        for (int bj = 0; bj < 2; ++bj)
#pragma unroll
            for (int n = 0; n < 2; ++n) gv[bj][n] = *(const f32x4*)(gate + u.pn * 256 + bj * 128 + wc * 32 + n * 16 + 4 * fq);
#pragma unroll
        for (int ai = 0; ai < 2; ++ai)
#pragma unroll
            for (int m = 0; m < 4; ++m) {
                const size_t row = (size_t)u.pm * 256 + ai * 128 + wr * 64 + m * 16 + fr;
#pragma unroll
                for (int bj = 0; bj < 2; ++bj)
#pragma unroll
                    for (int n = 0; n < 2; ++n) {
                        const size_t o = row * D + u.pn * 256 + bj * 128 + wc * 32 + n * 16 + 4 * fq;
                        const f32x4 s = *(const f32x4*)(src + o);
                        *(f32x4*)(dst + o) = s + gv[bj][n] * acc[ai][bj][m][n];
                    }
            }
    }
};
struct EpiU {
    bf16_t* O;
    __device__ __forceinline__ void operator()(const f32x4 (&acc)[2][2][4][2], const Unit& u, int wr, int wc, int fr, int fq) const {
#pragma unroll
        for (int ai = 0; ai < 2; ++ai)
#pragma unroll
            for (int m = 0; m < 4; ++m) {
                const size_t row = (size_t)u.pm * 256 + ai * 128 + wr * 64 + m * 16 + fr;
#pragma unroll
                for (int bj = 0; bj < 2; ++bj)
#pragma unroll
                    for (int n = 0; n < 2; ++n) {
                        const f32x4 v = acc[ai][bj][m][n];
                        u32x2 w; w.x = pk2(v[0], v[1]); w.y = pk2(v[2], v[3]);
                        *(u32x2*)(O + row * DUP + u.pn * 256 + bj * 128 + wc * 32 + n * 16 + 4 * fq) = w;
                    }
            }
    }
};

__device__ __forceinline__ void transpose_item(const float* W, int N, int k0, int n0, bf16_t* dst, int Kd, float* scr, int lane) {
#pragma unroll 8
    for (int i = 0; i < 32; ++i) { const int kk = 2 * i + (lane >> 5); scr[kk * 33 + (lane & 31)] = W[(size_t)(k0 + kk) * N + n0 + (lane & 31)]; }
    __builtin_amdgcn_wave_barrier();
    const int c = lane & 7;
#pragma unroll
    for (int j = 0; j < 4; ++j) {
        const int n = (lane >> 3) + 8 * j; const float* s = scr + (8 * c) * 33 + n;
        u32x4 o; o.x = pk2(s[0], s[33]); o.y = pk2(s[2 * 33], s[3 * 33]); o.z = pk2(s[4 * 33], s[5 * 33]); o.w = pk2(s[6 * 33], s[7 * 33]);
        *(u32x4*)(dst + (size_t)n * Kd + k0 + 8 * c) = o;
    }
    __builtin_amdgcn_wave_barrier();
}

__device__ __forceinline__ void phase0(const Params& p, unsigned char* shm) {
    const int tid = threadIdx.x, lane = tid & 63, wave = tid >> 6;
    unsigned char* ws = p.ws;
    if (blockIdx.x < 192) {
        float* sv = (float*)shm;
        float* red = sv + 3 * 1024;
        for (int i = tid; i < 3 * 1024; i += 512) {
            const int j = i >> 10, k = i & 1023;
            const float v = (j < 2) ? p.c[j * 1024 + k] : p.c_ctx[k];
            sv[i] = silu_(v);
        }
        __syncthreads();
        const int n0 = blockIdx.x * 32, col = tid & 31, ks = tid >> 5;
        float a0 = 0.f, a1 = 0.f, a2 = 0.f;
        const float* wp = p.w_mod + (size_t)(ks * 64) * 6144 + n0 + col;
#pragma unroll 8
        for (int k = 0; k < 64; ++k) {
            const float w = wp[(size_t)k * 6144];
            a0 += sv[ks * 64 + k] * w; a1 += sv[1024 + ks * 64 + k] * w; a2 += sv[2048 + ks * 64 + k] * w;
        }
        red[(ks * 3 + 0) * 32 + col] = a0; red[(ks * 3 + 1) * 32 + col] = a1; red[(ks * 3 + 2) * 32 + col] = a2;
        __syncthreads();
        if (tid < 96) {
            const int j = tid >> 5, cc = tid & 31; float s = p.b_mod[n0 + cc];
            for (int k = 0; k < 16; ++k) s += red[(k * 3 + j) * 32 + cc];
            ((float*)(ws + WS_MOD))[j * 6144 + n0 + cc] = s;
        }
        __syncthreads();
    }
    if (blockIdx.x >= 192 && blockIdx.x < 200) {
        const int idx = (blockIdx.x - 192) * 512 + tid;
        const int pos = idx >> 4, i = idx & 15;
        const float inv = powf(10000.0f, -(float)i / 16.0f);
        const float ang = (float)pos * inv;
        ((float*)(ws + WS_ROPE))[idx] = cosf(ang);
        ((float*)(ws + WS_ROPE))[4096 + idx] = sinf(ang);
    }
    float* scr = (float*)(shm + 32768) + wave * (64 * 33);
    const int gw = blockIdx.x * 8 + wave, NGW = gridDim.x * 8;
    constexpr int I_IN = (D / 64) * (DIN / 32), I_OUT = (D / 64) * (D / 32), I_UP = (D / 64) * (DUP / 32), I_DN = (DFF / 64) * (D / 32), I_LRU = 2 * 2 * 8 * 2;
    constexpr int NIT = I_IN + I_OUT + I_UP + I_DN + I_LRU;
    for (int it = gw; it < NIT; it += NGW) {
        int r = it;
        if (r < I_IN) { const int nb = DIN / 32, kb = r / nb, n0 = (r % nb) * 32; transpose_item(p.w_in, DIN, kb * 64, n0, (bf16_t*)(ws + WS_WIN) + (size_t)n0 * D, D, scr, lane); continue; } r -= I_IN;
        if (r < I_OUT) { const int nb = D / 32, kb = r / nb, n0 = (r % nb) * 32; transpose_item(p.w_out, D, kb * 64, n0, (bf16_t*)(ws + WS_WOUT) + (size_t)n0 * D, D, scr, lane); continue; } r -= I_OUT;
        if (r < I_UP) { const int nb = DUP / 32, kb = r / nb, n0 = (r % nb) * 32;
            const int isv = n0 >= DFF, nn = isv ? n0 - DFF : n0, drow = (nn / 128) * 256 + isv * 128 + (nn % 128);
            transpose_item(p.w_up, DUP, kb * 64, n0, (bf16_t*)(ws + WS_WUP) + (size_t)drow * D, D, scr, lane); continue; } r -= I_UP;
        if (r < I_DN) { const int nb = D / 32, kb = r / nb, n0 = (r % nb) * 32; transpose_item(p.w_down, D, kb * 64, n0, (bf16_t*)(ws + WS_WDN) + (size_t)n0 * DFF, DFF, scr, lane); continue; } r -= I_DN;
        {
            const int nh = r & 1, blk = (r >> 1) & 7, type = (r >> 4) & 1, dir = r >> 5;
            const float* src = (type ? p.lru_w_i : p.lru_w_a) + (size_t)(dir * 8 + blk) * 4096;
            bf16_t* dst = (bf16_t*)(ws + WS_LRU) + (size_t)((dir * 2 + type) * 8 + blk) * 4096 + (size_t)(nh * 32) * 64;
            transpose_item(src, 64, 0, nh * 32, dst, 64, scr, lane);
        }
    }
}

__device__ __forceinline__ void norm_mod_row(const float* src, const float* g, const float* sh, const float* sc, bf16_t* dst, int lane) {
    f32x4 v[4]; float ss = 0.f;
#pragma unroll
    for (int j = 0; j < 4; ++j) { v[j] = *(const f32x4*)(src + 4 * lane + 256 * j); ss += v[j][0] * v[j][0] + v[j][1] * v[j][1] + v[j][2] * v[j][2] + v[j][3] * v[j][3]; }
    const float rstd = rsqrtf(wave_sum(ss) * (1.0f / D) + EPS);
#pragma unroll
    for (int j = 0; j < 4; ++j) {
        const int c = 4 * lane + 256 * j;
        const f32x4 gg = *(const f32x4*)(g + c), s1 = *(const f32x4*)(sc + c), s0 = *(const f32x4*)(sh + c);
        const f32x4 o = (v[j] * rstd * gg) * (s1 + 1.0f) + s0;
        u32x2 w; w.x = pk2(o[0], o[1]); w.y = pk2(o[2], o[3]);
        *(u32x2*)(dst + c) = w;
    }
}
__device__ __forceinline__ void phase1(const Params& p) {
    const int lane = threadIdx.x & 63, gw = blockIdx.x * 8 + (threadIdx.x >> 6), NGW = gridDim.x * 8;
    const float* mod = (const float*)(p.ws + WS_MOD);
    bf16_t* hb = (bf16_t*)(p.ws + WS_HB);
    for (int r = gw; r < MROWS; r += NGW) {
        const int mi = r < NLAT ? (r >> 14) : 2;
        const float* src = r < NLAT ? p.x + (size_t)r * D : p.ctx + (size_t)(r - NLAT) * D;
        norm_mod_row(src, p.norm1_g, mod + mi * 6144, mod + mi * 6144 + 1024, hb + (size_t)r * D, lane);
    }
}

__device__ __forceinline__ void attn_naive(const Params& p, unsigned char* shm) {
    const int lane = threadIdx.x & 63, wave = threadIdx.x >> 6, gw = blockIdx.x * 8 + wave, NGW = gridDim.x * 8;
    float* qs = (float*)shm + wave * 640;
    float* ps = qs + 64;
    const bf16_t* proj = (const bf16_t*)(p.ws + WS_PROJ);
    bf16_t* att = (bf16_t*)(p.ws + WS_ATT);
    for (int item = gw; item < NLAT * 8; item += NGW) {
        const int r = item >> 3, hq = item & 7, hk = hq >> 2, b = r >> 14, t = r & (S - 1);
        qs[lane] = bf2f(proj[(size_t)r * DIN + 1024 + hq * 64 + lane]);
        __builtin_amdgcn_wave_barrier();
        float sc[9];
#pragma unroll
        for (int i = 0; i < 9; ++i) {
            int kp; bool valid; const bf16_t* krow;
            if (i < 5) { kp = t - 128 + lane + 64 * i; valid = kp >= 0 && kp < S && kp <= t + 128; krow = proj + (size_t)(b * S + (valid ? kp : 0)) * DIN + 1536 + hk * 64; }
            else { kp = lane + 64 * (i - 5); valid = true; krow = proj + (size_t)(NLAT + b * LC + kp) * DIN + 1536 + hk * 64; }
            float s = 0.f;
#pragma unroll
            for (int d8 = 0; d8 < 8; ++d8) {
                const u32x4 kv = *(const u32x4*)(krow + 8 * d8);
                const f32x4 q0 = *(const f32x4*)(qs + 8 * d8), q1 = *(const f32x4*)(qs + 8 * d8 + 4);
                s += q0[0] * bflo(kv.x) + q0[1] * bfhi(kv.x) + q0[2] * bflo(kv.y) + q0[3] * bfhi(kv.y)
                   + q1[0] * bflo(kv.z) + q1[1] * bfhi(kv.z) + q1[2] * bflo(kv.w) + q1[3] * bfhi(kv.w);
            }
            sc[i] = valid ? s * 0.125f : -1e30f;
        }
        const float sink = p.attn_sink[hq];
        float mx = sink;
#pragma unroll
        for (int i = 0; i < 9; ++i) mx = fmaxf(mx, sc[i]);
        mx = wave_max(mx);
        float sum = 0.f;
#pragma unroll
        for (int i = 0; i < 9; ++i) { const float e = sc[i] > -1e29f ? __expf(sc[i] - mx) : 0.f; ps[i * 64 + lane] = e; sum += e; }
        sum = wave_sum(sum) + __expf(sink - mx);
        __builtin_amdgcn_wave_barrier();
        float o = 0.f;
        const int jlo = max(0, 128 - t), jhi = min(256, S - 1 - t + 128);
        const bf16_t* vb = proj + (long)(b * S + t - 128) * DIN + 1664 + hk * 64 + lane;
        for (int j = jlo; j <= jhi; ++j) o += ps[j] * bf2f(vb[(long)j * DIN]);
        const bf16_t* vc = proj + (size_t)(NLAT + b * LC) * DIN + 1664 + hk * 64 + lane;
#pragma unroll 4
        for (int j = 0; j < 256; ++j) o += ps[320 + j] * bf2f(vc[(size_t)j * DIN]);
        att[(size_t)r * 512 + hq * 64 + lane] = f2bf(o / sum);
        __builtin_amdgcn_wave_barrier();
    }
}


typedef float f32x16 __attribute__((ext_vector_type(16)));
__device__ __forceinline__ unsigned cvt_pk_bf16(float lo, float hi) { unsigned r; asm("v_cvt_pk_bf16_f32 %0, %1, %2" : "=v"(r) : "v"(lo), "v"(hi)); return r; }
__device__ __forceinline__ void attn_mfma(const Params& p, unsigned char* shm) {
    int tid = threadIdx.x; asm volatile("" : "+v"(tid));
    const int lane = tid & 63, wave = tid >> 6, l31 = lane & 31, hl = lane >> 5;
    bf16_t* Ks = (bf16_t*)shm;
    bf16_t* Vt = (bf16_t*)(shm + 18432);
    const bf16_t* proj = (const bf16_t*)(p.ws + WS_PROJ);
    bf16_t* att = (bf16_t*)(p.ws + WS_ATT);
    const float L2E = 1.4426950408889634f;
    const float SC2 = 0.125f * L2E;
    for (int item = blockIdx.x; item < 512; item += gridDim.x) {
        const int hk = item & 1, qb = (item >> 1) & 127, b = item >> 8;
        const int g = wave >> 1, qh = wave & 1, hq = hk * 4 + g;
        const int qrow0 = b * S + 128 * qb + 64 * qh;
        bf16x8 qf[2][4];
#pragma unroll
        for (int qi = 0; qi < 2; ++qi)
#pragma unroll
            for (int st = 0; st < 4; ++st) qf[qi][st] = *(const bf16x8*)(proj + (size_t)(qrow0 + 32 * qi + l31) * DIN + 1024 + 64 * hq + 16 * st + 8 * hl);
        const float sink2 = p.attn_sink[hq] * L2E;
        float mrun[2] = {sink2, sink2};
        float lrun[2] = {hl == 0 ? 1.f : 0.f, hl == 0 ? 1.f : 0.f};
        f32x16 oacc[2][2];
#pragma unroll
        for (int a = 0; a < 2; ++a)
#pragma unroll
            for (int c = 0; c < 2; ++c)
#pragma unroll
                for (int i = 0; i < 16; ++i) oacc[a][c][i] = 0.f;
        u32x4 kreg[2], vreg[2];
        int ci = (qb == 0) ? 1 : 0;
#define ATT_GLOAD(CI) do { const int _row0 = (CI) < 3 ? b * S + 128 * (qb - 1 + (CI)) : NLAT + b * LC + 128 * ((CI) - 3); \
        _Pragma("unroll") for (int _i = 0; _i < 2; ++_i) { const int _pi = tid + 512 * _i, _key = _pi >> 3, _part = _pi & 7; \
            const bf16_t* _src = proj + (size_t)(_row0 + _key) * DIN + 1536 + 64 * hk + 8 * _part; kreg[_i] = *(const u32x4*)_src; vreg[_i] = *(const u32x4*)(_src + 128); } } while (0)
        ATT_GLOAD(ci);
        while (ci < 5) {
            __syncthreads();
#pragma unroll
            for (int i = 0; i < 2; ++i) {
                const int pi = tid + 512 * i, key = pi >> 3, part = pi & 7;
                *(u32x4*)(Ks + key * 72 + 8 * part) = kreg[i];
#pragma unroll
                for (int e = 0; e < 8; ++e) { const unsigned w = vreg[i][e >> 1]; Vt[(8 * part + e) * 132 + key] = (bf16_t)((e & 1) ? (w >> 16) : (w & 0xFFFFu)); }
            }
            __syncthreads();
            int cn = ci + 1; if (cn == 2 && qb == 127) cn = 3;
            if (cn < 5) ATT_GLOAD(cn);
#pragma unroll 1
            for (int kt = 0; kt < 4; ++kt) {
                bf16x8 kf[4];
#pragma unroll
                for (int st = 0; st < 4; ++st) kf[st] = *(const bf16x8*)(Ks + (32 * kt + l31) * 72 + 16 * st + 8 * hl);
                bf16x8 vf[2][2];
#pragma unroll
                for (int db = 0; db < 2; ++db)
#pragma unroll
                    for (int s2 = 0; s2 < 2; ++s2) {
                        const bf16_t* vp = Vt + (32 * db + l31) * 132 + 32 * kt + 16 * s2 + 4 * hl;
                        const u32x2 lo = *(const u32x2*)vp, hi = *(const u32x2*)(vp + 8);
                        u32x4 w; w.x = lo.x; w.y = lo.y; w.z = hi.x; w.w = hi.y;
                        vf[db][s2] = __builtin_bit_cast(bf16x8, w);
                    }
#pragma unroll
                for (int qi = 0; qi < 2; ++qi) {
                    f32x16 s;
#pragma unroll
                    for (int i = 0; i < 16; ++i) s[i] = 0.f;
#pragma unroll
                    for (int st = 0; st < 4; ++st) s = __builtin_amdgcn_mfma_f32_32x32x16_bf16(kf[st], qf[qi][st], s, 0, 0, 0);
                    const int qrel = 64 * qh + 32 * qi + l31;
                    float mx = -1e30f;
#pragma unroll
                    for (int i = 0; i < 16; ++i) {
                        const int koff = 32 * kt + 8 * (i >> 2) + 4 * hl + (i & 3);
                        float v = s[i] * SC2;
                        if (ci == 0) v = (qrel <= koff) ? v : -1e30f;
                        if (ci == 2) v = (koff <= qrel) ? v : -1e30f;
                        s[i] = v; mx = fmaxf(mx, v);
                    }
                    mx = fmaxf(mx, __shfl_xor(mx, 32));
                    const float mnew = fmaxf(mrun[qi], mx);
                    const float alpha = __builtin_amdgcn_exp2f(mrun[qi] - mnew);
                    mrun[qi] = mnew;
                    float ls = 0.f;
#pragma unroll
                    for (int i = 0; i < 16; ++i) { s[i] = __builtin_amdgcn_exp2f(s[i] - mnew); ls += s[i]; }
                    lrun[qi] = lrun[qi] * alpha + ls;
                    bf16x8 pf[2];
#pragma unroll
                    for (int s2 = 0; s2 < 2; ++s2) {
                        u32x4 w; w.x = cvt_pk_bf16(s[8 * s2 + 0], s[8 * s2 + 1]); w.y = cvt_pk_bf16(s[8 * s2 + 2], s[8 * s2 + 3]);
                        w.z = cvt_pk_bf16(s[8 * s2 + 4], s[8 * s2 + 5]); w.w = cvt_pk_bf16(s[8 * s2 + 6], s[8 * s2 + 7]);
                        pf[s2] = __builtin_bit_cast(bf16x8, w);
                    }
#pragma unroll
                    for (int db = 0; db < 2; ++db) {
#pragma unroll
                        for (int i = 0; i < 16; ++i) oacc[db][qi][i] *= alpha;
#pragma unroll
                        for (int s2 = 0; s2 < 2; ++s2) oacc[db][qi] = __builtin_amdgcn_mfma_f32_32x32x16_bf16(vf[db][s2], pf[s2], oacc[db][qi], 0, 0, 0);
                    }
                }
            }
            ci = cn;
        }
#undef ATT_GLOAD
#pragma unroll
        for (int qi = 0; qi < 2; ++qi) {
            const float lt = lrun[qi] + __shfl_xor(lrun[qi], 32);
            const float inv = 1.0f / lt;
            bf16_t* orow = att + (size_t)(qrow0 + 32 * qi + l31) * 512 + hq * 64;
#pragma unroll
            for (int db = 0; db < 2; ++db)
#pragma unroll
                for (int g4 = 0; g4 < 4; ++g4) {
                    u32x2 w; w.x = cvt_pk_bf16(oacc[db][qi][4 * g4] * inv, oacc[db][qi][4 * g4 + 1] * inv); w.y = cvt_pk_bf16(oacc[db][qi][4 * g4 + 2] * inv, oacc[db][qi][4 * g4 + 3] * inv);
                    *(u32x2*)(orow + 32 * db + 8 * g4 + 4 * hl) = w;
                }
        }
    }
    __syncthreads();
}

__device__ __forceinline__ void scan_naive(const Params& p, unsigned char* shm) {
    const int c = threadIdx.x;
    float* xs = (float*)shm;
    const bf16_t* proj = (const bf16_t*)(p.ws + WS_PROJ);
    float* sumb = (float*)(p.ws + WS_SUM);
    float* tmp = (float*)(p.ws + WS_TMP);
    bf16_t* yl = (bf16_t*)(p.ws + WS_YL); bf16_t* caf = (bf16_t*)(p.ws + WS_CAF); bf16_t* cab = (bf16_t*)(p.ws + WS_CAB);
    for (int id = blockIdx.x; id < NCHUNK; id += gridDim.x) {
        int rowbase, t0, seqlen; bool latent;
        if (id < 512) { const int b = id >> 8, k = id & 255; t0 = 64 * k; rowbase = b * S + t0; seqlen = S; latent = true; }
        else { const int j = id - 512, b = j >> 2, k = j & 3; t0 = 64 * k; rowbase = NLAT + b * LC + t0; seqlen = LC; latent = false; }
        const int seqbase = rowbase - t0;
        {
            const float cw0 = p.rnn_conv_w[c], cw1 = p.rnn_conv_w[512 + c], cw2 = p.rnn_conv_w[1024 + c], cw3 = p.rnn_conv_w[1536 + c], cb = p.rnn_conv_b[c];
            auto ld = [&](int tt) -> float { return (tt >= 0 && tt < seqlen) ? bf2f(proj[(size_t)(seqbase + tt) * DIN + c]) : 0.f; };
            float xm2 = ld(t0 - 2), xm1 = ld(t0 - 1), x0 = ld(t0);
            for (int t = 0; t < 64; ++t) {
                const float xp1 = ld(t0 + t + 1);
                xs[t * 512 + c] = cb + cw0 * xm2 + cw1 * xm1 + cw2 * x0 + cw3 * xp1;
                xm2 = xm1; xm1 = x0; x0 = xp1;
            }
        }
        __syncthreads();
        const int n = c >> 6, dd = c & 63;
        for (int dir = 0; dir < 2; ++dir) {
            float wa[64], wi[64];
#pragma unroll
            for (int ci = 0; ci < 64; ++ci) {
                wa[ci] = p.lru_w_a[(size_t)((dir * 8 + n) * 64 + ci) * 64 + dd];
                wi[ci] = p.lru_w_i[(size_t)((dir * 8 + n) * 64 + ci) * 64 + dd];
            }
            const float ba = p.lru_b_a[dir * 512 + c], bi = p.lru_b_i[dir * 512 + c];
            const float sp = log1pf(expf(-p.lru_lam[dir * 512 + c]));
            float h = 0.f, A = 1.f;
            for (int step = 0; step < 64; ++step) {
                const int t = dir ? 63 - step : step;
                const float* xr = xs + t * 512 + n * 64;
                float ga = ba, gi = bi;
#pragma unroll
                for (int c4 = 0; c4 < 16; ++c4) {
                    const f32x4 xv = *(const f32x4*)(xr + 4 * c4);
                    ga += xv[0] * wa[4 * c4] + xv[1] * wa[4 * c4 + 1] + xv[2] * wa[4 * c4 + 2] + xv[3] * wa[4 * c4 + 3];
                    gi += xv[0] * wi[4 * c4] + xv[1] * wi[4 * c4 + 1] + xv[2] * wi[4 * c4 + 2] + xv[3] * wi[4 * c4 + 3];
                }
                const float rr = sigmoidf_(ga), ii = sigmoidf_(gi);
                const float la = -8.0f * rr * sp;
                const float a = expf(la);
                const float uu = sqrtf(-expm1f(2.0f * la)) * (ii * xs[t * 512 + c]);
                h = a * h + uu; A *= a;
                if (latent) {
                    const size_t o = (size_t)(rowbase + t) * 512 + c;
                    if (dir == 0) { tmp[o] = h; caf[o] = f2bf(A); }
                    else { yl[o] = f2bf(tmp[o] + h); cab[o] = f2bf(A); }
                }
            }
            sumb[((size_t)(dir * NCHUNK + id) * 2 + 0) * 512 + c] = A;
            sumb[((size_t)(dir * NCHUNK + id) * 2 + 1) * 512 + c] = h;
        }
        __syncthreads();
    }
}


template <int DIR>
__device__ __forceinline__ void scan_dir(const Params& p, const bf16_t* xs, int n, int ct, int l31, int hl, int id, int rowbase, bool latent, float (&hf)[2][16]) {
    constexpr int XS = 520;
    const int ch = 64 * n + 32 * ct + l31;
    const float ba = p.lru_b_a[DIR * 512 + ch], bi = p.lru_b_i[DIR * 512 + ch];
    const float sp8 = -8.0f * log1pf(expf(-p.lru_lam[DIR * 512 + ch]));
    const bf16_t* lru = (const bf16_t*)(p.ws + WS_LRU);
    const bf16_t* wa_p = lru + (size_t)((DIR * 2 + 0) * 8 + n) * 4096 + (32 * ct + l31) * 64 + 8 * hl;
    const bf16_t* wi_p = lru + (size_t)((DIR * 2 + 1) * 8 + n) * 4096 + (32 * ct + l31) * 64 + 8 * hl;
    bf16x8 wfa[4], wfi[4];
#pragma unroll
    for (int st = 0; st < 4; ++st) { wfa[st] = *(const bf16x8*)(wa_p + 16 * st); wfi[st] = *(const bf16x8*)(wi_p + 16 * st); }
    float a[2][16], u[2][16];
#pragma unroll
    for (int rt = 0; rt < 2; ++rt) {
        bf16x8 af[4];
#pragma unroll
        for (int st = 0; st < 4; ++st) af[st] = *(const bf16x8*)(xs + (32 * rt + l31) * XS + 64 * n + 16 * st + 8 * hl);
        f32x16 ga, gi;
#pragma unroll
        for (int i = 0; i < 16; ++i) { ga[i] = 0.f; gi[i] = 0.f; }
#pragma unroll
        for (int st = 0; st < 4; ++st) { ga = __builtin_amdgcn_mfma_f32_32x32x16_bf16(af[st], wfa[st], ga, 0, 0, 0); gi = __builtin_amdgcn_mfma_f32_32x32x16_bf16(af[st], wfi[st], gi, 0, 0, 0); }
#pragma unroll
        for (int i = 0; i < 16; ++i) {
            const int token = 32 * rt + 8 * (i >> 2) + 4 * hl + (i & 3);
            const float xv = bf2f(xs[token * XS + ch]);
            const float rr = sigmoidf_(ga[i] + ba), ii = sigmoidf_(gi[i] + bi);
            const float la = rr * sp8;
            const float av = __expf(la);
            const float t2 = 2.0f * la;
            const float em1 = (t2 > -0.1f) ? t2 * (1.0f + t2 * (0.5f + t2 * (0.16666667f + t2 * (0.041666668f + t2 * 0.0083333333f)))) : (__expf(t2) - 1.0f);
            a[rt][i] = av; u[rt][i] = sqrtf(-em1) * (ii * xv);
        }
    }
    float Ao[8], Ho[8], Ap[8], Hp[8];
#pragma unroll
    for (int k = 0; k < 8; ++k) {
        const int rt = k >> 2, g = k & 3;
        float H = 0.f, A = 1.f;
#pragma unroll
        for (int jj = 0; jj < 4; ++jj) { const int j = DIR ? 3 - jj : jj; const float av = a[rt][4 * g + j]; H = av * H + u[rt][4 * g + j]; A *= av; }
        Ao[k] = A; Ho[k] = H; Ap[k] = __shfl_xor(A, 32); Hp[k] = __shfl_xor(H, 32);
    }
    float Sin[8], Pin[8]; float Sx = 0.f, Px = 1.f;
#pragma unroll
    for (int kk = 0; kk < 8; ++kk) {
        const int k = DIR ? 7 - kk : kk;
        const float A0 = hl ? Ap[k] : Ao[k], H0 = hl ? Hp[k] : Ho[k], A1 = hl ? Ao[k] : Ap[k], H1 = hl ? Ho[k] : Hp[k];
        float s0, p0, s1, p1;
        if (DIR == 0) { s0 = Sx; p0 = Px; Sx = A0 * Sx + H0; Px *= A0; s1 = Sx; p1 = Px; Sx = A1 * Sx + H1; Px *= A1; }
        else          { s1 = Sx; p1 = Px; Sx = A1 * Sx + H1; Px *= A1; s0 = Sx; p0 = Px; Sx = A0 * Sx + H0; Px *= A0; }
        Sin[k] = hl ? s1 : s0; Pin[k] = hl ? p1 : p0;
    }
    bf16_t* yl = (bf16_t*)(p.ws + WS_YL) + (size_t)rowbase * 512; bf16_t* caf = (bf16_t*)(p.ws + WS_CAF) + (size_t)rowbase * 512; bf16_t* cab = (bf16_t*)(p.ws + WS_CAB) + (size_t)rowbase * 512;
    unsigned lo = (unsigned)ch; asm volatile("" : "+v"(lo));
#pragma unroll
    for (int k = 0; k < 8; ++k) {
        const int rt = k >> 2, g = k & 3;
        float h = Sin[k], P = Pin[k];
#pragma unroll
        for (int jj = 0; jj < 4; ++jj) {
            const int j = DIR ? 3 - jj : jj, idx = 4 * g + j;
            h = a[rt][idx] * h + u[rt][idx]; P *= a[rt][idx];
            const int token = 32 * rt + 8 * g + 4 * hl + j;
            const unsigned o = lo + (unsigned)token * 512u;
            if (DIR == 0) { hf[rt][idx] = h; if (latent) caf[o] = f2bf(P); }
            else if (latent) { yl[o] = f2bf(hf[rt][idx] + h); cab[o] = f2bf(P); }
        }
    }
    if (hl == 0) {
        float* sumb = (float*)(p.ws + WS_SUM);
        sumb[((size_t)(DIR * NCHUNK + id) * 2 + 0) * 512 + ch] = Px;
        sumb[((size_t)(DIR * NCHUNK + id) * 2 + 1) * 512 + ch] = Sx;
    }
}
__device__ __forceinline__ void scan_mfma(const Params& p, unsigned char* shm) {
    int tid = threadIdx.x; asm volatile("" : "+v"(tid));
    const int lane = tid & 63, n = tid >> 6, l31 = lane & 31, hl = lane >> 5;
    constexpr int XS = 520;
    bf16_t* xs = (bf16_t*)shm;
    const bf16_t* proj = (const bf16_t*)(p.ws + WS_PROJ);
    for (int id = blockIdx.x; id < NCHUNK; id += gridDim.x) {
        int rowbase, t0, seqlen; bool latent;
        if (id < 512) { const int b = id >> 8, k = id & 255; t0 = 64 * k; rowbase = b * S + t0; seqlen = S; latent = true; }
        else { const int j = id - 512, b = j >> 2, k = j & 3; t0 = 64 * k; rowbase = NLAT + b * LC + t0; seqlen = LC; latent = false; }
        const int seqbase = rowbase - t0;
        {
            const int c = tid;
            const float cw0 = p.rnn_conv_w[c], cw1 = p.rnn_conv_w[512 + c], cw2 = p.rnn_conv_w[1024 + c], cw3 = p.rnn_conv_w[1536 + c], cb = p.rnn_conv_b[c];
            auto ld = [&](int tt) -> float { return (tt >= 0 && tt < seqlen) ? bf2f(proj[(size_t)(seqbase + tt) * DIN + c]) : 0.f; };
            float xm2 = ld(t0 - 2), xm1 = ld(t0 - 1), x0 = ld(t0);
#pragma unroll 8
            for (int t = 0; t < 64; ++t) {
                const float xp1 = ld(t0 + t + 1);
                xs[t * XS + c] = f2bf(cb + cw0 * xm2 + cw1 * xm1 + cw2 * x0 + cw3 * xp1);
                xm2 = xm1; xm1 = x0; x0 = xp1;
            }
        }
        __syncthreads();
#pragma unroll 1
        for (int ct = 0; ct < 2; ++ct) {
            float hf[2][16];
            scan_dir<0>(p, xs, n, ct, l31, hl, id, rowbase, latent, hf);
            scan_dir<1>(p, xs, n, ct, l31, hl, id, rowbase, latent, hf);
        }
        __syncthreads();
    }
}

__device__ __forceinline__ void carry_phase(const Params& p) {
    if (blockIdx.x >= 4) return;
    const int b = blockIdx.x >> 1, dir = blockIdx.x & 1, c = threadIdx.x;
    const float* sumb = (const float*)(p.ws + WS_SUM) + (size_t)dir * NCHUNK * 1024;
    float* car = (float*)(p.ws + WS_CAR) + (size_t)dir * NCHUNK * 512;
    float h = 0.f;
    for (int s = 0; s < 260; ++s) {
        int id;
        if (dir == 0) id = s < 4 ? 512 + 4 * b + s : 256 * b + (s - 4);
        else id = s < 4 ? 512 + 4 * b + (3 - s) : 256 * b + (255 - (s - 4));
        car[(size_t)id * 512 + c] = h;
        h = sumb[(size_t)id * 1024 + c] * h + sumb[(size_t)id * 1024 + 512 + c];
    }
}

__device__ __forceinline__ void mix_phase(const Params& p) {
    const int lane = threadIdx.x & 63, gw = blockIdx.x * 8 + (threadIdx.x >> 6), NGW = gridDim.x * 8;
    const bf16_t* proj = (const bf16_t*)(p.ws + WS_PROJ);
    const bf16_t* att = (const bf16_t*)(p.ws + WS_ATT);
    const bf16_t* yl = (const bf16_t*)(p.ws + WS_YL); const bf16_t* caf = (const bf16_t*)(p.ws + WS_CAF); const bf16_t* cab = (const bf16_t*)(p.ws + WS_CAB);
    const float* car = (const float*)(p.ws + WS_CAR);
    bf16_t* mix = (bf16_t*)(p.ws + WS_HB);
    const int c0 = 8 * lane;
    for (int r = gw; r < NLAT; r += NGW) {
        const int id = r >> 6;
        const u32x4 vy = *(const u32x4*)(yl + (size_t)r * 512 + c0), vf = *(const u32x4*)(caf + (size_t)r * 512 + c0), vb = *(const u32x4*)(cab + (size_t)r * 512 + c0);
        const u32x4 vg = *(const u32x4*)(proj + (size_t)r * DIN + 512 + c0), va = *(const u32x4*)(att + (size_t)r * 512 + c0);
        const float* cf = car + (size_t)id * 512 + c0; const float* cbk = car + (size_t)(NCHUNK + id) * 512 + c0;
        float rn[8], at[8]; float s1 = 0.f, s2 = 0.f;
#pragma unroll
        for (int e = 0; e < 8; ++e) {
            const unsigned wy = vy[e >> 1], wf = vf[e >> 1], wb = vb[e >> 1], wg = vg[e >> 1], wa = va[e >> 1];
            const float y = ((e & 1) ? bfhi(wy) : bflo(wy)) + ((e & 1) ? bfhi(wf) : bflo(wf)) * cf[e] + ((e & 1) ? bfhi(wb) : bflo(wb)) * cbk[e];
            const float xg = (e & 1) ? bfhi(wg) : bflo(wg);
            rn[e] = gelu_tanh_(xg) * y; s1 += rn[e] * rn[e];
            at[e] = (e & 1) ? bfhi(wa) : bflo(wa); s2 += at[e] * at[e];
        }
        const float r1 = rsqrtf(wave_sum(s1) * (1.0f / 512.0f) + EPS), r2 = rsqrtf(wave_sum(s2) * (1.0f / 512.0f) + EPS);
        u32x4 o1, o2;
#pragma unroll
        for (int e2 = 0; e2 < 4; ++e2) {
            o1[e2] = pk2(rn[2 * e2] * r1 * p.gn_rnn[c0 + 2 * e2], rn[2 * e2 + 1] * r1 * p.gn_rnn[c0 + 2 * e2 + 1]);
            o2[e2] = pk2(at[2 * e2] * r2 * p.gn_attn[c0 + 2 * e2], at[2 * e2 + 1] * r2 * p.gn_attn[c0 + 2 * e2 + 1]);
        }
        *(u32x4*)(mix + (size_t)r * D + c0) = o1; *(u32x4*)(mix + (size_t)r * D + 512 + c0) = o2;
    }
}

__device__ __forceinline__ void phase7(const Params& p) {
    const int lane = threadIdx.x & 63, gw = blockIdx.x * 8 + (threadIdx.x >> 6), NGW = gridDim.x * 8;
    const float* mod = (const float*)(p.ws + WS_MOD);
    bf16_t* hb = (bf16_t*)(p.ws + WS_HB);
    for (int r = gw; r < NLAT; r += NGW) {
        const int mi = r >> 14;
        norm_mod_row(p.out + (size_t)r * D, p.norm2_g, mod + mi * 6144 + 3072, mod + mi * 6144 + 4096, hb + (size_t)r * D, lane);
    }
}

__device__ __forceinline__ void convgate_phase(const Params& p, int hb) {
    const bf16_t* U = (const bf16_t*)(p.ws + WS_U);
    bf16_t* act = (bf16_t*)(p.ws + WS_ACT) + (size_t)hb * S * DFF;
    const size_t total = (size_t)S * (DFF / 8);
    for (size_t i = (size_t)blockIdx.x * 512 + threadIdx.x; i < total; i += (size_t)gridDim.x * 512) {
        const int t = (int)(i / (DFF / 8)), ch = (int)(i % (DFF / 8)) * 8;
        const int gcol = (ch / 128) * 256 + (ch % 128);
        const bf16_t* up = U + (size_t)t * DUP + gcol;
        const u32x4 z = {0u, 0u, 0u, 0u};
        const u32x4 g0 = t > 0 ? *(const u32x4*)(up - DUP) : z, g1 = *(const u32x4*)up, g2 = t < S - 1 ? *(const u32x4*)(up + DUP) : z;
        const u32x4 v0 = t > 0 ? *(const u32x4*)(up - DUP + 128) : z, v1 = *(const u32x4*)(up + 128), v2 = t < S - 1 ? *(const u32x4*)(up + DUP + 128) : z;
        u32x4 o;
#pragma unroll
        for (int e2 = 0; e2 < 4; ++e2) {
            float r[2];
#pragma unroll
            for (int h = 0; h < 2; ++h) {
                const int cg_ = ch + 2 * e2 + h, cv_ = cg_ + DFF;
                const float a0 = h ? bfhi(g0[e2]) : bflo(g0[e2]), a1 = h ? bfhi(g1[e2]) : bflo(g1[e2]), a2 = h ? bfhi(g2[e2]) : bflo(g2[e2]);
                const float b0 = h ? bfhi(v0[e2]) : bflo(v0[e2]), b1 = h ? bfhi(v1[e2]) : bflo(v1[e2]), b2 = h ? bfhi(v2[e2]) : bflo(v2[e2]);
                const float cg = p.ffn_conv_b[cg_] + p.ffn_conv_w[cg_] * a0 + p.ffn_conv_w[DUP + cg_] * a1 + p.ffn_conv_w[2 * DUP + cg_] * a2;
                const float cv = p.ffn_conv_b[cv_] + p.ffn_conv_w[cv_] * b0 + p.ffn_conv_w[DUP + cv_] * b1 + p.ffn_conv_w[2 * DUP + cv_] * b2;
                r[h] = silu_(cg) * cv;
            }
            o[e2] = pk2(r[0], r[1]);
        }
        *(u32x4*)(act + (size_t)t * DFF + ch) = o;
    }
}

__device__ __forceinline__ void final_phase(const Params& p) {
    const int lane = threadIdx.x & 63, gw = blockIdx.x * 8 + (threadIdx.x >> 6), NGW = gridDim.x * 8;
    for (int r = gw; r < NLAT; r += NGW) {
        float* row = p.out + (size_t)r * D;
        f32x4 v[4]; float ss = 0.f;
#pragma unroll
        for (int j = 0; j < 4; ++j) { v[j] = *(const f32x4*)(row + 4 * lane + 256 * j); ss += v[j][0] * v[j][0] + v[j][1] * v[j][1] + v[j][2] * v[j][2] + v[j][3] * v[j][3]; }
        const float rstd = rsqrtf(wave_sum(ss) * (1.0f / D) + EPS);
#pragma unroll
        for (int j = 0; j < 4; ++j) { const f32x4 gg = *(const f32x4*)(p.final_g + 4 * lane + 256 * j); *(f32x4*)(row + 4 * lane + 256 * j) = v[j] * rstd * gg; }
    }
}

__global__ void __launch_bounds__(512, 2) fwd_megakernel(Params p) {
    extern __shared__ __attribute__((aligned(16))) unsigned char shm[];
    cg::grid_group grid = cg::this_grid();
    LAS unsigned char* lds = (LAS unsigned char*)shm;
    unsigned char* ws = p.ws;
    const float* mod = (const float*)(ws + WS_MOD);
    pg8::StaticOrder so;
    volatile LAS unsigned* xst = (volatile LAS unsigned*)(lds + LDS_XB);
    if (threadIdx.x == 0) { xst[0] = 0u; xst[1] = 0u; }
    __syncthreads();
    const XcdBarrier xb = xcd_barrier_post((unsigned*)(ws + WS_BAR), xst);

    phase0(p, shm);
    grid.sync();

    phase1(p);
    xcd_barrier(xb);
    {
        pg8::Gemm g{(const bf16_t*)(ws + WS_HB), (const bf16_t*)(ws + WS_WIN), MROWS / 256, DIN / 256, D, 256};
        so.init(g.nM, g.nN, gridDim.x, blockIdx.x);
        EpiProj e{(bf16_t*)(ws + WS_PROJ), (const float*)(ws + WS_ROPE), (const float*)(ws + WS_ROPE) + 4096};
        pg8::gemm_phase(lds, g, so, e);
    }
    xcd_barrier(xb);
    scan_mfma(p, shm);
    attn_mfma(p, shm);
    xcd_barrier(xb);
    carry_phase(p);
    xcd_barrier(xb);
    mix_phase(p);
    xcd_barrier(xb);
    {
        pg8::Gemm g{(const bf16_t*)(ws + WS_HB), (const bf16_t*)(ws + WS_WOUT), NLAT / 256, D / 256, D, 256};
        so.init(g.nM, g.nN, gridDim.x, blockIdx.x);
        EpiRes e{p.x, p.out, mod + 2048, mod + 6144 + 2048};
        pg8::gemm_phase(lds, g, so, e);
    }
    xcd_barrier(xb);
    phase7(p);
    xcd_barrier(xb);
    for (int hb = 0; hb < 2; ++hb) {
        pg8::Gemm g{(const bf16_t*)(ws + WS_HB) + (size_t)hb * S * D, (const bf16_t*)(ws + WS_WUP), S / 256, DUP / 256, D, 256};
        so.init(g.nM, g.nN, gridDim.x, blockIdx.x);
        EpiU e{(bf16_t*)(ws + WS_U)};
        pg8::gemm_phase(lds, g, so, e);
        xcd_barrier(xb);
        convgate_phase(p, hb);
        xcd_barrier(xb);
    }
    {
        pg8::Gemm g{(const bf16_t*)(ws + WS_ACT), (const bf16_t*)(ws + WS_WDN), NLAT / 256, D / 256, DFF, 256};
        so.init(g.nM, g.nN, gridDim.x, blockIdx.x);
        EpiRes e{p.out, p.out, mod + 5120, mod + 6144 + 5120};
        pg8::gemm_phase(lds, g, so, e);
    }
    xcd_barrier(xb);
    final_phase(p);
}

extern "C" void kernel_launch(void* const* d_in, const int* in_sizes, int n_in, void* d_out, int out_size, void* d_ws, size_t ws_size, hipStream_t stream) {
    static int grid_blocks = 0;
    if (!grid_blocks) {
        int dev = 0, cus = 0, per_cu = 0;
        hipGetDevice(&dev);
        hipDeviceGetAttribute(&cus, hipDeviceAttributeMultiprocessorCount, dev);
        hipFuncSetAttribute((const void*)fwd_megakernel, hipFuncAttributeMaxDynamicSharedMemorySize, LDS_BYTES);
        hipOccupancyMaxActiveBlocksPerMultiprocessor(&per_cu, (const void*)fwd_megakernel, 512, LDS_BYTES);
        if (per_cu < 1) per_cu = 1;
        grid_blocks = cus * per_cu;
        if (ws_size < WS_END) fprintf(stderr, "kernel_launch: workspace too small: %zu < %zu\n", ws_size, (size_t)WS_END);
    }
    Params p{};
    const float** pp = (const float**)&p;
    for (int i = 0; i < 25; ++i) pp[i] = (const float*)d_in[i];
    p.out = (float*)d_out; p.ws = (unsigned char*)d_ws;
    hipMemsetAsync((unsigned char*)d_ws + WS_BAR, 0, 16384, stream);
    void* args[] = {&p};
    hipError_t e = hipLaunchCooperativeKernel((const void*)fwd_megakernel, dim3(grid_blocks), dim3(512), args, LDS_BYTES, stream);
    if (e != hipSuccess) fprintf(stderr, "cooperative launch failed: %s (grid %d)\n", hipGetErrorString(e), grid_blocks);
}
```

```cpp
#include <hip/hip_runtime.h>
#include <hip/hip_cooperative_groups.h>
#include <cstdio>
namespace cg = cooperative_groups;

#define LAS __attribute__((address_space(3)))
typedef unsigned short bf16_t;
typedef short bf16x8 __attribute__((ext_vector_type(8)));
typedef float f32x4 __attribute__((ext_vector_type(4)));
typedef unsigned u32x4 __attribute__((ext_vector_type(4)));
typedef unsigned u32x2 __attribute__((ext_vector_type(2)));

constexpr int D = 1024, NB = 2, S = 16384, LC = 256;
constexpr int NLAT = NB * S;
constexpr int NCTX = NB * LC;
constexpr int MROWS = NLAT + NCTX;
constexpr int DIN = 1792, DFF = 2816, DUP = 5632, DRNN = 512;
constexpr int NCHUNK = MROWS / 64;
constexpr float EPS = 1e-6f;

constexpr size_t AL(size_t x) { return (x + 255) & ~(size_t)255; }
constexpr size_t WS_WIN  = 0;
constexpr size_t WS_WOUT = WS_WIN  + AL((size_t)DIN * D * 2);
constexpr size_t WS_WUP  = WS_WOUT + AL((size_t)D * D * 2);
constexpr size_t WS_WDN  = WS_WUP  + AL((size_t)DUP * D * 2);
constexpr size_t WS_LRU  = WS_WDN  + AL((size_t)D * DFF * 2);
constexpr size_t WS_MOD  = WS_LRU  + AL((size_t)4 * 8 * 64 * 64 * 2);
constexpr size_t WS_ROPE = WS_MOD  + AL((size_t)3 * 6144 * 4);
constexpr size_t WS_SUM  = WS_ROPE + AL((size_t)2 * 256 * 16 * 4);
constexpr size_t WS_CAR  = WS_SUM  + AL((size_t)2 * NCHUNK * 2 * 512 * 4);
constexpr size_t WS_SP8  = WS_CAR  + AL((size_t)2 * NCHUNK * 512 * 4);
constexpr size_t WS_BAR  = WS_SP8  + 4096;
constexpr size_t WS_HB   = WS_BAR  + 16384;
constexpr size_t WS_R1   = WS_HB   + AL((size_t)MROWS * D * 2);
constexpr size_t WS_PROJ = WS_R1;
constexpr size_t WS_ATT  = WS_PROJ + AL((size_t)MROWS * DIN * 2);
constexpr size_t WS_YL   = WS_ATT  + AL((size_t)NLAT * 512 * 2);
constexpr size_t WS_CAF  = WS_YL   + AL((size_t)NLAT * 512 * 2);
constexpr size_t WS_CAB  = WS_CAF  + AL((size_t)NLAT * 512 * 2);
constexpr size_t WS_R1END = WS_CAB + AL((size_t)NLAT * 512 * 2);
constexpr size_t WS_ACT  = WS_R1;
constexpr size_t WS_O1   = WS_ACT + AL((size_t)NLAT * DFF * 2);
constexpr size_t WS_O2   = WS_HB;
constexpr size_t WS_END  = WS_R1END;
static_assert(WS_O1 + (size_t)NLAT * D * 2 <= WS_R1END, "o1");
static_assert(WS_ACT + (size_t)NLAT * DFF * 2 <= WS_R1END, "act");
constexpr int H2_BSTRIDE = 65 * 254;
constexpr int H2_ROWS = 130 * 254 + 2;
static_assert((size_t)H2_ROWS * D * 2 <= (size_t)MROWS * D * 2, "h2");

constexpr int LDS_BYTES = 131072 + 8192 + 256;
constexpr int LDS_XB = 131072 + 8192;

struct Params {
    const float *x, *c, *ctx, *c_ctx, *w_mod, *b_mod, *norm1_g, *w_in, *rnn_conv_w, *rnn_conv_b, *lru_w_a, *lru_b_a,
        *lru_w_i, *lru_b_i, *lru_lam, *attn_sink, *gn_rnn, *gn_attn, *w_out, *norm2_g, *w_up, *ffn_conv_w, *ffn_conv_b,
        *w_down, *final_g;
    float* out;
    unsigned char* ws;
};

typedef const Params __attribute__((address_space(4)))* PP;
__device__ __forceinline__ PP kparams() { PP k = (PP)__builtin_amdgcn_kernarg_segment_ptr(); asm volatile("" : "+s"(k)); return k; }
__device__ __forceinline__ int lane_fresh() { unsigned m = ~0u; asm volatile("" : "+s"(m)); return (int)__builtin_amdgcn_mbcnt_hi(m, __builtin_amdgcn_mbcnt_lo(m, 0u)); }
__device__ __forceinline__ int tid_opaque(int wv) { return wv * 64 + lane_fresh(); }
__device__ __forceinline__ bf16_t f2bf(float f) { unsigned u = __float_as_uint(f); u += 0x7FFFu + ((u >> 16) & 1u); return (bf16_t)(u >> 16); }
__device__ __forceinline__ float bf2f(bf16_t b) { return __uint_as_float(((unsigned)b) << 16); }
__device__ __forceinline__ unsigned pk2(float lo, float hi) { unsigned r; asm("v_cvt_pk_bf16_f32 %0, %1, %2" : "=v"(r) : "v"(lo), "v"(hi)); return r; }
__device__ __forceinline__ float bflo(unsigned w) { return __uint_as_float(w << 16); }
__device__ __forceinline__ float bfhi(unsigned w) { return __uint_as_float(w & 0xFFFF0000u); }
__device__ __forceinline__ float wave_sum(float v) {
#pragma unroll
    for (int o = 32; o >= 1; o >>= 1) v += __shfl_xor(v, o);
    return v;
}
__device__ __forceinline__ float wave_max(float v) {
#pragma unroll
    for (int o = 32; o >= 1; o >>= 1) v = fmaxf(v, __shfl_xor(v, o));
    return v;
}
__device__ __forceinline__ float sigmoidf_(float x) { return 1.0f / (1.0f + __expf(-x)); }
__device__ __forceinline__ float fast_sigmoid(float x) { return __builtin_amdgcn_rcpf(1.0f + __builtin_amdgcn_exp2f(-1.4426950408889634f * x)); }
__device__ __forceinline__ float silu_(float x) { return x * fast_sigmoid(x); }
__device__ __forceinline__ float gelu_tanh_(float x) {
    const float u = 0.7978845608028654f * (x + 0.044715f * x * x * x);
    const float e = __expf(2.0f * u);
    const float th = 1.0f - 2.0f / (e + 1.0f);
    return 0.5f * x * (1.0f + th);
}


#define XB_TMO      128
#define XB_XCNT(j)  (256  + 64 * (j))
#define XB_XSUB(j)  (1280 + 64 * (j))
#define XB_XGEN(j)  (2304 + 64 * (j))
#define XB_TOP      3328
#define XB_TOPGEN   3392
#define XCD_BAR_WORDS 3456
#define XB_SPIN_CAP (1u << 20)
__device__ __forceinline__ unsigned xb_ld(unsigned* p)              { return __hip_atomic_load(p, __ATOMIC_RELAXED, __HIP_MEMORY_SCOPE_AGENT); }
__device__ __forceinline__ unsigned xb_add(unsigned* p, unsigned v) { return __hip_atomic_fetch_add(p, v, __ATOMIC_RELAXED, __HIP_MEMORY_SCOPE_AGENT); }
__device__ __forceinline__ unsigned xb_xcc_id() { return (unsigned)__builtin_amdgcn_s_getreg((3 << 11) | 20) & 0xFu; }
#define XB_SPIN(cond, bar) do { unsigned _sp = 0; while (cond) { __builtin_amdgcn_s_sleep(1); \
    if ((++_sp & 255u) == 0u) { if (xb_ld(&(bar)[XB_TMO])) break; if (_sp > XB_SPIN_CAP) { atomicAdd(&(bar)[XB_TMO], 1u); break; } } } } while (0)
struct XcdBarrier { unsigned* bar; unsigned x; volatile LAS unsigned* st; };
__device__ __forceinline__ XcdBarrier xcd_barrier_post(unsigned* bar, volatile LAS unsigned* st, int wv) {
    XcdBarrier b; b.bar = bar; b.x = xb_xcc_id(); b.st = st;
    if (tid_opaque(wv) == 0) (void)xb_add(&bar[XB_XCNT(b.x)], 1u);
    return b;
}
__device__ __forceinline__ void xcd_barrier_complete(unsigned* bar, unsigned x, unsigned& nloc, unsigned& nx) {
    const unsigned G = gridDim.x * gridDim.y * gridDim.z;
    unsigned sum, cnt, mine, sp = 0u;
    for (;;) {
        sum = 0u; cnt = 0u; mine = 0u;
#pragma unroll
        for (unsigned j = 0; j < 16; ++j) { const unsigned c = xb_ld(&bar[XB_XCNT(j)]); sum += c; cnt += (c > 0u) ? 1u : 0u; mine = (j == x) ? c : mine; }
        if (sum == G) break;
        __builtin_amdgcn_s_sleep(1);
        if ((++sp & 255u) == 0u) { if (xb_ld(&bar[XB_TMO])) break; if (sp > XB_SPIN_CAP) { atomicAdd(&bar[XB_TMO], 1u); break; } }
    }
    nloc = mine > 0u ? mine : 1u; nx = cnt > 0u ? cnt : 1u;
}
__device__ __forceinline__ void xcd_barrier(const XcdBarrier& b, int wv) {
    asm volatile("s_waitcnt vmcnt(0)" ::: "memory");
    __syncthreads();
    if (tid_opaque(wv) == 0) {
        unsigned* bar = b.bar;
        __builtin_amdgcn_s_waitcnt(0);
        unsigned nloc = b.st[0], nx = b.st[1];
        if (nloc == 0u) { xcd_barrier_complete(bar, b.x, nloc, nx); b.st[0] = nloc; b.st[1] = nx; }
        const unsigned old = xb_add(&bar[XB_XSUB(b.x)], 1u);
        const unsigned gen = old / nloc;
        if (old + 1u == (gen + 1u) * nloc) {
            __builtin_amdgcn_fence(__ATOMIC_RELEASE, "agent");
            asm volatile("s_waitcnt vmcnt(0)" ::: "memory");
            const unsigned og = xb_add(&bar[XB_TOP], 1u);
            const unsigned tg = og / nx;
            if (og + 1u == (tg + 1u) * nx) xb_add(&bar[XB_TOPGEN], 1u);
            else XB_SPIN(xb_ld(&bar[XB_TOPGEN]) == tg, bar);
            __builtin_amdgcn_fence(__ATOMIC_ACQUIRE, "agent");
            xb_add(&bar[XB_XGEN(b.x)], 1u);
            asm volatile("s_waitcnt vmcnt(0)" ::: "memory");
        } else {
            XB_SPIN(xb_ld(&bar[XB_XGEN(b.x)]) == gen, bar);
            __builtin_amdgcn_fence(__ATOMIC_ACQUIRE, "agent");
            asm volatile("s_waitcnt vmcnt(0)" ::: "memory");
        }
    }
    __syncthreads();
}

namespace pg8 {
constexpr int BM = 256, BK = 64, HALF = 128, HTB = HALF * BK * 2, NXCD = 8, WGM = 8;
__host__ __device__ __forceinline__ int lds_byte(int r, int c) { const int st = (r >> 4) * 2 + (c >> 5), rr = r & 15, cc = c & 31, ob = rr * 64 + cc * 2; return st * 1024 + (ob ^ (((ob >> 9) & 1) << 5)); }
__host__ __device__ __forceinline__ void stage_rc(int b, int& R, int& C) { const int st = b / 1024, sb = b % 1024, swz = sb ^ (((sb >> 9) & 1) << 5); R = (st >> 1) * 16 + swz / 64; C = (st & 1) * 32 + (swz % 64) / 2; }
struct Unit { int pm, pn; };
struct Gemm { const bf16_t* A; const bf16_t* Bt; int nM, nN, K, a_tile_rows; };
struct StaticOrder {
    int nM, nN, nwg, G, c;
    __device__ void init(int nM_, int nN_, int G_, int c_) { nM = nM_; nN = nN_; nwg = nM * nN; G = G_; c = c_; }
    __device__ bool next(int i, Unit& u) const {
        const long L = (long)i * G + c; if (L >= nwg) return false;
        int wgid = (int)L; { const int q = nwg / NXCD, r = nwg % NXCD, xcd = wgid % NXCD, off = wgid / NXCD; wgid = (xcd < r ? xcd * (q + 1) : r * (q + 1) + (xcd - r) * q) + off; }
        const int nig = WGM * nN, gid = wgid / nig, fm = gid * WGM, gsz = (nM - fm) < WGM ? (nM - fm) : WGM;
        u.pm = fm + ((wgid % nig) % gsz); u.pn = (wgid % nig) / gsz; return true;
    }
};
template <class Epi>
__device__ __forceinline__ void gemm_phase(LAS unsigned char* lds, const Gemm g, const StaticOrder& S, const Epi& E, int wv) {
    const int tid = tid_opaque(wv);
    const int wid = __builtin_amdgcn_readfirstlane(tid >> 6), lane = tid & 63, wr = wid >> 2, wc = wid & 3, fr = lane & 15, fq = lane >> 4;
    const int K = g.K, nt = K / BK;
    unsigned voffA[2], voffB[2];
#pragma unroll
    for (int i = 0; i < 2; ++i) { int R, C; stage_rc(tid * 16 + i * 8192, R, C); voffA[i] = (unsigned)(R * K + C) * 2u; voffB[i] = voffA[i]; }
    const size_t kstep = (size_t)(BK * 2);
    const size_t hstep = (size_t)HALF * K * 2;
    const size_t tstepA = (size_t)g.a_tile_rows * K * 2;
    const size_t tstepB = 2 * hstep;
    const unsigned ldsw = (unsigned)wid * 1024u;
    const int aoff = lds_byte(wr * 64 + fr, fq * 8), boff = lds_byte(wc * 32 + fr, fq * 8);
#define PG8_SA(b, h) (((b) * 2 + (h)) * HTB)
#define PG8_SB(b, h) ((4 + (b) * 2 + (h)) * HTB)
#define PG8_STAGE(bufoff, gbase, voff) do { _Pragma("unroll") for (int _i = 0; _i < 2; ++_i) \
        __builtin_amdgcn_global_load_lds((const unsigned*)((const char*)(gbase) + (voff)[_i]), (LAS unsigned*)(lds + (bufoff) + ldsw + _i * 8192), 16, 0, 0); } while (0)
#define PG8_LDA(dst, b, h) do { _Pragma("unroll") for (int m = 0; m < 4; ++m) _Pragma("unroll") for (int k = 0; k < 2; ++k) dst[m][k] = *(const LAS bf16x8*)(lds + PG8_SA(b, h) + aoff + m * 2048 + k * 1024); } while (0)
#define PG8_LDB(dst, b, h) do { _Pragma("unroll") for (int n = 0; n < 2; ++n) _Pragma("unroll") for (int k = 0; k < 2; ++k) dst[n][k] = *(const LAS bf16x8*)(lds + PG8_SB(b, h) + boff + n * 2048 + k * 1024); } while (0)
#define PG8_MMA(ai, bj, At, Bt) do { __builtin_amdgcn_s_setprio(1); _Pragma("unroll") for (int m = 0; m < 4; ++m) _Pragma("unroll") for (int n = 0; n < 2; ++n) _Pragma("unroll") for (int k = 0; k < 2; ++k) \
        acc[ai][bj][m][n] = __builtin_amdgcn_mfma_f32_16x16x32_bf16(Bt[n][k], At[m][k], acc[ai][bj][m][n], 0, 0, 0); __builtin_amdgcn_s_setprio(0); } while (0)
#define PG8_WAIT_V(n) asm volatile("s_waitcnt vmcnt(" #n ")" ::: "memory")
#define PG8_WAIT_L(n) asm volatile("s_waitcnt lgkmcnt(" #n ")" ::: "memory")
#define PG8_BAR __builtin_amdgcn_s_barrier()
#define PG8_SCHED __builtin_amdgcn_sched_barrier(0)
    Unit cur, nxt; int ui = 0;
    if (!S.next(0, cur)) return;
    f32x4 acc[2][2][4][2];
#pragma unroll
    for (int a = 0; a < 2; ++a)
#pragma unroll
        for (int b = 0; b < 2; ++b)
#pragma unroll
            for (int m = 0; m < 4; ++m)
#pragma unroll
                for (int n = 0; n < 2; ++n) acc[a][b][m][n] = (f32x4){0.f, 0.f, 0.f, 0.f};
    bf16x8 At[4][2], B0[2][2], B1[2][2];
    const char* cA = (const char*)g.A + (size_t)cur.pm * tstepA; const char* cB = (const char*)g.Bt + (size_t)cur.pn * tstepB;
    PG8_STAGE(PG8_SB(0, 0), cB, voffB); PG8_STAGE(PG8_SA(0, 0), cA, voffA); PG8_STAGE(PG8_SB(0, 1), cB + hstep, voffB); PG8_STAGE(PG8_SA(0, 1), cA + hstep, voffA);
    if (wr == 1) PG8_BAR;
    PG8_WAIT_V(4); PG8_BAR;
    PG8_STAGE(PG8_SB(1, 0), cB + kstep, voffB); PG8_STAGE(PG8_SA(1, 0), cA + kstep, voffA); PG8_STAGE(PG8_SB(1, 1), cB + hstep + kstep, voffB);
    PG8_WAIT_V(6); PG8_BAR;
    for (;;) {
        const bool has_next = S.next(ui + 1, nxt);
        const char* nA = has_next ? (const char*)g.A + (size_t)nxt.pm * tstepA : cA; const char* nB = has_next ? (const char*)g.Bt + (size_t)nxt.pn * tstepB : cB;
        for (int t = 0; t < nt; t += 2) {
            const bool last = (t == nt - 2);
            const char* a1 = cA + (size_t)(t + 1) * kstep;
            const char* a2 = last ? nA : cA + (size_t)(t + 2) * kstep; const char* b2 = last ? nB : cB + (size_t)(t + 2) * kstep;
            const char* a3 = a2 + kstep; const char* b3 = b2 + kstep;
            PG8_LDB(B0, 0, 0); PG8_SCHED; PG8_LDA(At, 0, 0); PG8_STAGE(PG8_SA(1, 1), a1 + hstep, voffA);
            PG8_WAIT_L(8); PG8_BAR; PG8_WAIT_L(0); PG8_MMA(0, 0, At, B0); PG8_BAR; PG8_SCHED;
            PG8_LDB(B1, 0, 1); PG8_STAGE(PG8_SB(0, 0), b2, voffB);
            PG8_BAR; PG8_WAIT_L(0); PG8_MMA(0, 1, At, B1); PG8_BAR;
            PG8_LDA(At, 0, 1); PG8_STAGE(PG8_SA(0, 0), a2, voffA);
            PG8_BAR; PG8_WAIT_L(0); PG8_MMA(1, 0, At, B0); PG8_BAR; PG8_SCHED;
            PG8_STAGE(PG8_SB(0, 1), b2 + hstep, voffB);
            PG8_WAIT_V(6); PG8_BAR; PG8_MMA(1, 1, At, B1); PG8_BAR;
            PG8_LDB(B0, 1, 0); PG8_SCHED; PG8_LDA(At, 1, 0); PG8_STAGE(PG8_SA(0, 1), a2 + hstep, voffA);
            PG8_WAIT_L(8); PG8_BAR; PG8_WAIT_L(0); PG8_MMA(0, 0, At, B0); PG8_BAR; PG8_SCHED;
            PG8_LDB(B1, 1, 1); PG8_STAGE(PG8_SB(1, 0), b3, voffB);
            PG8_BAR; PG8_WAIT_L(0); PG8_MMA(0, 1, At, B1); PG8_BAR;
            PG8_LDA(At, 1, 1); PG8_STAGE(PG8_SA(1, 0), a3, voffA);
            PG8_BAR; PG8_WAIT_L(0); PG8_MMA(1, 0, At, B0); PG8_BAR; PG8_SCHED;
            PG8_STAGE(PG8_SB(1, 1), b3 + hstep, voffB);
            PG8_WAIT_V(6); PG8_BAR; PG8_MMA(1, 1, At, B1); PG8_BAR;
        }
        E(acc, cur, wr, wc, fr, fq);
        if (!has_next) break;
#pragma unroll
        for (int a = 0; a < 2; ++a)
#pragma unroll
            for (int b = 0; b < 2; ++b)
#pragma unroll
                for (int m = 0; m < 4; ++m)
#pragma unroll
                    for (int n = 0; n < 2; ++n) acc[a][b][m][n] = (f32x4){0.f, 0.f, 0.f, 0.f};
        cur = nxt; cA = nA; cB = nB; ++ui;
    }
    PG8_WAIT_V(0);
    if (wr == 0) PG8_BAR;
    PG8_BAR;
#undef PG8_SA
#undef PG8_SB
#undef PG8_STAGE
#undef PG8_LDA
#undef PG8_LDB
#undef PG8_MMA
#undef PG8_WAIT_V
#undef PG8_WAIT_L
#undef PG8_BAR
#undef PG8_SCHED
}
}
using pg8::Unit;

struct EpiProj {
    bf16_t* O; const float* cosT; const float* sinT;
    __device__ __forceinline__ void operator()(const f32x4 (&acc)[2][2][4][2], const Unit& u, int wr, int wc, int fr, int fq) const {
        const bool latent = u.pm < 128;
#pragma unroll
        for (int ai = 0; ai < 2; ++ai)
#pragma unroll
            for (int m = 0; m < 4; ++m) {
                const int row = u.pm * 256 + ai * 128 + wr * 64 + m * 16 + fr;
                const int t = row & (S - 1);
                const int pos = (wc & 1) ? (t & 63) : (t >> 6);
#pragma unroll
                for (int bj = 0; bj < 2; ++bj) {
                    const int col = u.pn * 256 + bj * 128 + wc * 32 + 4 * fq;
                    f32x4 v0 = acc[ai][bj][m][0], v1 = acc[ai][bj][m][1];
                    const bool rope = latent && (u.pn == 4 || u.pn == 5 || (u.pn == 6 && bj == 0));
                    if (rope) {
                        const f32x4 cs = *(const f32x4*)(cosT + pos * 16 + 4 * fq), sn = *(const f32x4*)(sinT + pos * 16 + 4 * fq);
                        const f32x4 n0 = v0 * cs - v1 * sn, n1 = v1 * cs + v0 * sn; v0 = n0; v1 = n1;
                    }
                    bf16_t* p = O + (size_t)row * DIN + col;
                    u32x2 w0, w1; w0.x = pk2(v0[0], v0[1]); w0.y = pk2(v0[2], v0[3]); w1.x = pk2(v1[0], v1[1]); w1.y = pk2(v1[2], v1[3]);
                    *(u32x2*)p = w0; *(u32x2*)(p + 16) = w1;
                }
            }
    }
};
struct EpiDelta {
    bf16_t* O; const float* gate0; const float* gate1;
    __device__ __forceinline__ void operator()(const f32x4 (&acc)[2][2][4][2], const Unit& u, int wr, int wc, int fr, int fq) const {
        const float* gate = (u.pm >= 64) ? gate1 : gate0;
        f32x4 gv[2][2];
#pragma unroll
        for (int bj = 0; bj < 2; ++bj)
#pragma unroll
            for (int n = 0; n < 2; ++n) gv[bj][n] = *(const f32x4*)(gate + u.pn * 256 + bj * 128 + wc * 32 + n * 16 + 4 * fq);
#pragma unroll
        for (int ai = 0; ai < 2; ++ai)
#pragma unroll
            for (int m = 0; m < 4; ++m) {
                const size_t row = (size_t)u.pm * 256 + ai * 128 + wr * 64 + m * 16 + fr;
#pragma unroll
                for (int bj = 0; bj < 2; ++bj)
#pragma unroll
                    for (int n = 0; n < 2; ++n) {
                        const f32x4 v = gv[bj][n] * acc[ai][bj][m][n];
                        u32x2 w; w.x = pk2(v[0], v[1]); w.y = pk2(v[2], v[3]);
                        *(u32x2*)(O + row * D + u.pn * 256 + bj * 128 + wc * 32 + n * 16 + 4 * fq) = w;
                    }
            }
    }
};

__device__ __forceinline__ float dpp_ror1(float v)  { return __int_as_float(__builtin_amdgcn_update_dpp(0, __float_as_int(v), 0x121, 0xF, 0xF, true)); }
__device__ __forceinline__ float dpp_ror15(float v) { return __int_as_float(__builtin_amdgcn_update_dpp(0, __float_as_int(v), 0x12F, 0xF, 0xF, true)); }
__device__ __forceinline__ float dpp_shr1(float v)  { return __int_as_float(__builtin_amdgcn_update_dpp(0, __float_as_int(v), 0x111, 0xF, 0xF, true)); }
__device__ __forceinline__ float dpp_shl1(float v)  { return __int_as_float(__builtin_amdgcn_update_dpp(0, __float_as_int(v), 0x101, 0xF, 0xF, true)); }
struct EpiConvGate {
    bf16_t* act; const float* cw; const float* cbias; LAS unsigned char* xl;
    __device__ __forceinline__ void operator()(const f32x4 (&acc)[2][2][4][2], const Unit& u, int wr, int wc, int fr, int fq) const {
        LAS float* X = (LAS float*)xl;
#pragma unroll
        for (int ai = 0; ai < 2; ++ai) {
            const int s = 2 * ai + wr;
            if (fr == 0) {
#pragma unroll
                for (int bj = 0; bj < 2; ++bj)
#pragma unroll
                    for (int n = 0; n < 2; ++n) *(LAS f32x4*)(X + ((s * 2 + 0) * 2 + bj) * 128 + 32 * wc + 16 * n + 4 * fq) = acc[ai][bj][0][n];
            }
            if (fr == 15) {
#pragma unroll
                for (int bj = 0; bj < 2; ++bj)
#pragma unroll
                    for (int n = 0; n < 2; ++n) *(LAS f32x4*)(X + ((s * 2 + 1) * 2 + bj) * 128 + 32 * wc + 16 * n + 4 * fq) = acc[ai][bj][3][n];
            }
        }
        asm volatile("s_waitcnt lgkmcnt(0)" ::: "memory");
        __builtin_amdgcn_s_barrier(); asm volatile("" ::: "memory");
        __builtin_amdgcn_s_barrier(); asm volatile("" ::: "memory");
#pragma unroll
        for (int n = 0; n < 2; ++n) {
            const int chg = 128 * u.pn + 32 * wc + 16 * n + 4 * fq;
            f32x4 w0[2], w1[2], w2[2], bb[2], w0m[2], w2m[2];
#pragma unroll
            for (int bj = 0; bj < 2; ++bj) {
                const int ch = chg + bj * DFF;
                w0[bj] = *(const f32x4*)(cw + ch); w1[bj] = *(const f32x4*)(cw + DUP + ch); w2[bj] = *(const f32x4*)(cw + 2 * DUP + ch); bb[bj] = *(const f32x4*)(cbias + ch);
                w0m[bj] = (fr == 0) ? w0[bj] : (f32x4){0.f, 0.f, 0.f, 0.f}; w2m[bj] = (fr == 15) ? w2[bj] : (f32x4){0.f, 0.f, 0.f, 0.f};
            }
#pragma unroll
            for (int ai = 0; ai < 2; ++ai) {
                const int s = 2 * ai + wr;
                f32x4 xp[2], xn[2];
#pragma unroll
                for (int bj = 0; bj < 2; ++bj) {
                    xp[bj] = *(const LAS f32x4*)(X + ((((s + 3) & 3) * 2 + 1) * 2 + bj) * 128 + 32 * wc + 16 * n + 4 * fq);
                    xn[bj] = *(const LAS f32x4*)(X + ((((s + 1) & 3) * 2 + 0) * 2 + bj) * 128 + 32 * wc + 16 * n + 4 * fq);
                }
#pragma unroll
                for (int m = 0; m < 4; ++m) {
                    const int lr = 128 * ai + 64 * wr + 16 * m + fr;
                    const int R = 254 * u.pm + lr;
                    const int b = R >= (H2_BSTRIDE + 1) ? 1 : 0;
                    const int t = R - 1 - H2_BSTRIDE * b;
                    const bool valid = lr >= 1 && lr <= 254 && t >= 0 && t < S;
                    f32x4 cv[2];
#pragma unroll
                    for (int bj = 0; bj < 2; ++bj) {
                        const f32x4 cur = acc[ai][bj][m][n];
                        f32x4 c = bb[bj] + w1[bj] * cur;
#pragma unroll
                        for (int j = 0; j < 4; ++j) {
                            c[j] = __builtin_fmaf(dpp_shr1(cur[j]), w0[bj][j], c[j]);
                            c[j] = __builtin_fmaf(dpp_shl1(cur[j]), w2[bj][j], c[j]);
                            if (m > 0) c[j] = __builtin_fmaf(dpp_ror1(acc[ai][bj][m > 0 ? m - 1 : 0][n][j]), w0m[bj][j], c[j]); else c[j] = __builtin_fmaf(xp[bj][j], w0m[bj][j], c[j]);
                            if (m < 3) c[j] = __builtin_fmaf(dpp_ror15(acc[ai][bj][m < 3 ? m + 1 : 3][n][j]), w2m[bj][j], c[j]); else c[j] = __builtin_fmaf(xn[bj][j], w2m[bj][j], c[j]);
                        }
                        cv[bj] = c;
                    }
                    if (valid) {
                        u32x2 w;
                        w.x = pk2(silu_(cv[0][0]) * cv[1][0], silu_(cv[0][1]) * cv[1][1]);
                        w.y = pk2(silu_(cv[0][2]) * cv[1][2], silu_(cv[0][3]) * cv[1][3]);
                        *(u32x2*)(act + (size_t)(b * S + t) * DFF + chg) = w;
                    }
                }
            }
        }
    }
};

__device__ __forceinline__ void transpose_item(const float* W, int N, int k0, int n0, bf16_t* dst, int Kd, float* scr, int lane) {
#pragma unroll 16
    for (int i = 0; i < 32; ++i) { const int kk = 2 * i + (lane >> 5); scr[kk * 33 + (lane & 31)] = W[(size_t)(k0 + kk) * N + n0 + (lane & 31)]; }
    __builtin_amdgcn_wave_barrier();
    const int c = lane & 7;
#pragma unroll
    for (int j = 0; j < 4; ++j) {
        const int n = (lane >> 3) + 8 * j; const float* s = scr + (8 * c) * 33 + n;
        u32x4 o; o.x = pk2(s[0], s[33]); o.y = pk2(s[2 * 33], s[3 * 33]); o.z = pk2(s[4 * 33], s[5 * 33]); o.w = pk2(s[6 * 33], s[7 * 33]);
        *(u32x4*)(dst + (size_t)n * Kd + k0 + 8 * c) = o;
    }
    __builtin_amdgcn_wave_barrier();
}

__device__ __forceinline__ void phase0(PP p, unsigned char* shm, int wv) {
    const int tid = tid_opaque(wv), lane = tid & 63, wave = tid >> 6;
    unsigned char* ws = p->ws;
    if (blockIdx.x < 192) {
        float* sv = (float*)shm;
        float* red = sv + 3 * 1024;
        for (int i = tid; i < 3 * 1024; i += 512) {
            const int j = i >> 10, k = i & 1023;
            const float v = (j < 2) ? p->c[j * 1024 + k] : p->c_ctx[k];
            sv[i] = silu_(v);
        }
        __syncthreads();
        const int n0 = blockIdx.x * 32, col = tid & 31, ks = tid >> 5;
        float a0 = 0.f, a1 = 0.f, a2 = 0.f;
        const float* wp = p->w_mod + (size_t)(ks * 64) * 6144 + n0 + col;
#pragma unroll 16
        for (int k = 0; k < 64; ++k) {
            const float w = wp[(size_t)k * 6144];
            a0 += sv[ks * 64 + k] * w; a1 += sv[1024 + ks * 64 + k] * w; a2 += sv[2048 + ks * 64 + k] * w;
        }
        red[(ks * 3 + 0) * 32 + col] = a0; red[(ks * 3 + 1) * 32 + col] = a1; red[(ks * 3 + 2) * 32 + col] = a2;
        __syncthreads();
        if (tid < 96) {
            const int j = tid >> 5, cc = tid & 31; float s = p->b_mod[n0 + cc];
            for (int k = 0; k < 16; ++k) s += red[(k * 3 + j) * 32 + cc];
            ((float*)(ws + WS_MOD))[j * 6144 + n0 + cc] = s;
        }
        __syncthreads();
    }
    if (blockIdx.x == 200) { for (int i = tid; i < 1024; i += 512) ((float*)(ws + WS_SP8))[i] = -8.0f * log1pf(expf(-p->lru_lam[i])); }
    if (blockIdx.x >= 192 && blockIdx.x < 200) {
        const int idx = (blockIdx.x - 192) * 512 + tid;
        const int pos = idx >> 4, i = idx & 15;
        const float inv = powf(10000.0f, -(float)i / 16.0f);
        const float ang = (float)pos * inv;
        ((float*)(ws + WS_ROPE))[idx] = cosf(ang);
        ((float*)(ws + WS_ROPE))[4096 + idx] = sinf(ang);
    }
    float* scr = (float*)(shm + 32768) + wave * (64 * 33);
    const int gw = blockIdx.x * 8 + wave, NGW = gridDim.x * 8;
    constexpr int I_IN = (D / 64) * (DIN / 32), I_OUT = (D / 64) * (D / 32), I_UP = (D / 64) * (DUP / 32), I_DN = (DFF / 64) * (D / 32), I_LRU = 2 * 2 * 8 * 2;
    constexpr int NIT = I_IN + I_OUT + I_UP + I_DN + I_LRU;
    for (int it = gw; it < NIT; it += NGW) {
        int r = it;
        if (r < I_IN) { const int nb = DIN / 32, kb = r / nb, n0 = (r % nb) * 32; transpose_item(p->w_in, DIN, kb * 64, n0, (bf16_t*)(ws + WS_WIN) + (size_t)n0 * D, D, scr, lane); continue; } r -= I_IN;
        if (r < I_OUT) { const int nb = D / 32, kb = r / nb, n0 = (r % nb) * 32; transpose_item(p->w_out, D, kb * 64, n0, (bf16_t*)(ws + WS_WOUT) + (size_t)n0 * D, D, scr, lane); continue; } r -= I_OUT;
        if (r < I_UP) { const int nb = DUP / 32, kb = r / nb, n0 = (r % nb) * 32;
            const int isv = n0 >= DFF, nn = isv ? n0 - DFF : n0, drow = (nn / 128) * 256 + isv * 128 + (nn % 128);
            transpose_item(p->w_up, DUP, kb * 64, n0, (bf16_t*)(ws + WS_WUP) + (size_t)drow * D, D, scr, lane); continue; } r -= I_UP;
        if (r < I_DN) { const int nb = D / 32, kb = r / nb, n0 = (r % nb) * 32; transpose_item(p->w_down, D, kb * 64, n0, (bf16_t*)(ws + WS_WDN) + (size_t)n0 * DFF, DFF, scr, lane); continue; } r -= I_DN;
        {
            const int nh = r & 1, blk = (r >> 1) & 7, type = (r >> 4) & 1, dir = r >> 5;
            const float* src = (type ? p->lru_w_i : p->lru_w_a) + (size_t)(dir * 8 + blk) * 4096;
            bf16_t* dst = (bf16_t*)(ws + WS_LRU) + (size_t)((dir * 2 + type) * 8 + blk) * 4096 + (size_t)(nh * 32) * 64;
            transpose_item(src, 64, 0, nh * 32, dst, 64, scr, lane);
        }
    }
}

__device__ __forceinline__ void row_load(const float* src, int lane, f32x4 (&v)[4]) {
#pragma unroll
    for (int j = 0; j < 4; ++j) v[j] = *(const f32x4*)(src + 4 * lane + 256 * j);
}
__device__ __forceinline__ float row_rstd(const f32x4 (&v)[4]) {
    float ss = 0.f;
#pragma unroll
    for (int j = 0; j < 4; ++j) ss += v[j][0] * v[j][0] + v[j][1] * v[j][1] + v[j][2] * v[j][2] + v[j][3] * v[j][3];
    return rsqrtf(wave_sum(ss) * (1.0f / D) + EPS);
}
__device__ __forceinline__ void norm_mod_store(const f32x4 (&v)[4], float rstd, const float* g, const float* sh, const float* sc, bf16_t* dst, int lane) {
#pragma unroll
    for (int j = 0; j < 4; ++j) {
        const int c = 4 * lane + 256 * j;
        const f32x4 gg = *(const f32x4*)(g + c), s1 = *(const f32x4*)(sc + c), s0 = *(const f32x4*)(sh + c);
        const f32x4 o = (v[j] * rstd * gg) * (s1 + 1.0f) + s0;
        u32x2 w; w.x = pk2(o[0], o[1]); w.y = pk2(o[2], o[3]);
        *(u32x2*)(dst + c) = w;
    }
}
__device__ __forceinline__ void phase1(PP p, int wv) {
    const int tid_ = tid_opaque(wv), lane = tid_ & 63, gw = blockIdx.x * 8 + (tid_ >> 6), NGW = gridDim.x * 8;
    const float* mod = (const float*)(p->ws + WS_MOD);
    bf16_t* hb = (bf16_t*)(p->ws + WS_HB);
    for (int r = gw; r < MROWS; r += 2 * NGW) {
        const int r2 = r + NGW; const bool has2 = r2 < MROWS;
        const int ra = r, rb = has2 ? r2 : r;
        f32x4 va[4], vb[4];
        row_load(ra < NLAT ? p->x + (size_t)ra * D : p->ctx + (size_t)(ra - NLAT) * D, lane, va);
        row_load(rb < NLAT ? p->x + (size_t)rb * D : p->ctx + (size_t)(rb - NLAT) * D, lane, vb);
        const int ma = ra < NLAT ? (ra >> 14) : 2, mb = rb < NLAT ? (rb >> 14) : 2;
        const float sa = row_rstd(va), sb = row_rstd(vb);
        norm_mod_store(va, sa, p->norm1_g, mod + ma * 6144, mod + ma * 6144 + 1024, hb + (size_t)ra * D, lane);
        if (has2) norm_mod_store(vb, sb, p->norm1_g, mod + mb * 6144, mod + mb * 6144 + 1024, hb + (size_t)rb * D, lane);
    }
}

typedef float f32x16 __attribute__((ext_vector_type(16)));
__device__ __forceinline__ unsigned cvt_pk_bf16(float lo, float hi) { unsigned r; asm("v_cvt_pk_bf16_f32 %0, %1, %2" : "=v"(r) : "v"(lo), "v"(hi)); return r; }
__device__ __forceinline__ void attn_mfma(PP p, unsigned char* shm, int wv) {
    const int tid = tid_opaque(wv);
    const int lane = tid & 63, wave = tid >> 6, l31 = lane & 31, hl = lane >> 5;
    bf16_t* Ks = (bf16_t*)shm;
    bf16_t* Vt = (bf16_t*)(shm + 18432);
    const bf16_t* proj = (const bf16_t*)(p->ws + WS_PROJ);
    bf16_t* att = (bf16_t*)(p->ws + WS_ATT);
    const float L2E = 1.4426950408889634f;
    const float SC2 = 0.125f * L2E;
    for (int item = blockIdx.x; item < 512; item += gridDim.x) {
        const int hk = item & 1, qb = (item >> 1) & 127, b = item >> 8;
        const int g = wave >> 1, qh = wave & 1, hq = hk * 4 + g;
        const int qrow0 = b * S + 128 * qb + 64 * qh;
        bf16x8 qf[2][4];
#pragma unroll
        for (int qi = 0; qi < 2; ++qi)
#pragma unroll
            for (int st = 0; st < 4; ++st) qf[qi][st] = *(const bf16x8*)(proj + (size_t)(qrow0 + 32 * qi + l31) * DIN + 1024 + 64 * hq + 16 * st + 8 * hl);
        const float sink2 = p->attn_sink[hq] * L2E;
        float mrun[2] = {sink2, sink2};
        float lrun[2] = {hl == 0 ? 1.f : 0.f, hl == 0 ? 1.f : 0.f};
        f32x16 oacc[2][2];
#pragma unroll
        for (int a = 0; a < 2; ++a)
#pragma unroll
            for (int c = 0; c < 2; ++c)
#pragma unroll
                for (int i = 0; i < 16; ++i) oacc[a][c][i] = 0.f;
        u32x4 kreg[2], vreg[2];
        int ci = (qb == 0) ? 1 : 0;
#define ATT_GLOAD(CI) do { const int _row0 = (CI) < 3 ? b * S + 128 * (qb - 1 + (CI)) : NLAT + b * LC + 128 * ((CI) - 3); \
        _Pragma("unroll") for (int _i = 0; _i < 2; ++_i) { const int _pi = tid + 512 * _i, _key = _pi >> 3, _part = _pi & 7; \
            const bf16_t* _src = proj + (size_t)(_row0 + _key) * DIN + 1536 + 64 * hk + 8 * _part; kreg[_i] = *(const u32x4*)_src; vreg[_i] = *(const u32x4*)(_src + 128); } } while (0)
        ATT_GLOAD(ci);
        while (ci < 5) {
            __syncthreads();
#pragma unroll
            for (int i = 0; i < 2; ++i) {
                const int pi = tid + 512 * i, key = pi >> 3, part = pi & 7;
                *(u32x4*)(Ks + key * 72 + 8 * part) = kreg[i];
#pragma unroll
                for (int e = 0; e < 8; ++e) { const unsigned w = vreg[i][e >> 1]; Vt[(8 * part + e) * 132 + key] = (bf16_t)((e & 1) ? (w >> 16) : (w & 0xFFFFu)); }
            }
            __syncthreads();
            int cn = ci + 1; if (cn == 2 && qb == 127) cn = 3;
            if (cn < 5) ATT_GLOAD(cn);
            const int kt_lo = (ci == 0 && qh == 1) ? 2 : 0, kt_hi = (ci == 2 && qh == 0) ? 2 : 4;
#pragma unroll 1
            for (int kt = kt_lo; kt < kt_hi; ++kt) {
                bf16x8 kf[4];
#pragma unroll
                for (int st = 0; st < 4; ++st) kf[st] = *(const bf16x8*)(Ks + (32 * kt + l31) * 72 + 16 * st + 8 * hl);
                bf16x8 vf[2][2];
#pragma unroll
                for (int db = 0; db < 2; ++db)
#pragma unroll
                    for (int s2 = 0; s2 < 2; ++s2) {
                        const bf16_t* vp = Vt + (32 * db + l31) * 132 + 32 * kt + 16 * s2 + 4 * hl;
                        const u32x2 lo = *(const u32x2*)vp, hi = *(const u32x2*)(vp + 8);
                        u32x4 w; w.x = lo.x; w.y = lo.y; w.z = hi.x; w.w = hi.y;
                        vf[db][s2] = __builtin_bit_cast(bf16x8, w);
                    }
#pragma unroll
                for (int qi = 0; qi < 2; ++qi) {
                    f32x16 s;
#pragma unroll
                    for (int i = 0; i < 16; ++i) s[i] = 0.f;
#pragma unroll
                    for (int st = 0; st < 4; ++st) s = __builtin_amdgcn_mfma_f32_32x32x16_bf16(kf[st], qf[qi][st], s, 0, 0, 0);
                    if (ci == 0 || ci == 2) {
                        const int qrel = 64 * qh + 32 * qi + l31;
#pragma unroll
                        for (int i = 0; i < 16; ++i) {
                            const int koff = 32 * kt + 8 * (i >> 2) + 4 * hl + (i & 3);
                            const bool ok = (ci == 0) ? (qrel <= koff) : (koff <= qrel);
                            s[i] = ok ? s[i] : -1e30f;
                        }
                    }
                    float mx = s[0];
#pragma unroll
                    for (int i = 1; i < 16; ++i) mx = fmaxf(mx, s[i]);
                    mx = fmaxf(mx, __shfl_xor(mx, 32));
                    const float mnew = fmaxf(mrun[qi], mx * SC2);
                    if (__builtin_amdgcn_ballot_w64(mnew > mrun[qi]) != 0ull) {
                        const float alpha = __builtin_amdgcn_exp2f(mrun[qi] - mnew);
                        lrun[qi] *= alpha;
#pragma unroll
                        for (int db = 0; db < 2; ++db)
#pragma unroll
                            for (int i = 0; i < 16; ++i) oacc[db][qi][i] *= alpha;
                        mrun[qi] = mnew;
                    }
                    float ls = 0.f;
#pragma unroll
                    for (int i = 0; i < 16; ++i) { s[i] = __builtin_amdgcn_exp2f(__builtin_fmaf(s[i], SC2, -mnew)); ls += s[i]; }
                    lrun[qi] += ls;
                    bf16x8 pf[2];
#pragma unroll
                    for (int s2 = 0; s2 < 2; ++s2) {
                        u32x4 w; w.x = cvt_pk_bf16(s[8 * s2 + 0], s[8 * s2 + 1]); w.y = cvt_pk_bf16(s[8 * s2 + 2], s[8 * s2 + 3]);
                        w.z = cvt_pk_bf16(s[8 * s2 + 4], s[8 * s2 + 5]); w.w = cvt_pk_bf16(s[8 * s2 + 6], s[8 * s2 + 7]);
                        pf[s2] = __builtin_bit_cast(bf16x8, w);
                    }
#pragma unroll
                    for (int db = 0; db < 2; ++db)
#pragma unroll
                        for (int s2 = 0; s2 < 2; ++s2) oacc[db][qi] = __builtin_amdgcn_mfma_f32_32x32x16_bf16(vf[db][s2], pf[s2], oacc[db][qi], 0, 0, 0);
                }
            }
            ci = cn;
        }
#undef ATT_GLOAD
#pragma unroll
        for (int qi = 0; qi < 2; ++qi) {
            const float lt = lrun[qi] + __shfl_xor(lrun[qi], 32);
            const float inv = 1.0f / lt;
            bf16_t* orow = att + (size_t)(qrow0 + 32 * qi + l31) * 512 + hq * 64;
#pragma unroll
            for (int db = 0; db < 2; ++db)
#pragma unroll
                for (int g4 = 0; g4 < 4; ++g4) {
                    u32x2 w; w.x = cvt_pk_bf16(oacc[db][qi][4 * g4] * inv, oacc[db][qi][4 * g4 + 1] * inv); w.y = cvt_pk_bf16(oacc[db][qi][4 * g4 + 2] * inv, oacc[db][qi][4 * g4 + 3] * inv);
                    *(u32x2*)(orow + 32 * db + 8 * g4 + 4 * hl) = w;
                }
        }
    }
    __syncthreads();
}


template <int DIR>
__device__ __forceinline__ void scan_dir(PP p, const bf16_t* xs, int n, int ct, int l31, int hl, int id, int rowbase, bool latent, float (&hf)[2][16]) {
    constexpr int XS = 520;
    const int ch = 64 * n + 32 * ct + l31;
    const float ba = p->lru_b_a[DIR * 512 + ch], bi = p->lru_b_i[DIR * 512 + ch];
    const float sp8l2 = ((const float*)(p->ws + WS_SP8))[DIR * 512 + ch] * 1.4426950408889634f;
    const bf16_t* lru = (const bf16_t*)(p->ws + WS_LRU);
    const bf16_t* wa_p = lru + (size_t)((DIR * 2 + 0) * 8 + n) * 4096 + (32 * ct + l31) * 64 + 8 * hl;
    const bf16_t* wi_p = lru + (size_t)((DIR * 2 + 1) * 8 + n) * 4096 + (32 * ct + l31) * 64 + 8 * hl;
    bf16x8 wfa[4], wfi[4];
#pragma unroll
    for (int st = 0; st < 4; ++st) { wfa[st] = *(const bf16x8*)(wa_p + 16 * st); wfi[st] = *(const bf16x8*)(wi_p + 16 * st); }
    float a[2][16], u[2][16];
#pragma unroll
    for (int rt = 0; rt < 2; ++rt) {
        bf16x8 af[4];
#pragma unroll
        for (int st = 0; st < 4; ++st) af[st] = *(const bf16x8*)(xs + (32 * rt + l31) * XS + 64 * n + 16 * st + 8 * hl);
        f32x16 ga, gi;
#pragma unroll
        for (int i = 0; i < 16; ++i) { ga[i] = 0.f; gi[i] = 0.f; }
#pragma unroll
        for (int st = 0; st < 4; ++st) { ga = __builtin_amdgcn_mfma_f32_32x32x16_bf16(af[st], wfa[st], ga, 0, 0, 0); gi = __builtin_amdgcn_mfma_f32_32x32x16_bf16(af[st], wfi[st], gi, 0, 0, 0); }
#pragma unroll
        for (int i = 0; i < 16; ++i) {
            const int token = 32 * rt + 8 * (i >> 2) + 4 * hl + (i & 3);
            const float xv = bf2f(xs[token * XS + ch]);
            const float rr = fast_sigmoid(ga[i] + ba), ii = fast_sigmoid(gi[i] + bi);
            const float la2 = rr * sp8l2;
            const float av = __builtin_amdgcn_exp2f(la2);
            const float t2 = la2 * 1.3862943611f;
            const float em1 = (t2 > -0.1f) ? t2 * (1.0f + t2 * (0.5f + t2 * (0.16666667f + t2 * (0.041666668f + t2 * 0.0083333333f)))) : (av * av - 1.0f);
            a[rt][i] = av; u[rt][i] = __builtin_amdgcn_sqrtf(-em1) * (ii * xv);
        }
    }
    float Ao[8], Ho[8], Ap[8], Hp[8];
#pragma unroll
    for (int k = 0; k < 8; ++k) {
        const int rt = k >> 2, g = k & 3;
        float H = 0.f, A = 1.f;
#pragma unroll
        for (int jj = 0; jj < 4; ++jj) { const int j = DIR ? 3 - jj : jj; const float av = a[rt][4 * g + j]; H = av * H + u[rt][4 * g + j]; A *= av; }
        Ao[k] = A; Ho[k] = H; Ap[k] = __shfl_xor(A, 32); Hp[k] = __shfl_xor(H, 32);
    }
    float Sin[8], Pin[8]; float Sx = 0.f, Px = 1.f;
#pragma unroll
    for (int kk = 0; kk < 8; ++kk) {
        const int k = DIR ? 7 - kk : kk;
        const float A0 = hl ? Ap[k] : Ao[k], H0 = hl ? Hp[k] : Ho[k], A1 = hl ? Ao[k] : Ap[k], H1 = hl ? Ho[k] : Hp[k];
        float s0, p0, s1, p1;
        if (DIR == 0) { s0 = Sx; p0 = Px; Sx = A0 * Sx + H0; Px *= A0; s1 = Sx; p1 = Px; Sx = A1 * Sx + H1; Px *= A1; }
        else          { s1 = Sx; p1 = Px; Sx = A1 * Sx + H1; Px *= A1; s0 = Sx; p0 = Px; Sx = A0 * Sx + H0; Px *= A0; }
        Sin[k] = hl ? s1 : s0; Pin[k] = hl ? p1 : p0;
    }
    bf16_t* yl = (bf16_t*)(p->ws + WS_YL) + (size_t)rowbase * 512; bf16_t* caf = (bf16_t*)(p->ws + WS_CAF) + (size_t)rowbase * 512; bf16_t* cab = (bf16_t*)(p->ws + WS_CAB) + (size_t)rowbase * 512;
    unsigned lo = (unsigned)ch; asm volatile("" : "+v"(lo));
#pragma unroll
    for (int k = 0; k < 8; ++k) {
        const int rt = k >> 2, g = k & 3;
        float h = Sin[k], P = Pin[k];
#pragma unroll
        for (int jj = 0; jj < 4; ++jj) {
            const int j = DIR ? 3 - jj : jj, idx = 4 * g + j;
            h = a[rt][idx] * h + u[rt][idx]; P *= a[rt][idx];
            const int token = 32 * rt + 8 * g + 4 * hl + j;
            const unsigned o = lo + (unsigned)token * 512u;
            if (DIR == 0) { hf[rt][idx] = h; if (latent) caf[o] = f2bf(P); }
            else if (latent) { yl[o] = f2bf(hf[rt][idx] + h); cab[o] = f2bf(P); }
        }
    }
    if (hl == 0) {
        float* sumb = (float*)(p->ws + WS_SUM);
        sumb[((size_t)(DIR * NCHUNK + id) * 2 + 0) * 512 + ch] = Px;
        sumb[((size_t)(DIR * NCHUNK + id) * 2 + 1) * 512 + ch] = Sx;
    }
}
__device__ __forceinline__ void scan_mfma(PP p, unsigned char* shm, int wv) {
    const int tid = tid_opaque(wv);
    const int lane = tid & 63, n = tid >> 6, l31 = lane & 31, hl = lane >> 5;
    constexpr int XS = 520;
    bf16_t* xs = (bf16_t*)shm;
    const bf16_t* proj = (const bf16_t*)(p->ws + WS_PROJ);
    for (int id = blockIdx.x; id < NCHUNK; id += gridDim.x) {
        int rowbase, t0, seqlen; bool latent;
        if (id < 512) { const int b = id >> 8, k = id & 255; t0 = 64 * k; rowbase = b * S + t0; seqlen = S; latent = true; }
        else { const int j = id - 512, b = j >> 2, k = j & 3; t0 = 64 * k; rowbase = NLAT + b * LC + t0; seqlen = LC; latent = false; }
        const int seqbase = rowbase - t0;
        {
            bf16_t* raw = (bf16_t*)(shm + 66560);
#pragma unroll
            for (int i = 0; i < 9; ++i) {
                const int piece = tid + 512 * i;
                if (piece < 67 * 64) {
                    const int row = piece >> 6, c8 = piece & 63, tt = t0 - 2 + row;
                    u32x4 v = {0u, 0u, 0u, 0u};
                    if (tt >= 0 && tt < seqlen) v = *(const u32x4*)(proj + (size_t)(seqbase + tt) * DIN + 8 * c8);
                    *(u32x4*)(raw + row * 512 + 8 * c8) = v;
                }
            }
            __syncthreads();
            const int c = tid;
            const float cw0 = p->rnn_conv_w[c], cw1 = p->rnn_conv_w[512 + c], cw2 = p->rnn_conv_w[1024 + c], cw3 = p->rnn_conv_w[1536 + c], cb = p->rnn_conv_b[c];
            float xm2 = bf2f(raw[c]), xm1 = bf2f(raw[512 + c]), x0 = bf2f(raw[1024 + c]);
#pragma unroll 8
            for (int t = 0; t < 64; ++t) {
                const float xp1 = bf2f(raw[(t + 3) * 512 + c]);
                xs[t * XS + c] = f2bf(cb + cw0 * xm2 + cw1 * xm1 + cw2 * x0 + cw3 * xp1);
                xm2 = xm1; xm1 = x0; x0 = xp1;
            }
        }
        __syncthreads();
#pragma unroll 1
        for (int ct = 0; ct < 2; ++ct) {
            float hf[2][16];
            scan_dir<0>(p, xs, n, ct, l31, hl, id, rowbase, latent, hf);
            scan_dir<1>(p, xs, n, ct, l31, hl, id, rowbase, latent, hf);
        }
        __syncthreads();
    }
}

__device__ __forceinline__ void carry_phase(PP p, unsigned char* shm, int wv) {
    if (blockIdx.x >= 128) return;
    const int tid = tid_opaque(wv), cl = tid & 15, sg = tid >> 4;
    const int b = blockIdx.x >> 6, dir = (blockIdx.x >> 5) & 1, c = (blockIdx.x & 31) * 16 + cl;
    const float* sumb = (const float*)(p->ws + WS_SUM) + (size_t)dir * NCHUNK * 1024;
    float* car = (float*)(p->ws + WS_CAR) + (size_t)dir * NCHUNK * 512;
    float* segA = (float*)shm; float* segH = segA + 512;
    float A[9], H[9]; int ids[9];
#pragma unroll
    for (int k = 0; k < 9; ++k) {
        const int s = sg * 9 + k;
        int id = -1;
        if (s < 260) { if (dir == 0) id = s < 4 ? 512 + 4 * b + s : 256 * b + (s - 4); else id = s < 4 ? 512 + 4 * b + (3 - s) : 256 * b + (255 - (s - 4)); }
        ids[k] = id;
        A[k] = id >= 0 ? sumb[(size_t)id * 1024 + c] : 1.f;
        H[k] = id >= 0 ? sumb[(size_t)id * 1024 + 512 + c] : 0.f;
    }
    float As = 1.f, Hs = 0.f;
#pragma unroll
    for (int k = 0; k < 9; ++k) { Hs = A[k] * Hs + H[k]; As *= A[k]; }
    segA[sg * 16 + cl] = As; segH[sg * 16 + cl] = Hs;
    __syncthreads();
    float h = 0.f;
    for (int j = 0; j < sg; ++j) h = segA[j * 16 + cl] * h + segH[j * 16 + cl];
#pragma unroll
    for (int k = 0; k < 9; ++k) { if (ids[k] >= 0) car[(size_t)ids[k] * 512 + c] = h; h = A[k] * h + H[k]; }
    __syncthreads();
}

__device__ __forceinline__ void mix_phase(PP p, int wv) {
    const int tid_ = tid_opaque(wv), lane = tid_ & 63, gw = blockIdx.x * 8 + (tid_ >> 6), NGW = gridDim.x * 8;
    const bf16_t* proj = (const bf16_t*)(p->ws + WS_PROJ);
    const bf16_t* att = (const bf16_t*)(p->ws + WS_ATT);
    const bf16_t* yl = (const bf16_t*)(p->ws + WS_YL); const bf16_t* caf = (const bf16_t*)(p->ws + WS_CAF); const bf16_t* cab = (const bf16_t*)(p->ws + WS_CAB);
    const float* car = (const float*)(p->ws + WS_CAR);
    bf16_t* mix = (bf16_t*)(p->ws + WS_HB);
    const int c0 = 8 * lane;
    for (int r = gw; r < NLAT; r += NGW) {
        const int id = r >> 6;
        const u32x4 vy = *(const u32x4*)(yl + (size_t)r * 512 + c0), vf = *(const u32x4*)(caf + (size_t)r * 512 + c0), vb = *(const u32x4*)(cab + (size_t)r * 512 + c0);
        const u32x4 vg = *(const u32x4*)(proj + (size_t)r * DIN + 512 + c0), va = *(const u32x4*)(att + (size_t)r * 512 + c0);
        const float* cf = car + (size_t)id * 512 + c0; const float* cbk = car + (size_t)(NCHUNK + id) * 512 + c0;
        float rn[8], at[8]; float s1 = 0.f, s2 = 0.f;
#pragma unroll
        for (int e = 0; e < 8; ++e) {
            const unsigned wy = vy[e >> 1], wf = vf[e >> 1], wb = vb[e >> 1], wg = vg[e >> 1], wa = va[e >> 1];
            const float y = ((e & 1) ? bfhi(wy) : bflo(wy)) + ((e & 1) ? bfhi(wf) : bflo(wf)) * cf[e] + ((e & 1) ? bfhi(wb) : bflo(wb)) * cbk[e];
            const float xg = (e & 1) ? bfhi(wg) : bflo(wg);
            rn[e] = gelu_tanh_(xg) * y; s1 += rn[e] * rn[e];
            at[e] = (e & 1) ? bfhi(wa) : bflo(wa); s2 += at[e] * at[e];
        }
        const float r1 = rsqrtf(wave_sum(s1) * (1.0f / 512.0f) + EPS), r2 = rsqrtf(wave_sum(s2) * (1.0f / 512.0f) + EPS);
        u32x4 o1, o2;
#pragma unroll
        for (int e2 = 0; e2 < 4; ++e2) {
            o1[e2] = pk2(rn[2 * e2] * r1 * p->gn_rnn[c0 + 2 * e2], rn[2 * e2 + 1] * r1 * p->gn_rnn[c0 + 2 * e2 + 1]);
            o2[e2] = pk2(at[2 * e2] * r2 * p->gn_attn[c0 + 2 * e2], at[2 * e2 + 1] * r2 * p->gn_attn[c0 + 2 * e2 + 1]);
        }
        *(u32x4*)(mix + (size_t)r * D + c0) = o1; *(u32x4*)(mix + (size_t)r * D + 512 + c0) = o2;
    }
}

__device__ __forceinline__ void phase7(PP p, int wv) {
    const int tid_ = tid_opaque(wv), lane = tid_ & 63, gw = blockIdx.x * 8 + (tid_ >> 6), NGW = gridDim.x * 8;
    const float* mod = (const float*)(p->ws + WS_MOD);
    bf16_t* hb = (bf16_t*)(p->ws + WS_HB);
    const bf16_t* o1 = (const bf16_t*)(p->ws + WS_O1);
    for (int r = gw; r < NLAT; r += 2 * NGW) {
        const int rb = r + NGW;
        f32x4 va[4], vb[4]; u32x2 da[4], db[4];
        row_load(p->x + (size_t)r * D, lane, va); row_load(p->x + (size_t)rb * D, lane, vb);
#pragma unroll
        for (int j = 0; j < 4; ++j) { da[j] = *(const u32x2*)(o1 + (size_t)r * D + 4 * lane + 256 * j); db[j] = *(const u32x2*)(o1 + (size_t)rb * D + 4 * lane + 256 * j); }
#pragma unroll
        for (int j = 0; j < 4; ++j) {
            va[j][0] += bflo(da[j].x); va[j][1] += bfhi(da[j].x); va[j][2] += bflo(da[j].y); va[j][3] += bfhi(da[j].y);
            vb[j][0] += bflo(db[j].x); vb[j][1] += bfhi(db[j].x); vb[j][2] += bflo(db[j].y); vb[j][3] += bfhi(db[j].y);
        }
        const float sa = row_rstd(va), sb = row_rstd(vb);
        const int ma = r >> 14, mb = rb >> 14;
        norm_mod_store(va, sa, p->norm2_g, mod + ma * 6144 + 3072, mod + ma * 6144 + 4096, hb + (size_t)(ma * H2_BSTRIDE + 1 + (r & (S - 1))) * D, lane);
        norm_mod_store(vb, sb, p->norm2_g, mod + mb * 6144 + 3072, mod + mb * 6144 + 4096, hb + (size_t)(mb * H2_BSTRIDE + 1 + (rb & (S - 1))) * D, lane);
    }
    for (int z = gw; z < 254; z += NGW) {
        const int R = z == 0 ? 0 : (z <= 126 ? S + z : 32895 + (z - 127));
        const u32x4 zz = {0u, 0u, 0u, 0u};
        *(u32x4*)(hb + (size_t)R * D + 8 * lane) = zz; *(u32x4*)(hb + (size_t)R * D + 512 + 8 * lane) = zz;
    }
}

__device__ __forceinline__ void final_phase(PP p, int wv) {
    const int tid_ = tid_opaque(wv), lane = tid_ & 63, gw = blockIdx.x * 8 + (tid_ >> 6), NGW = gridDim.x * 8;
    const bf16_t* o1 = (const bf16_t*)(p->ws + WS_O1); const bf16_t* o2 = (const bf16_t*)(p->ws + WS_O2);
    for (int r = gw; r < NLAT; r += 2 * NGW) {
        const int rb = r + NGW;
        f32x4 va[4], vb[4]; u32x2 da[4], db[4], ea[4], eb[4];
        row_load(p->x + (size_t)r * D, lane, va); row_load(p->x + (size_t)rb * D, lane, vb);
#pragma unroll
        for (int j = 0; j < 4; ++j) {
            da[j] = *(const u32x2*)(o1 + (size_t)r * D + 4 * lane + 256 * j); db[j] = *(const u32x2*)(o1 + (size_t)rb * D + 4 * lane + 256 * j);
            ea[j] = *(const u32x2*)(o2 + (size_t)r * D + 4 * lane + 256 * j); eb[j] = *(const u32x2*)(o2 + (size_t)rb * D + 4 * lane + 256 * j);
        }
#pragma unroll
        for (int j = 0; j < 4; ++j) {
            va[j][0] += bflo(da[j].x) + bflo(ea[j].x); va[j][1] += bfhi(da[j].x) + bfhi(ea[j].x); va[j][2] += bflo(da[j].y) + bflo(ea[j].y); va[j][3] += bfhi(da[j].y) + bfhi(ea[j].y);
            vb[j][0] += bflo(db[j].x) + bflo(eb[j].x); vb[j][1] += bfhi(db[j].x) + bfhi(eb[j].x); vb[j][2] += bflo(db[j].y) + bflo(eb[j].y); vb[j][3] += bfhi(db[j].y) + bfhi(eb[j].y);
        }
        const float sa = row_rstd(va), sb = row_rstd(vb);
        float* rowa = p->out + (size_t)r * D; float* rowb = p->out + (size_t)rb * D;
#pragma unroll
        for (int j = 0; j < 4; ++j) { const f32x4 gg = *(const f32x4*)(p->final_g + 4 * lane + 256 * j); *(f32x4*)(rowa + 4 * lane + 256 * j) = va[j] * sa * gg; *(f32x4*)(rowb + 4 * lane + 256 * j) = vb[j] * sb * gg; }
    }
}

__global__ void __launch_bounds__(512, 2) fwd_megakernel(Params p_arg) {
    extern __shared__ __attribute__((aligned(16))) unsigned char shm[];
    cg::grid_group grid = cg::this_grid();
    LAS unsigned char* lds = (LAS unsigned char*)shm;
    pg8::StaticOrder so;
    const int wv = __builtin_amdgcn_readfirstlane((int)(threadIdx.x >> 6));
    volatile LAS unsigned* xst = (volatile LAS unsigned*)(lds + LDS_XB);
    if (tid_opaque(wv) == 0) { xst[0] = 0u; xst[1] = 0u; }
    __syncthreads();
    (void)xcd_barrier_post((unsigned*)(kparams()->ws + WS_BAR), xst, wv);
#define XBAR() do { XcdBarrier _b; _b.bar = (unsigned*)(kparams()->ws + WS_BAR); _b.x = xb_xcc_id(); _b.st = (volatile LAS unsigned*)(lds + LDS_XB); xcd_barrier(_b, wv); } while (0)
    if (kparams()->out == nullptr) grid.sync();

    phase0(kparams(), shm, wv);
    XBAR();
    phase1(kparams(), wv);
    XBAR();
    {
        PP p = kparams(); unsigned char* ws = p->ws;
        pg8::Gemm g{(const bf16_t*)(ws + WS_HB), (const bf16_t*)(ws + WS_WIN), MROWS / 256, DIN / 256, D, 256};
        so.init(g.nM, g.nN, gridDim.x, blockIdx.x);
        EpiProj e{(bf16_t*)(ws + WS_PROJ), (const float*)(ws + WS_ROPE), (const float*)(ws + WS_ROPE) + 4096};
        pg8::gemm_phase(lds, g, so, e, wv);
    }
    XBAR();
    scan_mfma(kparams(), shm, wv);
    attn_mfma(kparams(), shm, wv);
    XBAR();
    carry_phase(kparams(), shm, wv);
    XBAR();
    mix_phase(kparams(), wv);
    XBAR();
    {
        PP p = kparams(); unsigned char* ws = p->ws; const float* mod = (const float*)(ws + WS_MOD);
        pg8::Gemm g{(const bf16_t*)(ws + WS_HB), (const bf16_t*)(ws + WS_WOUT), NLAT / 256, D / 256, D, 256};
        so.init(g.nM, g.nN, gridDim.x, blockIdx.x);
        EpiDelta e{(bf16_t*)(ws + WS_O1), mod + 2048, mod + 6144 + 2048};
        pg8::gemm_phase(lds, g, so, e, wv);
    }
    XBAR();
    phase7(kparams(), wv);
    XBAR();
    {
        PP p = kparams(); unsigned char* ws = p->ws;
        pg8::Gemm g{(const bf16_t*)(ws + WS_HB), (const bf16_t*)(ws + WS_WUP), 130, DUP / 256, D, 254};
        so.init(g.nM, g.nN, gridDim.x, blockIdx.x);
        EpiConvGate e{(bf16_t*)(ws + WS_ACT), p->ffn_conv_w, p->ffn_conv_b, lds + 131072};
        pg8::gemm_phase(lds, g, so, e, wv);
    }
    XBAR();
    {
        PP p = kparams(); unsigned char* ws = p->ws; const float* mod = (const float*)(ws + WS_MOD);
        pg8::Gemm g{(const bf16_t*)(ws + WS_ACT), (const bf16_t*)(ws + WS_WDN), NLAT / 256, D / 256, DFF, 256};
        so.init(g.nM, g.nN, gridDim.x, blockIdx.x);
        EpiDelta e{(bf16_t*)(ws + WS_O2), mod + 5120, mod + 6144 + 5120};
        pg8::gemm_phase(lds, g, so, e, wv);
    }
    XBAR();
    final_phase(kparams(), wv);
}

extern "C" void kernel_launch(void* const* d_in, const int* in_sizes, int n_in, void* d_out, int out_size, void* d_ws, size_t ws_size, hipStream_t stream) {
    static int grid_blocks = 0;
    if (!grid_blocks) {
        int dev = 0, cus = 0, per_cu = 0;
        hipGetDevice(&dev);
        hipDeviceGetAttribute(&cus, hipDeviceAttributeMultiprocessorCount, dev);
        hipFuncSetAttribute((const void*)fwd_megakernel, hipFuncAttributeMaxDynamicSharedMemorySize, LDS_BYTES);
        hipOccupancyMaxActiveBlocksPerMultiprocessor(&per_cu, (const void*)fwd_megakernel, 512, LDS_BYTES);
        if (per_cu < 1) per_cu = 1;
        grid_blocks = cus * per_cu;
        if (ws_size < WS_END) fprintf(stderr, "kernel_launch: workspace too small: %zu < %zu\n", ws_size, (size_t)WS_END);
    }
    Params p{};
    const float** pp = (const float**)&p;
    for (int i = 0; i < 25; ++i) pp[i] = (const float*)d_in[i];
    p.out = (float*)d_out; p.ws = (unsigned char*)d_ws;
    hipMemsetAsync((unsigned char*)d_ws + WS_BAR, 0, 16384, stream);
    void* args[] = {&p};
    hipError_t e = hipLaunchCooperativeKernel((const void*)fwd_megakernel, dim3(grid_blocks), dim3(512), args, LDS_BYTES, stream);
    if (e != hipSuccess) fprintf(stderr, "cooperative launch failed: %s (grid %d)\n", hipGetErrorString(e), grid_blocks);
}
```

```cpp
#include <hip/hip_runtime.h>
#include <hip/hip_cooperative_groups.h>
#include <cstdio>
namespace cg = cooperative_groups;

#define LAS __attribute__((address_space(3)))
typedef unsigned short bf16_t;
typedef short bf16x8 __attribute__((ext_vector_type(8)));
typedef float f32x4 __attribute__((ext_vector_type(4)));
typedef unsigned u32x4 __attribute__((ext_vector_type(4)));
typedef unsigned u32x2 __attribute__((ext_vector_type(2)));

constexpr int D = 1024, NB = 2, S = 16384, LC = 256;
constexpr int NLAT = NB * S;
constexpr int NCTX = NB * LC;
constexpr int MROWS = NLAT + NCTX;
constexpr int DIN = 1792, DFF = 2816, DUP = 5632, DRNN = 512;
constexpr int NCHUNK = MROWS / 64;
constexpr float EPS = 1e-6f;

constexpr size_t AL(size_t x) { return (x + 255) & ~(size_t)255; }
constexpr size_t WS_WIN  = 0;
constexpr size_t WS_WOUT = WS_WIN  + AL((size_t)DIN * D * 2);
constexpr size_t WS_WUP  = WS_WOUT + AL((size_t)D * D * 2);
constexpr size_t WS_WDN  = WS_WUP  + AL((size_t)DUP * D * 2);
constexpr size_t WS_LRU  = WS_WDN  + AL((size_t)D * DFF * 2);
constexpr size_t WS_MOD  = WS_LRU  + AL((size_t)4 * 8 * 64 * 64 * 2);
constexpr size_t WS_ROPE = WS_MOD  + AL((size_t)3 * 6144 * 4);
constexpr size_t WS_SUM  = WS_ROPE + AL((size_t)2 * 256 * 16 * 4);
constexpr size_t WS_CAR  = WS_SUM  + AL((size_t)2 * NCHUNK * 2 * 512 * 4);
constexpr size_t WS_SP8  = WS_CAR  + AL((size_t)2 * NCHUNK * 512 * 4);
constexpr size_t WS_BAR  = WS_SP8  + 4096;
constexpr size_t WS_HB   = WS_BAR  + 16384;
constexpr size_t WS_R1   = WS_HB   + AL((size_t)MROWS * D * 2);
constexpr size_t WS_PROJ = WS_R1;
constexpr size_t WS_ATT  = WS_PROJ + AL((size_t)MROWS * DIN * 2);
constexpr size_t WS_YL   = WS_ATT  + AL((size_t)NLAT * 512 * 2);
constexpr size_t WS_CAF  = WS_YL   + AL((size_t)NLAT * 512 * 2);
constexpr size_t WS_CAB  = WS_CAF  + AL((size_t)NLAT * 512 * 2);
constexpr size_t WS_R1END = WS_CAB + AL((size_t)NLAT * 512 * 2);
constexpr size_t WS_ACT  = WS_R1;
constexpr size_t WS_O1   = WS_ACT + AL((size_t)NLAT * DFF * 2);
constexpr size_t WS_O2   = WS_HB;
constexpr size_t WS_END  = WS_R1END;
static_assert(WS_O1 + (size_t)NLAT * D * 2 <= WS_R1END, "o1");
static_assert(WS_ACT + (size_t)NLAT * DFF * 2 <= WS_R1END, "act");
constexpr int H2_BSTRIDE = 65 * 254;
constexpr int H2_ROWS = 130 * 254 + 2;
static_assert((size_t)H2_ROWS * D * 2 <= (size_t)MROWS * D * 2, "h2");

constexpr int LDS_BYTES = 131072 + 8192 + 256;
constexpr int LDS_XB = 131072 + 8192;

struct Params {
    const float *x, *c, *ctx, *c_ctx, *w_mod, *b_mod, *norm1_g, *w_in, *rnn_conv_w, *rnn_conv_b, *lru_w_a, *lru_b_a,
        *lru_w_i, *lru_b_i, *lru_lam, *attn_sink, *gn_rnn, *gn_attn, *w_out, *norm2_g, *w_up, *ffn_conv_w, *ffn_conv_b,
        *w_down, *final_g;
    float* out;
    unsigned char* ws;
};

typedef const Params __attribute__((address_space(4)))* PP;
__device__ __forceinline__ PP kparams() { PP k = (PP)__builtin_amdgcn_kernarg_segment_ptr(); asm volatile("" : "+s"(k)); return k; }
__device__ __forceinline__ int lane_fresh() { unsigned m = ~0u; asm volatile("" : "+s"(m)); return (int)__builtin_amdgcn_mbcnt_hi(m, __builtin_amdgcn_mbcnt_lo(m, 0u)); }
__device__ __forceinline__ int tid_opaque(int wv) { return wv * 64 + lane_fresh(); }
__device__ __forceinline__ bf16_t f2bf(float f) { unsigned u = __float_as_uint(f); u += 0x7FFFu + ((u >> 16) & 1u); return (bf16_t)(u >> 16); }
__device__ __forceinline__ float bf2f(bf16_t b) { return __uint_as_float(((unsigned)b) << 16); }
__device__ __forceinline__ unsigned pk2(float lo, float hi) { unsigned r; asm("v_cvt_pk_bf16_f32 %0, %1, %2" : "=v"(r) : "v"(lo), "v"(hi)); return r; }
__device__ __forceinline__ float bflo(unsigned w) { return __uint_as_float(w << 16); }
__device__ __forceinline__ float bfhi(unsigned w) { return __uint_as_float(w & 0xFFFF0000u); }
__device__ __forceinline__ float wave_sum(float v) {
#pragma unroll
    for (int o = 32; o >= 1; o >>= 1) v += __shfl_xor(v, o);
    return v;
}
__device__ __forceinline__ float wave_max(float v) {
#pragma unroll
    for (int o = 32; o >= 1; o >>= 1) v = fmaxf(v, __shfl_xor(v, o));
    return v;
}
__device__ __forceinline__ float sigmoidf_(float x) { return 1.0f / (1.0f + __expf(-x)); }
__device__ __forceinline__ float fast_sigmoid(float x) { return __builtin_amdgcn_rcpf(1.0f + __builtin_amdgcn_exp2f(-1.4426950408889634f * x)); }
__device__ __forceinline__ float silu_(float x) { return x * fast_sigmoid(x); }
__device__ __forceinline__ float gelu_tanh_(float x) {
    const float u = 0.7978845608028654f * (x + 0.044715f * x * x * x);
    const float e = __expf(2.0f * u);
    const float th = 1.0f - 2.0f / (e + 1.0f);
    return 0.5f * x * (1.0f + th);
}


#define XB_TMO      128
#define XB_XCNT(j)  (256  + 64 * (j))
#define XB_XSUB(j)  (1280 + 64 * (j))
#define XB_XGEN(j)  (2304 + 64 * (j))
#define XB_TOP      3328
#define XB_TOPGEN   3392
#define XCD_BAR_WORDS 3456
#define XB_SPIN_CAP (1u << 20)
__device__ __forceinline__ unsigned xb_ld(unsigned* p)              { return __hip_atomic_load(p, __ATOMIC_RELAXED, __HIP_MEMORY_SCOPE_AGENT); }
__device__ __forceinline__ unsigned xb_add(unsigned* p, unsigned v) { return __hip_atomic_fetch_add(p, v, __ATOMIC_RELAXED, __HIP_MEMORY_SCOPE_AGENT); }
__device__ __forceinline__ unsigned xb_xcc_id() { return (unsigned)__builtin_amdgcn_s_getreg((3 << 11) | 20) & 0xFu; }
#define XB_SPIN(cond, bar) do { unsigned _sp = 0; while (cond) { __builtin_amdgcn_s_sleep(1); \
    if ((++_sp & 255u) == 0u) { if (xb_ld(&(bar)[XB_TMO])) break; if (_sp > XB_SPIN_CAP) { atomicAdd(&(bar)[XB_TMO], 1u); break; } } } } while (0)
struct XcdBarrier { unsigned* bar; unsigned x; volatile LAS unsigned* st; };
__device__ __forceinline__ XcdBarrier xcd_barrier_post(unsigned* bar, volatile LAS unsigned* st, int wv) {
    XcdBarrier b; b.bar = bar; b.x = xb_xcc_id(); b.st = st;
    if (tid_opaque(wv) == 0) (void)xb_add(&bar[XB_XCNT(b.x)], 1u);
    return b;
}
__device__ __forceinline__ void xcd_barrier_complete(unsigned* bar, unsigned x, unsigned& nloc, unsigned& nx) {
    const unsigned G = gridDim.x * gridDim.y * gridDim.z;
    unsigned sum, cnt, mine, sp = 0u;
    for (;;) {
        sum = 0u; cnt = 0u; mine = 0u;
#pragma unroll
        for (unsigned j = 0; j < 16; ++j) { const unsigned c = xb_ld(&bar[XB_XCNT(j)]); sum += c; cnt += (c > 0u) ? 1u : 0u; mine = (j == x) ? c : mine; }
        if (sum == G) break;
        __builtin_amdgcn_s_sleep(1);
        if ((++sp & 255u) == 0u) { if (xb_ld(&bar[XB_TMO])) break; if (sp > XB_SPIN_CAP) { atomicAdd(&bar[XB_TMO], 1u); break; } }
    }
    nloc = mine > 0u ? mine : 1u; nx = cnt > 0u ? cnt : 1u;
}
__device__ __forceinline__ void xcd_barrier(const XcdBarrier& b, int wv) {
    asm volatile("s_waitcnt vmcnt(0)" ::: "memory");
    __syncthreads();
    if (tid_opaque(wv) == 0) {
        unsigned* bar = b.bar;
        __builtin_amdgcn_s_waitcnt(0);
        unsigned nloc = b.st[0], nx = b.st[1];
        if (nloc == 0u) { xcd_barrier_complete(bar, b.x, nloc, nx); b.st[0] = nloc; b.st[1] = nx; }
        const unsigned old = xb_add(&bar[XB_XSUB(b.x)], 1u);
        const unsigned gen = old / nloc;
        if (old + 1u == (gen + 1u) * nloc) {
            __builtin_amdgcn_fence(__ATOMIC_RELEASE, "agent");
            asm volatile("s_waitcnt vmcnt(0)" ::: "memory");
            const unsigned og = xb_add(&bar[XB_TOP], 1u);
            const unsigned tg = og / nx;
            if (og + 1u == (tg + 1u) * nx) xb_add(&bar[XB_TOPGEN], 1u);
            else XB_SPIN(xb_ld(&bar[XB_TOPGEN]) == tg, bar);
            __builtin_amdgcn_fence(__ATOMIC_ACQUIRE, "agent");
            xb_add(&bar[XB_XGEN(b.x)], 1u);
            asm volatile("s_waitcnt vmcnt(0)" ::: "memory");
        } else {
            XB_SPIN(xb_ld(&bar[XB_XGEN(b.x)]) == gen, bar);
            __builtin_amdgcn_fence(__ATOMIC_ACQUIRE, "agent");
            asm volatile("s_waitcnt vmcnt(0)" ::: "memory");
        }
    }
    __syncthreads();
}

namespace pg8 {
constexpr int BM = 256, BK = 64, HALF = 128, HTB = HALF * BK * 2, NXCD = 8, WGM = 8;
__host__ __device__ __forceinline__ int lds_byte(int r, int c) { const int st = (r >> 4) * 2 + (c >> 5), rr = r & 15, cc = c & 31, ob = rr * 64 + cc * 2; return st * 1024 + (ob ^ (((ob >> 9) & 1) << 5)); }
__host__ __device__ __forceinline__ void stage_rc(int b, int& R, int& C) { const int st = b / 1024, sb = b % 1024, swz = sb ^ (((sb >> 9) & 1) << 5); R = (st >> 1) * 16 + swz / 64; C = (st & 1) * 32 + (swz % 64) / 2; }
struct Unit { int pm, pn; };
struct Gemm { const bf16_t* A; const bf16_t* Bt; int nM, nN, K, a_tile_rows; };
struct StaticOrder {
    int nM, nN, nwg, G, c;
    __device__ void init(int nM_, int nN_, int G_, int c_) { nM = nM_; nN = nN_; nwg = nM * nN; G = G_; c = c_; }
    __device__ bool next(int i, Unit& u) const {
        const long L = (long)i * G + c; if (L >= nwg) return false;
        int wgid = (int)L; { const int q = nwg / NXCD, r = nwg % NXCD, xcd = wgid % NXCD, off = wgid / NXCD; wgid = (xcd < r ? xcd * (q + 1) : r * (q + 1) + (xcd - r) * q) + off; }
        const int nig = WGM * nN, gid = wgid / nig, fm = gid * WGM, gsz = (nM - fm) < WGM ? (nM - fm) : WGM;
        u.pm = fm + ((wgid % nig) % gsz); u.pn = (wgid % nig) / gsz; return true;
    }
};
template <class Epi>
__device__ __forceinline__ void gemm_phase(LAS unsigned char* lds, const Gemm g, const StaticOrder& S, const Epi& E, int wv) {
    const int tid = tid_opaque(wv);
    const int wid = __builtin_amdgcn_readfirstlane(tid >> 6), lane = tid & 63, wr = wid >> 2, wc = wid & 3, fr = lane & 15, fq = lane >> 4;
    const int K = g.K, nt = K / BK;
    unsigned voffA[2], voffB[2];
#pragma unroll
    for (int i = 0; i < 2; ++i) { int R, C; stage_rc(tid * 16 + i * 8192, R, C);
        const int Ra = (R & ~63) + 4 * (R & 15) + ((R >> 4) & 3);
        voffA[i] = (unsigned)(Ra * K + C) * 2u; voffB[i] = (unsigned)(R * K + C) * 2u; }
    const size_t kstep = (size_t)(BK * 2);
    const size_t hstep = (size_t)HALF * K * 2;
    const size_t tstepA = (size_t)g.a_tile_rows * K * 2;
    const size_t tstepB = 2 * hstep;
    const unsigned ldsw = (unsigned)wid * 1024u;
    const int aoff = lds_byte(wr * 64 + fr, fq * 8), boff = lds_byte(wc * 32 + fr, fq * 8);
#define PG8_SA(b, h) (((b) * 2 + (h)) * HTB)
#define PG8_SB(b, h) ((4 + (b) * 2 + (h)) * HTB)
#define PG8_STAGE(bufoff, gbase, voff) do { _Pragma("unroll") for (int _i = 0; _i < 2; ++_i) \
        __builtin_amdgcn_global_load_lds((const unsigned*)((const char*)(gbase) + (voff)[_i]), (LAS unsigned*)(lds + (bufoff) + ldsw + _i * 8192), 16, 0, 0); } while (0)
#define PG8_LDA(dst, b, h) do { _Pragma("unroll") for (int m = 0; m < 4; ++m) _Pragma("unroll") for (int k = 0; k < 2; ++k) dst[m][k] = *(const LAS bf16x8*)(lds + PG8_SA(b, h) + aoff + m * 2048 + k * 1024); } while (0)
#define PG8_LDB(dst, b, h) do { _Pragma("unroll") for (int n = 0; n < 2; ++n) _Pragma("unroll") for (int k = 0; k < 2; ++k) dst[n][k] = *(const LAS bf16x8*)(lds + PG8_SB(b, h) + boff + n * 2048 + k * 1024); } while (0)
#define PG8_MMA(ai, bj, At, Bt) do { __builtin_amdgcn_s_setprio(1); _Pragma("unroll") for (int m = 0; m < 4; ++m) _Pragma("unroll") for (int n = 0; n < 2; ++n) _Pragma("unroll") for (int k = 0; k < 2; ++k) \
        acc[ai][bj][m][n] = __builtin_amdgcn_mfma_f32_16x16x32_bf16(Bt[n][k], At[m][k], acc[ai][bj][m][n], 0, 0, 0); __builtin_amdgcn_s_setprio(0); } while (0)
#define PG8_WAIT_V(n) asm volatile("s_waitcnt vmcnt(" #n ")" ::: "memory")
#define PG8_WAIT_L(n) asm volatile("s_waitcnt lgkmcnt(" #n ")" ::: "memory")
#define PG8_BAR __builtin_amdgcn_s_barrier()
#define PG8_SCHED __builtin_amdgcn_sched_barrier(0)
    Unit cur, nxt; int ui = 0;
    if (!S.next(0, cur)) return;
    f32x4 acc[2][2][4][2];
#pragma unroll
    for (int a = 0; a < 2; ++a)
#pragma unroll
        for (int b = 0; b < 2; ++b)
#pragma unroll
            for (int m = 0; m < 4; ++m)
#pragma unroll
                for (int n = 0; n < 2; ++n) acc[a][b][m][n] = (f32x4){0.f, 0.f, 0.f, 0.f};
    bf16x8 At[4][2], B0[2][2], B1[2][2];
    const char* cA = (const char*)g.A + (size_t)cur.pm * tstepA; const char* cB = (const char*)g.Bt + (size_t)cur.pn * tstepB;
    PG8_STAGE(PG8_SB(0, 0), cB, voffB); PG8_STAGE(PG8_SA(0, 0), cA, voffA); PG8_STAGE(PG8_SB(0, 1), cB + hstep, voffB); PG8_STAGE(PG8_SA(0, 1), cA + hstep, voffA);
    if (wr == 1) PG8_BAR;
    PG8_WAIT_V(4); PG8_BAR;
    PG8_STAGE(PG8_SB(1, 0), cB + kstep, voffB); PG8_STAGE(PG8_SA(1, 0), cA + kstep, voffA); PG8_STAGE(PG8_SB(1, 1), cB + hstep + kstep, voffB);
    PG8_WAIT_V(6); PG8_BAR;
    for (;;) {
        const bool has_next = S.next(ui + 1, nxt);
        const char* nA = has_next ? (const char*)g.A + (size_t)nxt.pm * tstepA : cA; const char* nB = has_next ? (const char*)g.Bt + (size_t)nxt.pn * tstepB : cB;
        for (int t = 0; t < nt; t += 2) {
            const bool last = (t == nt - 2);
            const char* a1 = cA + (size_t)(t + 1) * kstep;
            const char* a2 = last ? nA : cA + (size_t)(t + 2) * kstep; const char* b2 = last ? nB : cB + (size_t)(t + 2) * kstep;
            const char* a3 = a2 + kstep; const char* b3 = b2 + kstep;
            PG8_LDB(B0, 0, 0); PG8_SCHED; PG8_LDA(At, 0, 0); PG8_STAGE(PG8_SA(1, 1), a1 + hstep, voffA);
            PG8_WAIT_L(8); PG8_BAR; PG8_WAIT_L(0); PG8_MMA(0, 0, At, B0); PG8_BAR; PG8_SCHED;
            PG8_LDB(B1, 0, 1); PG8_STAGE(PG8_SB(0, 0), b2, voffB);
            PG8_BAR; PG8_WAIT_L(0); PG8_MMA(0, 1, At, B1); PG8_BAR;
            PG8_LDA(At, 0, 1); PG8_STAGE(PG8_SA(0, 0), a2, voffA);
            PG8_BAR; PG8_WAIT_L(0); PG8_MMA(1, 0, At, B0); PG8_BAR; PG8_SCHED;
            PG8_STAGE(PG8_SB(0, 1), b2 + hstep, voffB);
            PG8_WAIT_V(6); PG8_BAR; PG8_MMA(1, 1, At, B1); PG8_BAR;
            PG8_LDB(B0, 1, 0); PG8_SCHED; PG8_LDA(At, 1, 0); PG8_STAGE(PG8_SA(0, 1), a2 + hstep, voffA);
            PG8_WAIT_L(8); PG8_BAR; PG8_WAIT_L(0); PG8_MMA(0, 0, At, B0); PG8_BAR; PG8_SCHED;
            PG8_LDB(B1, 1, 1); PG8_STAGE(PG8_SB(1, 0), b3, voffB);
            PG8_BAR; PG8_WAIT_L(0); PG8_MMA(0, 1, At, B1); PG8_BAR;
            PG8_LDA(At, 1, 1); PG8_STAGE(PG8_SA(1, 0), a3, voffA);
            PG8_BAR; PG8_WAIT_L(0); PG8_MMA(1, 0, At, B0); PG8_BAR; PG8_SCHED;
            PG8_STAGE(PG8_SB(1, 1), b3 + hstep, voffB);
            PG8_WAIT_V(6); PG8_BAR; PG8_MMA(1, 1, At, B1); PG8_BAR;
        }
        { const int ln2 = lane_fresh();
          E(acc, cur, wr, wc, ln2 & 15, ln2 >> 4); }
        if (!has_next) break;
#pragma unroll
        for (int a = 0; a < 2; ++a)
#pragma unroll
            for (int b = 0; b < 2; ++b)
#pragma unroll
                for (int m = 0; m < 4; ++m)
#pragma unroll
                    for (int n = 0; n < 2; ++n) acc[a][b][m][n] = (f32x4){0.f, 0.f, 0.f, 0.f};
        cur = nxt; cA = nA; cB = nB; ++ui;
    }
    PG8_WAIT_V(0);
    if (wr == 0) PG8_BAR;
    PG8_BAR;
#undef PG8_SA
#undef PG8_SB
#undef PG8_STAGE
#undef PG8_LDA
#undef PG8_LDB
#undef PG8_MMA
#undef PG8_WAIT_V
#undef PG8_WAIT_L
#undef PG8_BAR
#undef PG8_SCHED
}
}
using pg8::Unit;

struct EpiProj {
    bf16_t* O; const float* cosT; const float* sinT;
    __device__ __forceinline__ void operator()(const f32x4 (&acc)[2][2][4][2], const Unit& u, int wr, int wc, int fr, int fq) const {
        const bool latent = u.pm < 128;
#pragma unroll
        for (int ai = 0; ai < 2; ++ai)
#pragma unroll
            for (int m = 0; m < 4; ++m) {
                const int row = u.pm * 256 + ai * 128 + wr * 64 + 4 * fr + m;
                const int t = row & (S - 1);
                const int pos = (wc & 1) ? (t & 63) : (t >> 6);
#pragma unroll
                for (int bj = 0; bj < 2; ++bj) {
                    const int col = u.pn * 256 + bj * 128 + wc * 32 + 4 * fq;
                    f32x4 v0 = acc[ai][bj][m][0], v1 = acc[ai][bj][m][1];
                    const bool rope = latent && (u.pn == 4 || u.pn == 5 || (u.pn == 6 && bj == 0));
                    if (rope) {
                        const f32x4 cs = *(const f32x4*)(cosT + pos * 16 + 4 * fq), sn = *(const f32x4*)(sinT + pos * 16 + 4 * fq);
                        const f32x4 n0 = v0 * cs - v1 * sn, n1 = v1 * cs + v0 * sn; v0 = n0; v1 = n1;
                    }
                    bf16_t* p = O + (size_t)row * DIN + col;
                    u32x2 w0, w1; w0.x = pk2(v0[0], v0[1]); w0.y = pk2(v0[2], v0[3]); w1.x = pk2(v1[0], v1[1]); w1.y = pk2(v1[2], v1[3]);
                    *(u32x2*)p = w0; *(u32x2*)(p + 16) = w1;
                }
            }
    }
};
struct EpiDelta {
    bf16_t* O; const float* gate0; const float* gate1;
    __device__ __forceinline__ void operator()(const f32x4 (&acc)[2][2][4][2], const Unit& u, int wr, int wc, int fr, int fq) const {
        const float* gate = (u.pm >= 64) ? gate1 : gate0;
        f32x4 gv[2][2];
#pragma unroll
        for (int bj = 0; bj < 2; ++bj)
#pragma unroll
            for (int n = 0; n < 2; ++n) gv[bj][n] = *(const f32x4*)(gate + u.pn * 256 + bj * 128 + wc * 32 + n * 16 + 4 * fq);
#pragma unroll
        for (int ai = 0; ai < 2; ++ai)
#pragma unroll
            for (int m = 0; m < 4; ++m) {
                const size_t row = (size_t)u.pm * 256 + ai * 128 + wr * 64 + 4 * fr + m;
#pragma unroll
                for (int bj = 0; bj < 2; ++bj)
#pragma unroll
                    for (int n = 0; n < 2; ++n) {
                        const f32x4 v = gv[bj][n] * acc[ai][bj][m][n];
                        u32x2 w; w.x = pk2(v[0], v[1]); w.y = pk2(v[2], v[3]);
                        *(u32x2*)(O + row * D + u.pn * 256 + bj * 128 + wc * 32 + n * 16 + 4 * fq) = w;
                    }
            }
    }
};

__device__ __forceinline__ float dpp_ror1(float v)  { return __int_as_float(__builtin_amdgcn_update_dpp(0, __float_as_int(v), 0x121, 0xF, 0xF, true)); }
__device__ __forceinline__ float dpp_ror15(float v) { return __int_as_float(__builtin_amdgcn_update_dpp(0, __float_as_int(v), 0x12F, 0xF, 0xF, true)); }
__device__ __forceinline__ float dpp_shr1(float v)  { return __int_as_float(__builtin_amdgcn_update_dpp(0, __float_as_int(v), 0x111, 0xF, 0xF, true)); }
__device__ __forceinline__ float dpp_shl1(float v)  { return __int_as_float(__builtin_amdgcn_update_dpp(0, __float_as_int(v), 0x101, 0xF, 0xF, true)); }

#define DPP_FMAC4X2(C, SA, WA, CTRLA, SB, WB, CTRLB) do { float _c0 = (C)[0], _c1 = (C)[1], _c2 = (C)[2], _c3 = (C)[3]; \
    asm("s_nop 1\n\t" \
        "v_fmac_f32_dpp %0, %4, %8 " CTRLA " row_mask:0xf bank_mask:0xf bound_ctrl:1\n\t" \
        "v_fmac_f32_dpp %1, %5, %9 " CTRLA " row_mask:0xf bank_mask:0xf bound_ctrl:1\n\t" \
        "v_fmac_f32_dpp %2, %6, %10 " CTRLA " row_mask:0xf bank_mask:0xf bound_ctrl:1\n\t" \
        "v_fmac_f32_dpp %3, %7, %11 " CTRLA " row_mask:0xf bank_mask:0xf bound_ctrl:1\n\t" \
        "v_fmac_f32_dpp %0, %12, %16 " CTRLB " row_mask:0xf bank_mask:0xf bound_ctrl:1\n\t" \
        "v_fmac_f32_dpp %1, %13, %17 " CTRLB " row_mask:0xf bank_mask:0xf bound_ctrl:1\n\t" \
        "v_fmac_f32_dpp %2, %14, %18 " CTRLB " row_mask:0xf bank_mask:0xf bound_ctrl:1\n\t" \
        "v_fmac_f32_dpp %3, %15, %19 " CTRLB " row_mask:0xf bank_mask:0xf bound_ctrl:1" \
        : "+v"(_c0), "+v"(_c1), "+v"(_c2), "+v"(_c3) \
        : "v"((SA)[0]), "v"((SA)[1]), "v"((SA)[2]), "v"((SA)[3]), "v"((WA)[0]), "v"((WA)[1]), "v"((WA)[2]), "v"((WA)[3]), \
          "v"((SB)[0]), "v"((SB)[1]), "v"((SB)[2]), "v"((SB)[3]), "v"((WB)[0]), "v"((WB)[1]), "v"((WB)[2]), "v"((WB)[3])); \
    (C)[0] = _c0; (C)[1] = _c1; (C)[2] = _c2; (C)[3] = _c3; } while (0)
#define DPP_FMAC4(C, SA, WA, CTRLA) do { float _c0 = (C)[0], _c1 = (C)[1], _c2 = (C)[2], _c3 = (C)[3]; \
    asm("s_nop 1\n\t" \
        "v_fmac_f32_dpp %0, %4, %8 " CTRLA " row_mask:0xf bank_mask:0xf bound_ctrl:1\n\t" \
        "v_fmac_f32_dpp %1, %5, %9 " CTRLA " row_mask:0xf bank_mask:0xf bound_ctrl:1\n\t" \
        "v_fmac_f32_dpp %2, %6, %10 " CTRLA " row_mask:0xf bank_mask:0xf bound_ctrl:1\n\t" \
        "v_fmac_f32_dpp %3, %7, %11 " CTRLA " row_mask:0xf bank_mask:0xf bound_ctrl:1" \
        : "+v"(_c0), "+v"(_c1), "+v"(_c2), "+v"(_c3) \
        : "v"((SA)[0]), "v"((SA)[1]), "v"((SA)[2]), "v"((SA)[3]), "v"((WA)[0]), "v"((WA)[1]), "v"((WA)[2]), "v"((WA)[3])); \
    (C)[0] = _c0; (C)[1] = _c1; (C)[2] = _c2; (C)[3] = _c3; } while (0)
struct EpiConvGate {
    bf16_t* act; const float* cw; const float* cbias; LAS unsigned char* xl;
    __device__ __forceinline__ void operator()(const f32x4 (&acc)[2][2][4][2], const Unit& u, int wr, int wc, int fr, int fq) const {
        if (wr == 0) { __builtin_amdgcn_s_barrier(); } asm volatile("" ::: "memory");
        LAS float* X = (LAS float*)xl;
        f32x4 wq[2][2][4];
#define CG_LOADW(N) do { _Pragma("unroll") for (int bj = 0; bj < 2; ++bj) { const int ch = 128 * u.pn + 32 * wc + 16 * (N) + 4 * fq + bj * DFF; \
            wq[N][bj][0] = *(const f32x4*)(cw + ch); wq[N][bj][1] = *(const f32x4*)(cw + DUP + ch); wq[N][bj][2] = *(const f32x4*)(cw + 2 * DUP + ch); wq[N][bj][3] = *(const f32x4*)(cbias + ch); } } while (0)
        CG_LOADW(0);
#pragma unroll
        for (int ai = 0; ai < 2; ++ai) {
            const int s = 2 * ai + wr;
            if (fr == 0) {
#pragma unroll
                for (int bj = 0; bj < 2; ++bj)
#pragma unroll
                    for (int n = 0; n < 2; ++n) *(LAS f32x4*)(X + ((s * 2 + 0) * 2 + bj) * 128 + 32 * wc + 16 * n + 4 * fq) = acc[ai][bj][0][n];
            }
            if (fr == 15) {
#pragma unroll
                for (int bj = 0; bj < 2; ++bj)
#pragma unroll
                    for (int n = 0; n < 2; ++n) *(LAS f32x4*)(X + ((s * 2 + 1) * 2 + bj) * 128 + 32 * wc + 16 * n + 4 * fq) = acc[ai][bj][3][n];
            }
        }
        asm volatile("s_waitcnt lgkmcnt(0)" ::: "memory");
        __builtin_amdgcn_s_barrier(); asm volatile("" ::: "memory");
#pragma unroll
        for (int n = 0; n < 2; ++n) {
            const int chg = 128 * u.pn + 32 * wc + 16 * n + 4 * fq;
            if (n == 1) CG_LOADW(1);
            f32x4 w0[2], w1[2], w2[2], bb[2], w0m[2], w2m[2];
#pragma unroll
            for (int bj = 0; bj < 2; ++bj) {
                w0[bj] = wq[n][bj][0]; w1[bj] = wq[n][bj][1]; w2[bj] = wq[n][bj][2]; bb[bj] = wq[n][bj][3];
                w0m[bj] = (fr == 0) ? w0[bj] : (f32x4){0.f, 0.f, 0.f, 0.f}; w2m[bj] = (fr == 15) ? w2[bj] : (f32x4){0.f, 0.f, 0.f, 0.f};
            }
#pragma unroll
            for (int ai = 0; ai < 2; ++ai) {
                const int s = 2 * ai + wr;
                f32x4 xp[2], xn[2];
#pragma unroll
                for (int bj = 0; bj < 2; ++bj) {
                    xp[bj] = *(const LAS f32x4*)(X + ((((s + 3) & 3) * 2 + 1) * 2 + bj) * 128 + 32 * wc + 16 * n + 4 * fq);
                    xn[bj] = *(const LAS f32x4*)(X + ((((s + 1) & 3) * 2 + 0) * 2 + bj) * 128 + 32 * wc + 16 * n + 4 * fq);
                }
                f32x4 cvv[4][2];
#pragma unroll
                for (int bj = 0; bj < 2; ++bj) {
                    const f32x4 a0 = acc[ai][bj][0][n], a1 = acc[ai][bj][1][n], a2 = acc[ai][bj][2][n], a3 = acc[ai][bj][3][n];
                    f32x4 c0 = bb[bj] + w1[bj] * a0 + w2[bj] * a1 + w0m[bj] * xp[bj];
                    f32x4 c1 = bb[bj] + w1[bj] * a1 + w0[bj] * a0 + w2[bj] * a2;
                    f32x4 c2 = bb[bj] + w1[bj] * a2 + w0[bj] * a1 + w2[bj] * a3;
                    f32x4 c3 = bb[bj] + w1[bj] * a3 + w0[bj] * a2 + w2m[bj] * xn[bj];
                    DPP_FMAC4(c0, a3, w0[bj], "row_shr:1");
                    DPP_FMAC4(c3, a0, w2[bj], "row_shl:1");
                    cvv[0][bj] = c0; cvv[1][bj] = c1; cvv[2][bj] = c2; cvv[3][bj] = c3;
                }
#pragma unroll
                for (int m = 0; m < 4; ++m) {
                    const int lr = 128 * ai + 64 * wr + 4 * fr + m;
                    const int R = 254 * u.pm + lr;
                    const int b = R >= (H2_BSTRIDE + 1) ? 1 : 0;
                    const int t = R - 1 - H2_BSTRIDE * b;
                    const bool valid = lr >= 1 && lr <= 254 && t >= 0 && t < S;
                    if (valid) {
                        u32x2 w;
                        w.x = pk2(silu_(cvv[m][0][0]) * cvv[m][1][0], silu_(cvv[m][0][1]) * cvv[m][1][1]);
                        w.y = pk2(silu_(cvv[m][0][2]) * cvv[m][1][2], silu_(cvv[m][0][3]) * cvv[m][1][3]);
                        *(u32x2*)(act + (size_t)(b * S + t) * DFF + chg) = w;
                    }
                }
            }
        }
        asm volatile("" ::: "memory"); if (wr == 1) { __builtin_amdgcn_s_barrier(); }
    }
};

#undef CG_LOADW
__device__ __forceinline__ void transpose_item(const float* W, int N, int k0, int n0, bf16_t* dst, int Kd, float* scr, int lane) {
#pragma unroll 16
    for (int i = 0; i < 32; ++i) { const int kk = 2 * i + (lane >> 5); scr[kk * 33 + (lane & 31)] = W[(size_t)(k0 + kk) * N + n0 + (lane & 31)]; }
    __builtin_amdgcn_wave_barrier();
    const int c = lane & 7;
#pragma unroll
    for (int j = 0; j < 4; ++j) {
        const int n = (lane >> 3) + 8 * j; const float* s = scr + (8 * c) * 33 + n;
        u32x4 o; o.x = pk2(s[0], s[33]); o.y = pk2(s[2 * 33], s[3 * 33]); o.z = pk2(s[4 * 33], s[5 * 33]); o.w = pk2(s[6 * 33], s[7 * 33]);
        *(u32x4*)(dst + (size_t)n * Kd + k0 + 8 * c) = o;
    }
    __builtin_amdgcn_wave_barrier();
}

__device__ __forceinline__ void phase0(PP p, unsigned char* shm, int wv) {
    const int tid = tid_opaque(wv), lane = tid & 63, wave = tid >> 6;
    unsigned char* ws = p->ws;
    if (blockIdx.x < 192) {
        float* sv = (float*)shm;
        float* red = sv + 3 * 1024;
        for (int i = tid; i < 3 * 1024; i += 512) {
            const int j = i >> 10, k = i & 1023;
            const float v = (j < 2) ? p->c[j * 1024 + k] : p->c_ctx[k];
            sv[i] = silu_(v);
        }
        __syncthreads();
        const int n0 = blockIdx.x * 32, col = tid & 31, ks = tid >> 5;
        float a0 = 0.f, a1 = 0.f, a2 = 0.f;
        const float* wp = p->w_mod + (size_t)(ks * 64) * 6144 + n0 + col;
#pragma unroll
        for (int k = 0; k < 64; ++k) {
            const float w = wp[(size_t)k * 6144];
            a0 += sv[ks * 64 + k] * w; a1 += sv[1024 + ks * 64 + k] * w; a2 += sv[2048 + ks * 64 + k] * w;
        }
        red[(ks * 3 + 0) * 32 + col] = a0; red[(ks * 3 + 1) * 32 + col] = a1; red[(ks * 3 + 2) * 32 + col] = a2;
        __syncthreads();
        if (tid < 96) {
            const int j = tid >> 5, cc = tid & 31; float s = p->b_mod[n0 + cc];
            for (int k = 0; k < 16; ++k) s += red[(k * 3 + j) * 32 + cc];
            ((float*)(ws + WS_MOD))[j * 6144 + n0 + cc] = s;
        }
        __syncthreads();
    }
    if (blockIdx.x == 200) { for (int i = tid; i < 1024; i += 512) ((float*)(ws + WS_SP8))[i] = -8.0f * log1pf(expf(-p->lru_lam[i])); }
    if (blockIdx.x >= 192 && blockIdx.x < 200) {
        const int idx = (blockIdx.x - 192) * 512 + tid;
        const int pos = idx >> 4, i = idx & 15;
        const float inv = powf(10000.0f, -(float)i / 16.0f);
        const float ang = (float)pos * inv;
        ((float*)(ws + WS_ROPE))[idx] = cosf(ang);
        ((float*)(ws + WS_ROPE))[4096 + idx] = sinf(ang);
    }
}
__device__ __forceinline__ void transpose_phase(PP p, unsigned char* shm, int wv, int it_lo, int it_hi, int gw0, int NGW) {
    const int tid = tid_opaque(wv), lane = tid & 63, wave = wv;
    unsigned char* ws = p->ws;
    float* scr = (float*)(shm + 32768) + wave * (64 * 33);
    const int gw = gw0 + wave;
    constexpr int I_IN = (D / 64) * (DIN / 32), I_OUT = (D / 64) * (D / 32), I_UP = (D / 64) * (DUP / 32), I_DN = (DFF / 64) * (D / 32), I_LRU = 2 * 2 * 8 * 2;
    constexpr int NIT = I_IN + I_OUT + I_UP + I_DN + I_LRU;
    (void)NIT;
    for (int it = it_lo + gw; it < it_hi; it += NGW) {
        int r = it;
        if (r >= I_IN + I_OUT + I_UP + I_DN + I_LRU) continue;
        if (r < I_IN) { const int nb = DIN / 32, kb = r / nb, n0 = (r % nb) * 32; transpose_item(p->w_in, DIN, kb * 64, n0, (bf16_t*)(ws + WS_WIN) + (size_t)n0 * D, D, scr, lane); continue; } r -= I_IN;
        if (r < I_OUT) { const int nb = D / 32, kb = r / nb, n0 = (r % nb) * 32; transpose_item(p->w_out, D, kb * 64, n0, (bf16_t*)(ws + WS_WOUT) + (size_t)n0 * D, D, scr, lane); continue; } r -= I_OUT;
        if (r < I_UP) { const int nb = DUP / 32, kb = r / nb, n0 = (r % nb) * 32;
            const int isv = n0 >= DFF, nn = isv ? n0 - DFF : n0, drow = (nn / 128) * 256 + isv * 128 + (nn % 128);
            transpose_item(p->w_up, DUP, kb * 64, n0, (bf16_t*)(ws + WS_WUP) + (size_t)drow * D, D, scr, lane); continue; } r -= I_UP;
        if (r < I_DN) { const int nb = D / 32, kb = r / nb, n0 = (r % nb) * 32; transpose_item(p->w_down, D, kb * 64, n0, (bf16_t*)(ws + WS_WDN) + (size_t)n0 * DFF, DFF, scr, lane); continue; } r -= I_DN;
        {
            const int nh = r & 1, blk = (r >> 1) & 7, type = (r >> 4) & 1, dir = r >> 5;
            const float* src = (type ? p->lru_w_i : p->lru_w_a) + (size_t)(dir * 8 + blk) * 4096;
            bf16_t* dst = (bf16_t*)(ws + WS_LRU) + (size_t)((dir * 2 + type) * 8 + blk) * 4096 + (size_t)(nh * 32) * 64;
            transpose_item(src, 64, 0, nh * 32, dst, 64, scr, lane);
        }
    }
}

__device__ __forceinline__ void row_load(const float* src, int lane, f32x4 (&v)[4]) {
#pragma unroll
    for (int j = 0; j < 4; ++j) v[j] = *(const f32x4*)(src + 4 * lane + 256 * j);
}
__device__ __forceinline__ float row_rstd(const f32x4 (&v)[4]) {
    float ss = 0.f;
#pragma unroll
    for (int j = 0; j < 4; ++j) ss += v[j][0] * v[j][0] + v[j][1] * v[j][1] + v[j][2] * v[j][2] + v[j][3] * v[j][3];
    return rsqrtf(wave_sum(ss) * (1.0f / D) + EPS);
}
__device__ __forceinline__ void norm_mod_store(const f32x4 (&v)[4], float rstd, const float* g, const float* sh, const float* sc, bf16_t* dst, int lane) {
#pragma unroll
    for (int j = 0; j < 4; ++j) {
        const int c = 4 * lane + 256 * j;
        const f32x4 gg = *(const f32x4*)(g + c), s1 = *(const f32x4*)(sc + c), s0 = *(const f32x4*)(sh + c);
        const f32x4 o = (v[j] * rstd * gg) * (s1 + 1.0f) + s0;
        u32x2 w; w.x = pk2(o[0], o[1]); w.y = pk2(o[2], o[3]);
        *(u32x2*)(dst + c) = w;
    }
}
__device__ __forceinline__ void phase1(PP p, int wv) {
    const int tid_ = tid_opaque(wv), lane = tid_ & 63, gw = blockIdx.x * 8 + (tid_ >> 6), NGW = gridDim.x * 8;
    const float* mod = (const float*)(p->ws + WS_MOD);
    bf16_t* hb = (bf16_t*)(p->ws + WS_HB);
    for (int r = gw; r < MROWS; r += 2 * NGW) {
        const int r2 = r + NGW; const bool has2 = r2 < MROWS;
        const int ra = r, rb = has2 ? r2 : r;
        f32x4 va[4], vb[4];
        row_load(ra < NLAT ? p->x + (size_t)ra * D : p->ctx + (size_t)(ra - NLAT) * D, lane, va);
        row_load(rb < NLAT ? p->x + (size_t)rb * D : p->ctx + (size_t)(rb - NLAT) * D, lane, vb);
        const int ma = ra < NLAT ? (ra >> 14) : 2, mb = rb < NLAT ? (rb >> 14) : 2;
        const float sa = row_rstd(va), sb = row_rstd(vb);
        norm_mod_store(va, sa, p->norm1_g, mod + ma * 6144, mod + ma * 6144 + 1024, hb + (size_t)ra * D, lane);
        if (has2) norm_mod_store(vb, sb, p->norm1_g, mod + mb * 6144, mod + mb * 6144 + 1024, hb + (size_t)rb * D, lane);
    }
}

typedef float f32x16 __attribute__((ext_vector_type(16)));
__device__ __forceinline__ unsigned cvt_pk_bf16(float lo, float hi) { unsigned r; asm("v_cvt_pk_bf16_f32 %0, %1, %2" : "=v"(r) : "v"(lo), "v"(hi)); return r; }
__device__ __forceinline__ void attn_mfma(PP p, unsigned char* shm, int wv) {
    const int tid = tid_opaque(wv);
    const int lane = tid & 63, wave = wv, l31 = lane & 31, hl = lane >> 5;
    bf16_t* Ks = (bf16_t*)shm;
    bf16_t* Vt = (bf16_t*)(shm + 18432);
    const bf16_t* proj = (const bf16_t*)(p->ws + WS_PROJ);
    bf16_t* att = (bf16_t*)(p->ws + WS_ATT);
    const float L2E = 1.4426950408889634f;
    const float SC2 = 0.125f * L2E;
    for (int item = blockIdx.x; item < 512; item += gridDim.x) {
        const int hk = item & 1, qb = (item >> 1) & 127, b = item >> 8;
        const int g = wave >> 1, qh = wave & 1, hq = hk * 4 + g;
        const int qrow0 = b * S + 128 * qb + 64 * qh;
        bf16x8 qf[2][4];
#pragma unroll
        for (int qi = 0; qi < 2; ++qi)
#pragma unroll
            for (int st = 0; st < 4; ++st) qf[qi][st] = *(const bf16x8*)(proj + (size_t)(qrow0 + 32 * qi + l31) * DIN + 1024 + 64 * hq + 16 * st + 8 * hl);
        const float sink2 = p->attn_sink[hq] * L2E;
        float mrun[2] = {sink2, sink2};
        float lrun[2] = {hl == 0 ? 1.f : 0.f, hl == 0 ? 1.f : 0.f};
        f32x16 oacc[2][2];
#pragma unroll
        for (int a = 0; a < 2; ++a)
#pragma unroll
            for (int c = 0; c < 2; ++c)
#pragma unroll
                for (int i = 0; i < 16; ++i) oacc[a][c][i] = 0.f;
        u32x4 kreg[2], vreg[2];
        int ci = (qb == 0) ? 1 : 0;
#define ATT_GLOAD(CI) do { const int _row0 = (CI) < 3 ? b * S + 128 * (qb - 1 + (CI)) : NLAT + b * LC + 128 * ((CI) - 3); \
        _Pragma("unroll") for (int _i = 0; _i < 2; ++_i) { const int _pi = tid + 512 * _i, _key = _pi >> 3, _part = _pi & 7; \
            const bf16_t* _src = proj + (size_t)(_row0 + _key) * DIN + 1536 + 64 * hk + 8 * _part; kreg[_i] = *(const u32x4*)_src; vreg[_i] = *(const u32x4*)(_src + 128); } } while (0)
        ATT_GLOAD(ci);
        while (ci < 5) {
            __syncthreads();
#pragma unroll
            for (int i = 0; i < 2; ++i) {
                const int pi = tid + 512 * i, key = pi >> 3, part = pi & 7;
                *(u32x4*)(Ks + key * 72 + 8 * part) = kreg[i];
#pragma unroll
                for (int e = 0; e < 8; ++e) { const unsigned w = vreg[i][e >> 1]; Vt[(8 * part + e) * 132 + key] = (bf16_t)((e & 1) ? (w >> 16) : (w & 0xFFFFu)); }
            }
            __syncthreads();
            int cn = ci + 1; if (cn == 2 && qb == 127) cn = 3;
            if (cn < 5) ATT_GLOAD(cn);
            const int kt_lo = (ci == 0 && qh == 1) ? 2 : 0, kt_hi = (ci == 2 && qh == 0) ? 2 : 4;
#pragma unroll 1
            for (int kt = kt_lo; kt < kt_hi; ++kt) {
                bf16x8 kf[4];
#pragma unroll
                for (int st = 0; st < 4; ++st) kf[st] = *(const bf16x8*)(Ks + (32 * kt + l31) * 72 + 16 * st + 8 * hl);
                bf16x8 vf[2][2];
#pragma unroll
                for (int db = 0; db < 2; ++db)
#pragma unroll
                    for (int s2 = 0; s2 < 2; ++s2) {
                        const bf16_t* vp = Vt + (32 * db + l31) * 132 + 32 * kt + 16 * s2 + 4 * hl;
                        const u32x2 lo = *(const u32x2*)vp, hi = *(const u32x2*)(vp + 8);
                        u32x4 w; w.x = lo.x; w.y = lo.y; w.z = hi.x; w.w = hi.y;
                        vf[db][s2] = __builtin_bit_cast(bf16x8, w);
                    }
#pragma unroll
                for (int qi = 0; qi < 2; ++qi) {
                    f32x16 s;
#pragma unroll
                    for (int i = 0; i < 16; ++i) s[i] = 0.f;
#pragma unroll
                    for (int st = 0; st < 4; ++st) s = __builtin_amdgcn_mfma_f32_32x32x16_bf16(kf[st], qf[qi][st], s, 0, 0, 0);
                    if (ci == 0 || ci == 2) {
                        asm volatile("");
                        const int dl = (ci == 0) ? (32 * kt + 4 * hl - (64 * qh + 32 * qi + l31)) : ((64 * qh + 32 * qi + l31) - 32 * kt - 4 * hl);
#pragma unroll
                        for (int i = 0; i < 16; ++i) {
                            const int ki = 8 * (i >> 2) + (i & 3);
                            const bool ok = (ci == 0) ? (dl + ki >= 0) : (dl - ki >= 0);
                            s[i] = ok ? s[i] : -1e30f;
                        }
                    }
                    float mx = s[0];
#pragma unroll
                    for (int i = 1; i < 16; ++i) mx = fmaxf(mx, s[i]);
                    mx = fmaxf(mx, __shfl_xor(mx, 32));
                    const float mnew = fmaxf(mrun[qi], mx * SC2);
                    if (__builtin_amdgcn_ballot_w64(mnew > mrun[qi]) != 0ull) {
                        const float alpha = __builtin_amdgcn_exp2f(mrun[qi] - mnew);
                        lrun[qi] *= alpha;
#pragma unroll
                        for (int db = 0; db < 2; ++db)
#pragma unroll
                            for (int i = 0; i < 16; ++i) oacc[db][qi][i] *= alpha;
                        mrun[qi] = mnew;
                    }
                    float ls = 0.f;
#pragma unroll
                    for (int i = 0; i < 16; ++i) { s[i] = __builtin_amdgcn_exp2f(__builtin_fmaf(s[i], SC2, -mnew)); ls += s[i]; }
                    lrun[qi] += ls;
                    bf16x8 pf[2];
#pragma unroll
                    for (int s2 = 0; s2 < 2; ++s2) {
                        u32x4 w; w.x = cvt_pk_bf16(s[8 * s2 + 0], s[8 * s2 + 1]); w.y = cvt_pk_bf16(s[8 * s2 + 2], s[8 * s2 + 3]);
                        w.z = cvt_pk_bf16(s[8 * s2 + 4], s[8 * s2 + 5]); w.w = cvt_pk_bf16(s[8 * s2 + 6], s[8 * s2 + 7]);
                        pf[s2] = __builtin_bit_cast(bf16x8, w);
                    }
#pragma unroll
                    for (int db = 0; db < 2; ++db)
#pragma unroll
                        for (int s2 = 0; s2 < 2; ++s2) oacc[db][qi] = __builtin_amdgcn_mfma_f32_32x32x16_bf16(vf[db][s2], pf[s2], oacc[db][qi], 0, 0, 0);
                }
            }
            ci = cn;
        }
#undef ATT_GLOAD
#pragma unroll
        for (int qi = 0; qi < 2; ++qi) {
            const float lt = lrun[qi] + __shfl_xor(lrun[qi], 32);
            const float inv = 1.0f / lt;
            bf16_t* orow = att + (size_t)(qrow0 + 32 * qi + l31) * 512 + hq * 64;
#pragma unroll
            for (int db = 0; db < 2; ++db)
#pragma unroll
                for (int g4 = 0; g4 < 4; ++g4) {
                    u32x2 w; w.x = cvt_pk_bf16(oacc[db][qi][4 * g4] * inv, oacc[db][qi][4 * g4 + 1] * inv); w.y = cvt_pk_bf16(oacc[db][qi][4 * g4 + 2] * inv, oacc[db][qi][4 * g4 + 3] * inv);
                    *(u32x2*)(orow + 32 * db + 8 * g4 + 4 * hl) = w;
                }
        }
    }
    __syncthreads();
}


template <int DIR>
__device__ __forceinline__ void scan_dir(PP p, const bf16_t* xs, int n, int ct, int l31, int hl, int id, int rowbase, bool latent, float (&hf)[2][16]) {
    constexpr int XS = 520;
    const int ch = 64 * n + 32 * ct + l31;
    const float ba = p->lru_b_a[DIR * 512 + ch], bi = p->lru_b_i[DIR * 512 + ch];
    const float sp8l2 = ((const float*)(p->ws + WS_SP8))[DIR * 512 + ch] * 1.4426950408889634f;
    const bf16_t* lru = (const bf16_t*)(p->ws + WS_LRU);
    const bf16_t* wa_p = lru + (size_t)((DIR * 2 + 0) * 8 + n) * 4096 + (32 * ct + l31) * 64 + 8 * hl;
    const bf16_t* wi_p = lru + (size_t)((DIR * 2 + 1) * 8 + n) * 4096 + (32 * ct + l31) * 64 + 8 * hl;
    bf16x8 wfa[4], wfi[4];
#pragma unroll
    for (int st = 0; st < 4; ++st) { wfa[st] = *(const bf16x8*)(wa_p + 16 * st); wfi[st] = *(const bf16x8*)(wi_p + 16 * st); }
    float a[2][16], u[2][16];
#pragma unroll
    for (int rt = 0; rt < 2; ++rt) {
        bf16x8 af[4];
#pragma unroll
        for (int st = 0; st < 4; ++st) af[st] = *(const bf16x8*)(xs + (32 * rt + l31) * XS + 64 * n + 16 * st + 8 * hl);
        f32x16 ga, gi;
#pragma unroll
        for (int i = 0; i < 16; ++i) { ga[i] = 0.f; gi[i] = 0.f; }
#pragma unroll
        for (int st = 0; st < 4; ++st) { ga = __builtin_amdgcn_mfma_f32_32x32x16_bf16(af[st], wfa[st], ga, 0, 0, 0); gi = __builtin_amdgcn_mfma_f32_32x32x16_bf16(af[st], wfi[st], gi, 0, 0, 0); }
#pragma unroll
        for (int i = 0; i < 16; ++i) {
            const int token = 32 * rt + 8 * (i >> 2) + 4 * hl + (i & 3);
            const float xv = bf2f(xs[token * XS + ch]);
            const float rr = fast_sigmoid(ga[i] + ba), ii = fast_sigmoid(gi[i] + bi);
            const float la2 = rr * sp8l2;
            const float av = __builtin_amdgcn_exp2f(la2);
            const float t2 = la2 * 1.3862943611f;
            float em1p = t2 * (1.0f + t2 * (0.5f + t2 * (0.16666667f + t2 * (0.041666668f + t2 * 0.0083333333f)))), em1e = __builtin_fmaf(av, av, -1.0f);
            asm volatile("" : "+v"(em1p), "+v"(em1e));
            const float em1 = (t2 > -0.1f) ? em1p : em1e;
            a[rt][i] = av; u[rt][i] = __builtin_amdgcn_sqrtf(-em1) * (ii * xv);
        }
    }
    float Ao[8], Ho[8], Ap[8], Hp[8];
#pragma unroll
    for (int k = 0; k < 8; ++k) {
        const int rt = k >> 2, g = k & 3;
        float H = 0.f, A = 1.f;
#pragma unroll
        for (int jj = 0; jj < 4; ++jj) { const int j = DIR ? 3 - jj : jj; const float av = a[rt][4 * g + j]; H = av * H + u[rt][4 * g + j]; A *= av; }
        Ao[k] = A; Ho[k] = H; Ap[k] = __shfl_xor(A, 32); Hp[k] = __shfl_xor(H, 32);
    }
    float Sin[8], Pin[8]; float Sx = 0.f, Px = 1.f;
#pragma unroll
    for (int kk = 0; kk < 8; ++kk) {
        const int k = DIR ? 7 - kk : kk;
        const float A0 = hl ? Ap[k] : Ao[k], H0 = hl ? Hp[k] : Ho[k], A1 = hl ? Ao[k] : Ap[k], H1 = hl ? Ho[k] : Hp[k];
        float s0, p0, s1, p1;
        if (DIR == 0) { s0 = Sx; p0 = Px; Sx = A0 * Sx + H0; Px *= A0; s1 = Sx; p1 = Px; Sx = A1 * Sx + H1; Px *= A1; }
        else          { s1 = Sx; p1 = Px; Sx = A1 * Sx + H1; Px *= A1; s0 = Sx; p0 = Px; Sx = A0 * Sx + H0; Px *= A0; }
        Sin[k] = hl ? s1 : s0; Pin[k] = hl ? p1 : p0;
    }
    bf16_t* yl = (bf16_t*)(p->ws + WS_YL) + (size_t)rowbase * 512; bf16_t* caf = (bf16_t*)(p->ws + WS_CAF) + (size_t)rowbase * 512; bf16_t* cab = (bf16_t*)(p->ws + WS_CAB) + (size_t)rowbase * 512;
    unsigned lo = (unsigned)ch; asm volatile("" : "+v"(lo));
#pragma unroll
    for (int k = 0; k < 8; ++k) {
        const int rt = k >> 2, g = k & 3;
        float h = Sin[k], P = Pin[k];
#pragma unroll
        for (int jj = 0; jj < 4; ++jj) {
            const int j = DIR ? 3 - jj : jj, idx = 4 * g + j;
            h = a[rt][idx] * h + u[rt][idx]; P *= a[rt][idx];
            const int token = 32 * rt + 8 * g + 4 * hl + j;
            const unsigned o = lo + (unsigned)token * 512u;
            if (DIR == 0) { hf[rt][idx] = h; if (latent) caf[o] = f2bf(P); }
            else if (latent) { yl[o] = f2bf(hf[rt][idx] + h); cab[o] = f2bf(P); }
        }
    }
    if (hl == 0) {
        float* sumb = (float*)(p->ws + WS_SUM);
        sumb[((size_t)(DIR * NCHUNK + id) * 2 + 0) * 512 + ch] = Px;
        sumb[((size_t)(DIR * NCHUNK + id) * 2 + 1) * 512 + ch] = Sx;
    }
}
__device__ __forceinline__ void scan_mfma(PP p, unsigned char* shm, int wv) {
    const int tid = tid_opaque(wv);
    const int lane = tid & 63, n = wv, l31 = lane & 31, hl = lane >> 5;
    constexpr int XS = 520;
    bf16_t* xs = (bf16_t*)shm;
    const bf16_t* proj = (const bf16_t*)(p->ws + WS_PROJ);
    for (int item = blockIdx.x; item < 512 + 32; item += gridDim.x) {
        const int id = item < 512 ? item : 512 + ((item - 512) >> 2);
        const int quarter = item < 512 ? -1 : ((item - 512) & 3);
        int rowbase, t0, seqlen; bool latent;
        if (id < 512) { const int b = id >> 8, k = id & 255; t0 = 64 * k; rowbase = b * S + t0; seqlen = S; latent = true; }
        else { const int j = id - 512, b = j >> 2, k = j & 3; t0 = 64 * k; rowbase = NLAT + b * LC + t0; seqlen = LC; latent = false; }
        const int seqbase = rowbase - t0;
        {
            bf16_t* raw = (bf16_t*)(shm + 66560);
#pragma unroll
            for (int i = 0; i < 9; ++i) {
                const int piece = tid + 512 * i;
                if (piece < 67 * 64) {
                    const int row = piece >> 6, c8 = piece & 63, tt = t0 - 2 + row;
                    u32x4 v = {0u, 0u, 0u, 0u};
                    if (tt >= 0 && tt < seqlen) v = *(const u32x4*)(proj + (size_t)(seqbase + tt) * DIN + 8 * c8);
                    *(u32x4*)(raw + row * 512 + 8 * c8) = v;
                }
            }
            __syncthreads();
            const int c = tid;
            const float cw0 = p->rnn_conv_w[c], cw1 = p->rnn_conv_w[512 + c], cw2 = p->rnn_conv_w[1024 + c], cw3 = p->rnn_conv_w[1536 + c], cb = p->rnn_conv_b[c];
            float xm2 = bf2f(raw[c]), xm1 = bf2f(raw[512 + c]), x0 = bf2f(raw[1024 + c]);
#pragma unroll 8
            for (int t = 0; t < 64; ++t) {
                const float xp1 = bf2f(raw[(t + 3) * 512 + c]);
                xs[t * XS + c] = f2bf(cb + cw0 * xm2 + cw1 * xm1 + cw2 * x0 + cw3 * xp1);
                xm2 = xm1; xm1 = x0; x0 = xp1;
            }
        }
        __syncthreads();
#pragma unroll 1
        for (int ct = 0; ct < 2; ++ct) {
            float hf[2][16];
            if (quarter < 0 || quarter == 2 * ct + 0) scan_dir<0>(p, xs, n, ct, l31, hl, id, rowbase, latent, hf);
            if (quarter < 0 || quarter == 2 * ct + 1) scan_dir<1>(p, xs, n, ct, l31, hl, id, rowbase, latent, hf);
        }
        __syncthreads();
    }
}

__device__ __forceinline__ void carry_phase(PP p, unsigned char* shm, int wv) {
    if (blockIdx.x >= 128) return;
    const int tid = tid_opaque(wv), cl = tid & 15, sg = tid >> 4;
    const int b = blockIdx.x >> 6, dir = (blockIdx.x >> 5) & 1, c = (blockIdx.x & 31) * 16 + cl;
    const float* sumb = (const float*)(p->ws + WS_SUM) + (size_t)dir * NCHUNK * 1024;
    float* car = (float*)(p->ws + WS_CAR) + (size_t)dir * NCHUNK * 512;
    float* segA = (float*)shm; float* segH = segA + 512;
    float A[9], H[9]; int ids[9];
#pragma unroll
    for (int k = 0; k < 9; ++k) {
        const int s = sg * 9 + k;
        int id = -1;
        if (s < 260) { if (dir == 0) id = s < 4 ? 512 + 4 * b + s : 256 * b + (s - 4); else id = s < 4 ? 512 + 4 * b + (3 - s) : 256 * b + (255 - (s - 4)); }
        ids[k] = id;
        A[k] = id >= 0 ? sumb[(size_t)id * 1024 + c] : 1.f;
        H[k] = id >= 0 ? sumb[(size_t)id * 1024 + 512 + c] : 0.f;
    }
    float As = 1.f, Hs = 0.f;
#pragma unroll
    for (int k = 0; k < 9; ++k) { Hs = A[k] * Hs + H[k]; As *= A[k]; }
    segA[sg * 16 + cl] = As; segH[sg * 16 + cl] = Hs;
    __syncthreads();
    float h = 0.f;
    for (int j = 0; j < sg; ++j) h = segA[j * 16 + cl] * h + segH[j * 16 + cl];
#pragma unroll
    for (int k = 0; k < 9; ++k) { if (ids[k] >= 0) car[(size_t)ids[k] * 512 + c] = h; h = A[k] * h + H[k]; }
    __syncthreads();
}

__device__ __forceinline__ void mix_phase(PP p, int wv) {
    const int tid_ = tid_opaque(wv), lane = tid_ & 63, gw = blockIdx.x * 8 + (tid_ >> 6), NGW = gridDim.x * 8;
    const bf16_t* proj = (const bf16_t*)(p->ws + WS_PROJ);
    const bf16_t* att = (const bf16_t*)(p->ws + WS_ATT);
    const bf16_t* yl = (const bf16_t*)(p->ws + WS_YL); const bf16_t* caf = (const bf16_t*)(p->ws + WS_CAF); const bf16_t* cab = (const bf16_t*)(p->ws + WS_CAB);
    const float* car = (const float*)(p->ws + WS_CAR);
    bf16_t* mix = (bf16_t*)(p->ws + WS_HB);
    const int c0 = 8 * lane;
    for (int r = gw; r < NLAT; r += NGW) {
        const int id = r >> 6;
        const u32x4 vy = *(const u32x4*)(yl + (size_t)r * 512 + c0), vf = *(const u32x4*)(caf + (size_t)r * 512 + c0), vb = *(const u32x4*)(cab + (size_t)r * 512 + c0);
        const u32x4 vg = *(const u32x4*)(proj + (size_t)r * DIN + 512 + c0), va = *(const u32x4*)(att + (size_t)r * 512 + c0);
        const float* cf = car + (size_t)id * 512 + c0; const float* cbk = car + (size_t)(NCHUNK + id) * 512 + c0;
        float rn[8], at[8]; float s1 = 0.f, s2 = 0.f;
#pragma unroll
        for (int e = 0; e < 8; ++e) {
            const unsigned wy = vy[e >> 1], wf = vf[e >> 1], wb = vb[e >> 1], wg = vg[e >> 1], wa = va[e >> 1];
            const float y = ((e & 1) ? bfhi(wy) : bflo(wy)) + ((e & 1) ? bfhi(wf) : bflo(wf)) * cf[e] + ((e & 1) ? bfhi(wb) : bflo(wb)) * cbk[e];
            const float xg = (e & 1) ? bfhi(wg) : bflo(wg);
            rn[e] = gelu_tanh_(xg) * y; s1 += rn[e] * rn[e];
            at[e] = (e & 1) ? bfhi(wa) : bflo(wa); s2 += at[e] * at[e];
        }
        const float r1 = rsqrtf(wave_sum(s1) * (1.0f / 512.0f) + EPS), r2 = rsqrtf(wave_sum(s2) * (1.0f / 512.0f) + EPS);
        u32x4 o1, o2;
#pragma unroll
        for (int e2 = 0; e2 < 4; ++e2) {
            o1[e2] = pk2(rn[2 * e2] * r1 * p->gn_rnn[c0 + 2 * e2], rn[2 * e2 + 1] * r1 * p->gn_rnn[c0 + 2 * e2 + 1]);
            o2[e2] = pk2(at[2 * e2] * r2 * p->gn_attn[c0 + 2 * e2], at[2 * e2 + 1] * r2 * p->gn_attn[c0 + 2 * e2 + 1]);
        }
        *(u32x4*)(mix + (size_t)r * D + c0) = o1; *(u32x4*)(mix + (size_t)r * D + 512 + c0) = o2;
    }
}

__device__ __forceinline__ void phase7(PP p, int wv) {
    const int tid_ = tid_opaque(wv), lane = tid_ & 63, gw = blockIdx.x * 8 + (tid_ >> 6), NGW = gridDim.x * 8;
    const float* mod = (const float*)(p->ws + WS_MOD);
    bf16_t* hb = (bf16_t*)(p->ws + WS_HB);
    const bf16_t* o1 = (const bf16_t*)(p->ws + WS_O1);
    for (int r = gw; r < NLAT; r += 2 * NGW) {
        const int rb = r + NGW;
        f32x4 va[4], vb[4]; u32x2 da[4], db[4];
        row_load(p->x + (size_t)r * D, lane, va); row_load(p->x + (size_t)rb * D, lane, vb);
#pragma unroll
        for (int j = 0; j < 4; ++j) { da[j] = *(const u32x2*)(o1 + (size_t)r * D + 4 * lane + 256 * j); db[j] = *(const u32x2*)(o1 + (size_t)rb * D + 4 * lane + 256 * j); }
#pragma unroll
        for (int j = 0; j < 4; ++j) {
            va[j][0] += bflo(da[j].x); va[j][1] += bfhi(da[j].x); va[j][2] += bflo(da[j].y); va[j][3] += bfhi(da[j].y);
            vb[j][0] += bflo(db[j].x); vb[j][1] += bfhi(db[j].x); vb[j][2] += bflo(db[j].y); vb[j][3] += bfhi(db[j].y);
        }
        const float sa = row_rstd(va), sb = row_rstd(vb);
        const int ma = r >> 14, mb = rb >> 14;
        norm_mod_store(va, sa, p->norm2_g, mod + ma * 6144 + 3072, mod + ma * 6144 + 4096, hb + (size_t)(ma * H2_BSTRIDE + 1 + (r & (S - 1))) * D, lane);
        norm_mod_store(vb, sb, p->norm2_g, mod + mb * 6144 + 3072, mod + mb * 6144 + 4096, hb + (size_t)(mb * H2_BSTRIDE + 1 + (rb & (S - 1))) * D, lane);
    }
    for (int z = gw; z < 254; z += NGW) {
        const int R = z == 0 ? 0 : (z <= 126 ? S + z : 32895 + (z - 127));
        const u32x4 zz = {0u, 0u, 0u, 0u};
        *(u32x4*)(hb + (size_t)R * D + 8 * lane) = zz; *(u32x4*)(hb + (size_t)R * D + 512 + 8 * lane) = zz;
    }
}

__device__ __forceinline__ void final_phase(PP p, int wv) {
    const int tid_ = tid_opaque(wv), lane = tid_ & 63, gw = blockIdx.x * 8 + (tid_ >> 6), NGW = gridDim.x * 8;
    const bf16_t* o1 = (const bf16_t*)(p->ws + WS_O1); const bf16_t* o2 = (const bf16_t*)(p->ws + WS_O2);
    for (int r = gw; r < NLAT; r += 2 * NGW) {
        const int rb = r + NGW;
        f32x4 va[4], vb[4]; u32x2 da[4], db[4], ea[4], eb[4];
        row_load(p->x + (size_t)r * D, lane, va); row_load(p->x + (size_t)rb * D, lane, vb);
#pragma unroll
        for (int j = 0; j < 4; ++j) {
            da[j] = *(const u32x2*)(o1 + (size_t)r * D + 4 * lane + 256 * j); db[j] = *(const u32x2*)(o1 + (size_t)rb * D + 4 * lane + 256 * j);
            ea[j] = *(const u32x2*)(o2 + (size_t)r * D + 4 * lane + 256 * j); eb[j] = *(const u32x2*)(o2 + (size_t)rb * D + 4 * lane + 256 * j);
        }
#pragma unroll
        for (int j = 0; j < 4; ++j) {
            va[j][0] += bflo(da[j].x) + bflo(ea[j].x); va[j][1] += bfhi(da[j].x) + bfhi(ea[j].x); va[j][2] += bflo(da[j].y) + bflo(ea[j].y); va[j][3] += bfhi(da[j].y) + bfhi(ea[j].y);
            vb[j][0] += bflo(db[j].x) + bflo(eb[j].x); vb[j][1] += bfhi(db[j].x) + bfhi(eb[j].x); vb[j][2] += bflo(db[j].y) + bflo(eb[j].y); vb[j][3] += bfhi(db[j].y) + bfhi(eb[j].y);
        }
        const float sa = row_rstd(va), sb = row_rstd(vb);
        float* rowa = p->out + (size_t)r * D; float* rowb = p->out + (size_t)rb * D;
#pragma unroll
        for (int j = 0; j < 4; ++j) { const f32x4 gg = *(const f32x4*)(p->final_g + 4 * lane + 256 * j); *(f32x4*)(rowa + 4 * lane + 256 * j) = va[j] * sa * gg; *(f32x4*)(rowb + 4 * lane + 256 * j) = vb[j] * sb * gg; }
    }
}

__global__ void __launch_bounds__(512, 2) fwd_megakernel(Params p_arg) {
    extern __shared__ __attribute__((aligned(16))) unsigned char shm[];
    cg::grid_group grid = cg::this_grid();
    LAS unsigned char* lds = (LAS unsigned char*)shm;
    pg8::StaticOrder so;
    const int wv = __builtin_amdgcn_readfirstlane((int)(threadIdx.x >> 6));
    volatile LAS unsigned* xst = (volatile LAS unsigned*)(lds + LDS_XB);
    if (tid_opaque(wv) == 0) { xst[0] = 0u; xst[1] = 0u; }
    __syncthreads();
    (void)xcd_barrier_post((unsigned*)(kparams()->ws + WS_BAR), xst, wv);
#define XBAR() do { XcdBarrier _b; _b.bar = (unsigned*)(kparams()->ws + WS_BAR); _b.x = xb_xcc_id(); _b.st = (volatile LAS unsigned*)(lds + LDS_XB); xcd_barrier(_b, wv); } while (0)
    if (kparams()->out == nullptr) grid.sync();

    phase0(kparams(), shm, wv);
    {
        constexpr int T_IN = (D / 64) * (DIN / 32), T_B = (D / 64) * (D / 32) + (D / 64) * (DUP / 32) + (DFF / 64) * (D / 32), T_LRU = 64;
        const int nfree = (int)gridDim.x > 192 ? (int)gridDim.x - 192 : 0;
        const int first = nfree ? 192 : 0, nblk = nfree ? nfree : (int)gridDim.x;
        if ((int)blockIdx.x >= first) {
            transpose_phase(kparams(), shm, wv, 0, T_IN, ((int)blockIdx.x - first) * 8, nblk * 8);
            transpose_phase(kparams(), shm, wv, T_IN + T_B, T_IN + T_B + T_LRU, ((int)blockIdx.x - first) * 8, nblk * 8);
        }
    }
    XBAR();
    phase1(kparams(), wv);
    XBAR();
    {
        PP p = kparams(); unsigned char* ws = p->ws;
        pg8::Gemm g{(const bf16_t*)(ws + WS_HB), (const bf16_t*)(ws + WS_WIN), MROWS / 256, DIN / 256, D, 256};
        so.init(g.nM, g.nN, gridDim.x, blockIdx.x);
        EpiProj e{(bf16_t*)(ws + WS_PROJ), (const float*)(ws + WS_ROPE), (const float*)(ws + WS_ROPE) + 4096};
        pg8::gemm_phase(lds, g, so, e, wv);
        {
            constexpr int T_IN = (D / 64) * (DIN / 32), T_B = (D / 64) * (D / 32) + (D / 64) * (DUP / 32) + (DFF / 64) * (D / 32);
            const int G = (int)gridDim.x, rem = (g.nM * g.nN) % G;
            const int first = rem ? rem : 0, nblk = G - first;
            if ((int)blockIdx.x >= first) transpose_phase(p, shm, wv, T_IN, T_IN + T_B, ((int)blockIdx.x - first) * 8, nblk * 8);
        }
    }
    XBAR();
    scan_mfma(kparams(), shm, wv);
    attn_mfma(kparams(), shm, wv);
    XBAR();
    carry_phase(kparams(), shm, wv);
    XBAR();
    mix_phase(kparams(), wv);
    XBAR();
    {
        PP p = kparams(); unsigned char* ws = p->ws; const float* mod = (const float*)(ws + WS_MOD);
        pg8::Gemm g{(const bf16_t*)(ws + WS_HB), (const bf16_t*)(ws + WS_WOUT), NLAT / 256, D / 256, D, 256};
        so.init(g.nM, g.nN, gridDim.x, blockIdx.x);
        EpiDelta e{(bf16_t*)(ws + WS_O1), mod + 2048, mod + 6144 + 2048};
        pg8::gemm_phase(lds, g, so, e, wv);
    }
    XBAR();
    phase7(kparams(), wv);
    XBAR();
    {
        PP p = kparams(); unsigned char* ws = p->ws;
        pg8::Gemm g{(const bf16_t*)(ws + WS_HB), (const bf16_t*)(ws + WS_WUP), 130, DUP / 256, D, 254};
        so.init(g.nM, g.nN, gridDim.x, blockIdx.x);
        EpiConvGate e{(bf16_t*)(ws + WS_ACT), p->ffn_conv_w, p->ffn_conv_b, lds + 131072};
        pg8::gemm_phase(lds, g, so, e, wv);
    }
    XBAR();
    {
        PP p = kparams(); unsigned char* ws = p->ws; const float* mod = (const float*)(ws + WS_MOD);
        pg8::Gemm g{(const bf16_t*)(ws + WS_ACT), (const bf16_t*)(ws + WS_WDN), NLAT / 256, D / 256, DFF, 256};
        so.init(g.nM, g.nN, gridDim.x, blockIdx.x);
        EpiDelta e{(bf16_t*)(ws + WS_O2), mod + 5120, mod + 6144 + 5120};
        pg8::gemm_phase(lds, g, so, e, wv);
    }
    XBAR();
    final_phase(kparams(), wv);
}

extern "C" void kernel_launch(void* const* d_in, const int* in_sizes, int n_in, void* d_out, int out_size, void* d_ws, size_t ws_size, hipStream_t stream) {
    static int grid_blocks = 0;
    if (!grid_blocks) {
        int dev = 0, cus = 0, per_cu = 0;
        hipGetDevice(&dev);
        hipDeviceGetAttribute(&cus, hipDeviceAttributeMultiprocessorCount, dev);
        hipFuncSetAttribute((const void*)fwd_megakernel, hipFuncAttributeMaxDynamicSharedMemorySize, LDS_BYTES);
        hipOccupancyMaxActiveBlocksPerMultiprocessor(&per_cu, (const void*)fwd_megakernel, 512, LDS_BYTES);
        if (per_cu < 1) per_cu = 1;
        grid_blocks = cus * per_cu;
        if (ws_size < WS_END) fprintf(stderr, "kernel_launch: workspace too small: %zu < %zu\n", ws_size, (size_t)WS_END);
    }
    Params p{};
    const float** pp = (const float**)&p;
    for (int i = 0; i < 25; ++i) pp[i] = (const float*)d_in[i];
    p.out = (float*)d_out; p.ws = (unsigned char*)d_ws;
    hipMemsetAsync((unsigned char*)d_ws + WS_BAR, 0, 16384, stream);
    void* args[] = {&p};
    hipError_t e = hipLaunchCooperativeKernel((const void*)fwd_megakernel, dim3(grid_blocks), dim3(512), args, LDS_BYTES, stream);
    if (e != hipSuccess) fprintf(stderr, "cooperative launch failed: %s (grid %d)\n", hipGetErrorString(e), grid_blocks);
}
```

```cpp
#include <hip/hip_runtime.h>
#include <hip/hip_cooperative_groups.h>
#include <cstdio>
namespace cg = cooperative_groups;

#define LAS __attribute__((address_space(3)))
typedef unsigned short bf16_t;
typedef short bf16x8 __attribute__((ext_vector_type(8)));
typedef float f32x4 __attribute__((ext_vector_type(4)));
typedef unsigned u32x4 __attribute__((ext_vector_type(4)));
typedef unsigned u32x2 __attribute__((ext_vector_type(2)));

constexpr int D = 1024, NB = 2, S = 16384, LC = 256;
constexpr int NLAT = NB * S;
constexpr int NCTX = NB * LC;
constexpr int MROWS = NLAT + NCTX;
constexpr int DIN = 1792, DFF = 2816, DUP = 5632, DRNN = 512;
constexpr int NCHUNK = MROWS / 64;
constexpr float EPS = 1e-6f;

constexpr size_t AL(size_t x) { return (x + 255) & ~(size_t)255; }
constexpr size_t WS_WIN  = 0;
constexpr size_t WS_WOUT = WS_WIN  + AL((size_t)DIN * D * 2);
constexpr size_t WS_WUP  = WS_WOUT + AL((size_t)D * D * 2);
constexpr size_t WS_WDN  = WS_WUP  + AL((size_t)DUP * D * 2);
constexpr size_t WS_LRU  = WS_WDN  + AL((size_t)D * DFF * 2);
constexpr size_t WS_MOD  = WS_LRU  + AL((size_t)4 * 8 * 64 * 64 * 2);
constexpr size_t WS_ROPE = WS_MOD  + AL((size_t)3 * 6144 * 4);
constexpr size_t WS_SUM  = WS_ROPE + AL((size_t)2 * 256 * 16 * 4);
constexpr size_t WS_CAR  = WS_SUM  + AL((size_t)2 * NCHUNK * 2 * 512 * 4);
constexpr size_t WS_SP8  = WS_CAR  + AL((size_t)2 * NCHUNK * 512 * 4);
constexpr size_t WS_BAR  = WS_SP8  + 4096;
constexpr size_t WS_HB   = WS_BAR  + 16384;
constexpr size_t WS_R1   = WS_HB   + AL((size_t)MROWS * D * 2);
constexpr size_t WS_PROJ = WS_R1;
constexpr size_t WS_ATT  = WS_PROJ + AL((size_t)MROWS * DIN * 2);
constexpr size_t WS_YL   = WS_ATT  + AL((size_t)NLAT * 512 * 2);
constexpr size_t WS_CAF  = WS_YL   + AL((size_t)NLAT * 512 * 2);
constexpr size_t WS_CAB  = WS_CAF  + AL((size_t)NLAT * 512 * 2);
constexpr size_t WS_R1END = WS_CAB + AL((size_t)NLAT * 512 * 2);
constexpr size_t WS_ACT  = WS_R1;
constexpr size_t WS_O1   = WS_ACT + AL((size_t)NLAT * DFF * 2);
constexpr size_t WS_O2   = WS_HB;
constexpr size_t WS_END  = WS_R1END;
static_assert(WS_O1 + (size_t)NLAT * D * 2 <= WS_R1END, "o1");
static_assert(WS_ACT + (size_t)NLAT * DFF * 2 <= WS_R1END, "act");
constexpr int H2_BSTRIDE = 65 * 254;
constexpr int H2_ROWS = 130 * 254 + 2;
static_assert((size_t)H2_ROWS * D * 2 <= (size_t)MROWS * D * 2, "h2");

constexpr int LDS_BYTES = 131072 + 8192 + 256;
constexpr int LDS_XB = 131072 + 8192;

struct Params {
    const float *x, *c, *ctx, *c_ctx, *w_mod, *b_mod, *norm1_g, *w_in, *rnn_conv_w, *rnn_conv_b, *lru_w_a, *lru_b_a,
        *lru_w_i, *lru_b_i, *lru_lam, *attn_sink, *gn_rnn, *gn_attn, *w_out, *norm2_g, *w_up, *ffn_conv_w, *ffn_conv_b,
        *w_down, *final_g;
    float* out;
    unsigned char* ws;
};

typedef const Params __attribute__((address_space(4)))* PP;
__device__ __forceinline__ PP kparams() { PP k = (PP)__builtin_amdgcn_kernarg_segment_ptr(); asm volatile("" : "+s"(k)); return k; }
__device__ __forceinline__ int lane_fresh() { unsigned m = ~0u; asm volatile("" : "+s"(m)); return (int)__builtin_amdgcn_mbcnt_hi(m, __builtin_amdgcn_mbcnt_lo(m, 0u)); }
__device__ __forceinline__ int tid_opaque(int wv) { return wv * 64 + lane_fresh(); }
__device__ __forceinline__ bf16_t f2bf(float f) { unsigned u = __float_as_uint(f); u += 0x7FFFu + ((u >> 16) & 1u); return (bf16_t)(u >> 16); }
__device__ __forceinline__ float bf2f(bf16_t b) { return __uint_as_float(((unsigned)b) << 16); }
__device__ __forceinline__ unsigned pk2(float lo, float hi) { unsigned r; asm("v_cvt_pk_bf16_f32 %0, %1, %2" : "=v"(r) : "v"(lo), "v"(hi)); return r; }
__device__ __forceinline__ float bflo(unsigned w) { return __uint_as_float(w << 16); }
__device__ __forceinline__ float bfhi(unsigned w) { return __uint_as_float(w & 0xFFFF0000u); }
__device__ __forceinline__ float wave_sum(float v) {
#pragma unroll
    for (int o = 32; o >= 1; o >>= 1) v += __shfl_xor(v, o);
    return v;
}
__device__ __forceinline__ float wave_max(float v) {
#pragma unroll
    for (int o = 32; o >= 1; o >>= 1) v = fmaxf(v, __shfl_xor(v, o));
    return v;
}
__device__ __forceinline__ float sigmoidf_(float x) { return 1.0f / (1.0f + __expf(-x)); }
__device__ __forceinline__ float fast_sigmoid(float x) { return __builtin_amdgcn_rcpf(1.0f + __builtin_amdgcn_exp2f(-1.4426950408889634f * x)); }
__device__ __forceinline__ float silu_(float x) { return x * fast_sigmoid(x); }
__device__ __forceinline__ float gelu_tanh_(float x) {
    const float u = 0.7978845608028654f * (x + 0.044715f * x * x * x);
    const float e = __expf(2.0f * u);
    const float th = 1.0f - 2.0f / (e + 1.0f);
    return 0.5f * x * (1.0f + th);
}


#define XB_TMO      128
#define XB_XCNT(j)  (256  + 64 * (j))
#define XB_XSUB(j)  (1280 + 64 * (j))
#define XB_XGEN(j)  (2304 + 64 * (j))
#define XB_TOP      3328
#define XB_TOPGEN   3392
#define XCD_BAR_WORDS 3456
#define XB_SPIN_CAP (1u << 20)
__device__ __forceinline__ unsigned xb_ld(unsigned* p)              { return __hip_atomic_load(p, __ATOMIC_RELAXED, __HIP_MEMORY_SCOPE_AGENT); }
__device__ __forceinline__ unsigned xb_add(unsigned* p, unsigned v) { return __hip_atomic_fetch_add(p, v, __ATOMIC_RELAXED, __HIP_MEMORY_SCOPE_AGENT); }
__device__ __forceinline__ unsigned xb_xcc_id() { return (unsigned)__builtin_amdgcn_s_getreg((3 << 11) | 20) & 0xFu; }
#define XB_SPIN(cond, bar) do { unsigned _sp = 0; while (cond) { __builtin_amdgcn_s_sleep(1); \
    if ((++_sp & 255u) == 0u) { if (xb_ld(&(bar)[XB_TMO])) break; if (_sp > XB_SPIN_CAP) { atomicAdd(&(bar)[XB_TMO], 1u); break; } } } } while (0)
struct XcdBarrier { unsigned* bar; unsigned x; volatile LAS unsigned* st; };
__device__ __forceinline__ XcdBarrier xcd_barrier_post(unsigned* bar, volatile LAS unsigned* st, int wv) {
    XcdBarrier b; b.bar = bar; b.x = xb_xcc_id(); b.st = st;
    if (tid_opaque(wv) == 0) (void)xb_add(&bar[XB_XCNT(b.x)], 1u);
    return b;
}
__device__ __forceinline__ void xcd_barrier_complete(unsigned* bar, unsigned x, unsigned& nloc, unsigned& nx) {
    const unsigned G = gridDim.x * gridDim.y * gridDim.z;
    unsigned sum, cnt, mine, sp = 0u;
    for (;;) {
        sum = 0u; cnt = 0u; mine = 0u;
#pragma unroll
        for (unsigned j = 0; j < 16; ++j) { const unsigned c = xb_ld(&bar[XB_XCNT(j)]); sum += c; cnt += (c > 0u) ? 1u : 0u; mine = (j == x) ? c : mine; }
        if (sum == G) break;
        __builtin_amdgcn_s_sleep(1);
        if ((++sp & 255u) == 0u) { if (xb_ld(&bar[XB_TMO])) break; if (sp > XB_SPIN_CAP) { atomicAdd(&bar[XB_TMO], 1u); break; } }
    }
    nloc = mine > 0u ? mine : 1u; nx = cnt > 0u ? cnt : 1u;
}
__device__ __forceinline__ void xcd_barrier(const XcdBarrier& b, int wv) {
    asm volatile("s_waitcnt vmcnt(0)" ::: "memory");
    __syncthreads();
    if (tid_opaque(wv) == 0) {
        unsigned* bar = b.bar;
        __builtin_amdgcn_s_waitcnt(0);
        unsigned nloc = b.st[0], nx = b.st[1];
        if (nloc == 0u) { xcd_barrier_complete(bar, b.x, nloc, nx); b.st[0] = nloc; b.st[1] = nx; }
        const unsigned old = xb_add(&bar[XB_XSUB(b.x)], 1u);
        const unsigned gen = old / nloc;
        if (old + 1u == (gen + 1u) * nloc) {
            __builtin_amdgcn_fence(__ATOMIC_RELEASE, "agent");
            asm volatile("s_waitcnt vmcnt(0)" ::: "memory");
            const unsigned og = xb_add(&bar[XB_TOP], 1u);
            const unsigned tg = og / nx;
            if (og + 1u == (tg + 1u) * nx) xb_add(&bar[XB_TOPGEN], 1u);
            else XB_SPIN(xb_ld(&bar[XB_TOPGEN]) == tg, bar);
            __builtin_amdgcn_fence(__ATOMIC_ACQUIRE, "agent");
            xb_add(&bar[XB_XGEN(b.x)], 1u);
            asm volatile("s_waitcnt vmcnt(0)" ::: "memory");
        } else {
            XB_SPIN(xb_ld(&bar[XB_XGEN(b.x)]) == gen, bar);
            __builtin_amdgcn_fence(__ATOMIC_ACQUIRE, "agent");
            asm volatile("s_waitcnt vmcnt(0)" ::: "memory");
        }
    }
    __syncthreads();
}

namespace pg8 {
constexpr int BM = 256, BK = 64, HALF = 128, HTB = HALF * BK * 2, NXCD = 8, WGM = 8;
__host__ __device__ __forceinline__ int lds_byte(int r, int c) { const int st = (r >> 4) * 2 + (c >> 5), rr = r & 15, cc = c & 31, ob = rr * 64 + cc * 2; return st * 1024 + (ob ^ (((ob >> 9) & 1) << 5)); }
__host__ __device__ __forceinline__ void stage_rc(int b, int& R, int& C) { const int st = b / 1024, sb = b % 1024, swz = sb ^ (((sb >> 9) & 1) << 5); R = (st >> 1) * 16 + swz / 64; C = (st & 1) * 32 + (swz % 64) / 2; }
struct Unit { int pm, pn; };
struct Gemm { const bf16_t* A; const bf16_t* Bt; int nM, nN, K, a_tile_rows; };
struct StaticOrder {
    int nM, nN, nwg, G, c;
    __device__ void init(int nM_, int nN_, int G_, int c_) { nM = nM_; nN = nN_; nwg = nM * nN; G = G_; c = c_; }
    __device__ bool next(int i, Unit& u) const {
        const long L = (long)i * G + c; if (L >= nwg) return false;
        int wgid = (int)L; { const int q = nwg / NXCD, r = nwg % NXCD, xcd = wgid % NXCD, off = wgid / NXCD; wgid = (xcd < r ? xcd * (q + 1) : r * (q + 1) + (xcd - r) * q) + off; }
        const int nig = WGM * nN, gid = wgid / nig, fm = gid * WGM, gsz = (nM - fm) < WGM ? (nM - fm) : WGM;
        u.pm = fm + ((wgid % nig) % gsz); u.pn = (wgid % nig) / gsz; return true;
    }
};
template <class Epi>
__device__ __forceinline__ void gemm_phase(LAS unsigned char* lds, const Gemm g, const StaticOrder& S, const Epi& E, int wv) {
    const int tid = tid_opaque(wv);
    const int wid = __builtin_amdgcn_readfirstlane(tid >> 6), lane = tid & 63, wr = wid >> 2, wc = wid & 3, fr = lane & 15, fq = lane >> 4;
    const int K = g.K, nt = K / BK;
    unsigned voffA[2], voffB[2];
#pragma unroll
    for (int i = 0; i < 2; ++i) { int R, C; stage_rc(tid * 16 + i * 8192, R, C);
        const int Ra = (R & ~63) + 4 * (R & 15) + ((R >> 4) & 3);
        voffA[i] = (unsigned)(Ra * K + C) * 2u; voffB[i] = (unsigned)(R * K + C) * 2u; }
    const size_t kstep = (size_t)(BK * 2);
    const size_t hstep = (size_t)HALF * K * 2;
    const size_t tstepA = (size_t)g.a_tile_rows * K * 2;
    const size_t tstepB = 2 * hstep;
    const unsigned ldsw = (unsigned)wid * 1024u;
    const int aoff = lds_byte(wr * 64 + fr, fq * 8), boff = lds_byte(wc * 32 + fr, fq * 8);
#define PG8_SA(b, h) (((b) * 2 + (h)) * HTB)
#define PG8_SB(b, h) ((4 + (b) * 2 + (h)) * HTB)
#define PG8_STAGE(bufoff, gbase, voff) do { _Pragma("unroll") for (int _i = 0; _i < 2; ++_i) \
        __builtin_amdgcn_global_load_lds((const unsigned*)((const char*)(gbase) + (voff)[_i]), (LAS unsigned*)(lds + (bufoff) + ldsw + _i * 8192), 16, 0, 0); } while (0)
#define PG8_LDA(dst, b, h) do { _Pragma("unroll") for (int m = 0; m < 4; ++m) _Pragma("unroll") for (int k = 0; k < 2; ++k) dst[m][k] = *(const LAS bf16x8*)(lds + PG8_SA(b, h) + aoff + m * 2048 + k * 1024); } while (0)
#define PG8_LDB(dst, b, h) do { _Pragma("unroll") for (int n = 0; n < 2; ++n) _Pragma("unroll") for (int k = 0; k < 2; ++k) dst[n][k] = *(const LAS bf16x8*)(lds + PG8_SB(b, h) + boff + n * 2048 + k * 1024); } while (0)
#define PG8_MMA(ai, bj, At, Bt) do { __builtin_amdgcn_s_setprio(1); _Pragma("unroll") for (int m = 0; m < 4; ++m) _Pragma("unroll") for (int n = 0; n < 2; ++n) _Pragma("unroll") for (int k = 0; k < 2; ++k) \
        acc[ai][bj][m][n] = __builtin_amdgcn_mfma_f32_16x16x32_bf16(Bt[n][k], At[m][k], acc[ai][bj][m][n], 0, 0, 0); __builtin_amdgcn_s_setprio(0); } while (0)
#define PG8_WAIT_V(n) asm volatile("s_waitcnt vmcnt(" #n ")" ::: "memory")
#define PG8_WAIT_L(n) asm volatile("s_waitcnt lgkmcnt(" #n ")" ::: "memory")
#define PG8_BAR __builtin_amdgcn_s_barrier()
#define PG8_SCHED __builtin_amdgcn_sched_barrier(0)
    Unit cur, nxt; int ui = 0;
    if (!S.next(0, cur)) return;
    f32x4 acc[2][2][4][2];
#pragma unroll
    for (int a = 0; a < 2; ++a)
#pragma unroll
        for (int b = 0; b < 2; ++b)
#pragma unroll
            for (int m = 0; m < 4; ++m)
#pragma unroll
                for (int n = 0; n < 2; ++n) acc[a][b][m][n] = (f32x4){0.f, 0.f, 0.f, 0.f};
    bf16x8 At[4][2], B0[2][2], B1[2][2];
    const char* cA = (const char*)g.A + (size_t)cur.pm * tstepA; const char* cB = (const char*)g.Bt + (size_t)cur.pn * tstepB;
    PG8_STAGE(PG8_SB(0, 0), cB, voffB); PG8_STAGE(PG8_SA(0, 0), cA, voffA); PG8_STAGE(PG8_SB(0, 1), cB + hstep, voffB); PG8_STAGE(PG8_SA(0, 1), cA + hstep, voffA);
    if (wr == 1) PG8_BAR;
    PG8_WAIT_V(4); PG8_BAR;
    PG8_STAGE(PG8_SB(1, 0), cB + kstep, voffB); PG8_STAGE(PG8_SA(1, 0), cA + kstep, voffA); PG8_STAGE(PG8_SB(1, 1), cB + hstep + kstep, voffB);
    PG8_WAIT_V(6); PG8_BAR;
    for (;;) {
        const bool has_next = S.next(ui + 1, nxt);
        const char* nA = has_next ? (const char*)g.A + (size_t)nxt.pm * tstepA : cA; const char* nB = has_next ? (const char*)g.Bt + (size_t)nxt.pn * tstepB : cB;
        for (int t = 0; t < nt; t += 2) {
            const bool last = (t == nt - 2);
            const char* a1 = cA + (size_t)(t + 1) * kstep;
            const char* a2 = last ? nA : cA + (size_t)(t + 2) * kstep; const char* b2 = last ? nB : cB + (size_t)(t + 2) * kstep;
            const char* a3 = a2 + kstep; const char* b3 = b2 + kstep;
            PG8_LDB(B0, 0, 0); PG8_SCHED; PG8_LDA(At, 0, 0); PG8_STAGE(PG8_SA(1, 1), a1 + hstep, voffA);
            PG8_WAIT_L(8); PG8_BAR; PG8_WAIT_L(0); PG8_MMA(0, 0, At, B0); PG8_BAR; PG8_SCHED;
            PG8_LDB(B1, 0, 1); PG8_STAGE(PG8_SB(0, 0), b2, voffB);
            PG8_BAR; PG8_WAIT_L(0); PG8_MMA(0, 1, At, B1); PG8_BAR;
            PG8_LDA(At, 0, 1); PG8_STAGE(PG8_SA(0, 0), a2, voffA);
            PG8_BAR; PG8_WAIT_L(0); PG8_MMA(1, 0, At, B0); PG8_BAR; PG8_SCHED;
            PG8_STAGE(PG8_SB(0, 1), b2 + hstep, voffB);
            PG8_WAIT_V(6); PG8_BAR; PG8_MMA(1, 1, At, B1); PG8_BAR;
            PG8_LDB(B0, 1, 0); PG8_SCHED; PG8_LDA(At, 1, 0); PG8_STAGE(PG8_SA(0, 1), a2 + hstep, voffA);
            PG8_WAIT_L(8); PG8_BAR; PG8_WAIT_L(0); PG8_MMA(0, 0, At, B0); PG8_BAR; PG8_SCHED;
            PG8_LDB(B1, 1, 1); PG8_STAGE(PG8_SB(1, 0), b3, voffB);
            PG8_BAR; PG8_WAIT_L(0); PG8_MMA(0, 1, At, B1); PG8_BAR;
            PG8_LDA(At, 1, 1); PG8_STAGE(PG8_SA(1, 0), a3, voffA);
            PG8_BAR; PG8_WAIT_L(0); PG8_MMA(1, 0, At, B0); PG8_BAR; PG8_SCHED;
            PG8_STAGE(PG8_SB(1, 1), b3 + hstep, voffB);
            PG8_WAIT_V(6); PG8_BAR; PG8_MMA(1, 1, At, B1); PG8_BAR;
        }
        { const int ln2 = lane_fresh();
          E(acc, cur, wr, wc, ln2 & 15, ln2 >> 4); }
        if (!has_next) break;
#pragma unroll
        for (int a = 0; a < 2; ++a)
#pragma unroll
            for (int b = 0; b < 2; ++b)
#pragma unroll
                for (int m = 0; m < 4; ++m)
#pragma unroll
                    for (int n = 0; n < 2; ++n) acc[a][b][m][n] = (f32x4){0.f, 0.f, 0.f, 0.f};
        cur = nxt; cA = nA; cB = nB; ++ui;
    }
    PG8_WAIT_V(0);
    if (wr == 0) PG8_BAR;
    PG8_BAR;
#undef PG8_SA
#undef PG8_SB
#undef PG8_STAGE
#undef PG8_LDA
#undef PG8_LDB
#undef PG8_MMA
#undef PG8_WAIT_V
#undef PG8_WAIT_L
#undef PG8_BAR
#undef PG8_SCHED
}
}
using pg8::Unit;

struct EpiProj {
    bf16_t* O; const float* cosT; const float* sinT;
    __device__ __forceinline__ void operator()(const f32x4 (&acc)[2][2][4][2], const Unit& u, int wr, int wc, int fr, int fq) const {
        const bool latent = u.pm < 128;
#pragma unroll
        for (int ai = 0; ai < 2; ++ai)
#pragma unroll
            for (int m = 0; m < 4; ++m) {
                const int row = u.pm * 256 + ai * 128 + wr * 64 + 4 * fr + m;
                const int t = row & (S - 1);
                const int pos = (wc & 1) ? (t & 63) : (t >> 6);
#pragma unroll
                for (int bj = 0; bj < 2; ++bj) {
                    const int col = u.pn * 256 + bj * 128 + wc * 32 + 4 * fq;
                    f32x4 v0 = acc[ai][bj][m][0], v1 = acc[ai][bj][m][1];
                    const bool rope = latent && (u.pn == 4 || u.pn == 5 || (u.pn == 6 && bj == 0));
                    if (rope) {
                        const f32x4 cs = *(const f32x4*)(cosT + pos * 16 + 4 * fq), sn = *(const f32x4*)(sinT + pos * 16 + 4 * fq);
                        const f32x4 n0 = v0 * cs - v1 * sn, n1 = v1 * cs + v0 * sn; v0 = n0; v1 = n1;
                    }
                    bf16_t* p = O + (size_t)row * DIN + col;
                    u32x2 w0, w1; w0.x = pk2(v0[0], v0[1]); w0.y = pk2(v0[2], v0[3]); w1.x = pk2(v1[0], v1[1]); w1.y = pk2(v1[2], v1[3]);
                    *(u32x2*)p = w0; *(u32x2*)(p + 16) = w1;
                }
            }
    }
};
struct EpiDelta {
    bf16_t* O; const float* gate0; const float* gate1;
    __device__ __forceinline__ void operator()(const f32x4 (&acc)[2][2][4][2], const Unit& u, int wr, int wc, int fr, int fq) const {
        const float* gate = (u.pm >= 64) ? gate1 : gate0;
        f32x4 gv[2][2];
#pragma unroll
        for (int bj = 0; bj < 2; ++bj)
#pragma unroll
            for (int n = 0; n < 2; ++n) gv[bj][n] = *(const f32x4*)(gate + u.pn * 256 + bj * 128 + wc * 32 + n * 16 + 4 * fq);
#pragma unroll
        for (int ai = 0; ai < 2; ++ai)
#pragma unroll
            for (int m = 0; m < 4; ++m) {
                const size_t row = (size_t)u.pm * 256 + ai * 128 + wr * 64 + 4 * fr + m;
#pragma unroll
                for (int bj = 0; bj < 2; ++bj)
#pragma unroll
                    for (int n = 0; n < 2; ++n) {
                        const f32x4 v = gv[bj][n] * acc[ai][bj][m][n];
                        u32x2 w; w.x = pk2(v[0], v[1]); w.y = pk2(v[2], v[3]);
                        *(u32x2*)(O + row * D + u.pn * 256 + bj * 128 + wc * 32 + n * 16 + 4 * fq) = w;
                    }
            }
    }
};

__device__ __forceinline__ float dpp_ror1(float v)  { return __int_as_float(__builtin_amdgcn_update_dpp(0, __float_as_int(v), 0x121, 0xF, 0xF, true)); }
__device__ __forceinline__ float dpp_ror15(float v) { return __int_as_float(__builtin_amdgcn_update_dpp(0, __float_as_int(v), 0x12F, 0xF, 0xF, true)); }
__device__ __forceinline__ float dpp_shr1(float v)  { return __int_as_float(__builtin_amdgcn_update_dpp(0, __float_as_int(v), 0x111, 0xF, 0xF, true)); }
__device__ __forceinline__ float dpp_shl1(float v)  { return __int_as_float(__builtin_amdgcn_update_dpp(0, __float_as_int(v), 0x101, 0xF, 0xF, true)); }

#define DPP_FMAC4X2(C, SA, WA, CTRLA, SB, WB, CTRLB) do { float _c0 = (C)[0], _c1 = (C)[1], _c2 = (C)[2], _c3 = (C)[3]; \
    asm("s_nop 1\n\t" \
        "v_fmac_f32_dpp %0, %4, %8 " CTRLA " row_mask:0xf bank_mask:0xf bound_ctrl:1\n\t" \
        "v_fmac_f32_dpp %1, %5, %9 " CTRLA " row_mask:0xf bank_mask:0xf bound_ctrl:1\n\t" \
        "v_fmac_f32_dpp %2, %6, %10 " CTRLA " row_mask:0xf bank_mask:0xf bound_ctrl:1\n\t" \
        "v_fmac_f32_dpp %3, %7, %11 " CTRLA " row_mask:0xf bank_mask:0xf bound_ctrl:1\n\t" \
        "v_fmac_f32_dpp %0, %12, %16 " CTRLB " row_mask:0xf bank_mask:0xf bound_ctrl:1\n\t" \
        "v_fmac_f32_dpp %1, %13, %17 " CTRLB " row_mask:0xf bank_mask:0xf bound_ctrl:1\n\t" \
        "v_fmac_f32_dpp %2, %14, %18 " CTRLB " row_mask:0xf bank_mask:0xf bound_ctrl:1\n\t" \
        "v_fmac_f32_dpp %3, %15, %19 " CTRLB " row_mask:0xf bank_mask:0xf bound_ctrl:1" \
        : "+v"(_c0), "+v"(_c1), "+v"(_c2), "+v"(_c3) \
        : "v"((SA)[0]), "v"((SA)[1]), "v"((SA)[2]), "v"((SA)[3]), "v"((WA)[0]), "v"((WA)[1]), "v"((WA)[2]), "v"((WA)[3]), \
          "v"((SB)[0]), "v"((SB)[1]), "v"((SB)[2]), "v"((SB)[3]), "v"((WB)[0]), "v"((WB)[1]), "v"((WB)[2]), "v"((WB)[3])); \
    (C)[0] = _c0; (C)[1] = _c1; (C)[2] = _c2; (C)[3] = _c3; } while (0)
#define DPP_FMAC4(C, SA, WA, CTRLA) do { float _c0 = (C)[0], _c1 = (C)[1], _c2 = (C)[2], _c3 = (C)[3]; \
    asm("s_nop 1\n\t" \
        "v_fmac_f32_dpp %0, %4, %8 " CTRLA " row_mask:0xf bank_mask:0xf bound_ctrl:1\n\t" \
        "v_fmac_f32_dpp %1, %5, %9 " CTRLA " row_mask:0xf bank_mask:0xf bound_ctrl:1\n\t" \
        "v_fmac_f32_dpp %2, %6, %10 " CTRLA " row_mask:0xf bank_mask:0xf bound_ctrl:1\n\t" \
        "v_fmac_f32_dpp %3, %7, %11 " CTRLA " row_mask:0xf bank_mask:0xf bound_ctrl:1" \
        : "+v"(_c0), "+v"(_c1), "+v"(_c2), "+v"(_c3) \
        : "v"((SA)[0]), "v"((SA)[1]), "v"((SA)[2]), "v"((SA)[3]), "v"((WA)[0]), "v"((WA)[1]), "v"((WA)[2]), "v"((WA)[3])); \
    (C)[0] = _c0; (C)[1] = _c1; (C)[2] = _c2; (C)[3] = _c3; } while (0)
struct EpiConvGate {
    bf16_t* act; const float* cw; const float* cbias; LAS unsigned char* xl;
    __device__ __forceinline__ void operator()(const f32x4 (&acc)[2][2][4][2], const Unit& u, int wr, int wc, int fr, int fq) const {
        if (wr == 0) { __builtin_amdgcn_s_barrier(); } asm volatile("" ::: "memory");
        LAS float* X = (LAS float*)xl;
        f32x4 wq[2][2][4];
#define CG_LOADW(N) do { _Pragma("unroll") for (int bj = 0; bj < 2; ++bj) { const int ch = 128 * u.pn + 32 * wc + 16 * (N) + 4 * fq + bj * DFF; \
            wq[N][bj][0] = *(const f32x4*)(cw + ch); wq[N][bj][1] = *(const f32x4*)(cw + DUP + ch); wq[N][bj][2] = *(const f32x4*)(cw + 2 * DUP + ch); wq[N][bj][3] = *(const f32x4*)(cbias + ch); } } while (0)
        CG_LOADW(0);
#pragma unroll
        for (int ai = 0; ai < 2; ++ai) {
            const int s = 2 * ai + wr;
            if (fr == 0) {
#pragma unroll
                for (int bj = 0; bj < 2; ++bj)
#pragma unroll
                    for (int n = 0; n < 2; ++n) *(LAS f32x4*)(X + ((s * 2 + 0) * 2 + bj) * 128 + 32 * wc + 16 * n + 4 * fq) = acc[ai][bj][0][n];
            }
            if (fr == 15) {
#pragma unroll
                for (int bj = 0; bj < 2; ++bj)
#pragma unroll
                    for (int n = 0; n < 2; ++n) *(LAS f32x4*)(X + ((s * 2 + 1) * 2 + bj) * 128 + 32 * wc + 16 * n + 4 * fq) = acc[ai][bj][3][n];
            }
        }
        asm volatile("s_waitcnt lgkmcnt(0)" ::: "memory");
        __builtin_amdgcn_s_barrier(); asm volatile("" ::: "memory");
#pragma unroll
        for (int n = 0; n < 2; ++n) {
            const int chg = 128 * u.pn + 32 * wc + 16 * n + 4 * fq;
            if (n == 1) CG_LOADW(1);
            f32x4 w0[2], w1[2], w2[2], bb[2], w0m[2], w2m[2];
#pragma unroll
            for (int bj = 0; bj < 2; ++bj) {
                w0[bj] = wq[n][bj][0]; w1[bj] = wq[n][bj][1]; w2[bj] = wq[n][bj][2]; bb[bj] = wq[n][bj][3];
                w0m[bj] = (fr == 0) ? w0[bj] : (f32x4){0.f, 0.f, 0.f, 0.f}; w2m[bj] = (fr == 15) ? w2[bj] : (f32x4){0.f, 0.f, 0.f, 0.f};
            }
#pragma unroll
            for (int ai = 0; ai < 2; ++ai) {
                const int s = 2 * ai + wr;
                f32x4 xp[2], xn[2];
#pragma unroll
                for (int bj = 0; bj < 2; ++bj) {
                    xp[bj] = *(const LAS f32x4*)(X + ((((s + 3) & 3) * 2 + 1) * 2 + bj) * 128 + 32 * wc + 16 * n + 4 * fq);
                    xn[bj] = *(const LAS f32x4*)(X + ((((s + 1) & 3) * 2 + 0) * 2 + bj) * 128 + 32 * wc + 16 * n + 4 * fq);
                }
                f32x4 cvv[4][2];
#pragma unroll
                for (int bj = 0; bj < 2; ++bj) {
                    const f32x4 a0 = acc[ai][bj][0][n], a1 = acc[ai][bj][1][n], a2 = acc[ai][bj][2][n], a3 = acc[ai][bj][3][n];
                    f32x4 c0 = bb[bj] + w1[bj] * a0 + w2[bj] * a1 + w0m[bj] * xp[bj];
                    f32x4 c1 = bb[bj] + w1[bj] * a1 + w0[bj] * a0 + w2[bj] * a2;
                    f32x4 c2 = bb[bj] + w1[bj] * a2 + w0[bj] * a1 + w2[bj] * a3;
                    f32x4 c3 = bb[bj] + w1[bj] * a3 + w0[bj] * a2 + w2m[bj] * xn[bj];
                    DPP_FMAC4(c0, a3, w0[bj], "row_shr:1");
                    DPP_FMAC4(c3, a0, w2[bj], "row_shl:1");
                    cvv[0][bj] = c0; cvv[1][bj] = c1; cvv[2][bj] = c2; cvv[3][bj] = c3;
                }
#pragma unroll
                for (int m = 0; m < 4; ++m) {
                    const int lr = 128 * ai + 64 * wr + 4 * fr + m;
                    const int R = 254 * u.pm + lr;
                    const int b = R >= (H2_BSTRIDE + 1) ? 1 : 0;
                    const int t = R - 1 - H2_BSTRIDE * b;
                    const bool valid = lr >= 1 && lr <= 254 && t >= 0 && t < S;
                    if (valid) {
                        u32x2 w;
                        w.x = pk2(silu_(cvv[m][0][0]) * cvv[m][1][0], silu_(cvv[m][0][1]) * cvv[m][1][1]);
                        w.y = pk2(silu_(cvv[m][0][2]) * cvv[m][1][2], silu_(cvv[m][0][3]) * cvv[m][1][3]);
                        *(u32x2*)(act + (size_t)(b * S + t) * DFF + chg) = w;
                    }
                }
            }
        }
        asm volatile("" ::: "memory"); if (wr == 1) { __builtin_amdgcn_s_barrier(); }
    }
};

#undef CG_LOADW
__device__ __forceinline__ void transpose_item(const float* W, int N, int k0, int n0, bf16_t* dst, int Kd, float* scr, int lane) {
#pragma unroll 16
    for (int i = 0; i < 32; ++i) { const int kk = 2 * i + (lane >> 5); scr[kk * 33 + (lane & 31)] = W[(size_t)(k0 + kk) * N + n0 + (lane & 31)]; }
    __builtin_amdgcn_wave_barrier();
    const int c = lane & 7;
#pragma unroll
    for (int j = 0; j < 4; ++j) {
        const int n = (lane >> 3) + 8 * j; const float* s = scr + (8 * c) * 33 + n;
        u32x4 o; o.x = pk2(s[0], s[33]); o.y = pk2(s[2 * 33], s[3 * 33]); o.z = pk2(s[4 * 33], s[5 * 33]); o.w = pk2(s[6 * 33], s[7 * 33]);
        *(u32x4*)(dst + (size_t)n * Kd + k0 + 8 * c) = o;
    }
    __builtin_amdgcn_wave_barrier();
}

__device__ __forceinline__ void phase0(PP p, unsigned char* shm, int wv) {
    const int tid = tid_opaque(wv), lane = tid & 63, wave = tid >> 6;
    unsigned char* ws = p->ws;
    if (blockIdx.x < 192) {
        float* sv = (float*)shm;
        float* red = sv + 3 * 1024;
        for (int i = tid; i < 3 * 1024; i += 512) {
            const int j = i >> 10, k = i & 1023;
            const float v = (j < 2) ? p->c[j * 1024 + k] : p->c_ctx[k];
            sv[i] = silu_(v);
        }
        __syncthreads();
        const int n0 = blockIdx.x * 32, col = tid & 31, ks = tid >> 5;
        float a0 = 0.f, a1 = 0.f, a2 = 0.f;
        const float* wp = p->w_mod + (size_t)(ks * 64) * 6144 + n0 + col;
#pragma unroll
        for (int k = 0; k < 64; ++k) {
            const float w = wp[(size_t)k * 6144];
            a0 += sv[ks * 64 + k] * w; a1 += sv[1024 + ks * 64 + k] * w; a2 += sv[2048 + ks * 64 + k] * w;
        }
        red[(ks * 3 + 0) * 32 + col] = a0; red[(ks * 3 + 1) * 32 + col] = a1; red[(ks * 3 + 2) * 32 + col] = a2;
        __syncthreads();
        if (tid < 96) {
            const int j = tid >> 5, cc = tid & 31; float s = p->b_mod[n0 + cc];
            for (int k = 0; k < 16; ++k) s += red[(k * 3 + j) * 32 + cc];
            ((float*)(ws + WS_MOD))[j * 6144 + n0 + cc] = s;
        }
        __syncthreads();
    }
    if (blockIdx.x == 200) { for (int i = tid; i < 1024; i += 512) ((float*)(ws + WS_SP8))[i] = -8.0f * log1pf(expf(-p->lru_lam[i])); }
    if (blockIdx.x >= 192 && blockIdx.x < 200) {
        const int idx = (blockIdx.x - 192) * 512 + tid;
        const int pos = idx >> 4, i = idx & 15;
        const float inv = powf(10000.0f, -(float)i / 16.0f);
        const float ang = (float)pos * inv;
        ((float*)(ws + WS_ROPE))[idx] = cosf(ang);
        ((float*)(ws + WS_ROPE))[4096 + idx] = sinf(ang);
    }
}
__device__ __forceinline__ void transpose_phase(PP p, unsigned char* shm, int wv, int it_lo, int it_hi, int gw0, int NGW) {
    const int tid = tid_opaque(wv), lane = tid & 63, wave = wv;
    unsigned char* ws = p->ws;
    float* scr = (float*)(shm + 32768) + wave * (64 * 33);
    const int gw = gw0 + wave;
    constexpr int I_IN = (D / 64) * (DIN / 32), I_OUT = (D / 64) * (D / 32), I_UP = (D / 64) * (DUP / 32), I_DN = (DFF / 64) * (D / 32), I_LRU = 2 * 2 * 8 * 2;
    constexpr int NIT = I_IN + I_OUT + I_UP + I_DN + I_LRU;
    (void)NIT;
    for (int it = it_lo + gw; it < it_hi; it += NGW) {
        int r = it;
        if (r >= I_IN + I_OUT + I_UP + I_DN + I_LRU) continue;
        if (r < I_IN) { const int nb = DIN / 32, kb = r / nb, n0 = (r % nb) * 32; transpose_item(p->w_in, DIN, kb * 64, n0, (bf16_t*)(ws + WS_WIN) + (size_t)n0 * D, D, scr, lane); continue; } r -= I_IN;
        if (r < I_OUT) { const int nb = D / 32, kb = r / nb, n0 = (r % nb) * 32; transpose_item(p->w_out, D, kb * 64, n0, (bf16_t*)(ws + WS_WOUT) + (size_t)n0 * D, D, scr, lane); continue; } r -= I_OUT;
        if (r < I_UP) { const int nb = DUP / 32, kb = r / nb, n0 = (r % nb) * 32;
            const int isv = n0 >= DFF, nn = isv ? n0 - DFF : n0, drow = (nn / 128) * 256 + isv * 128 + (nn % 128);
            transpose_item(p->w_up, DUP, kb * 64, n0, (bf16_t*)(ws + WS_WUP) + (size_t)drow * D, D, scr, lane); continue; } r -= I_UP;
        if (r < I_DN) { const int nb = D / 32, kb = r / nb, n0 = (r % nb) * 32; transpose_item(p->w_down, D, kb * 64, n0, (bf16_t*)(ws + WS_WDN) + (size_t)n0 * DFF, DFF, scr, lane); continue; } r -= I_DN;
        {
            const int nh = r & 1, blk = (r >> 1) & 7, type = (r >> 4) & 1, dir = r >> 5;
            const float* src = (type ? p->lru_w_i : p->lru_w_a) + (size_t)(dir * 8 + blk) * 4096;
            bf16_t* dst = (bf16_t*)(ws + WS_LRU) + (size_t)((dir * 2 + type) * 8 + blk) * 4096 + (size_t)(nh * 32) * 64;
            transpose_item(src, 64, 0, nh * 32, dst, 64, scr, lane);
        }
    }
}

__device__ __forceinline__ void row_load(const float* src, int lane, f32x4 (&v)[4]) {
#pragma unroll
    for (int j = 0; j < 4; ++j) v[j] = *(const f32x4*)(src + 4 * lane + 256 * j);
}
__device__ __forceinline__ float row_rstd(const f32x4 (&v)[4]) {
    float ss = 0.f;
#pragma unroll
    for (int j = 0; j < 4; ++j) ss += v[j][0] * v[j][0] + v[j][1] * v[j][1] + v[j][2] * v[j][2] + v[j][3] * v[j][3];
    return rsqrtf(wave_sum(ss) * (1.0f / D) + EPS);
}
__device__ __forceinline__ void norm_mod_store(const f32x4 (&v)[4], float rstd, const float* g, const float* sh, const float* sc, bf16_t* dst, int lane) {
#pragma unroll
    for (int j = 0; j < 4; ++j) {
        const int c = 4 * lane + 256 * j;
        const f32x4 gg = *(const f32x4*)(g + c), s1 = *(const f32x4*)(sc + c), s0 = *(const f32x4*)(sh + c);
        const f32x4 o = (v[j] * rstd * gg) * (s1 + 1.0f) + s0;
        u32x2 w; w.x = pk2(o[0], o[1]); w.y = pk2(o[2], o[3]);
        *(u32x2*)(dst + c) = w;
    }
}
__device__ __forceinline__ void phase1(PP p, int wv) {
    const int tid_ = tid_opaque(wv), lane = tid_ & 63, gw = blockIdx.x * 8 + (tid_ >> 6), NGW = gridDim.x * 8;
    const float* mod = (const float*)(p->ws + WS_MOD);
    bf16_t* hb = (bf16_t*)(p->ws + WS_HB);
    for (int r = gw; r < MROWS; r += 2 * NGW) {
        const int r2 = r + NGW; const bool has2 = r2 < MROWS;
        const int ra = r, rb = has2 ? r2 : r;
        f32x4 va[4], vb[4];
        row_load(ra < NLAT ? p->x + (size_t)ra * D : p->ctx + (size_t)(ra - NLAT) * D, lane, va);
        row_load(rb < NLAT ? p->x + (size_t)rb * D : p->ctx + (size_t)(rb - NLAT) * D, lane, vb);
        const int ma = ra < NLAT ? (ra >> 14) : 2, mb = rb < NLAT ? (rb >> 14) : 2;
        const float sa = row_rstd(va), sb = row_rstd(vb);
        norm_mod_store(va, sa, p->norm1_g, mod + ma * 6144, mod + ma * 6144 + 1024, hb + (size_t)ra * D, lane);
        if (has2) norm_mod_store(vb, sb, p->norm1_g, mod + mb * 6144, mod + mb * 6144 + 1024, hb + (size_t)rb * D, lane);
    }
}

typedef float f32x16 __attribute__((ext_vector_type(16)));
__device__ __forceinline__ unsigned cvt_pk_bf16(float lo, float hi) { unsigned r; asm("v_cvt_pk_bf16_f32 %0, %1, %2" : "=v"(r) : "v"(lo), "v"(hi)); return r; }
__device__ __forceinline__ void attn_mfma(PP p, unsigned char* shm, int wv) {
    const int tid = tid_opaque(wv);
    const int lane = tid & 63, wave = wv, l31 = lane & 31, hl = lane >> 5;
    bf16_t* Ks = (bf16_t*)shm;
    bf16_t* Vt = (bf16_t*)(shm + 18432);
    const bf16_t* proj = (const bf16_t*)(p->ws + WS_PROJ);
    bf16_t* att = (bf16_t*)(p->ws + WS_ATT);
    const float L2E = 1.4426950408889634f;
    const float SC2 = 0.125f * L2E;
    for (int item = blockIdx.x; item < 512; item += gridDim.x) {
        const int hk = item & 1, qb = (item >> 1) & 127, b = item >> 8;
        const int g = wave >> 1, qh = wave & 1, hq = hk * 4 + g;
        const int qrow0 = b * S + 128 * qb + 64 * qh;
        bf16x8 qf[2][4];
#pragma unroll
        for (int qi = 0; qi < 2; ++qi)
#pragma unroll
            for (int st = 0; st < 4; ++st) qf[qi][st] = *(const bf16x8*)(proj + (size_t)(qrow0 + 32 * qi + l31) * DIN + 1024 + 64 * hq + 16 * st + 8 * hl);
        const float sink2 = p->attn_sink[hq] * L2E;
        float mrun[2] = {sink2, sink2};
        float lrun[2] = {hl == 0 ? 1.f : 0.f, hl == 0 ? 1.f : 0.f};
        f32x16 oacc[2][2];
#pragma unroll
        for (int a = 0; a < 2; ++a)
#pragma unroll
            for (int c = 0; c < 2; ++c)
#pragma unroll
                for (int i = 0; i < 16; ++i) oacc[a][c][i] = 0.f;
        u32x4 kreg[2], vreg[2];
        int ci = (qb == 0) ? 1 : 0;
#define ATT_GLOAD(CI) do { const int _row0 = (CI) < 3 ? b * S + 128 * (qb - 1 + (CI)) : NLAT + b * LC + 128 * ((CI) - 3); \
        _Pragma("unroll") for (int _i = 0; _i < 2; ++_i) { const int _pi = tid + 512 * _i, _key = _pi >> 3, _part = _pi & 7; \
            const bf16_t* _src = proj + (size_t)(_row0 + _key) * DIN + 1536 + 64 * hk + 8 * _part; kreg[_i] = *(const u32x4*)_src; vreg[_i] = *(const u32x4*)(_src + 128); } } while (0)
        ATT_GLOAD(ci);
        while (ci < 5) {
            __syncthreads();
#pragma unroll
            for (int i = 0; i < 2; ++i) {
                const int pi = tid + 512 * i, key = pi >> 3, part = pi & 7;
                *(u32x4*)(Ks + key * 72 + 8 * part) = kreg[i];
#pragma unroll
                for (int e = 0; e < 8; ++e) { const unsigned w = vreg[i][e >> 1]; Vt[(8 * part + e) * 132 + key] = (bf16_t)((e & 1) ? (w >> 16) : (w & 0xFFFFu)); }
            }
            __syncthreads();
            int cn = ci + 1; if (cn == 2 && qb == 127) cn = 3;
            if (cn < 5) ATT_GLOAD(cn);
            const int kt_lo = (ci == 0 && qh == 1) ? 2 : 0, kt_hi = (ci == 2 && qh == 0) ? 2 : 4;
#pragma unroll 1
            for (int kt = kt_lo; kt < kt_hi; ++kt) {
                bf16x8 kf[4];
#pragma unroll
                for (int st = 0; st < 4; ++st) kf[st] = *(const bf16x8*)(Ks + (32 * kt + l31) * 72 + 16 * st + 8 * hl);
                bf16x8 vf[2][2];
#pragma unroll
                for (int db = 0; db < 2; ++db)
#pragma unroll
                    for (int s2 = 0; s2 < 2; ++s2) {
                        const bf16_t* vp = Vt + (32 * db + l31) * 132 + 32 * kt + 16 * s2 + 4 * hl;
                        const u32x2 lo = *(const u32x2*)vp, hi = *(const u32x2*)(vp + 8);
                        u32x4 w; w.x = lo.x; w.y = lo.y; w.z = hi.x; w.w = hi.y;
                        vf[db][s2] = __builtin_bit_cast(bf16x8, w);
                    }
#pragma unroll
                for (int qi = 0; qi < 2; ++qi) {
                    f32x16 s;
#pragma unroll
                    for (int i = 0; i < 16; ++i) s[i] = 0.f;
#pragma unroll
                    for (int st = 0; st < 4; ++st) s = __builtin_amdgcn_mfma_f32_32x32x16_bf16(kf[st], qf[qi][st], s, 0, 0, 0);
                    if (ci == 0 || ci == 2) {
                        asm volatile("");
                        const int dl = (ci == 0) ? (32 * kt + 4 * hl - (64 * qh + 32 * qi + l31)) : ((64 * qh + 32 * qi + l31) - 32 * kt - 4 * hl);
#pragma unroll
                        for (int i = 0; i < 16; ++i) {
                            const int ki = 8 * (i >> 2) + (i & 3);
                            const bool ok = (ci == 0) ? (dl + ki >= 0) : (dl - ki >= 0);
                            s[i] = ok ? s[i] : -1e30f;
                        }
                    }
                    float mx = s[0];
#pragma unroll
                    for (int i = 1; i < 16; ++i) mx = fmaxf(mx, s[i]);
                    mx = fmaxf(mx, __shfl_xor(mx, 32));
                    const float mnew = fmaxf(mrun[qi], mx * SC2);
                    if (__builtin_amdgcn_ballot_w64(mnew > mrun[qi]) != 0ull) {
                        const float alpha = __builtin_amdgcn_exp2f(mrun[qi] - mnew);
                        lrun[qi] *= alpha;
#pragma unroll
                        for (int db = 0; db < 2; ++db)
#pragma unroll
                            for (int i = 0; i < 16; ++i) oacc[db][qi][i] *= alpha;
                        mrun[qi] = mnew;
                    }
                    float ls = 0.f;
#pragma unroll
                    for (int i = 0; i < 16; ++i) { s[i] = __builtin_amdgcn_exp2f(__builtin_fmaf(s[i], SC2, -mnew)); ls += s[i]; }
                    lrun[qi] += ls;
                    bf16x8 pf[2];
#pragma unroll
                    for (int s2 = 0; s2 < 2; ++s2) {
                        u32x4 w; w.x = cvt_pk_bf16(s[8 * s2 + 0], s[8 * s2 + 1]); w.y = cvt_pk_bf16(s[8 * s2 + 2], s[8 * s2 + 3]);
                        w.z = cvt_pk_bf16(s[8 * s2 + 4], s[8 * s2 + 5]); w.w = cvt_pk_bf16(s[8 * s2 + 6], s[8 * s2 + 7]);
                        pf[s2] = __builtin_bit_cast(bf16x8, w);
                    }
#pragma unroll
                    for (int db = 0; db < 2; ++db)
#pragma unroll
                        for (int s2 = 0; s2 < 2; ++s2) oacc[db][qi] = __builtin_amdgcn_mfma_f32_32x32x16_bf16(vf[db][s2], pf[s2], oacc[db][qi], 0, 0, 0);
                }
            }
            ci = cn;
        }
#undef ATT_GLOAD
#pragma unroll
        for (int qi = 0; qi < 2; ++qi) {
            const float lt = lrun[qi] + __shfl_xor(lrun[qi], 32);
            const float inv = 1.0f / lt;
            bf16_t* orow = att + (size_t)(qrow0 + 32 * qi + l31) * 512 + hq * 64;
#pragma unroll
            for (int db = 0; db < 2; ++db)
#pragma unroll
                for (int g4 = 0; g4 < 4; ++g4) {
                    u32x2 w; w.x = cvt_pk_bf16(oacc[db][qi][4 * g4] * inv, oacc[db][qi][4 * g4 + 1] * inv); w.y = cvt_pk_bf16(oacc[db][qi][4 * g4 + 2] * inv, oacc[db][qi][4 * g4 + 3] * inv);
                    *(u32x2*)(orow + 32 * db + 8 * g4 + 4 * hl) = w;
                }
        }
    }
    __syncthreads();
}


template <int DIR>
__device__ __forceinline__ void scan_dir(PP p, const bf16_t* xs, int n, int ct, int l31, int hl, int id, int rowbase, bool latent, float (&hf)[2][16]) {
    constexpr int XS = 520;
    const int ch = 64 * n + 32 * ct + l31;
    const float ba = p->lru_b_a[DIR * 512 + ch], bi = p->lru_b_i[DIR * 512 + ch];
    const float sp8l2 = ((const float*)(p->ws + WS_SP8))[DIR * 512 + ch] * 1.4426950408889634f;
    const bf16_t* lru = (const bf16_t*)(p->ws + WS_LRU);
    const bf16_t* wa_p = lru + (size_t)((DIR * 2 + 0) * 8 + n) * 4096 + (32 * ct + l31) * 64 + 8 * hl;
    const bf16_t* wi_p = lru + (size_t)((DIR * 2 + 1) * 8 + n) * 4096 + (32 * ct + l31) * 64 + 8 * hl;
    bf16x8 wfa[4], wfi[4];
#pragma unroll
    for (int st = 0; st < 4; ++st) { wfa[st] = *(const bf16x8*)(wa_p + 16 * st); wfi[st] = *(const bf16x8*)(wi_p + 16 * st); }
    float a[2][16], u[2][16];
#pragma unroll
    for (int rt = 0; rt < 2; ++rt) {
        bf16x8 af[4];
#pragma unroll
        for (int st = 0; st < 4; ++st) af[st] = *(const bf16x8*)(xs + (32 * rt + l31) * XS + 64 * n + 16 * st + 8 * hl);
        f32x16 ga, gi;
#pragma unroll
        for (int i = 0; i < 16; ++i) { ga[i] = 0.f; gi[i] = 0.f; }
#pragma unroll
        for (int st = 0; st < 4; ++st) { ga = __builtin_amdgcn_mfma_f32_32x32x16_bf16(af[st], wfa[st], ga, 0, 0, 0); gi = __builtin_amdgcn_mfma_f32_32x32x16_bf16(af[st], wfi[st], gi, 0, 0, 0); }
#pragma unroll
        for (int i = 0; i < 16; ++i) {
            const int token = 32 * rt + 8 * (i >> 2) + 4 * hl + (i & 3);
            const float xv = bf2f(xs[token * XS + ch]);
            const float rr = fast_sigmoid(ga[i] + ba), ii = fast_sigmoid(gi[i] + bi);
            const float la2 = rr * sp8l2;
            const float av = __builtin_amdgcn_exp2f(la2);
            const float t2 = la2 * 1.3862943611f;
            float em1p = t2 * (1.0f + t2 * (0.5f + t2 * (0.16666667f + t2 * (0.041666668f + t2 * 0.0083333333f)))), em1e = __builtin_fmaf(av, av, -1.0f);
            asm volatile("" : "+v"(em1p), "+v"(em1e));
            const float em1 = (t2 > -0.1f) ? em1p : em1e;
            a[rt][i] = av; u[rt][i] = __builtin_amdgcn_sqrtf(-em1) * (ii * xv);
        }
    }
    float Ao[8], Ho[8], Ap[8], Hp[8];
#pragma unroll
    for (int k = 0; k < 8; ++k) {
        const int rt = k >> 2, g = k & 3;
        float H = 0.f, A = 1.f;
#pragma unroll
        for (int jj = 0; jj < 4; ++jj) { const int j = DIR ? 3 - jj : jj; const float av = a[rt][4 * g + j]; H = av * H + u[rt][4 * g + j]; A *= av; }
        Ao[k] = A; Ho[k] = H; Ap[k] = __shfl_xor(A, 32); Hp[k] = __shfl_xor(H, 32);
    }
    float Sin[8], Pin[8]; float Sx = 0.f, Px = 1.f;
#pragma unroll
    for (int kk = 0; kk < 8; ++kk) {
        const int k = DIR ? 7 - kk : kk;
        const float A0 = hl ? Ap[k] : Ao[k], H0 = hl ? Hp[k] : Ho[k], A1 = hl ? Ao[k] : Ap[k], H1 = hl ? Ho[k] : Hp[k];
        float s0, p0, s1, p1;
        if (DIR == 0) { s0 = Sx; p0 = Px; Sx = A0 * Sx + H0; Px *= A0; s1 = Sx; p1 = Px; Sx = A1 * Sx + H1; Px *= A1; }
        else          { s1 = Sx; p1 = Px; Sx = A1 * Sx + H1; Px *= A1; s0 = Sx; p0 = Px; Sx = A0 * Sx + H0; Px *= A0; }
        Sin[k] = hl ? s1 : s0; Pin[k] = hl ? p1 : p0;
    }
    bf16_t* yl = (bf16_t*)(p->ws + WS_YL) + (size_t)rowbase * 512; bf16_t* caf = (bf16_t*)(p->ws + WS_CAF) + (size_t)rowbase * 512; bf16_t* cab = (bf16_t*)(p->ws + WS_CAB) + (size_t)rowbase * 512;
    unsigned lo = (unsigned)ch; asm volatile("" : "+v"(lo));
#pragma unroll
    for (int k = 0; k < 8; ++k) {
        const int rt = k >> 2, g = k & 3;
        float h = Sin[k], P = Pin[k];
#pragma unroll
        for (int jj = 0; jj < 4; ++jj) {
            const int j = DIR ? 3 - jj : jj, idx = 4 * g + j;
            h = a[rt][idx] * h + u[rt][idx]; P *= a[rt][idx];
            const int token = 32 * rt + 8 * g + 4 * hl + j;
            const unsigned o = lo + (unsigned)token * 512u;
            if (DIR == 0) { hf[rt][idx] = h; if (latent) caf[o] = f2bf(P); }
            else if (latent) { yl[o] = f2bf(hf[rt][idx] + h); cab[o] = f2bf(P); }
        }
    }
    if (hl == 0) {
        float* sumb = (float*)(p->ws + WS_SUM);
        sumb[((size_t)(DIR * NCHUNK + id) * 2 + 0) * 512 + ch] = Px;
        sumb[((size_t)(DIR * NCHUNK + id) * 2 + 1) * 512 + ch] = Sx;
    }
}
__device__ __forceinline__ void scan_mfma(PP p, unsigned char* shm, int wv) {
    const int tid = tid_opaque(wv);
    const int lane = tid & 63, n = wv, l31 = lane & 31, hl = lane >> 5;
    constexpr int XS = 520;
    bf16_t* xs = (bf16_t*)shm;
    const bf16_t* proj = (const bf16_t*)(p->ws + WS_PROJ);
    for (int item = blockIdx.x; item < 512 + 32; item += gridDim.x) {
        const int id = item < 512 ? item : 512 + ((item - 512) >> 2);
        const int quarter = item < 512 ? -1 : ((item - 512) & 3);
        int rowbase, t0, seqlen; bool latent;
        if (id < 512) { const int b = id >> 8, k = id & 255; t0 = 64 * k; rowbase = b * S + t0; seqlen = S; latent = true; }
        else { const int j = id - 512, b = j >> 2, k = j & 3; t0 = 64 * k; rowbase = NLAT + b * LC + t0; seqlen = LC; latent = false; }
        const int seqbase = rowbase - t0;
        {
            bf16_t* raw = (bf16_t*)(shm + 66560);
#pragma unroll
            for (int i = 0; i < 9; ++i) {
                const int piece = tid + 512 * i;
                if (piece < 67 * 64) {
                    const int row = piece >> 6, c8 = piece & 63, tt = t0 - 2 + row;
                    u32x4 v = {0u, 0u, 0u, 0u};
                    if (tt >= 0 && tt < seqlen) v = *(const u32x4*)(proj + (size_t)(seqbase + tt) * DIN + 8 * c8);
                    *(u32x4*)(raw + row * 512 + 8 * c8) = v;
                }
            }
            __syncthreads();
            const int c = tid;
            const float cw0 = p->rnn_conv_w[c], cw1 = p->rnn_conv_w[512 + c], cw2 = p->rnn_conv_w[1024 + c], cw3 = p->rnn_conv_w[1536 + c], cb = p->rnn_conv_b[c];
            float xm2 = bf2f(raw[c]), xm1 = bf2f(raw[512 + c]), x0 = bf2f(raw[1024 + c]);
#pragma unroll 8
            for (int t = 0; t < 64; ++t) {
                const float xp1 = bf2f(raw[(t + 3) * 512 + c]);
                xs[t * XS + c] = f2bf(cb + cw0 * xm2 + cw1 * xm1 + cw2 * x0 + cw3 * xp1);
                xm2 = xm1; xm1 = x0; x0 = xp1;
            }
        }
        __syncthreads();
#pragma unroll 1
        for (int ct = 0; ct < 2; ++ct) {
            float hf[2][16];
            if (quarter < 0 || quarter == 2 * ct + 0) scan_dir<0>(p, xs, n, ct, l31, hl, id, rowbase, latent, hf);
            if (quarter < 0 || quarter == 2 * ct + 1) scan_dir<1>(p, xs, n, ct, l31, hl, id, rowbase, latent, hf);
        }
        __syncthreads();
    }
}

__device__ __forceinline__ void carry_phase(PP p, unsigned char* shm, int wv) {
    if (blockIdx.x >= 128) return;
    const int tid = tid_opaque(wv), cl = tid & 15, sg = tid >> 4;
    const int b = blockIdx.x >> 6, dir = (blockIdx.x >> 5) & 1, c = (blockIdx.x & 31) * 16 + cl;
    const float* sumb = (const float*)(p->ws + WS_SUM) + (size_t)dir * NCHUNK * 1024;
    float* car = (float*)(p->ws + WS_CAR) + (size_t)dir * NCHUNK * 512;
    float* segA = (float*)shm; float* segH = segA + 512;
    float A[9], H[9]; int ids[9];
#pragma unroll
    for (int k = 0; k < 9; ++k) {
        const int s = sg * 9 + k;
        int id = -1;
        if (s < 260) { if (dir == 0) id = s < 4 ? 512 + 4 * b + s : 256 * b + (s - 4); else id = s < 4 ? 512 + 4 * b + (3 - s) : 256 * b + (255 - (s - 4)); }
        ids[k] = id;
        A[k] = id >= 0 ? sumb[(size_t)id * 1024 + c] : 1.f;
        H[k] = id >= 0 ? sumb[(size_t)id * 1024 + 512 + c] : 0.f;
    }
    float As = 1.f, Hs = 0.f;
#pragma unroll
    for (int k = 0; k < 9; ++k) { Hs = A[k] * Hs + H[k]; As *= A[k]; }
    segA[sg * 16 + cl] = As; segH[sg * 16 + cl] = Hs;
    __syncthreads();
    float h = 0.f;
    for (int j = 0; j < sg; ++j) h = segA[j * 16 + cl] * h + segH[j * 16 + cl];
#pragma unroll
    for (int k = 0; k < 9; ++k) { if (ids[k] >= 0) car[(size_t)ids[k] * 512 + c] = h; h = A[k] * h + H[k]; }
    __syncthreads();
}

struct MixRow { u32x4 vy, vf, vb, vg, va; f32x4 cf0, cf1, cb0, cb1; };
__device__ __forceinline__ void mix_load(PP p, int r, int c0, MixRow& m) {
    const bf16_t* proj = (const bf16_t*)(p->ws + WS_PROJ);
    const bf16_t* att = (const bf16_t*)(p->ws + WS_ATT);
    const bf16_t* yl = (const bf16_t*)(p->ws + WS_YL); const bf16_t* caf = (const bf16_t*)(p->ws + WS_CAF); const bf16_t* cab = (const bf16_t*)(p->ws + WS_CAB);
    const float* car = (const float*)(p->ws + WS_CAR);
    const int id = r >> 6;
    m.vy = *(const u32x4*)(yl + (size_t)r * 512 + c0); m.vf = *(const u32x4*)(caf + (size_t)r * 512 + c0); m.vb = *(const u32x4*)(cab + (size_t)r * 512 + c0);
    m.vg = *(const u32x4*)(proj + (size_t)r * DIN + 512 + c0); m.va = *(const u32x4*)(att + (size_t)r * 512 + c0);
    const float* cf = car + (size_t)id * 512 + c0; const float* cbk = car + (size_t)(NCHUNK + id) * 512 + c0;
    m.cf0 = *(const f32x4*)cf; m.cf1 = *(const f32x4*)(cf + 4); m.cb0 = *(const f32x4*)cbk; m.cb1 = *(const f32x4*)(cbk + 4);
}
__device__ __forceinline__ void mix_store(PP p, int r, int c0, const MixRow& m, const f32x4 (&gr)[2], const f32x4 (&ga)[2]) {
    bf16_t* mix = (bf16_t*)(p->ws + WS_HB);
    float rn[8], at[8]; float s1 = 0.f, s2 = 0.f;
#pragma unroll
    for (int e = 0; e < 8; ++e) {
        const unsigned wy = m.vy[e >> 1], wf = m.vf[e >> 1], wb = m.vb[e >> 1], wg = m.vg[e >> 1], wa = m.va[e >> 1];
        const float cfe = e < 4 ? m.cf0[e & 3] : m.cf1[e & 3], cbe = e < 4 ? m.cb0[e & 3] : m.cb1[e & 3];
        const float y = ((e & 1) ? bfhi(wy) : bflo(wy)) + ((e & 1) ? bfhi(wf) : bflo(wf)) * cfe + ((e & 1) ? bfhi(wb) : bflo(wb)) * cbe;
        const float xg = (e & 1) ? bfhi(wg) : bflo(wg);
        rn[e] = gelu_tanh_(xg) * y; s1 += rn[e] * rn[e];
        at[e] = (e & 1) ? bfhi(wa) : bflo(wa); s2 += at[e] * at[e];
    }
    const float r1 = rsqrtf(wave_sum(s1) * (1.0f / 512.0f) + EPS), r2 = rsqrtf(wave_sum(s2) * (1.0f / 512.0f) + EPS);
    u32x4 o1, o2;
#pragma unroll
    for (int e2 = 0; e2 < 4; ++e2) {
        o1[e2] = pk2(rn[2 * e2] * r1 * gr[e2 >> 1][(2 * e2) & 3], rn[2 * e2 + 1] * r1 * gr[e2 >> 1][(2 * e2 + 1) & 3]);
        o2[e2] = pk2(at[2 * e2] * r2 * ga[e2 >> 1][(2 * e2) & 3], at[2 * e2 + 1] * r2 * ga[e2 >> 1][(2 * e2 + 1) & 3]);
    }
    *(u32x4*)(mix + (size_t)r * D + c0) = o1; *(u32x4*)(mix + (size_t)r * D + 512 + c0) = o2;
}
__device__ __forceinline__ void mix_phase(PP p, int wv) {
    const int tid_ = tid_opaque(wv), lane = tid_ & 63, gw = blockIdx.x * 8 + (tid_ >> 6), NGW = gridDim.x * 8;
    const int c0 = 8 * lane;
    f32x4 gr[2], ga[2];
    gr[0] = *(const f32x4*)(p->gn_rnn + c0); gr[1] = *(const f32x4*)(p->gn_rnn + c0 + 4); ga[0] = *(const f32x4*)(p->gn_attn + c0); ga[1] = *(const f32x4*)(p->gn_attn + c0 + 4);
    for (int r = gw; r < NLAT; r += 2 * NGW) {
        const int rb = (r + NGW < NLAT) ? r + NGW : r;
        MixRow ma, mb;
        mix_load(p, r, c0, ma); mix_load(p, rb, c0, mb);
        mix_store(p, r, c0, ma, gr, ga);
        if (rb != r) mix_store(p, rb, c0, mb, gr, ga);
    }
}

__device__ __forceinline__ void phase7(PP p, int wv) {
    const int tid_ = tid_opaque(wv), lane = tid_ & 63, gw = blockIdx.x * 8 + (tid_ >> 6), NGW = gridDim.x * 8;
    const float* mod = (const float*)(p->ws + WS_MOD);
    bf16_t* hb = (bf16_t*)(p->ws + WS_HB);
    const bf16_t* o1 = (const bf16_t*)(p->ws + WS_O1);
    for (int r = gw; r < NLAT; r += 2 * NGW) {
        const int rb = r + NGW;
        f32x4 va[4], vb[4]; u32x2 da[4], db[4];
        row_load(p->x + (size_t)r * D, lane, va); row_load(p->x + (size_t)rb * D, lane, vb);
#pragma unroll
        for (int j = 0; j < 4; ++j) { da[j] = *(const u32x2*)(o1 + (size_t)r * D + 4 * lane + 256 * j); db[j] = *(const u32x2*)(o1 + (size_t)rb * D + 4 * lane + 256 * j); }
#pragma unroll
        for (int j = 0; j < 4; ++j) {
            va[j][0] += bflo(da[j].x); va[j][1] += bfhi(da[j].x); va[j][2] += bflo(da[j].y); va[j][3] += bfhi(da[j].y);
            vb[j][0] += bflo(db[j].x); vb[j][1] += bfhi(db[j].x); vb[j][2] += bflo(db[j].y); vb[j][3] += bfhi(db[j].y);
        }
        const float sa = row_rstd(va), sb = row_rstd(vb);
        const int ma = r >> 14, mb = rb >> 14;
        norm_mod_store(va, sa, p->norm2_g, mod + ma * 6144 + 3072, mod + ma * 6144 + 4096, hb + (size_t)(ma * H2_BSTRIDE + 1 + (r & (S - 1))) * D, lane);
        norm_mod_store(vb, sb, p->norm2_g, mod + mb * 6144 + 3072, mod + mb * 6144 + 4096, hb + (size_t)(mb * H2_BSTRIDE + 1 + (rb & (S - 1))) * D, lane);
    }
    for (int z = gw; z < 254; z += NGW) {
        const int R = z == 0 ? 0 : (z <= 126 ? S + z : 32895 + (z - 127));
        const u32x4 zz = {0u, 0u, 0u, 0u};
        *(u32x4*)(hb + (size_t)R * D + 8 * lane) = zz; *(u32x4*)(hb + (size_t)R * D + 512 + 8 * lane) = zz;
    }
}

__device__ __forceinline__ void final_phase(PP p, int wv) {
    const int tid_ = tid_opaque(wv), lane = tid_ & 63, gw = blockIdx.x * 8 + (tid_ >> 6), NGW = gridDim.x * 8;
    const bf16_t* o1 = (const bf16_t*)(p->ws + WS_O1); const bf16_t* o2 = (const bf16_t*)(p->ws + WS_O2);
    for (int r = gw; r < NLAT; r += 2 * NGW) {
        const int rb = r + NGW;
        f32x4 va[4], vb[4]; u32x2 da[4], db[4], ea[4], eb[4];
        row_load(p->x + (size_t)r * D, lane, va); row_load(p->x + (size_t)rb * D, lane, vb);
#pragma unroll
        for (int j = 0; j < 4; ++j) {
            da[j] = *(const u32x2*)(o1 + (size_t)r * D + 4 * lane + 256 * j); db[j] = *(const u32x2*)(o1 + (size_t)rb * D + 4 * lane + 256 * j);
            ea[j] = *(const u32x2*)(o2 + (size_t)r * D + 4 * lane + 256 * j); eb[j] = *(const u32x2*)(o2 + (size_t)rb * D + 4 * lane + 256 * j);
        }
#pragma unroll
        for (int j = 0; j < 4; ++j) {
            va[j][0] += bflo(da[j].x) + bflo(ea[j].x); va[j][1] += bfhi(da[j].x) + bfhi(ea[j].x); va[j][2] += bflo(da[j].y) + bflo(ea[j].y); va[j][3] += bfhi(da[j].y) + bfhi(ea[j].y);
            vb[j][0] += bflo(db[j].x) + bflo(eb[j].x); vb[j][1] += bfhi(db[j].x) + bfhi(eb[j].x); vb[j][2] += bflo(db[j].y) + bflo(eb[j].y); vb[j][3] += bfhi(db[j].y) + bfhi(eb[j].y);
        }
        const float sa = row_rstd(va), sb = row_rstd(vb);
        float* rowa = p->out + (size_t)r * D; float* rowb = p->out + (size_t)rb * D;
#pragma unroll
        for (int j = 0; j < 4; ++j) { const f32x4 gg = *(const f32x4*)(p->final_g + 4 * lane + 256 * j); *(f32x4*)(rowa + 4 * lane + 256 * j) = va[j] * sa * gg; *(f32x4*)(rowb + 4 * lane + 256 * j) = vb[j] * sb * gg; }
    }
}

__global__ void __launch_bounds__(512, 2) fwd_megakernel(Params p_arg) {
    extern __shared__ __attribute__((aligned(16))) unsigned char shm[];
    cg::grid_group grid = cg::this_grid();
    LAS unsigned char* lds = (LAS unsigned char*)shm;
    pg8::StaticOrder so;
    const int wv = __builtin_amdgcn_readfirstlane((int)(threadIdx.x >> 6));
    volatile LAS unsigned* xst = (volatile LAS unsigned*)(lds + LDS_XB);
    if (tid_opaque(wv) == 0) { xst[0] = 0u; xst[1] = 0u; }
    __syncthreads();
    (void)xcd_barrier_post((unsigned*)(kparams()->ws + WS_BAR), xst, wv);
#define XBAR() do { XcdBarrier _b; _b.bar = (unsigned*)(kparams()->ws + WS_BAR); _b.x = xb_xcc_id(); _b.st = (volatile LAS unsigned*)(lds + LDS_XB); xcd_barrier(_b, wv); } while (0)
    if (kparams()->out == nullptr) grid.sync();

    phase0(kparams(), shm, wv);
    {
        constexpr int T_IN = (D / 64) * (DIN / 32), T_B = (D / 64) * (D / 32) + (D / 64) * (DUP / 32) + (DFF / 64) * (D / 32), T_LRU = 64;
        const int nfree = (int)gridDim.x > 192 ? (int)gridDim.x - 192 : 0;
        const int first = nfree ? 192 : 0, nblk = nfree ? nfree : (int)gridDim.x;
        if ((int)blockIdx.x >= first) {
            transpose_phase(kparams(), shm, wv, 0, T_IN, ((int)blockIdx.x - first) * 8, nblk * 8);
            transpose_phase(kparams(), shm, wv, T_IN + T_B, T_IN + T_B + T_LRU, ((int)blockIdx.x - first) * 8, nblk * 8);
        }
    }
    XBAR();
    phase1(kparams(), wv);
    XBAR();
    {
        PP p = kparams(); unsigned char* ws = p->ws;
        pg8::Gemm g{(const bf16_t*)(ws + WS_HB), (const bf16_t*)(ws + WS_WIN), MROWS / 256, DIN / 256, D, 256};
        so.init(g.nM, g.nN, gridDim.x, blockIdx.x);
        EpiProj e{(bf16_t*)(ws + WS_PROJ), (const float*)(ws + WS_ROPE), (const float*)(ws + WS_ROPE) + 4096};
        pg8::gemm_phase(lds, g, so, e, wv);
        {
            constexpr int T_IN = (D / 64) * (DIN / 32), T_B = (D / 64) * (D / 32) + (D / 64) * (DUP / 32) + (DFF / 64) * (D / 32);
            const int G = (int)gridDim.x, rem = (g.nM * g.nN) % G;
            const int first = rem ? rem : 0, nblk = G - first;
            if ((int)blockIdx.x >= first) transpose_phase(p, shm, wv, T_IN, T_IN + T_B, ((int)blockIdx.x - first) * 8, nblk * 8);
        }
    }
    XBAR();
    scan_mfma(kparams(), shm, wv);
    attn_mfma(kparams(), shm, wv);
    XBAR();
    carry_phase(kparams(), shm, wv);
    XBAR();
    mix_phase(kparams(), wv);
    XBAR();
    {
        PP p = kparams(); unsigned char* ws = p->ws; const float* mod = (const float*)(ws + WS_MOD);
        pg8::Gemm g{(const bf16_t*)(ws + WS_HB), (const bf16_t*)(ws + WS_WOUT), NLAT / 256, D / 256, D, 256};
        so.init(g.nM, g.nN, gridDim.x, blockIdx.x);
        EpiDelta e{(bf16_t*)(ws + WS_O1), mod + 2048, mod + 6144 + 2048};
        pg8::gemm_phase(lds, g, so, e, wv);
    }
    XBAR();
    phase7(kparams(), wv);
    XBAR();
    {
        PP p = kparams(); unsigned char* ws = p->ws;
        pg8::Gemm g{(const bf16_t*)(ws + WS_HB), (const bf16_t*)(ws + WS_WUP), 130, DUP / 256, D, 254};
        so.init(g.nM, g.nN, gridDim.x, blockIdx.x);
        EpiConvGate e{(bf16_t*)(ws + WS_ACT), p->ffn_conv_w, p->ffn_conv_b, lds + 131072};
        pg8::gemm_phase(lds, g, so, e, wv);
    }
    XBAR();
    {
        PP p = kparams(); unsigned char* ws = p->ws; const float* mod = (const float*)(ws + WS_MOD);
        pg8::Gemm g{(const bf16_t*)(ws + WS_ACT), (const bf16_t*)(ws + WS_WDN), NLAT / 256, D / 256, DFF, 256};
        so.init(g.nM, g.nN, gridDim.x, blockIdx.x);
        EpiDelta e{(bf16_t*)(ws + WS_O2), mod + 5120, mod + 6144 + 5120};
        pg8::gemm_phase(lds, g, so, e, wv);
    }
    XBAR();
    final_phase(kparams(), wv);
}

extern "C" void kernel_launch(void* const* d_in, const int* in_sizes, int n_in, void* d_out, int out_size, void* d_ws, size_t ws_size, hipStream_t stream) {
    static int grid_blocks = 0;
    if (!grid_blocks) {
        int dev = 0, cus = 0, per_cu = 0;
        hipGetDevice(&dev);
        hipDeviceGetAttribute(&cus, hipDeviceAttributeMultiprocessorCount, dev);
        hipFuncSetAttribute((const void*)fwd_megakernel, hipFuncAttributeMaxDynamicSharedMemorySize, LDS_BYTES);
        hipOccupancyMaxActiveBlocksPerMultiprocessor(&per_cu, (const void*)fwd_megakernel, 512, LDS_BYTES);
        if (per_cu < 1) per_cu = 1;
        grid_blocks = cus * per_cu;
        if (ws_size < WS_END) fprintf(stderr, "kernel_launch: workspace too small: %zu < %zu\n", ws_size, (size_t)WS_END);
    }
    Params p{};
    const float** pp = (const float**)&p;
    for (int i = 0; i < 25; ++i) pp[i] = (const float*)d_in[i];
    p.out = (float*)d_out; p.ws = (unsigned char*)d_ws;
    hipMemsetAsync((unsigned char*)d_ws + WS_BAR, 0, 16384, stream);
    void* args[] = {&p};
    hipError_t e = hipLaunchCooperativeKernel((const void*)fwd_megakernel, dim3(grid_blocks), dim3(512), args, LDS_BYTES, stream);
    if (e != hipSuccess) fprintf(stderr, "cooperative launch failed: %s (grid %d)\n", hipGetErrorString(e), grid_blocks);
}
```

```cpp
#include <hip/hip_runtime.h>
#include <hip/hip_cooperative_groups.h>
#include <cstdio>
namespace cg = cooperative_groups;

#define LAS __attribute__((address_space(3)))
typedef unsigned short bf16_t;
typedef short bf16x8 __attribute__((ext_vector_type(8)));
typedef float f32x4 __attribute__((ext_vector_type(4)));
typedef unsigned u32x4 __attribute__((ext_vector_type(4)));
typedef unsigned u32x2 __attribute__((ext_vector_type(2)));

constexpr int D = 1024, NB = 2, S = 16384, LC = 256;
constexpr int NLAT = NB * S;
constexpr int NCTX = NB * LC;
constexpr int MROWS = NLAT + NCTX;
constexpr int DIN = 1792, DFF = 2816, DUP = 5632, DRNN = 512;
constexpr int NCHUNK = MROWS / 64;
constexpr float EPS = 1e-6f;

constexpr size_t AL(size_t x) { return (x + 255) & ~(size_t)255; }
constexpr size_t WS_WIN  = 0;
constexpr size_t WS_WOUT = WS_WIN  + AL((size_t)DIN * D * 2);
constexpr size_t WS_WUP  = WS_WOUT + AL((size_t)D * D * 2);
constexpr size_t WS_WDN  = WS_WUP  + AL((size_t)DUP * D * 2);
constexpr size_t WS_LRU  = WS_WDN  + AL((size_t)D * DFF * 2);
constexpr size_t WS_MOD  = WS_LRU  + AL((size_t)4 * 8 * 64 * 64 * 2);
constexpr size_t WS_ROPE = WS_MOD  + AL((size_t)3 * 6144 * 4);
constexpr size_t WS_SUM  = WS_ROPE + AL((size_t)2 * 256 * 16 * 4);
constexpr size_t WS_CAR  = WS_SUM  + AL((size_t)2 * NCHUNK * 2 * 512 * 4);
constexpr size_t WS_SP8  = WS_CAR  + AL((size_t)2 * NCHUNK * 512 * 4);
constexpr size_t WS_BAR  = WS_SP8  + 4096;
constexpr size_t WS_HB   = WS_BAR  + 16384;
constexpr size_t WS_R1   = WS_HB   + AL((size_t)MROWS * D * 2);
constexpr size_t WS_PROJ = WS_R1;
constexpr size_t WS_ATT  = WS_PROJ + AL((size_t)MROWS * DIN * 2);
constexpr size_t WS_YL   = WS_ATT  + AL((size_t)NLAT * 512 * 2);
constexpr size_t WS_CAF  = WS_YL   + AL((size_t)NLAT * 512 * 2);
constexpr size_t WS_CAB  = WS_CAF  + AL((size_t)NLAT * 512 * 2);
constexpr size_t WS_R1END = WS_CAB + AL((size_t)NLAT * 512 * 2);
constexpr size_t WS_ACT  = WS_R1;
constexpr size_t WS_O1   = WS_ACT + AL((size_t)NLAT * DFF * 2);
constexpr size_t WS_O2   = WS_HB;
constexpr size_t WS_END  = WS_R1END;
static_assert(WS_O1 + (size_t)NLAT * D * 2 <= WS_R1END, "o1");
static_assert(WS_ACT + (size_t)NLAT * DFF * 2 <= WS_R1END, "act");
constexpr int H2_BSTRIDE = 65 * 254;
constexpr int H2_ROWS = 130 * 254 + 2;
static_assert((size_t)H2_ROWS * D * 2 <= (size_t)MROWS * D * 2, "h2");

constexpr int LDS_BYTES = 131072 + 8192 + 256;
constexpr int LDS_XB = 131072 + 8192;

struct Params {
    const float *x, *c, *ctx, *c_ctx, *w_mod, *b_mod, *norm1_g, *w_in, *rnn_conv_w, *rnn_conv_b, *lru_w_a, *lru_b_a,
        *lru_w_i, *lru_b_i, *lru_lam, *attn_sink, *gn_rnn, *gn_attn, *w_out, *norm2_g, *w_up, *ffn_conv_w, *ffn_conv_b,
        *w_down, *final_g;
    float* out;
    unsigned char* ws;
};

typedef const Params __attribute__((address_space(4)))* PP;
__device__ __forceinline__ PP kparams() { PP k = (PP)__builtin_amdgcn_kernarg_segment_ptr(); asm volatile("" : "+s"(k)); return k; }
__device__ __forceinline__ int lane_fresh() { unsigned m = ~0u; asm volatile("" : "+s"(m)); return (int)__builtin_amdgcn_mbcnt_hi(m, __builtin_amdgcn_mbcnt_lo(m, 0u)); }
__device__ __forceinline__ int tid_opaque(int wv) { return wv * 64 + lane_fresh(); }
__device__ __forceinline__ bf16_t f2bf(float f) { unsigned u = __float_as_uint(f); u += 0x7FFFu + ((u >> 16) & 1u); return (bf16_t)(u >> 16); }
__device__ __forceinline__ float bf2f(bf16_t b) { return __uint_as_float(((unsigned)b) << 16); }
__device__ __forceinline__ unsigned pk2(float lo, float hi) { unsigned r; asm("v_cvt_pk_bf16_f32 %0, %1, %2" : "=v"(r) : "v"(lo), "v"(hi)); return r; }
__device__ __forceinline__ float bflo(unsigned w) { return __uint_as_float(w << 16); }
__device__ __forceinline__ float bfhi(unsigned w) { return __uint_as_float(w & 0xFFFF0000u); }
__device__ __forceinline__ float wave_sum(float v) {
#pragma unroll
    for (int o = 32; o >= 1; o >>= 1) v += __shfl_xor(v, o);
    return v;
}
__device__ __forceinline__ float wave_max(float v) {
#pragma unroll
    for (int o = 32; o >= 1; o >>= 1) v = fmaxf(v, __shfl_xor(v, o));
    return v;
}
__device__ __forceinline__ float sigmoidf_(float x) { return 1.0f / (1.0f + __expf(-x)); }
__device__ __forceinline__ float fast_sigmoid(float x) { return __builtin_amdgcn_rcpf(1.0f + __builtin_amdgcn_exp2f(-1.4426950408889634f * x)); }
__device__ __forceinline__ float silu_(float x) { return x * fast_sigmoid(x); }
__device__ __forceinline__ float gelu_tanh_(float x) {
    const float u = 0.7978845608028654f * (x + 0.044715f * x * x * x);
    const float e = __expf(2.0f * u);
    const float th = 1.0f - 2.0f / (e + 1.0f);
    return 0.5f * x * (1.0f + th);
}


#define XB_TMO      128
#define XB_XCNT(j)  (256  + 64 * (j))
#define XB_XSUB(j)  (1280 + 64 * (j))
#define XB_XGEN(j)  (2304 + 64 * (j))
#define XB_TOP      3328
#define XB_TOPGEN   3392
#define XCD_BAR_WORDS 3456
#define XB_SPIN_CAP (1u << 20)
__device__ __forceinline__ unsigned xb_ld(unsigned* p)              { return __hip_atomic_load(p, __ATOMIC_RELAXED, __HIP_MEMORY_SCOPE_AGENT); }
__device__ __forceinline__ unsigned xb_add(unsigned* p, unsigned v) { return __hip_atomic_fetch_add(p, v, __ATOMIC_RELAXED, __HIP_MEMORY_SCOPE_AGENT); }
__device__ __forceinline__ unsigned xb_xcc_id() { return (unsigned)__builtin_amdgcn_s_getreg((3 << 11) | 20) & 0xFu; }
#define XB_SPIN(cond, bar) do { unsigned _sp = 0; while (cond) { __builtin_amdgcn_s_sleep(1); \
    if ((++_sp & 255u) == 0u) { if (xb_ld(&(bar)[XB_TMO])) break; if (_sp > XB_SPIN_CAP) { atomicAdd(&(bar)[XB_TMO], 1u); break; } } } } while (0)
struct XcdBarrier { unsigned* bar; unsigned x; volatile LAS unsigned* st; };
__device__ __forceinline__ XcdBarrier xcd_barrier_post(unsigned* bar, volatile LAS unsigned* st, int wv) {
    XcdBarrier b; b.bar = bar; b.x = xb_xcc_id(); b.st = st;
    if (tid_opaque(wv) == 0) (void)xb_add(&bar[XB_XCNT(b.x)], 1u);
    return b;
}
__device__ __forceinline__ void xcd_barrier_complete(unsigned* bar, unsigned x, unsigned& nloc, unsigned& nx) {
    const unsigned G = gridDim.x * gridDim.y * gridDim.z;
    unsigned sum, cnt, mine, sp = 0u;
    for (;;) {
        sum = 0u; cnt = 0u; mine = 0u;
#pragma unroll
        for (unsigned j = 0; j < 16; ++j) { const unsigned c = xb_ld(&bar[XB_XCNT(j)]); sum += c; cnt += (c > 0u) ? 1u : 0u; mine = (j == x) ? c : mine; }
        if (sum == G) break;
        __builtin_amdgcn_s_sleep(1);
        if ((++sp & 255u) == 0u) { if (xb_ld(&bar[XB_TMO])) break; if (sp > XB_SPIN_CAP) { atomicAdd(&bar[XB_TMO], 1u); break; } }
    }
    nloc = mine > 0u ? mine : 1u; nx = cnt > 0u ? cnt : 1u;
}
__device__ __forceinline__ void xcd_barrier(const XcdBarrier& b, int wv) {
    asm volatile("s_waitcnt vmcnt(0)" ::: "memory");
    __syncthreads();
    if (tid_opaque(wv) == 0) {
        unsigned* bar = b.bar;
        __builtin_amdgcn_s_waitcnt(0);
        unsigned nloc = b.st[0], nx = b.st[1];
        if (nloc == 0u) { xcd_barrier_complete(bar, b.x, nloc, nx); b.st[0] = nloc; b.st[1] = nx; }
        const unsigned old = xb_add(&bar[XB_XSUB(b.x)], 1u);
        const unsigned gen = old / nloc;
        if (old + 1u == (gen + 1u) * nloc) {
            __builtin_amdgcn_fence(__ATOMIC_RELEASE, "agent");
            asm volatile("s_waitcnt vmcnt(0)" ::: "memory");
            const unsigned og = xb_add(&bar[XB_TOP], 1u);
            const unsigned tg = og / nx;
            if (og + 1u == (tg + 1u) * nx) xb_add(&bar[XB_TOPGEN], 1u);
            else XB_SPIN(xb_ld(&bar[XB_TOPGEN]) == tg, bar);
            __builtin_amdgcn_fence(__ATOMIC_ACQUIRE, "agent");
            xb_add(&bar[XB_XGEN(b.x)], 1u);
            asm volatile("s_waitcnt vmcnt(0)" ::: "memory");
        } else {
            XB_SPIN(xb_ld(&bar[XB_XGEN(b.x)]) == gen, bar);
            __builtin_amdgcn_fence(__ATOMIC_ACQUIRE, "agent");
            asm volatile("s_waitcnt vmcnt(0)" ::: "memory");
        }
    }
    __syncthreads();
}

namespace pg8 {
constexpr int BM = 256, BK = 64, HALF = 128, HTB = HALF * BK * 2, NXCD = 8, WGM = 8;
__host__ __device__ __forceinline__ int lds_byte(int r, int c) { const int st = (r >> 4) * 2 + (c >> 5), rr = r & 15, cc = c & 31, ob = rr * 64 + cc * 2; return st * 1024 + (ob ^ (((ob >> 9) & 1) << 5)); }
__host__ __device__ __forceinline__ void stage_rc(int b, int& R, int& C) { const int st = b / 1024, sb = b % 1024, swz = sb ^ (((sb >> 9) & 1) << 5); R = (st >> 1) * 16 + swz / 64; C = (st & 1) * 32 + (swz % 64) / 2; }
struct Unit { int pm, pn; };
struct Gemm { const bf16_t* A; const bf16_t* Bt; int nM, nN, K, a_tile_rows; };
struct StaticOrder {
    int nM, nN, nwg, G, c;
    __device__ void init(int nM_, int nN_, int G_, int c_) { nM = nM_; nN = nN_; nwg = nM * nN; G = G_; c = c_; }
    __device__ bool next(int i, Unit& u) const {
        const long L = (long)i * G + c; if (L >= nwg) return false;
        int wgid = (int)L; { const int q = nwg / NXCD, r = nwg % NXCD, xcd = wgid % NXCD, off = wgid / NXCD; wgid = (xcd < r ? xcd * (q + 1) : r * (q + 1) + (xcd - r) * q) + off; }
        const int nig = WGM * nN, gid = wgid / nig, fm = gid * WGM, gsz = (nM - fm) < WGM ? (nM - fm) : WGM;
        u.pm = fm + ((wgid % nig) % gsz); u.pn = (wgid % nig) / gsz; return true;
    }
};
template <class Epi>
__device__ __forceinline__ void gemm_phase(LAS unsigned char* lds, const Gemm g, const StaticOrder& S, const Epi& E, int wv) {
    const int tid = tid_opaque(wv);
    const int wid = __builtin_amdgcn_readfirstlane(tid >> 6), lane = tid & 63, wr = wid >> 2, wc = wid & 3, fr = lane & 15, fq = lane >> 4;
    const int K = g.K, nt = K / BK;
    unsigned voffA[2], voffB[2];
#pragma unroll
    for (int i = 0; i < 2; ++i) { int R, C; stage_rc(tid * 16 + i * 8192, R, C);
        const int Ra = (R & ~63) + 4 * (R & 15) + ((R >> 4) & 3);
        voffA[i] = (unsigned)(Ra * K + C) * 2u; voffB[i] = (unsigned)(R * K + C) * 2u; }
    const size_t kstep = (size_t)(BK * 2);
    const size_t hstep = (size_t)HALF * K * 2;
    const size_t tstepA = (size_t)g.a_tile_rows * K * 2;
    const size_t tstepB = 2 * hstep;
    const unsigned ldsw = (unsigned)wid * 1024u;
    const int aoff = lds_byte(wr * 64 + fr, fq * 8), boff = lds_byte(wc * 32 + fr, fq * 8);
#define PG8_SA(b, h) (((b) * 2 + (h)) * HTB)
#define PG8_SB(b, h) ((4 + (b) * 2 + (h)) * HTB)
#define PG8_STAGE(bufoff, gbase, voff) do { _Pragma("unroll") for (int _i = 0; _i < 2; ++_i) \
        __builtin_amdgcn_global_load_lds((const unsigned*)((const char*)(gbase) + (voff)[_i]), (LAS unsigned*)(lds + (bufoff) + ldsw + _i * 8192), 16, 0, 0); } while (0)
#define PG8_LDA(dst, b, h) do { _Pragma("unroll") for (int m = 0; m < 4; ++m) _Pragma("unroll") for (int k = 0; k < 2; ++k) dst[m][k] = *(const LAS bf16x8*)(lds + PG8_SA(b, h) + aoff + m * 2048 + k * 1024); } while (0)
#define PG8_LDB(dst, b, h) do { _Pragma("unroll") for (int n = 0; n < 2; ++n) _Pragma("unroll") for (int k = 0; k < 2; ++k) dst[n][k] = *(const LAS bf16x8*)(lds + PG8_SB(b, h) + boff + n * 2048 + k * 1024); } while (0)
#define PG8_MMA(ai, bj, At, Bt) do { __builtin_amdgcn_s_setprio(1); _Pragma("unroll") for (int m = 0; m < 4; ++m) _Pragma("unroll") for (int n = 0; n < 2; ++n) _Pragma("unroll") for (int k = 0; k < 2; ++k) \
        acc[ai][bj][m][n] = __builtin_amdgcn_mfma_f32_16x16x32_bf16(Bt[n][k], At[m][k], acc[ai][bj][m][n], 0, 0, 0); __builtin_amdgcn_s_setprio(0); } while (0)
#define PG8_WAIT_V(n) asm volatile("s_waitcnt vmcnt(" #n ")" ::: "memory")
#define PG8_WAIT_L(n) asm volatile("s_waitcnt lgkmcnt(" #n ")" ::: "memory")
#define PG8_BAR __builtin_amdgcn_s_barrier()
#define PG8_SCHED __builtin_amdgcn_sched_barrier(0)
    Unit cur, nxt; int ui = 0;
    if (!S.next(0, cur)) return;
    f32x4 acc[2][2][4][2];
#pragma unroll
    for (int a = 0; a < 2; ++a)
#pragma unroll
        for (int b = 0; b < 2; ++b)
#pragma unroll
            for (int m = 0; m < 4; ++m)
#pragma unroll
                for (int n = 0; n < 2; ++n) acc[a][b][m][n] = (f32x4){0.f, 0.f, 0.f, 0.f};
    bf16x8 At[4][2], B0[2][2], B1[2][2];
    const char* cA = (const char*)g.A + (size_t)cur.pm * tstepA; const char* cB = (const char*)g.Bt + (size_t)cur.pn * tstepB;
    PG8_STAGE(PG8_SB(0, 0), cB, voffB); PG8_STAGE(PG8_SA(0, 0), cA, voffA); PG8_STAGE(PG8_SB(0, 1), cB + hstep, voffB); PG8_STAGE(PG8_SA(0, 1), cA + hstep, voffA);
    if (wr == 1) PG8_BAR;
    PG8_WAIT_V(4); PG8_BAR;
    PG8_STAGE(PG8_SB(1, 0), cB + kstep, voffB); PG8_STAGE(PG8_SA(1, 0), cA + kstep, voffA); PG8_STAGE(PG8_SB(1, 1), cB + hstep + kstep, voffB);
    PG8_WAIT_V(6); PG8_BAR;
    for (;;) {
        const bool has_next = S.next(ui + 1, nxt);
        const char* nA = has_next ? (const char*)g.A + (size_t)nxt.pm * tstepA : cA; const char* nB = has_next ? (const char*)g.Bt + (size_t)nxt.pn * tstepB : cB;
        for (int t = 0; t < nt; t += 2) {
            const bool last = (t == nt - 2);
            const char* a1 = cA + (size_t)(t + 1) * kstep;
            const char* a2 = last ? nA : cA + (size_t)(t + 2) * kstep; const char* b2 = last ? nB : cB + (size_t)(t + 2) * kstep;
            const char* a3 = a2 + kstep; const char* b3 = b2 + kstep;
            PG8_LDB(B0, 0, 0); PG8_SCHED; PG8_LDA(At, 0, 0); PG8_STAGE(PG8_SA(1, 1), a1 + hstep, voffA);
            PG8_WAIT_L(8); PG8_BAR; PG8_WAIT_L(0); PG8_MMA(0, 0, At, B0); PG8_BAR; PG8_SCHED;
            PG8_LDB(B1, 0, 1); PG8_STAGE(PG8_SB(0, 0), b2, voffB);
            PG8_BAR; PG8_WAIT_L(0); PG8_MMA(0, 1, At, B1); PG8_BAR;
            PG8_LDA(At, 0, 1); PG8_STAGE(PG8_SA(0, 0), a2, voffA);
            PG8_BAR; PG8_WAIT_L(0); PG8_MMA(1, 0, At, B0); PG8_BAR; PG8_SCHED;
            PG8_STAGE(PG8_SB(0, 1), b2 + hstep, voffB);
            PG8_WAIT_V(6); PG8_BAR; PG8_MMA(1, 1, At, B1); PG8_BAR;
            PG8_LDB(B0, 1, 0); PG8_SCHED; PG8_LDA(At, 1, 0); PG8_STAGE(PG8_SA(0, 1), a2 + hstep, voffA);
            PG8_WAIT_L(8); PG8_BAR; PG8_WAIT_L(0); PG8_MMA(0, 0, At, B0); PG8_BAR; PG8_SCHED;
            PG8_LDB(B1, 1, 1); PG8_STAGE(PG8_SB(1, 0), b3, voffB);
            PG8_BAR; PG8_WAIT_L(0); PG8_MMA(0, 1, At, B1); PG8_BAR;
            PG8_LDA(At, 1, 1); PG8_STAGE(PG8_SA(1, 0), a3, voffA);
            PG8_BAR; PG8_WAIT_L(0); PG8_MMA(1, 0, At, B0); PG8_BAR; PG8_SCHED;
            PG8_STAGE(PG8_SB(1, 1), b3 + hstep, voffB);
            PG8_WAIT_V(6); PG8_BAR; PG8_MMA(1, 1, At, B1); PG8_BAR;
        }
        { const int ln2 = lane_fresh();
          E(acc, cur, wr, wc, ln2 & 15, ln2 >> 4); }
        if (!has_next) break;
#pragma unroll
        for (int a = 0; a < 2; ++a)
#pragma unroll
            for (int b = 0; b < 2; ++b)
#pragma unroll
                for (int m = 0; m < 4; ++m)
#pragma unroll
                    for (int n = 0; n < 2; ++n) acc[a][b][m][n] = (f32x4){0.f, 0.f, 0.f, 0.f};
        cur = nxt; cA = nA; cB = nB; ++ui;
    }
    PG8_WAIT_V(0);
    if (wr == 0) PG8_BAR;
    PG8_BAR;
#undef PG8_SA
#undef PG8_SB
#undef PG8_STAGE
#undef PG8_LDA
#undef PG8_LDB
#undef PG8_MMA
#undef PG8_WAIT_V
#undef PG8_WAIT_L
#undef PG8_BAR
#undef PG8_SCHED
}
}
using pg8::Unit;

struct EpiProj {
    bf16_t* O; const float* cosT; const float* sinT;
    __device__ __forceinline__ void operator()(const f32x4 (&acc)[2][2][4][2], const Unit& u, int wr, int wc, int fr, int fq) const {
        const bool latent = u.pm < 128;
#pragma unroll
        for (int ai = 0; ai < 2; ++ai)
#pragma unroll
            for (int m = 0; m < 4; ++m) {
                const int row = u.pm * 256 + ai * 128 + wr * 64 + 4 * fr + m;
                const int t = row & (S - 1);
                const int pos = (wc & 1) ? (t & 63) : (t >> 6);
#pragma unroll
                for (int bj = 0; bj < 2; ++bj) {
                    const int col = u.pn * 256 + bj * 128 + wc * 32 + 4 * fq;
                    f32x4 v0 = acc[ai][bj][m][0], v1 = acc[ai][bj][m][1];
                    const bool rope = latent && (u.pn == 4 || u.pn == 5 || (u.pn == 6 && bj == 0));
                    if (rope) {
                        const f32x4 cs = *(const f32x4*)(cosT + pos * 16 + 4 * fq), sn = *(const f32x4*)(sinT + pos * 16 + 4 * fq);
                        const f32x4 n0 = v0 * cs - v1 * sn, n1 = v1 * cs + v0 * sn; v0 = n0; v1 = n1;
                    }
                    bf16_t* p = O + (size_t)row * DIN + col;
                    u32x2 w0, w1; w0.x = pk2(v0[0], v0[1]); w0.y = pk2(v0[2], v0[3]); w1.x = pk2(v1[0], v1[1]); w1.y = pk2(v1[2], v1[3]);
                    *(u32x2*)p = w0; *(u32x2*)(p + 16) = w1;
                }
            }
    }
};
struct EpiDelta {
    bf16_t* O; const float* gate0; const float* gate1;
    __device__ __forceinline__ void operator()(const f32x4 (&acc)[2][2][4][2], const Unit& u, int wr, int wc, int fr, int fq) const {
        const float* gate = (u.pm >= 64) ? gate1 : gate0;
        f32x4 gv[2][2];
#pragma unroll
        for (int bj = 0; bj < 2; ++bj)
#pragma unroll
            for (int n = 0; n < 2; ++n) gv[bj][n] = *(const f32x4*)(gate + u.pn * 256 + bj * 128 + wc * 32 + n * 16 + 4 * fq);
#pragma unroll
        for (int ai = 0; ai < 2; ++ai)
#pragma unroll
            for (int m = 0; m < 4; ++m) {
                const size_t row = (size_t)u.pm * 256 + ai * 128 + wr * 64 + 4 * fr + m;
#pragma unroll
                for (int bj = 0; bj < 2; ++bj)
#pragma unroll
                    for (int n = 0; n < 2; ++n) {
                        const f32x4 v = gv[bj][n] * acc[ai][bj][m][n];
                        u32x2 w; w.x = pk2(v[0], v[1]); w.y = pk2(v[2], v[3]);
                        *(u32x2*)(O + row * D + u.pn * 256 + bj * 128 + wc * 32 + n * 16 + 4 * fq) = w;
                    }
            }
    }
};

__device__ __forceinline__ float dpp_ror1(float v)  { return __int_as_float(__builtin_amdgcn_update_dpp(0, __float_as_int(v), 0x121, 0xF, 0xF, true)); }
__device__ __forceinline__ float dpp_ror15(float v) { return __int_as_float(__builtin_amdgcn_update_dpp(0, __float_as_int(v), 0x12F, 0xF, 0xF, true)); }
__device__ __forceinline__ float dpp_shr1(float v)  { return __int_as_float(__builtin_amdgcn_update_dpp(0, __float_as_int(v), 0x111, 0xF, 0xF, true)); }
__device__ __forceinline__ float dpp_shl1(float v)  { return __int_as_float(__builtin_amdgcn_update_dpp(0, __float_as_int(v), 0x101, 0xF, 0xF, true)); }

#define DPP_FMAC4X2(C, SA, WA, CTRLA, SB, WB, CTRLB) do { float _c0 = (C)[0], _c1 = (C)[1], _c2 = (C)[2], _c3 = (C)[3]; \
    asm("s_nop 1\n\t" \
        "v_fmac_f32_dpp %0, %4, %8 " CTRLA " row_mask:0xf bank_mask:0xf bound_ctrl:1\n\t" \
        "v_fmac_f32_dpp %1, %5, %9 " CTRLA " row_mask:0xf bank_mask:0xf bound_ctrl:1\n\t" \
        "v_fmac_f32_dpp %2, %6, %10 " CTRLA " row_mask:0xf bank_mask:0xf bound_ctrl:1\n\t" \
        "v_fmac_f32_dpp %3, %7, %11 " CTRLA " row_mask:0xf bank_mask:0xf bound_ctrl:1\n\t" \
        "v_fmac_f32_dpp %0, %12, %16 " CTRLB " row_mask:0xf bank_mask:0xf bound_ctrl:1\n\t" \
        "v_fmac_f32_dpp %1, %13, %17 " CTRLB " row_mask:0xf bank_mask:0xf bound_ctrl:1\n\t" \
        "v_fmac_f32_dpp %2, %14, %18 " CTRLB " row_mask:0xf bank_mask:0xf bound_ctrl:1\n\t" \
        "v_fmac_f32_dpp %3, %15, %19 " CTRLB " row_mask:0xf bank_mask:0xf bound_ctrl:1" \
        : "+v"(_c0), "+v"(_c1), "+v"(_c2), "+v"(_c3) \
        : "v"((SA)[0]), "v"((SA)[1]), "v"((SA)[2]), "v"((SA)[3]), "v"((WA)[0]), "v"((WA)[1]), "v"((WA)[2]), "v"((WA)[3]), \
          "v"((SB)[0]), "v"((SB)[1]), "v"((SB)[2]), "v"((SB)[3]), "v"((WB)[0]), "v"((WB)[1]), "v"((WB)[2]), "v"((WB)[3])); \
    (C)[0] = _c0; (C)[1] = _c1; (C)[2] = _c2; (C)[3] = _c3; } while (0)
#define DPP_FMAC4(C, SA, WA, CTRLA) do { float _c0 = (C)[0], _c1 = (C)[1], _c2 = (C)[2], _c3 = (C)[3]; \
    asm("s_nop 1\n\t" \
        "v_fmac_f32_dpp %0, %4, %8 " CTRLA " row_mask:0xf bank_mask:0xf bound_ctrl:1\n\t" \
        "v_fmac_f32_dpp %1, %5, %9 " CTRLA " row_mask:0xf bank_mask:0xf bound_ctrl:1\n\t" \
        "v_fmac_f32_dpp %2, %6, %10 " CTRLA " row_mask:0xf bank_mask:0xf bound_ctrl:1\n\t" \
        "v_fmac_f32_dpp %3, %7, %11 " CTRLA " row_mask:0xf bank_mask:0xf bound_ctrl:1" \
        : "+v"(_c0), "+v"(_c1), "+v"(_c2), "+v"(_c3) \
        : "v"((SA)[0]), "v"((SA)[1]), "v"((SA)[2]), "v"((SA)[3]), "v"((WA)[0]), "v"((WA)[1]), "v"((WA)[2]), "v"((WA)[3])); \
    (C)[0] = _c0; (C)[1] = _c1; (C)[2] = _c2; (C)[3] = _c3; } while (0)
struct EpiConvGate {
    bf16_t* act; const float* cw; const float* cbias; LAS unsigned char* xl;
    __device__ __forceinline__ void operator()(const f32x4 (&acc)[2][2][4][2], const Unit& u, int wr, int wc, int fr, int fq) const {
        if (wr == 0) { __builtin_amdgcn_s_barrier(); } asm volatile("" ::: "memory");
        LAS float* X = (LAS float*)xl;
        f32x4 wq[2][2][4];
#define CG_LOADW(N) do { _Pragma("unroll") for (int bj = 0; bj < 2; ++bj) { const int ch = 128 * u.pn + 32 * wc + 16 * (N) + 4 * fq + bj * DFF; \
            wq[N][bj][0] = *(const f32x4*)(cw + ch); wq[N][bj][1] = *(const f32x4*)(cw + DUP + ch); wq[N][bj][2] = *(const f32x4*)(cw + 2 * DUP + ch); wq[N][bj][3] = *(const f32x4*)(cbias + ch); } } while (0)
        CG_LOADW(0);
#pragma unroll
        for (int ai = 0; ai < 2; ++ai) {
            const int s = 2 * ai + wr;
            if (fr == 0) {
#pragma unroll
                for (int bj = 0; bj < 2; ++bj)
#pragma unroll
                    for (int n = 0; n < 2; ++n) *(LAS f32x4*)(X + ((s * 2 + 0) * 2 + bj) * 128 + 32 * wc + 16 * n + 4 * fq) = acc[ai][bj][0][n];
            }
            if (fr == 15) {
#pragma unroll
                for (int bj = 0; bj < 2; ++bj)
#pragma unroll
                    for (int n = 0; n < 2; ++n) *(LAS f32x4*)(X + ((s * 2 + 1) * 2 + bj) * 128 + 32 * wc + 16 * n + 4 * fq) = acc[ai][bj][3][n];
            }
        }
        asm volatile("s_waitcnt lgkmcnt(0)" ::: "memory");
        __builtin_amdgcn_s_barrier(); asm volatile("" ::: "memory");
#pragma unroll
        for (int n = 0; n < 2; ++n) {
            const int chg = 128 * u.pn + 32 * wc + 16 * n + 4 * fq;
            if (n == 1) CG_LOADW(1);
            f32x4 w0[2], w1[2], w2[2], bb[2], w0m[2], w2m[2];
#pragma unroll
            for (int bj = 0; bj < 2; ++bj) {
                w0[bj] = wq[n][bj][0]; w1[bj] = wq[n][bj][1]; w2[bj] = wq[n][bj][2]; bb[bj] = wq[n][bj][3];
                w0m[bj] = (fr == 0) ? w0[bj] : (f32x4){0.f, 0.f, 0.f, 0.f}; w2m[bj] = (fr == 15) ? w2[bj] : (f32x4){0.f, 0.f, 0.f, 0.f};
            }
#pragma unroll
            for (int ai = 0; ai < 2; ++ai) {
                const int s = 2 * ai + wr;
                f32x4 xp[2], xn[2];
#pragma unroll
                for (int bj = 0; bj < 2; ++bj) {
                    xp[bj] = *(const LAS f32x4*)(X + ((((s + 3) & 3) * 2 + 1) * 2 + bj) * 128 + 32 * wc + 16 * n + 4 * fq);
                    xn[bj] = *(const LAS f32x4*)(X + ((((s + 1) & 3) * 2 + 0) * 2 + bj) * 128 + 32 * wc + 16 * n + 4 * fq);
                }
                f32x4 cvv[4][2];
#pragma unroll
                for (int bj = 0; bj < 2; ++bj) {
                    const f32x4 a0 = acc[ai][bj][0][n], a1 = acc[ai][bj][1][n], a2 = acc[ai][bj][2][n], a3 = acc[ai][bj][3][n];
                    f32x4 c0 = bb[bj] + w1[bj] * a0 + w2[bj] * a1 + w0m[bj] * xp[bj];
                    f32x4 c1 = bb[bj] + w1[bj] * a1 + w0[bj] * a0 + w2[bj] * a2;
                    f32x4 c2 = bb[bj] + w1[bj] * a2 + w0[bj] * a1 + w2[bj] * a3;
                    f32x4 c3 = bb[bj] + w1[bj] * a3 + w0[bj] * a2 + w2m[bj] * xn[bj];
                    DPP_FMAC4(c0, a3, w0[bj], "row_shr:1");
                    DPP_FMAC4(c3, a0, w2[bj], "row_shl:1");
                    cvv[0][bj] = c0; cvv[1][bj] = c1; cvv[2][bj] = c2; cvv[3][bj] = c3;
                }
#pragma unroll
                for (int m = 0; m < 4; ++m) {
                    const int lr = 128 * ai + 64 * wr + 4 * fr + m;
                    const int R = 254 * u.pm + lr;
                    const int b = R >= (H2_BSTRIDE + 1) ? 1 : 0;
                    const int t = R - 1 - H2_BSTRIDE * b;
                    const bool valid = lr >= 1 && lr <= 254 && t >= 0 && t < S;
                    if (valid) {
                        u32x2 w;
                        w.x = pk2(silu_(cvv[m][0][0]) * cvv[m][1][0], silu_(cvv[m][0][1]) * cvv[m][1][1]);
                        w.y = pk2(silu_(cvv[m][0][2]) * cvv[m][1][2], silu_(cvv[m][0][3]) * cvv[m][1][3]);
                        *(u32x2*)(act + (size_t)(b * S + t) * DFF + chg) = w;
                    }
                }
            }
        }
        asm volatile("" ::: "memory"); if (wr == 1) { __builtin_amdgcn_s_barrier(); }
    }
};

#undef CG_LOADW
__device__ __forceinline__ void transpose_item(const float* W, int N, int k0, int n0, bf16_t* dst, int Kd, float* scr, int lane) {
#pragma unroll 16
    for (int i = 0; i < 32; ++i) { const int kk = 2 * i + (lane >> 5); scr[kk * 33 + (lane & 31)] = W[(size_t)(k0 + kk) * N + n0 + (lane & 31)]; }
    __builtin_amdgcn_wave_barrier();
    const int c = lane & 7;
#pragma unroll
    for (int j = 0; j < 4; ++j) {
        const int n = (lane >> 3) + 8 * j; const float* s = scr + (8 * c) * 33 + n;
        u32x4 o; o.x = pk2(s[0], s[33]); o.y = pk2(s[2 * 33], s[3 * 33]); o.z = pk2(s[4 * 33], s[5 * 33]); o.w = pk2(s[6 * 33], s[7 * 33]);
        *(u32x4*)(dst + (size_t)n * Kd + k0 + 8 * c) = o;
    }
    __builtin_amdgcn_wave_barrier();
}

__device__ __forceinline__ void phase0(PP p, unsigned char* shm, int wv) {
    const int tid = tid_opaque(wv), lane = tid & 63, wave = tid >> 6;
    unsigned char* ws = p->ws;
    if (blockIdx.x < 192) {
        float* sv = (float*)shm;
        float* red = sv + 3 * 1024;
        for (int i = tid; i < 3 * 1024; i += 512) {
            const int j = i >> 10, k = i & 1023;
            const float v = (j < 2) ? p->c[j * 1024 + k] : p->c_ctx[k];
            sv[i] = silu_(v);
        }
        __syncthreads();
        const int n0 = blockIdx.x * 32, col = tid & 31, ks = tid >> 5;
        float a0 = 0.f, a1 = 0.f, a2 = 0.f;
        const float* wp = p->w_mod + (size_t)(ks * 64) * 6144 + n0 + col;
#pragma unroll
        for (int k = 0; k < 64; ++k) {
            const float w = wp[(size_t)k * 6144];
            a0 += sv[ks * 64 + k] * w; a1 += sv[1024 + ks * 64 + k] * w; a2 += sv[2048 + ks * 64 + k] * w;
        }
        red[(ks * 3 + 0) * 32 + col] = a0; red[(ks * 3 + 1) * 32 + col] = a1; red[(ks * 3 + 2) * 32 + col] = a2;
        __syncthreads();
        if (tid < 96) {
            const int j = tid >> 5, cc = tid & 31; float s = p->b_mod[n0 + cc];
            for (int k = 0; k < 16; ++k) s += red[(k * 3 + j) * 32 + cc];
            ((float*)(ws + WS_MOD))[j * 6144 + n0 + cc] = s;
        }
        __syncthreads();
    }
    if (blockIdx.x == 200) { for (int i = tid; i < 1024; i += 512) ((float*)(ws + WS_SP8))[i] = -8.0f * log1pf(expf(-p->lru_lam[i])); }
    if (blockIdx.x >= 192 && blockIdx.x < 200) {
        const int idx = (blockIdx.x - 192) * 512 + tid;
        const int pos = idx >> 4, i = idx & 15;
        const float inv = powf(10000.0f, -(float)i / 16.0f);
        const float ang = (float)pos * inv;
        ((float*)(ws + WS_ROPE))[idx] = cosf(ang);
        ((float*)(ws + WS_ROPE))[4096 + idx] = sinf(ang);
    }
}
__device__ __forceinline__ void transpose_phase(PP p, unsigned char* shm, int wv, int it_lo, int it_hi, int gw0, int NGW) {
    const int tid = tid_opaque(wv), lane = tid & 63, wave = wv;
    unsigned char* ws = p->ws;
    float* scr = (float*)(shm + 32768) + wave * (64 * 33);
    const int gw = gw0 + wave;
    constexpr int I_IN = (D / 64) * (DIN / 32), I_OUT = (D / 64) * (D / 32), I_UP = (D / 64) * (DUP / 32), I_DN = (DFF / 64) * (D / 32), I_LRU = 2 * 2 * 8 * 2;
    constexpr int NIT = I_IN + I_OUT + I_UP + I_DN + I_LRU;
    (void)NIT;
    for (int it = it_lo + gw; it < it_hi; it += NGW) {
        int r = it;
        if (r >= I_IN + I_OUT + I_UP + I_DN + I_LRU) continue;
        if (r < I_IN) { const int nb = DIN / 32, kb = r / nb, n0 = (r % nb) * 32; transpose_item(p->w_in, DIN, kb * 64, n0, (bf16_t*)(ws + WS_WIN) + (size_t)n0 * D, D, scr, lane); continue; } r -= I_IN;
        if (r < I_OUT) { const int nb = D / 32, kb = r / nb, n0 = (r % nb) * 32; transpose_item(p->w_out, D, kb * 64, n0, (bf16_t*)(ws + WS_WOUT) + (size_t)n0 * D, D, scr, lane); continue; } r -= I_OUT;
        if (r < I_UP) { const int nb = DUP / 32, kb = r / nb, n0 = (r % nb) * 32;
            const int isv = n0 >= DFF, nn = isv ? n0 - DFF : n0, drow = (nn / 128) * 256 + isv * 128 + (nn % 128);
            transpose_item(p->w_up, DUP, kb * 64, n0, (bf16_t*)(ws + WS_WUP) + (size_t)drow * D, D, scr, lane); continue; } r -= I_UP;
        if (r < I_DN) { const int nb = D / 32, kb = r / nb, n0 = (r % nb) * 32; transpose_item(p->w_down, D, kb * 64, n0, (bf16_t*)(ws + WS_WDN) + (size_t)n0 * DFF, DFF, scr, lane); continue; } r -= I_DN;
        {
            const int nh = r & 1, blk = (r >> 1) & 7, type = (r >> 4) & 1, dir = r >> 5;
            const float* src = (type ? p->lru_w_i : p->lru_w_a) + (size_t)(dir * 8 + blk) * 4096;
            bf16_t* dst = (bf16_t*)(ws + WS_LRU) + (size_t)((dir * 2 + type) * 8 + blk) * 4096 + (size_t)(nh * 32) * 64;
            transpose_item(src, 64, 0, nh * 32, dst, 64, scr, lane);
        }
    }
}

__device__ __forceinline__ void row_load(const float* src, int lane, f32x4 (&v)[4]) {
#pragma unroll
    for (int j = 0; j < 4; ++j) v[j] = *(const f32x4*)(src + 4 * lane + 256 * j);
}
__device__ __forceinline__ float row_rstd(const f32x4 (&v)[4]) {
    float ss = 0.f;
#pragma unroll
    for (int j = 0; j < 4; ++j) ss += v[j][0] * v[j][0] + v[j][1] * v[j][1] + v[j][2] * v[j][2] + v[j][3] * v[j][3];
    return rsqrtf(wave_sum(ss) * (1.0f / D) + EPS);
}
__device__ __forceinline__ void norm_mod_store(const f32x4 (&v)[4], float rstd, const float* g, const float* sh, const float* sc, bf16_t* dst, int lane) {
#pragma unroll
    for (int j = 0; j < 4; ++j) {
        const int c = 4 * lane + 256 * j;
        const f32x4 gg = *(const f32x4*)(g + c), s1 = *(const f32x4*)(sc + c), s0 = *(const f32x4*)(sh + c);
        const f32x4 o = (v[j] * rstd * gg) * (s1 + 1.0f) + s0;
        u32x2 w; w.x = pk2(o[0], o[1]); w.y = pk2(o[2], o[3]);
        *(u32x2*)(dst + c) = w;
    }
}
__device__ __forceinline__ void phase1(PP p, int wv) {
    const int tid_ = tid_opaque(wv), lane = tid_ & 63, gw = blockIdx.x * 8 + (tid_ >> 6), NGW = gridDim.x * 8;
    const float* mod = (const float*)(p->ws + WS_MOD);
    bf16_t* hb = (bf16_t*)(p->ws + WS_HB);
    int cur = -1; f32x4 gsc[4], gsh[4];
    for (int r0 = gw; r0 < MROWS; r0 += 4 * NGW) {
        f32x4 v[4][4];
#pragma unroll
        for (int q = 0; q < 4; ++q) {
            const int r = (r0 + q * NGW < MROWS) ? r0 + q * NGW : r0;
            row_load(r < NLAT ? p->x + (size_t)r * D : p->ctx + (size_t)(r - NLAT) * D, lane, v[q]);
        }
#pragma unroll
        for (int q = 0; q < 4; ++q) {
            const int r = r0 + q * NGW;
            if (r < MROWS) {
                const int mi = r < NLAT ? (r >> 14) : 2;
                if (mi != cur) {
                    cur = mi;
#pragma unroll
                    for (int j = 0; j < 4; ++j) {
                        const int c = 4 * lane + 256 * j;
                        gsc[j] = *(const f32x4*)(p->norm1_g + c) * (*(const f32x4*)(mod + mi * 6144 + 1024 + c) + 1.0f);
                        gsh[j] = *(const f32x4*)(mod + mi * 6144 + c);
                    }
                }
                const float rstd = row_rstd(v[q]);
#pragma unroll
                for (int j = 0; j < 4; ++j) {
                    const f32x4 o = v[q][j] * rstd * gsc[j] + gsh[j];
                    u32x2 w; w.x = pk2(o[0], o[1]); w.y = pk2(o[2], o[3]);
                    *(u32x2*)(hb + (size_t)r * D + 4 * lane + 256 * j) = w;
                }
            }
        }
    }
}

typedef float f32x16 __attribute__((ext_vector_type(16)));
__device__ __forceinline__ unsigned cvt_pk_bf16(float lo, float hi) { unsigned r; asm("v_cvt_pk_bf16_f32 %0, %1, %2" : "=v"(r) : "v"(lo), "v"(hi)); return r; }
__device__ __forceinline__ void attn_mfma(PP p, unsigned char* shm, int wv) {
    const int tid = tid_opaque(wv);
    const int lane = tid & 63, wave = wv, l31 = lane & 31, hl = lane >> 5;
    bf16_t* Ks = (bf16_t*)shm;
    bf16_t* Vt = (bf16_t*)(shm + 18432);
    const bf16_t* proj = (const bf16_t*)(p->ws + WS_PROJ);
    bf16_t* att = (bf16_t*)(p->ws + WS_ATT);
    const float L2E = 1.4426950408889634f;
    const float SC2 = 0.125f * L2E;
    for (int item = blockIdx.x; item < 512; item += gridDim.x) {
        const int hk = item & 1, qb = (item >> 1) & 127, b = item >> 8;
        const int g = wave >> 1, qh = wave & 1, hq = hk * 4 + g;
        const int qrow0 = b * S + 128 * qb + 64 * qh;
        bf16x8 qf[2][4];
#pragma unroll
        for (int qi = 0; qi < 2; ++qi)
#pragma unroll
            for (int st = 0; st < 4; ++st) qf[qi][st] = *(const bf16x8*)(proj + (size_t)(qrow0 + 32 * qi + l31) * DIN + 1024 + 64 * hq + 16 * st + 8 * hl);
        const float sink2 = p->attn_sink[hq] * L2E;
        float mrun[2] = {sink2, sink2};
        float lrun[2] = {hl == 0 ? 1.f : 0.f, hl == 0 ? 1.f : 0.f};
        f32x16 oacc[2][2];
#pragma unroll
        for (int a = 0; a < 2; ++a)
#pragma unroll
            for (int c = 0; c < 2; ++c)
#pragma unroll
                for (int i = 0; i < 16; ++i) oacc[a][c][i] = 0.f;
        u32x4 kreg[2], vreg[2];
        int ci = (qb == 0) ? 1 : 0;
#define ATT_GLOAD(CI) do { const int _row0 = (CI) < 3 ? b * S + 128 * (qb - 1 + (CI)) : NLAT + b * LC + 128 * ((CI) - 3); \
        _Pragma("unroll") for (int _i = 0; _i < 2; ++_i) { const int _pi = tid + 512 * _i, _key = _pi >> 3, _part = _pi & 7; \
            const bf16_t* _src = proj + (size_t)(_row0 + _key) * DIN + 1536 + 64 * hk + 8 * _part; kreg[_i] = *(const u32x4*)_src; vreg[_i] = *(const u32x4*)(_src + 128); } } while (0)
        ATT_GLOAD(ci);
        while (ci < 5) {
            __syncthreads();
#pragma unroll
            for (int i = 0; i < 2; ++i) {
                const int pi = tid + 512 * i, key = pi >> 3, part = pi & 7;
                *(u32x4*)(Ks + key * 72 + 8 * part) = kreg[i];
#pragma unroll
                for (int e = 0; e < 8; ++e) { const unsigned w = vreg[i][e >> 1]; Vt[(8 * part + e) * 132 + key] = (bf16_t)((e & 1) ? (w >> 16) : (w & 0xFFFFu)); }
            }
            __syncthreads();
            int cn = ci + 1; if (cn == 2 && qb == 127) cn = 3;
            if (cn < 5) ATT_GLOAD(cn);
            const int kt_lo = (ci == 0 && qh == 1) ? 2 : 0, kt_hi = (ci == 2 && qh == 0) ? 2 : 4;
#pragma unroll 1
            for (int kt = kt_lo; kt < kt_hi; ++kt) {
                bf16x8 kf[4];
#pragma unroll
                for (int st = 0; st < 4; ++st) kf[st] = *(const bf16x8*)(Ks + (32 * kt + l31) * 72 + 16 * st + 8 * hl);
                bf16x8 vf[2][2];
#pragma unroll
                for (int db = 0; db < 2; ++db)
#pragma unroll
                    for (int s2 = 0; s2 < 2; ++s2) {
                        const bf16_t* vp = Vt + (32 * db + l31) * 132 + 32 * kt + 16 * s2 + 4 * hl;
                        const u32x2 lo = *(const u32x2*)vp, hi = *(const u32x2*)(vp + 8);
                        u32x4 w; w.x = lo.x; w.y = lo.y; w.z = hi.x; w.w = hi.y;
                        vf[db][s2] = __builtin_bit_cast(bf16x8, w);
                    }
#pragma unroll
                for (int qi = 0; qi < 2; ++qi) {
                    f32x16 s;
#pragma unroll
                    for (int i = 0; i < 16; ++i) s[i] = 0.f;
#pragma unroll
                    for (int st = 0; st < 4; ++st) s = __builtin_amdgcn_mfma_f32_32x32x16_bf16(kf[st], qf[qi][st], s, 0, 0, 0);
                    if (ci == 0 || ci == 2) {
                        asm volatile("");
                        const int dl = (ci == 0) ? (32 * kt + 4 * hl - (64 * qh + 32 * qi + l31)) : ((64 * qh + 32 * qi + l31) - 32 * kt - 4 * hl);
#pragma unroll
                        for (int i = 0; i < 16; ++i) {
                            const int ki = 8 * (i >> 2) + (i & 3);
                            const bool ok = (ci == 0) ? (dl + ki >= 0) : (dl - ki >= 0);
                            s[i] = ok ? s[i] : -1e30f;
                        }
                    }
                    float mx = s[0];
#pragma unroll
                    for (int i = 1; i < 16; ++i) mx = fmaxf(mx, s[i]);
                    mx = fmaxf(mx, __shfl_xor(mx, 32));
                    const float mnew = fmaxf(mrun[qi], mx * SC2);
                    if (__builtin_amdgcn_ballot_w64(mnew > mrun[qi]) != 0ull) {
                        const float alpha = __builtin_amdgcn_exp2f(mrun[qi] - mnew);
                        lrun[qi] *= alpha;
#pragma unroll
                        for (int db = 0; db < 2; ++db)
#pragma unroll
                            for (int i = 0; i < 16; ++i) oacc[db][qi][i] *= alpha;
                        mrun[qi] = mnew;
                    }
                    float ls = 0.f;
#pragma unroll
                    for (int i = 0; i < 16; ++i) { s[i] = __builtin_amdgcn_exp2f(__builtin_fmaf(s[i], SC2, -mnew)); ls += s[i]; }
                    lrun[qi] += ls;
                    bf16x8 pf[2];
#pragma unroll
                    for (int s2 = 0; s2 < 2; ++s2) {
                        u32x4 w; w.x = cvt_pk_bf16(s[8 * s2 + 0], s[8 * s2 + 1]); w.y = cvt_pk_bf16(s[8 * s2 + 2], s[8 * s2 + 3]);
                        w.z = cvt_pk_bf16(s[8 * s2 + 4], s[8 * s2 + 5]); w.w = cvt_pk_bf16(s[8 * s2 + 6], s[8 * s2 + 7]);
                        pf[s2] = __builtin_bit_cast(bf16x8, w);
                    }
#pragma unroll
                    for (int db = 0; db < 2; ++db)
#pragma unroll
                        for (int s2 = 0; s2 < 2; ++s2) oacc[db][qi] = __builtin_amdgcn_mfma_f32_32x32x16_bf16(vf[db][s2], pf[s2], oacc[db][qi], 0, 0, 0);
                }
            }
            ci = cn;
        }
#undef ATT_GLOAD
#pragma unroll
        for (int qi = 0; qi < 2; ++qi) {
            const float lt = lrun[qi] + __shfl_xor(lrun[qi], 32);
            const float inv = 1.0f / lt;
            bf16_t* orow = att + (size_t)(qrow0 + 32 * qi + l31) * 512 + hq * 64;
#pragma unroll
            for (int db = 0; db < 2; ++db)
#pragma unroll
                for (int g4 = 0; g4 < 4; ++g4) {
                    u32x2 w; w.x = cvt_pk_bf16(oacc[db][qi][4 * g4] * inv, oacc[db][qi][4 * g4 + 1] * inv); w.y = cvt_pk_bf16(oacc[db][qi][4 * g4 + 2] * inv, oacc[db][qi][4 * g4 + 3] * inv);
                    *(u32x2*)(orow + 32 * db + 8 * g4 + 4 * hl) = w;
                }
        }
    }
    __syncthreads();
}


struct ScanW { bf16x8 wfa[4], wfi[4]; float ba, bi, sp8l2; };
__device__ __forceinline__ void scan_loadw(PP p, int dir, int n, int ct, int l31, int hl, ScanW& w) {
    unsigned chv = (unsigned)(32 * ct + l31); asm volatile("" : "+v"(chv));
    const unsigned ch = (unsigned)(dir * 512 + 64 * n) + chv;
    w.ba = p->lru_b_a[ch]; w.bi = p->lru_b_i[ch];
    w.sp8l2 = ((const float*)(p->ws + WS_SP8))[ch] * 1.4426950408889634f;
    const bf16_t* wa_b = (const bf16_t*)(p->ws + WS_LRU) + (size_t)((dir * 2 + 0) * 8 + n) * 4096;
    const bf16_t* wi_b = (const bf16_t*)(p->ws + WS_LRU) + (size_t)((dir * 2 + 1) * 8 + n) * 4096;
    const unsigned lo = chv * 64u + 8u * (unsigned)hl;
#pragma unroll
    for (int st = 0; st < 4; ++st) { w.wfa[st] = *(const bf16x8*)(wa_b + lo + 16 * st); w.wfi[st] = *(const bf16x8*)(wi_b + lo + 16 * st); }
}
template <int DIR>
__device__ __forceinline__ void scan_dir(PP p, const bf16_t* xs, const ScanW& w, ScanW& wn, int ndir, int nct, bool do_next, int n, int ct, int l31, int hl, int id, int rowbase, bool latent, float (&hf)[2][16]) {
    constexpr int XS = 520;
    const int ch = 64 * n + 32 * ct + l31;
    const float ba = w.ba, bi = w.bi, sp8l2 = w.sp8l2;
    const bf16x8 (&wfa)[4] = w.wfa; const bf16x8 (&wfi)[4] = w.wfi;
    float a[2][16], u[2][16];
#pragma unroll
    for (int rt = 0; rt < 2; ++rt) {
        bf16x8 af[4];
#pragma unroll
        for (int st = 0; st < 4; ++st) af[st] = *(const bf16x8*)(xs + (32 * rt + l31) * XS + 64 * n + 16 * st + 8 * hl);
        f32x16 ga, gi;
#pragma unroll
        for (int i = 0; i < 16; ++i) { ga[i] = 0.f; gi[i] = 0.f; }
#pragma unroll
        for (int st = 0; st < 4; ++st) { ga = __builtin_amdgcn_mfma_f32_32x32x16_bf16(af[st], wfa[st], ga, 0, 0, 0); gi = __builtin_amdgcn_mfma_f32_32x32x16_bf16(af[st], wfi[st], gi, 0, 0, 0); }
#pragma unroll
        for (int i = 0; i < 16; ++i) {
            const int token = 32 * rt + 8 * (i >> 2) + 4 * hl + (i & 3);
            const float xv = bf2f(xs[token * XS + ch]);
            const float rr = fast_sigmoid(ga[i] + ba), ii = fast_sigmoid(gi[i] + bi);
            const float la2 = rr * sp8l2;
            const float av = __builtin_amdgcn_exp2f(la2);
            const float t2 = la2 * 1.3862943611f;
            float em1p = t2 * (1.0f + t2 * (0.5f + t2 * (0.16666667f + t2 * (0.041666668f + t2 * 0.0083333333f)))), em1e = __builtin_fmaf(av, av, -1.0f);
            asm volatile("" : "+v"(em1p), "+v"(em1e));
            const float em1 = (t2 > -0.1f) ? em1p : em1e;
            a[rt][i] = av; u[rt][i] = __builtin_amdgcn_sqrtf(-em1) * (ii * xv);
        }
    }
    float Ao[8], Ho[8], Ap[8], Hp[8];
#pragma unroll
    for (int k = 0; k < 8; ++k) {
        const int rt = k >> 2, g = k & 3;
        float H = 0.f, A = 1.f;
#pragma unroll
        for (int jj = 0; jj < 4; ++jj) { const int j = DIR ? 3 - jj : jj; const float av = a[rt][4 * g + j]; H = av * H + u[rt][4 * g + j]; A *= av; }
        Ao[k] = A; Ho[k] = H; Ap[k] = __shfl_xor(A, 32); Hp[k] = __shfl_xor(H, 32);
    }
    float Sin[8], Pin[8]; float Sx = 0.f, Px = 1.f;
#pragma unroll
    for (int kk = 0; kk < 8; ++kk) {
        const int k = DIR ? 7 - kk : kk;
        const float A0 = hl ? Ap[k] : Ao[k], H0 = hl ? Hp[k] : Ho[k], A1 = hl ? Ao[k] : Ap[k], H1 = hl ? Ho[k] : Hp[k];
        float s0, p0, s1, p1;
        if (DIR == 0) { s0 = Sx; p0 = Px; Sx = A0 * Sx + H0; Px *= A0; s1 = Sx; p1 = Px; Sx = A1 * Sx + H1; Px *= A1; }
        else          { s1 = Sx; p1 = Px; Sx = A1 * Sx + H1; Px *= A1; s0 = Sx; p0 = Px; Sx = A0 * Sx + H0; Px *= A0; }
        Sin[k] = hl ? s1 : s0; Pin[k] = hl ? p1 : p0;
    }
    asm volatile("" ::: "memory");
    if (do_next) scan_loadw(p, ndir, n, nct, l31, hl, wn);
    bf16_t* yl = (bf16_t*)(p->ws + WS_YL) + (size_t)rowbase * 512; bf16_t* caf = (bf16_t*)(p->ws + WS_CAF) + (size_t)rowbase * 512; bf16_t* cab = (bf16_t*)(p->ws + WS_CAB) + (size_t)rowbase * 512;
    unsigned lo = (unsigned)ch; asm volatile("" : "+v"(lo));
#pragma unroll
    for (int k = 0; k < 8; ++k) {
        const int rt = k >> 2, g = k & 3;
        float h = Sin[k], P = Pin[k];
#pragma unroll
        for (int jj = 0; jj < 4; ++jj) {
            const int j = DIR ? 3 - jj : jj, idx = 4 * g + j;
            h = a[rt][idx] * h + u[rt][idx]; P *= a[rt][idx];
            const int token = 32 * rt + 8 * g + 4 * hl + j;
            const unsigned o = lo + (unsigned)token * 512u;
            if (DIR == 0) { hf[rt][idx] = h; if (latent) caf[o] = f2bf(P); }
            else if (latent) { yl[o] = f2bf(hf[rt][idx] + h); cab[o] = f2bf(P); }
        }
    }
    if (hl == 0) {
        float* sumb = (float*)(p->ws + WS_SUM);
        sumb[((size_t)(DIR * NCHUNK + id) * 2 + 0) * 512 + ch] = Px;
        sumb[((size_t)(DIR * NCHUNK + id) * 2 + 1) * 512 + ch] = Sx;
    }
}
__device__ __forceinline__ void scan_mfma(PP p, unsigned char* shm, int wv) {
    const int tid_ = tid_opaque(wv); const int tid = tid_;
    const int lane = tid & 63, n = wv, l31 = lane & 31, hl = lane >> 5;
    constexpr int XS = 520;
    bf16_t* xs = (bf16_t*)shm;
    const bf16_t* proj = (const bf16_t*)(p->ws + WS_PROJ);
    for (int item = blockIdx.x; item < 512 + 32; item += gridDim.x) {
        const int id = item < 512 ? item : 512 + ((item - 512) >> 2);
        const int quarter = item < 512 ? -1 : ((item - 512) & 3);
        int rowbase, t0, seqlen; bool latent;
        if (id < 512) { const int b = id >> 8, k = id & 255; t0 = 64 * k; rowbase = b * S + t0; seqlen = S; latent = true; }
        else { const int j = id - 512, b = j >> 2, k = j & 3; t0 = 64 * k; rowbase = NLAT + b * LC + t0; seqlen = LC; latent = false; }
        const int seqbase = rowbase - t0;
        ScanW w0, w1;
        if (quarter < 0) scan_loadw(p, 0, n, 0, l31, hl, w0);
        {
            const int tid = tid_opaque(wv);
            bf16_t* raw = (bf16_t*)(shm + 66560);
#pragma unroll
            for (int i = 0; i < 9; ++i) {
                const int piece = tid + 512 * i;
                if (piece < 67 * 64) {
                    const int row = piece >> 6, c8 = piece & 63, tt = t0 - 2 + row;
                    u32x4 v = {0u, 0u, 0u, 0u};
                    if (tt >= 0 && tt < seqlen) v = *(const u32x4*)(proj + (size_t)(seqbase + tt) * DIN + 8 * c8);
                    *(u32x4*)(raw + row * 512 + 8 * c8) = v;
                }
            }
            __syncthreads();
            const int c = tid;
            const float cw0 = p->rnn_conv_w[c], cw1 = p->rnn_conv_w[512 + c], cw2 = p->rnn_conv_w[1024 + c], cw3 = p->rnn_conv_w[1536 + c], cb = p->rnn_conv_b[c];
            float xm2 = bf2f(raw[c]), xm1 = bf2f(raw[512 + c]), x0 = bf2f(raw[1024 + c]);
#pragma unroll 8
            for (int t = 0; t < 64; ++t) {
                const float xp1 = bf2f(raw[(t + 3) * 512 + c]);
                xs[t * XS + c] = f2bf(cb + cw0 * xm2 + cw1 * xm1 + cw2 * x0 + cw3 * xp1);
                xm2 = xm1; xm1 = x0; x0 = xp1;
            }
        }
        __syncthreads();
#pragma unroll 1
        for (int ct = 0; ct < 2; ++ct) {
            float hf[2][16];
            const bool run0 = quarter < 0 || quarter == 2 * ct, run1 = quarter < 0 || quarter == 2 * ct + 1;
            if (quarter >= 0) { if (run0) scan_loadw(p, 0, n, ct, l31, hl, w0); if (run1) scan_loadw(p, 1, n, ct, l31, hl, w1); }
            if (run0) scan_dir<0>(p, xs, w0, w1, 1, ct, quarter < 0, n, ct, l31, hl, id, rowbase, latent, hf);
            if (run1) scan_dir<1>(p, xs, w1, w0, 0, 1, quarter < 0 && ct == 0, n, ct, l31, hl, id, rowbase, latent, hf);
        }
        __syncthreads();
    }
}

__device__ __forceinline__ void carry_phase(PP p, unsigned char* shm, int wv) {
    if (blockIdx.x >= 128) return;
    const int tid = tid_opaque(wv), cl = tid & 15, sg = tid >> 4;
    const int b = blockIdx.x >> 6, dir = (blockIdx.x >> 5) & 1, c = (blockIdx.x & 31) * 16 + cl;
    const float* sumb = (const float*)(p->ws + WS_SUM) + (size_t)dir * NCHUNK * 1024;
    float* car = (float*)(p->ws + WS_CAR) + (size_t)dir * NCHUNK * 512;
    float* segA = (float*)shm; float* segH = segA + 512;
    float A[9], H[9]; int ids[9];
#pragma unroll
    for (int k = 0; k < 9; ++k) {
        const int s = sg * 9 + k;
        int id = -1;
        if (s < 260) { if (dir == 0) id = s < 4 ? 512 + 4 * b + s : 256 * b + (s - 4); else id = s < 4 ? 512 + 4 * b + (3 - s) : 256 * b + (255 - (s - 4)); }
        ids[k] = id;
        A[k] = id >= 0 ? sumb[(size_t)id * 1024 + c] : 1.f;
        H[k] = id >= 0 ? sumb[(size_t)id * 1024 + 512 + c] : 0.f;
    }
    float As = 1.f, Hs = 0.f;
#pragma unroll
    for (int k = 0; k < 9; ++k) { Hs = A[k] * Hs + H[k]; As *= A[k]; }
    segA[sg * 16 + cl] = As; segH[sg * 16 + cl] = Hs;
    __syncthreads();
    float h = 0.f;
    for (int j = 0; j < sg; ++j) h = segA[j * 16 + cl] * h + segH[j * 16 + cl];
#pragma unroll
    for (int k = 0; k < 9; ++k) { if (ids[k] >= 0) car[(size_t)ids[k] * 512 + c] = h; h = A[k] * h + H[k]; }
    __syncthreads();
}

struct MixRow { u32x4 vy, vf, vb, vg, va; f32x4 cf0, cf1, cb0, cb1; };
__device__ __forceinline__ void mix_load(PP p, int r, int c0, MixRow& m) {
    const bf16_t* proj = (const bf16_t*)(p->ws + WS_PROJ);
    const bf16_t* att = (const bf16_t*)(p->ws + WS_ATT);
    const bf16_t* yl = (const bf16_t*)(p->ws + WS_YL); const bf16_t* caf = (const bf16_t*)(p->ws + WS_CAF); const bf16_t* cab = (const bf16_t*)(p->ws + WS_CAB);
    const float* car = (const float*)(p->ws + WS_CAR);
    const int id = r >> 6;
    m.vy = *(const u32x4*)(yl + (size_t)r * 512 + c0); m.vf = *(const u32x4*)(caf + (size_t)r * 512 + c0); m.vb = *(const u32x4*)(cab + (size_t)r * 512 + c0);
    m.vg = *(const u32x4*)(proj + (size_t)r * DIN + 512 + c0); m.va = *(const u32x4*)(att + (size_t)r * 512 + c0);
    const float* cf = car + (size_t)id * 512 + c0; const float* cbk = car + (size_t)(NCHUNK + id) * 512 + c0;
    m.cf0 = *(const f32x4*)cf; m.cf1 = *(const f32x4*)(cf + 4); m.cb0 = *(const f32x4*)cbk; m.cb1 = *(const f32x4*)(cbk + 4);
}
__device__ __forceinline__ void mix_store(PP p, int r, int c0, const MixRow& m, const f32x4 (&gr)[2], const f32x4 (&ga)[2]) {
    bf16_t* mix = (bf16_t*)(p->ws + WS_HB);
    float rn[8], at[8]; float s1 = 0.f, s2 = 0.f;
#pragma unroll
    for (int e = 0; e < 8; ++e) {
        const unsigned wy = m.vy[e >> 1], wf = m.vf[e >> 1], wb = m.vb[e >> 1], wg = m.vg[e >> 1], wa = m.va[e >> 1];
        const float cfe = e < 4 ? m.cf0[e & 3] : m.cf1[e & 3], cbe = e < 4 ? m.cb0[e & 3] : m.cb1[e & 3];
        const float y = ((e & 1) ? bfhi(wy) : bflo(wy)) + ((e & 1) ? bfhi(wf) : bflo(wf)) * cfe + ((e & 1) ? bfhi(wb) : bflo(wb)) * cbe;
        const float xg = (e & 1) ? bfhi(wg) : bflo(wg);
        rn[e] = gelu_tanh_(xg) * y; s1 += rn[e] * rn[e];
        at[e] = (e & 1) ? bfhi(wa) : bflo(wa); s2 += at[e] * at[e];
    }
    const float r1 = rsqrtf(wave_sum(s1) * (1.0f / 512.0f) + EPS), r2 = rsqrtf(wave_sum(s2) * (1.0f / 512.0f) + EPS);
    u32x4 o1, o2;
#pragma unroll
    for (int e2 = 0; e2 < 4; ++e2) {
        o1[e2] = pk2(rn[2 * e2] * r1 * gr[e2 >> 1][(2 * e2) & 3], rn[2 * e2 + 1] * r1 * gr[e2 >> 1][(2 * e2 + 1) & 3]);
        o2[e2] = pk2(at[2 * e2] * r2 * ga[e2 >> 1][(2 * e2) & 3], at[2 * e2 + 1] * r2 * ga[e2 >> 1][(2 * e2 + 1) & 3]);
    }
    *(u32x4*)(mix + (size_t)r * D + c0) = o1; *(u32x4*)(mix + (size_t)r * D + 512 + c0) = o2;
}
__device__ __forceinline__ void mix_phase(PP p, int wv) {
    const int tid_ = tid_opaque(wv), lane = tid_ & 63, gw = blockIdx.x * 8 + (tid_ >> 6), NGW = gridDim.x * 8;
    const int c0 = 8 * lane;
    f32x4 gr[2], ga[2];
    gr[0] = *(const f32x4*)(p->gn_rnn + c0); gr[1] = *(const f32x4*)(p->gn_rnn + c0 + 4); ga[0] = *(const f32x4*)(p->gn_attn + c0); ga[1] = *(const f32x4*)(p->gn_attn + c0 + 4);
    for (int r = gw; r < NLAT; r += 2 * NGW) {
        const int rb = (r + NGW < NLAT) ? r + NGW : r;
        MixRow ma, mb;
        mix_load(p, r, c0, ma); mix_load(p, rb, c0, mb);
        mix_store(p, r, c0, ma, gr, ga);
        if (rb != r) mix_store(p, rb, c0, mb, gr, ga);
    }
}

__device__ __forceinline__ void phase7(PP p, int wv) {
    const int tid_ = tid_opaque(wv), lane = tid_ & 63, gw = blockIdx.x * 8 + (tid_ >> 6), NGW = gridDim.x * 8;
    const float* mod = (const float*)(p->ws + WS_MOD);
    bf16_t* hb = (bf16_t*)(p->ws + WS_HB);
    const bf16_t* o1 = (const bf16_t*)(p->ws + WS_O1);
    for (int r = gw; r < NLAT; r += 2 * NGW) {
        const int rb = r + NGW;
        f32x4 va[4], vb[4]; u32x2 da[4], db[4];
        row_load(p->x + (size_t)r * D, lane, va); row_load(p->x + (size_t)rb * D, lane, vb);
#pragma unroll
        for (int j = 0; j < 4; ++j) { da[j] = *(const u32x2*)(o1 + (size_t)r * D + 4 * lane + 256 * j); db[j] = *(const u32x2*)(o1 + (size_t)rb * D + 4 * lane + 256 * j); }
#pragma unroll
        for (int j = 0; j < 4; ++j) {
            va[j][0] += bflo(da[j].x); va[j][1] += bfhi(da[j].x); va[j][2] += bflo(da[j].y); va[j][3] += bfhi(da[j].y);
            vb[j][0] += bflo(db[j].x); vb[j][1] += bfhi(db[j].x); vb[j][2] += bflo(db[j].y); vb[j][3] += bfhi(db[j].y);
        }
        const float sa = row_rstd(va), sb = row_rstd(vb);
        const int ma = r >> 14, mb = rb >> 14;
        norm_mod_store(va, sa, p->norm2_g, mod + ma * 6144 + 3072, mod + ma * 6144 + 4096, hb + (size_t)(ma * H2_BSTRIDE + 1 + (r & (S - 1))) * D, lane);
        norm_mod_store(vb, sb, p->norm2_g, mod + mb * 6144 + 3072, mod + mb * 6144 + 4096, hb + (size_t)(mb * H2_BSTRIDE + 1 + (rb & (S - 1))) * D, lane);
    }
    for (int z = gw; z < 254; z += NGW) {
        const int R = z == 0 ? 0 : (z <= 126 ? S + z : 32895 + (z - 127));
        const u32x4 zz = {0u, 0u, 0u, 0u};
        *(u32x4*)(hb + (size_t)R * D + 8 * lane) = zz; *(u32x4*)(hb + (size_t)R * D + 512 + 8 * lane) = zz;
    }
}

__device__ __forceinline__ void final_phase(PP p, int wv) {
    const int tid_ = tid_opaque(wv), lane = tid_ & 63, gw = blockIdx.x * 8 + (tid_ >> 6), NGW = gridDim.x * 8;
    const bf16_t* o1 = (const bf16_t*)(p->ws + WS_O1); const bf16_t* o2 = (const bf16_t*)(p->ws + WS_O2);
    for (int r = gw; r < NLAT; r += 2 * NGW) {
        const int rb = r + NGW;
        f32x4 va[4], vb[4]; u32x2 da[4], db[4], ea[4], eb[4];
        row_load(p->x + (size_t)r * D, lane, va); row_load(p->x + (size_t)rb * D, lane, vb);
#pragma unroll
        for (int j = 0; j < 4; ++j) {
            da[j] = *(const u32x2*)(o1 + (size_t)r * D + 4 * lane + 256 * j); db[j] = *(const u32x2*)(o1 + (size_t)rb * D + 4 * lane + 256 * j);
            ea[j] = *(const u32x2*)(o2 + (size_t)r * D + 4 * lane + 256 * j); eb[j] = *(const u32x2*)(o2 + (size_t)rb * D + 4 * lane + 256 * j);
        }
#pragma unroll
        for (int j = 0; j < 4; ++j) {
            va[j][0] += bflo(da[j].x) + bflo(ea[j].x); va[j][1] += bfhi(da[j].x) + bfhi(ea[j].x); va[j][2] += bflo(da[j].y) + bflo(ea[j].y); va[j][3] += bfhi(da[j].y) + bfhi(ea[j].y);
            vb[j][0] += bflo(db[j].x) + bflo(eb[j].x); vb[j][1] += bfhi(db[j].x) + bfhi(eb[j].x); vb[j][2] += bflo(db[j].y) + bflo(eb[j].y); vb[j][3] += bfhi(db[j].y) + bfhi(eb[j].y);
        }
        const float sa = row_rstd(va), sb = row_rstd(vb);
        float* rowa = p->out + (size_t)r * D; float* rowb = p->out + (size_t)rb * D;
#pragma unroll
        for (int j = 0; j < 4; ++j) { const f32x4 gg = *(const f32x4*)(p->final_g + 4 * lane + 256 * j); *(f32x4*)(rowa + 4 * lane + 256 * j) = va[j] * sa * gg; *(f32x4*)(rowb + 4 * lane + 256 * j) = vb[j] * sb * gg; }
    }
}

__global__ void __launch_bounds__(512, 2) fwd_megakernel(Params p_arg) {
    extern __shared__ __attribute__((aligned(16))) unsigned char shm[];
    cg::grid_group grid = cg::this_grid();
    LAS unsigned char* lds = (LAS unsigned char*)shm;
    pg8::StaticOrder so;
    const int wv = __builtin_amdgcn_readfirstlane((int)(threadIdx.x >> 6));
    volatile LAS unsigned* xst = (volatile LAS unsigned*)(lds + LDS_XB);
    if (tid_opaque(wv) == 0) { xst[0] = 0u; xst[1] = 0u; }
    __syncthreads();
    (void)xcd_barrier_post((unsigned*)(kparams()->ws + WS_BAR), xst, wv);
#define XBAR() do { XcdBarrier _b; _b.bar = (unsigned*)(kparams()->ws + WS_BAR); _b.x = xb_xcc_id(); _b.st = (volatile LAS unsigned*)(lds + LDS_XB); xcd_barrier(_b, wv); } while (0)
    if (kparams()->out == nullptr) grid.sync();

    phase0(kparams(), shm, wv);
    {
        constexpr int T_IN = (D / 64) * (DIN / 32), T_B = (D / 64) * (D / 32) + (D / 64) * (DUP / 32) + (DFF / 64) * (D / 32), T_LRU = 64;
        const int nfree = (int)gridDim.x > 192 ? (int)gridDim.x - 192 : 0;
        const int first = nfree ? 192 : 0, nblk = nfree ? nfree : (int)gridDim.x;
        if ((int)blockIdx.x >= first) {
            transpose_phase(kparams(), shm, wv, 0, T_IN, ((int)blockIdx.x - first) * 8, nblk * 8);
            transpose_phase(kparams(), shm, wv, T_IN + T_B, T_IN + T_B + T_LRU, ((int)blockIdx.x - first) * 8, nblk * 8);
        }
    }
    XBAR();
    phase1(kparams(), wv);
    XBAR();
    {
        PP p = kparams(); unsigned char* ws = p->ws;
        pg8::Gemm g{(const bf16_t*)(ws + WS_HB), (const bf16_t*)(ws + WS_WIN), MROWS / 256, DIN / 256, D, 256};
        so.init(g.nM, g.nN, gridDim.x, blockIdx.x);
        EpiProj e{(bf16_t*)(ws + WS_PROJ), (const float*)(ws + WS_ROPE), (const float*)(ws + WS_ROPE) + 4096};
        pg8::gemm_phase(lds, g, so, e, wv);
        {
            constexpr int T_IN = (D / 64) * (DIN / 32), T_B = (D / 64) * (D / 32) + (D / 64) * (DUP / 32) + (DFF / 64) * (D / 32);
            const int G = (int)gridDim.x, rem = (g.nM * g.nN) % G;
            const int first = rem ? rem : 0, nblk = G - first;
            if ((int)blockIdx.x >= first) transpose_phase(p, shm, wv, T_IN, T_IN + T_B, ((int)blockIdx.x - first) * 8, nblk * 8);
        }
    }
    XBAR();
    scan_mfma(kparams(), shm, wv);
    attn_mfma(kparams(), shm, wv);
    XBAR();
    carry_phase(kparams(), shm, wv);
    XBAR();
    mix_phase(kparams(), wv);
    XBAR();
    {
        PP p = kparams(); unsigned char* ws = p->ws; const float* mod = (const float*)(ws + WS_MOD);
        pg8::Gemm g{(const bf16_t*)(ws + WS_HB), (const bf16_t*)(ws + WS_WOUT), NLAT / 256, D / 256, D, 256};
        so.init(g.nM, g.nN, gridDim.x, blockIdx.x);
        EpiDelta e{(bf16_t*)(ws + WS_O1), mod + 2048, mod + 6144 + 2048};
        pg8::gemm_phase(lds, g, so, e, wv);
    }
    XBAR();
    phase7(kparams(), wv);
    XBAR();
    {
        PP p = kparams(); unsigned char* ws = p->ws;
        pg8::Gemm g{(const bf16_t*)(ws + WS_HB), (const bf16_t*)(ws + WS_WUP), 130, DUP / 256, D, 254};
        so.init(g.nM, g.nN, gridDim.x, blockIdx.x);
        EpiConvGate e{(bf16_t*)(ws + WS_ACT), p->ffn_conv_w, p->ffn_conv_b, lds + 131072};
        pg8::gemm_phase(lds, g, so, e, wv);
    }
    XBAR();
    {
        PP p = kparams(); unsigned char* ws = p->ws; const float* mod = (const float*)(ws + WS_MOD);
        pg8::Gemm g{(const bf16_t*)(ws + WS_ACT), (const bf16_t*)(ws + WS_WDN), NLAT / 256, D / 256, DFF, 256};
        so.init(g.nM, g.nN, gridDim.x, blockIdx.x);
        EpiDelta e{(bf16_t*)(ws + WS_O2), mod + 5120, mod + 6144 + 5120};
        pg8::gemm_phase(lds, g, so, e, wv);
    }
    XBAR();
    final_phase(kparams(), wv);
}

extern "C" void kernel_launch(void* const* d_in, const int* in_sizes, int n_in, void* d_out, int out_size, void* d_ws, size_t ws_size, hipStream_t stream) {
    static int grid_blocks = 0;
    if (!grid_blocks) {
        int dev = 0, cus = 0, per_cu = 0;
        hipGetDevice(&dev);
        hipDeviceGetAttribute(&cus, hipDeviceAttributeMultiprocessorCount, dev);
        hipFuncSetAttribute((const void*)fwd_megakernel, hipFuncAttributeMaxDynamicSharedMemorySize, LDS_BYTES);
        hipOccupancyMaxActiveBlocksPerMultiprocessor(&per_cu, (const void*)fwd_megakernel, 512, LDS_BYTES);
        if (per_cu < 1) per_cu = 1;
        grid_blocks = cus * per_cu;
        if (ws_size < WS_END) fprintf(stderr, "kernel_launch: workspace too small: %zu < %zu\n", ws_size, (size_t)WS_END);
    }
    Params p{};
    const float** pp = (const float**)&p;
    for (int i = 0; i < 25; ++i) pp[i] = (const float*)d_in[i];
    p.out = (float*)d_out; p.ws = (unsigned char*)d_ws;
    hipMemsetAsync((unsigned char*)d_ws + WS_BAR, 0, 16384, stream);
    void* args[] = {&p};
    hipError_t e = hipLaunchCooperativeKernel((const void*)fwd_megakernel, dim3(grid_blocks), dim3(512), args, LDS_BYTES, stream);
    if (e != hipSuccess) fprintf(stderr, "cooperative launch failed: %s (grid %d)\n", hipGetErrorString(e), grid_blocks);
}
```

```cpp
#include <hip/hip_runtime.h>
#include <hip/hip_cooperative_groups.h>
#include <cstdio>
namespace cg = cooperative_groups;

#define LAS __attribute__((address_space(3)))
typedef unsigned short bf16_t;
typedef short bf16x8 __attribute__((ext_vector_type(8)));
typedef float f32x4 __attribute__((ext_vector_type(4)));
typedef unsigned u32x4 __attribute__((ext_vector_type(4)));
typedef unsigned u32x2 __attribute__((ext_vector_type(2)));

constexpr int D = 1024, NB = 2, S = 16384, LC = 256;
constexpr int NLAT = NB * S;
constexpr int NCTX = NB * LC;
constexpr int MROWS = NLAT + NCTX;
constexpr int DIN = 1792, DFF = 2816, DUP = 5632, DRNN = 512;
constexpr int NCHUNK = MROWS / 64;
constexpr float EPS = 1e-6f;

constexpr size_t AL(size_t x) { return (x + 255) & ~(size_t)255; }
constexpr size_t WS_WIN  = 0;
constexpr size_t WS_WOUT = WS_WIN  + AL((size_t)DIN * D * 2);
constexpr size_t WS_WUP  = WS_WOUT + AL((size_t)D * D * 2);
constexpr size_t WS_WDN  = WS_WUP  + AL((size_t)DUP * D * 2);
constexpr size_t WS_LRU  = WS_WDN  + AL((size_t)D * DFF * 2);
constexpr size_t WS_MOD  = WS_LRU  + AL((size_t)4 * 8 * 64 * 64 * 2);
constexpr size_t WS_ROPE = WS_MOD  + AL((size_t)3 * 6144 * 4);
constexpr size_t WS_SUM  = WS_ROPE + AL((size_t)2 * 256 * 16 * 4);
constexpr size_t WS_CAR  = WS_SUM  + AL((size_t)2 * NCHUNK * 2 * 512 * 4);
constexpr size_t WS_SP8  = WS_CAR  + AL((size_t)2 * NCHUNK * 512 * 4);
constexpr size_t WS_BAR  = WS_SP8  + 4096;
constexpr size_t WS_HB   = WS_BAR  + 16384;
constexpr size_t WS_R1   = WS_HB   + AL((size_t)MROWS * D * 2);
constexpr size_t WS_PROJ = WS_R1;
constexpr size_t WS_ATT  = WS_PROJ + AL((size_t)MROWS * DIN * 2);
constexpr size_t WS_YL   = WS_ATT  + AL((size_t)NLAT * 512 * 2);
constexpr size_t WS_CAF  = WS_YL   + AL((size_t)NLAT * 512 * 2);
constexpr size_t WS_CAB  = WS_CAF  + AL((size_t)NLAT * 512 * 2);
constexpr size_t WS_R1END = WS_CAB + AL((size_t)NLAT * 512 * 2);
constexpr size_t WS_ACT  = WS_R1;
constexpr size_t WS_O1   = WS_ACT + AL((size_t)NLAT * DFF * 2);
constexpr size_t WS_O2   = WS_HB;
constexpr size_t WS_END  = WS_R1END;
static_assert(WS_O1 + (size_t)NLAT * D * 2 <= WS_R1END, "o1");
static_assert(WS_ACT + (size_t)NLAT * DFF * 2 <= WS_R1END, "act");
constexpr int H2_BSTRIDE = 65 * 254;
constexpr int H2_ROWS = 130 * 254 + 2;
static_assert((size_t)H2_ROWS * D * 2 <= (size_t)MROWS * D * 2, "h2");

constexpr int LDS_BYTES = 131072 + 8192 + 256;
constexpr int LDS_XB = 131072 + 8192;

struct Params {
    const float *x, *c, *ctx, *c_ctx, *w_mod, *b_mod, *norm1_g, *w_in, *rnn_conv_w, *rnn_conv_b, *lru_w_a, *lru_b_a,
        *lru_w_i, *lru_b_i, *lru_lam, *attn_sink, *gn_rnn, *gn_attn, *w_out, *norm2_g, *w_up, *ffn_conv_w, *ffn_conv_b,
        *w_down, *final_g;
    float* out;
    unsigned char* ws;
};

typedef const Params __attribute__((address_space(4)))* PP;
__device__ __forceinline__ PP kparams() { PP k = (PP)__builtin_amdgcn_kernarg_segment_ptr(); asm volatile("" : "+s"(k)); return k; }
__device__ __forceinline__ int lane_fresh() { unsigned m = ~0u; asm volatile("" : "+s"(m)); return (int)__builtin_amdgcn_mbcnt_hi(m, __builtin_amdgcn_mbcnt_lo(m, 0u)); }
__device__ __forceinline__ int tid_opaque(int wv) { return wv * 64 + lane_fresh(); }
__device__ __forceinline__ bf16_t f2bf(float f) { unsigned u = __float_as_uint(f); u += 0x7FFFu + ((u >> 16) & 1u); return (bf16_t)(u >> 16); }
__device__ __forceinline__ float bf2f(bf16_t b) { return __uint_as_float(((unsigned)b) << 16); }
__device__ __forceinline__ unsigned pk2(float lo, float hi) { unsigned r; asm("v_cvt_pk_bf16_f32 %0, %1, %2" : "=v"(r) : "v"(lo), "v"(hi)); return r; }
__device__ __forceinline__ float bflo(unsigned w) { return __uint_as_float(w << 16); }
__device__ __forceinline__ float bfhi(unsigned w) { return __uint_as_float(w & 0xFFFF0000u); }
__device__ __forceinline__ float wave_sum(float v) {
#pragma unroll
    for (int o = 32; o >= 1; o >>= 1) v += __shfl_xor(v, o);
    return v;
}
__device__ __forceinline__ float wave_max(float v) {
#pragma unroll
    for (int o = 32; o >= 1; o >>= 1) v = fmaxf(v, __shfl_xor(v, o));
    return v;
}
__device__ __forceinline__ float sigmoidf_(float x) { return 1.0f / (1.0f + __expf(-x)); }
__device__ __forceinline__ float fast_sigmoid(float x) { return __builtin_amdgcn_rcpf(1.0f + __builtin_amdgcn_exp2f(-1.4426950408889634f * x)); }
__device__ __forceinline__ float silu_(float x) { return x * fast_sigmoid(x); }
__device__ __forceinline__ float gelu_tanh_(float x) {
    const float u = 0.7978845608028654f * (x + 0.044715f * x * x * x);
    const float e = __expf(2.0f * u);
    const float th = 1.0f - 2.0f / (e + 1.0f);
    return 0.5f * x * (1.0f + th);
}


#define XB_TMO      128
#define XB_XCNT(j)  (256  + 64 * (j))
#define XB_XSUB(j)  (1280 + 64 * (j))
#define XB_XGEN(j)  (2304 + 64 * (j))
#define XB_TOP      3328
#define XB_TOPGEN   3392
#define XCD_BAR_WORDS 3456
#define XB_SPIN_CAP (1u << 20)
__device__ __forceinline__ unsigned xb_ld(unsigned* p)              { return __hip_atomic_load(p, __ATOMIC_RELAXED, __HIP_MEMORY_SCOPE_AGENT); }
__device__ __forceinline__ unsigned xb_add(unsigned* p, unsigned v) { return __hip_atomic_fetch_add(p, v, __ATOMIC_RELAXED, __HIP_MEMORY_SCOPE_AGENT); }
__device__ __forceinline__ unsigned xb_xcc_id() { return (unsigned)__builtin_amdgcn_s_getreg((3 << 11) | 20) & 0xFu; }
#define XB_SPIN(cond, bar) do { unsigned _sp = 0; while (cond) { __builtin_amdgcn_s_sleep(1); \
    if ((++_sp & 255u) == 0u) { if (xb_ld(&(bar)[XB_TMO])) break; if (_sp > XB_SPIN_CAP) { atomicAdd(&(bar)[XB_TMO], 1u); break; } } } } while (0)
struct XcdBarrier { unsigned* bar; unsigned x; volatile LAS unsigned* st; };
__device__ __forceinline__ XcdBarrier xcd_barrier_post(unsigned* bar, volatile LAS unsigned* st, int wv) {
    XcdBarrier b; b.bar = bar; b.x = xb_xcc_id(); b.st = st;
    if (tid_opaque(wv) == 0) (void)xb_add(&bar[XB_XCNT(b.x)], 1u);
    return b;
}
__device__ __forceinline__ void xcd_barrier_complete(unsigned* bar, unsigned x, unsigned& nloc, unsigned& nx) {
    const unsigned G = gridDim.x * gridDim.y * gridDim.z;
    unsigned sum, cnt, mine, sp = 0u;
    for (;;) {
        sum = 0u; cnt = 0u; mine = 0u;
#pragma unroll
        for (unsigned j = 0; j < 16; ++j) { const unsigned c = xb_ld(&bar[XB_XCNT(j)]); sum += c; cnt += (c > 0u) ? 1u : 0u; mine = (j == x) ? c : mine; }
        if (sum == G) break;
        __builtin_amdgcn_s_sleep(1);
        if ((++sp & 255u) == 0u) { if (xb_ld(&bar[XB_TMO])) break; if (sp > XB_SPIN_CAP) { atomicAdd(&bar[XB_TMO], 1u); break; } }
    }
    nloc = mine > 0u ? mine : 1u; nx = cnt > 0u ? cnt : 1u;
}
__device__ __forceinline__ void xcd_barrier(const XcdBarrier& b, int wv) {
    asm volatile("s_waitcnt vmcnt(0)" ::: "memory");
    __syncthreads();
    if (tid_opaque(wv) == 0) {
        unsigned* bar = b.bar;
        __builtin_amdgcn_s_waitcnt(0);
        unsigned nloc = b.st[0], nx = b.st[1];
        if (nloc == 0u) { xcd_barrier_complete(bar, b.x, nloc, nx); b.st[0] = nloc; b.st[1] = nx; }
        const unsigned old = xb_add(&bar[XB_XSUB(b.x)], 1u);
        const unsigned gen = old / nloc;
        if (old + 1u == (gen + 1u) * nloc) {
            __builtin_amdgcn_fence(__ATOMIC_RELEASE, "agent");
            asm volatile("s_waitcnt vmcnt(0)" ::: "memory");
            const unsigned og = xb_add(&bar[XB_TOP], 1u);
            const unsigned tg = og / nx;
            if (og + 1u == (tg + 1u) * nx) xb_add(&bar[XB_TOPGEN], 1u);
            else XB_SPIN(xb_ld(&bar[XB_TOPGEN]) == tg, bar);
            __builtin_amdgcn_fence(__ATOMIC_ACQUIRE, "agent");
            xb_add(&bar[XB_XGEN(b.x)], 1u);
            asm volatile("s_waitcnt vmcnt(0)" ::: "memory");
        } else {
            XB_SPIN(xb_ld(&bar[XB_XGEN(b.x)]) == gen, bar);
            __builtin_amdgcn_fence(__ATOMIC_ACQUIRE, "agent");
            asm volatile("s_waitcnt vmcnt(0)" ::: "memory");
        }
    }
    __syncthreads();
}

namespace pg8 {
constexpr int BM = 256, BK = 64, HALF = 128, HTB = HALF * BK * 2, NXCD = 8, WGM = 8;
__host__ __device__ __forceinline__ int lds_byte(int r, int c) { const int st = (r >> 4) * 2 + (c >> 5), rr = r & 15, cc = c & 31, ob = rr * 64 + cc * 2; return st * 1024 + (ob ^ (((ob >> 9) & 1) << 5)); }
__host__ __device__ __forceinline__ void stage_rc(int b, int& R, int& C) { const int st = b / 1024, sb = b % 1024, swz = sb ^ (((sb >> 9) & 1) << 5); R = (st >> 1) * 16 + swz / 64; C = (st & 1) * 32 + (swz % 64) / 2; }
struct Unit { int pm, pn; };
struct Gemm { const bf16_t* A; const bf16_t* Bt; int nM, nN, K, a_tile_rows; };
struct StaticOrder {
    int nM, nN, nwg, G, c;
    __device__ void init(int nM_, int nN_, int G_, int c_) { nM = nM_; nN = nN_; nwg = nM * nN; G = G_; c = c_; }
    __device__ bool next(int i, Unit& u) const {
        const long L = (long)i * G + c; if (L >= nwg) return false;
        int wgid = (int)L; { const int q = nwg / NXCD, r = nwg % NXCD, xcd = wgid % NXCD, off = wgid / NXCD; wgid = (xcd < r ? xcd * (q + 1) : r * (q + 1) + (xcd - r) * q) + off; }
        const int nig = WGM * nN, gid = wgid / nig, fm = gid * WGM, gsz = (nM - fm) < WGM ? (nM - fm) : WGM;
        u.pm = fm + ((wgid % nig) % gsz); u.pn = (wgid % nig) / gsz; return true;
    }
};
template <class Epi>
__device__ __forceinline__ void gemm_phase(LAS unsigned char* lds, const Gemm g, const StaticOrder& S, const Epi& E, int wv) {
    const int tid = tid_opaque(wv);
    const int wid = __builtin_amdgcn_readfirstlane(tid >> 6), lane = tid & 63, wr = wid >> 2, wc = wid & 3, fr = lane & 15, fq = lane >> 4;
    const int K = g.K, nt = K / BK;
    unsigned voffA[2], voffB[2];
#pragma unroll
    for (int i = 0; i < 2; ++i) { int R, C; stage_rc(tid * 16 + i * 8192, R, C);
        const int Ra = (R & ~63) + 4 * (R & 15) + ((R >> 4) & 3);
        voffA[i] = (unsigned)(Ra * K + C) * 2u; voffB[i] = (unsigned)(R * K + C) * 2u; }
    const size_t kstep = (size_t)(BK * 2);
    const size_t hstep = (size_t)HALF * K * 2;
    const size_t tstepA = (size_t)g.a_tile_rows * K * 2;
    const size_t tstepB = 2 * hstep;
    const unsigned ldsw = (unsigned)wid * 1024u;
    const int aoff = lds_byte(wr * 64 + fr, fq * 8), boff = lds_byte(wc * 32 + fr, fq * 8);
#define PG8_SA(b, h) (((b) * 2 + (h)) * HTB)
#define PG8_SB(b, h) ((4 + (b) * 2 + (h)) * HTB)
#define PG8_STAGE(bufoff, gbase, voff) do { _Pragma("unroll") for (int _i = 0; _i < 2; ++_i) \
        __builtin_amdgcn_global_load_lds((const unsigned*)((const char*)(gbase) + (voff)[_i]), (LAS unsigned*)(lds + (bufoff) + ldsw + _i * 8192), 16, 0, 0); } while (0)
#define PG8_LDA(dst, b, h) do { _Pragma("unroll") for (int m = 0; m < 4; ++m) _Pragma("unroll") for (int k = 0; k < 2; ++k) dst[m][k] = *(const LAS bf16x8*)(lds + PG8_SA(b, h) + aoff + m * 2048 + k * 1024); } while (0)
#define PG8_LDB(dst, b, h) do { _Pragma("unroll") for (int n = 0; n < 2; ++n) _Pragma("unroll") for (int k = 0; k < 2; ++k) dst[n][k] = *(const LAS bf16x8*)(lds + PG8_SB(b, h) + boff + n * 2048 + k * 1024); } while (0)
#define PG8_MMA(ai, bj, At, Bt) do { __builtin_amdgcn_s_setprio(1); _Pragma("unroll") for (int m = 0; m < 4; ++m) _Pragma("unroll") for (int n = 0; n < 2; ++n) _Pragma("unroll") for (int k = 0; k < 2; ++k) \
        acc[ai][bj][m][n] = __builtin_amdgcn_mfma_f32_16x16x32_bf16(Bt[n][k], At[m][k], acc[ai][bj][m][n], 0, 0, 0); __builtin_amdgcn_s_setprio(0); } while (0)
#define PG8_WAIT_V(n) asm volatile("s_waitcnt vmcnt(" #n ")" ::: "memory")
#define PG8_WAIT_L(n) asm volatile("s_waitcnt lgkmcnt(" #n ")" ::: "memory")
#define PG8_BAR __builtin_amdgcn_s_barrier()
#define PG8_SCHED __builtin_amdgcn_sched_barrier(0)
    Unit cur, nxt; int ui = 0;
    if (!S.next(0, cur)) return;
    f32x4 acc[2][2][4][2];
#pragma unroll
    for (int a = 0; a < 2; ++a)
#pragma unroll
        for (int b = 0; b < 2; ++b)
#pragma unroll
            for (int m = 0; m < 4; ++m)
#pragma unroll
                for (int n = 0; n < 2; ++n) acc[a][b][m][n] = (f32x4){0.f, 0.f, 0.f, 0.f};
    bf16x8 At[4][2], B0[2][2], B1[2][2];
    const char* cA = (const char*)g.A + (size_t)cur.pm * tstepA; const char* cB = (const char*)g.Bt + (size_t)cur.pn * tstepB;
    PG8_STAGE(PG8_SB(0, 0), cB, voffB); PG8_STAGE(PG8_SA(0, 0), cA, voffA); PG8_STAGE(PG8_SB(0, 1), cB + hstep, voffB); PG8_STAGE(PG8_SA(0, 1), cA + hstep, voffA);
    if (wr == 1) PG8_BAR;
    PG8_WAIT_V(4); PG8_BAR;
    PG8_STAGE(PG8_SB(1, 0), cB + kstep, voffB); PG8_STAGE(PG8_SA(1, 0), cA + kstep, voffA); PG8_STAGE(PG8_SB(1, 1), cB + hstep + kstep, voffB);
    PG8_WAIT_V(6); PG8_BAR;
    for (;;) {
        const bool has_next = S.next(ui + 1, nxt);
        const char* nA = has_next ? (const char*)g.A + (size_t)nxt.pm * tstepA : cA; const char* nB = has_next ? (const char*)g.Bt + (size_t)nxt.pn * tstepB : cB;
        for (int t = 0; t < nt; t += 2) {
            const bool last = (t == nt - 2);
            const char* a1 = cA + (size_t)(t + 1) * kstep;
            const char* a2 = last ? nA : cA + (size_t)(t + 2) * kstep; const char* b2 = last ? nB : cB + (size_t)(t + 2) * kstep;
            const char* a3 = a2 + kstep; const char* b3 = b2 + kstep;
            PG8_LDB(B0, 0, 0); PG8_SCHED; PG8_LDA(At, 0, 0); PG8_STAGE(PG8_SA(1, 1), a1 + hstep, voffA);
            PG8_WAIT_L(8); PG8_BAR; PG8_WAIT_L(0); PG8_MMA(0, 0, At, B0); PG8_BAR; PG8_SCHED;
            PG8_LDB(B1, 0, 1); PG8_STAGE(PG8_SB(0, 0), b2, voffB);
            PG8_BAR; PG8_WAIT_L(0); PG8_MMA(0, 1, At, B1); PG8_BAR;
            PG8_LDA(At, 0, 1); PG8_STAGE(PG8_SA(0, 0), a2, voffA);
            PG8_BAR; PG8_WAIT_L(0); PG8_MMA(1, 0, At, B0); PG8_BAR; PG8_SCHED;
            PG8_STAGE(PG8_SB(0, 1), b2 + hstep, voffB);
            PG8_WAIT_V(6); PG8_BAR; PG8_MMA(1, 1, At, B1); PG8_BAR;
            PG8_LDB(B0, 1, 0); PG8_SCHED; PG8_LDA(At, 1, 0); PG8_STAGE(PG8_SA(0, 1), a2 + hstep, voffA);
            PG8_WAIT_L(8); PG8_BAR; PG8_WAIT_L(0); PG8_MMA(0, 0, At, B0); PG8_BAR; PG8_SCHED;
            PG8_LDB(B1, 1, 1); PG8_STAGE(PG8_SB(1, 0), b3, voffB);
            PG8_BAR; PG8_WAIT_L(0); PG8_MMA(0, 1, At, B1); PG8_BAR;
            PG8_LDA(At, 1, 1); PG8_STAGE(PG8_SA(1, 0), a3, voffA);
            PG8_BAR; PG8_WAIT_L(0); PG8_MMA(1, 0, At, B0); PG8_BAR; PG8_SCHED;
            PG8_STAGE(PG8_SB(1, 1), b3 + hstep, voffB);
            PG8_WAIT_V(6); PG8_BAR; PG8_MMA(1, 1, At, B1); PG8_BAR;
        }
        { const int ln2 = lane_fresh();
          E(acc, cur, wr, wc, ln2 & 15, ln2 >> 4); }
        if (!has_next) break;
#pragma unroll
        for (int a = 0; a < 2; ++a)
#pragma unroll
            for (int b = 0; b < 2; ++b)
#pragma unroll
                for (int m = 0; m < 4; ++m)
#pragma unroll
                    for (int n = 0; n < 2; ++n) acc[a][b][m][n] = (f32x4){0.f, 0.f, 0.f, 0.f};
        cur = nxt; cA = nA; cB = nB; ++ui;
    }
    PG8_WAIT_V(0);
    if (wr == 0) PG8_BAR;
    PG8_BAR;
#undef PG8_SA
#undef PG8_SB
#undef PG8_STAGE
#undef PG8_LDA
#undef PG8_LDB
#undef PG8_MMA
#undef PG8_WAIT_V
#undef PG8_WAIT_L
#undef PG8_BAR
#undef PG8_SCHED
}
}
using pg8::Unit;

struct EpiProj {
    bf16_t* O; const float* cosT; const float* sinT;
    __device__ __forceinline__ void operator()(const f32x4 (&acc)[2][2][4][2], const Unit& u, int wr, int wc, int fr, int fq) const {
        const bool latent = u.pm < 128;
#pragma unroll
        for (int ai = 0; ai < 2; ++ai)
#pragma unroll
            for (int m = 0; m < 4; ++m) {
                const int row = u.pm * 256 + ai * 128 + wr * 64 + 4 * fr + m;
                const int t = row & (S - 1);
                const int pos = (wc & 1) ? (t & 63) : (t >> 6);
#pragma unroll
                for (int bj = 0; bj < 2; ++bj) {
                    const int col = u.pn * 256 + bj * 128 + wc * 32 + 4 * fq;
                    f32x4 v0 = acc[ai][bj][m][0], v1 = acc[ai][bj][m][1];
                    const bool rope = latent && (u.pn == 4 || u.pn == 5 || (u.pn == 6 && bj == 0));
                    if (rope) {
                        const f32x4 cs = *(const f32x4*)(cosT + pos * 16 + 4 * fq), sn = *(const f32x4*)(sinT + pos * 16 + 4 * fq);
                        const f32x4 n0 = v0 * cs - v1 * sn, n1 = v1 * cs + v0 * sn; v0 = n0; v1 = n1;
                    }
                    bf16_t* p = O + (size_t)row * DIN + col;
                    u32x2 w0, w1; w0.x = pk2(v0[0], v0[1]); w0.y = pk2(v0[2], v0[3]); w1.x = pk2(v1[0], v1[1]); w1.y = pk2(v1[2], v1[3]);
                    *(u32x2*)p = w0; *(u32x2*)(p + 16) = w1;
                }
            }
    }
};
struct EpiDelta {
    bf16_t* O; const float* gate0; const float* gate1;
    __device__ __forceinline__ void operator()(const f32x4 (&acc)[2][2][4][2], const Unit& u, int wr, int wc, int fr, int fq) const {
        const float* gate = (u.pm >= 64) ? gate1 : gate0;
        f32x4 gv[2][2];
#pragma unroll
        for (int bj = 0; bj < 2; ++bj)
#pragma unroll
            for (int n = 0; n < 2; ++n) gv[bj][n] = *(const f32x4*)(gate + u.pn * 256 + bj * 128 + wc * 32 + n * 16 + 4 * fq);
#pragma unroll
        for (int ai = 0; ai < 2; ++ai)
#pragma unroll
            for (int m = 0; m < 4; ++m) {
                const size_t row = (size_t)u.pm * 256 + ai * 128 + wr * 64 + 4 * fr + m;
#pragma unroll
                for (int bj = 0; bj < 2; ++bj)
#pragma unroll
                    for (int n = 0; n < 2; ++n) {
                        const f32x4 v = gv[bj][n] * acc[ai][bj][m][n];
                        u32x2 w; w.x = pk2(v[0], v[1]); w.y = pk2(v[2], v[3]);
                        *(u32x2*)(O + row * D + u.pn * 256 + bj * 128 + wc * 32 + n * 16 + 4 * fq) = w;
                    }
            }
    }
};

__device__ __forceinline__ float dpp_ror1(float v)  { return __int_as_float(__builtin_amdgcn_update_dpp(0, __float_as_int(v), 0x121, 0xF, 0xF, true)); }
__device__ __forceinline__ float dpp_ror15(float v) { return __int_as_float(__builtin_amdgcn_update_dpp(0, __float_as_int(v), 0x12F, 0xF, 0xF, true)); }
__device__ __forceinline__ float dpp_shr1(float v)  { return __int_as_float(__builtin_amdgcn_update_dpp(0, __float_as_int(v), 0x111, 0xF, 0xF, true)); }
__device__ __forceinline__ float dpp_shl1(float v)  { return __int_as_float(__builtin_amdgcn_update_dpp(0, __float_as_int(v), 0x101, 0xF, 0xF, true)); }

#define DPP_FMAC4X2(C, SA, WA, CTRLA, SB, WB, CTRLB) do { float _c0 = (C)[0], _c1 = (C)[1], _c2 = (C)[2], _c3 = (C)[3]; \
    asm("s_nop 1\n\t" \
        "v_fmac_f32_dpp %0, %4, %8 " CTRLA " row_mask:0xf bank_mask:0xf bound_ctrl:1\n\t" \
        "v_fmac_f32_dpp %1, %5, %9 " CTRLA " row_mask:0xf bank_mask:0xf bound_ctrl:1\n\t" \
        "v_fmac_f32_dpp %2, %6, %10 " CTRLA " row_mask:0xf bank_mask:0xf bound_ctrl:1\n\t" \
        "v_fmac_f32_dpp %3, %7, %11 " CTRLA " row_mask:0xf bank_mask:0xf bound_ctrl:1\n\t" \
        "v_fmac_f32_dpp %0, %12, %16 " CTRLB " row_mask:0xf bank_mask:0xf bound_ctrl:1\n\t" \
        "v_fmac_f32_dpp %1, %13, %17 " CTRLB " row_mask:0xf bank_mask:0xf bound_ctrl:1\n\t" \
        "v_fmac_f32_dpp %2, %14, %18 " CTRLB " row_mask:0xf bank_mask:0xf bound_ctrl:1\n\t" \
        "v_fmac_f32_dpp %3, %15, %19 " CTRLB " row_mask:0xf bank_mask:0xf bound_ctrl:1" \
        : "+v"(_c0), "+v"(_c1), "+v"(_c2), "+v"(_c3) \
        : "v"((SA)[0]), "v"((SA)[1]), "v"((SA)[2]), "v"((SA)[3]), "v"((WA)[0]), "v"((WA)[1]), "v"((WA)[2]), "v"((WA)[3]), \
          "v"((SB)[0]), "v"((SB)[1]), "v"((SB)[2]), "v"((SB)[3]), "v"((WB)[0]), "v"((WB)[1]), "v"((WB)[2]), "v"((WB)[3])); \
    (C)[0] = _c0; (C)[1] = _c1; (C)[2] = _c2; (C)[3] = _c3; } while (0)
#define DPP_FMAC4(C, SA, WA, CTRLA) do { float _c0 = (C)[0], _c1 = (C)[1], _c2 = (C)[2], _c3 = (C)[3]; \
    asm("s_nop 1\n\t" \
        "v_fmac_f32_dpp %0, %4, %8 " CTRLA " row_mask:0xf bank_mask:0xf bound_ctrl:1\n\t" \
        "v_fmac_f32_dpp %1, %5, %9 " CTRLA " row_mask:0xf bank_mask:0xf bound_ctrl:1\n\t" \
        "v_fmac_f32_dpp %2, %6, %10 " CTRLA " row_mask:0xf bank_mask:0xf bound_ctrl:1\n\t" \
        "v_fmac_f32_dpp %3, %7, %11 " CTRLA " row_mask:0xf bank_mask:0xf bound_ctrl:1" \
        : "+v"(_c0), "+v"(_c1), "+v"(_c2), "+v"(_c3) \
        : "v"((SA)[0]), "v"((SA)[1]), "v"((SA)[2]), "v"((SA)[3]), "v"((WA)[0]), "v"((WA)[1]), "v"((WA)[2]), "v"((WA)[3])); \
    (C)[0] = _c0; (C)[1] = _c1; (C)[2] = _c2; (C)[3] = _c3; } while (0)
struct EpiConvGate {
    bf16_t* act; const float* cw; const float* cbias; LAS unsigned char* xl;
    __device__ __forceinline__ void operator()(const f32x4 (&acc)[2][2][4][2], const Unit& u, int wr, int wc, int fr, int fq) const {
        if (wr == 0) { __builtin_amdgcn_s_barrier(); } asm volatile("" ::: "memory");
        LAS float* X = (LAS float*)xl;
        f32x4 wq[2][2][4];
#define CG_LOADW(N) do { _Pragma("unroll") for (int bj = 0; bj < 2; ++bj) { const int ch = 128 * u.pn + 32 * wc + 16 * (N) + 4 * fq + bj * DFF; \
            wq[N][bj][0] = *(const f32x4*)(cw + ch); wq[N][bj][1] = *(const f32x4*)(cw + DUP + ch); wq[N][bj][2] = *(const f32x4*)(cw + 2 * DUP + ch); wq[N][bj][3] = *(const f32x4*)(cbias + ch); } } while (0)
        CG_LOADW(0);
#pragma unroll
        for (int ai = 0; ai < 2; ++ai) {
            const int s = 2 * ai + wr;
            if (fr == 0) {
#pragma unroll
                for (int bj = 0; bj < 2; ++bj)
#pragma unroll
                    for (int n = 0; n < 2; ++n) *(LAS f32x4*)(X + ((s * 2 + 0) * 2 + bj) * 128 + 32 * wc + 16 * n + 4 * fq) = acc[ai][bj][0][n];
            }
            if (fr == 15) {
#pragma unroll
                for (int bj = 0; bj < 2; ++bj)
#pragma unroll
                    for (int n = 0; n < 2; ++n) *(LAS f32x4*)(X + ((s * 2 + 1) * 2 + bj) * 128 + 32 * wc + 16 * n + 4 * fq) = acc[ai][bj][3][n];
            }
        }
        asm volatile("s_waitcnt lgkmcnt(0)" ::: "memory");
        __builtin_amdgcn_s_barrier(); asm volatile("" ::: "memory");
#pragma unroll
        for (int n = 0; n < 2; ++n) {
            const int chg = 128 * u.pn + 32 * wc + 16 * n + 4 * fq;
            if (n == 1) CG_LOADW(1);
            f32x4 w0[2], w1[2], w2[2], bb[2], w0m[2], w2m[2];
#pragma unroll
            for (int bj = 0; bj < 2; ++bj) {
                w0[bj] = wq[n][bj][0]; w1[bj] = wq[n][bj][1]; w2[bj] = wq[n][bj][2]; bb[bj] = wq[n][bj][3];
                w0m[bj] = (fr == 0) ? w0[bj] : (f32x4){0.f, 0.f, 0.f, 0.f}; w2m[bj] = (fr == 15) ? w2[bj] : (f32x4){0.f, 0.f, 0.f, 0.f};
            }
#pragma unroll
            for (int ai = 0; ai < 2; ++ai) {
                const int s = 2 * ai + wr;
                f32x4 xp[2], xn[2];
#pragma unroll
                for (int bj = 0; bj < 2; ++bj) {
                    xp[bj] = *(const LAS f32x4*)(X + ((((s + 3) & 3) * 2 + 1) * 2 + bj) * 128 + 32 * wc + 16 * n + 4 * fq);
                    xn[bj] = *(const LAS f32x4*)(X + ((((s + 1) & 3) * 2 + 0) * 2 + bj) * 128 + 32 * wc + 16 * n + 4 * fq);
                }
                f32x4 cvv[4][2];
#pragma unroll
                for (int bj = 0; bj < 2; ++bj) {
                    const f32x4 a0 = acc[ai][bj][0][n], a1 = acc[ai][bj][1][n], a2 = acc[ai][bj][2][n], a3 = acc[ai][bj][3][n];
                    f32x4 c0 = bb[bj] + w1[bj] * a0 + w2[bj] * a1 + w0m[bj] * xp[bj];
                    f32x4 c1 = bb[bj] + w1[bj] * a1 + w0[bj] * a0 + w2[bj] * a2;
                    f32x4 c2 = bb[bj] + w1[bj] * a2 + w0[bj] * a1 + w2[bj] * a3;
                    f32x4 c3 = bb[bj] + w1[bj] * a3 + w0[bj] * a2 + w2m[bj] * xn[bj];
                    DPP_FMAC4(c0, a3, w0[bj], "row_shr:1");
                    DPP_FMAC4(c3, a0, w2[bj], "row_shl:1");
                    cvv[0][bj] = c0; cvv[1][bj] = c1; cvv[2][bj] = c2; cvv[3][bj] = c3;
                }
#pragma unroll
                for (int m = 0; m < 4; ++m) {
                    const int lr = 128 * ai + 64 * wr + 4 * fr + m;
                    const int R = 254 * u.pm + lr;
                    const int b = R >= (H2_BSTRIDE + 1) ? 1 : 0;
                    const int t = R - 1 - H2_BSTRIDE * b;
                    const bool valid = lr >= 1 && lr <= 254 && t >= 0 && t < S;
                    if (valid) {
                        u32x2 w;
                        w.x = pk2(silu_(cvv[m][0][0]) * cvv[m][1][0], silu_(cvv[m][0][1]) * cvv[m][1][1]);
                        w.y = pk2(silu_(cvv[m][0][2]) * cvv[m][1][2], silu_(cvv[m][0][3]) * cvv[m][1][3]);
                        *(u32x2*)(act + (size_t)(b * S + t) * DFF + chg) = w;
                    }
                }
            }
        }
        asm volatile("" ::: "memory"); if (wr == 1) { __builtin_amdgcn_s_barrier(); }
    }
};

#undef CG_LOADW
__device__ __forceinline__ void transpose_item(const float* W, int N, int k0, int n0, bf16_t* dst, int Kd, float* scr, int lane) {
#pragma unroll 16
    for (int i = 0; i < 32; ++i) { const int kk = 2 * i + (lane >> 5); scr[kk * 33 + (lane & 31)] = W[(size_t)(k0 + kk) * N + n0 + (lane & 31)]; }
    __builtin_amdgcn_wave_barrier();
    const int c = lane & 7;
#pragma unroll
    for (int j = 0; j < 4; ++j) {
        const int n = (lane >> 3) + 8 * j; const float* s = scr + (8 * c) * 33 + n;
        u32x4 o; o.x = pk2(s[0], s[33]); o.y = pk2(s[2 * 33], s[3 * 33]); o.z = pk2(s[4 * 33], s[5 * 33]); o.w = pk2(s[6 * 33], s[7 * 33]);
        *(u32x4*)(dst + (size_t)n * Kd + k0 + 8 * c) = o;
    }
    __builtin_amdgcn_wave_barrier();
}

__device__ __forceinline__ void phase0(PP p, unsigned char* shm, int wv) {
    const int tid = tid_opaque(wv), lane = tid & 63, wave = tid >> 6;
    unsigned char* ws = p->ws;
    if (blockIdx.x < 192) {
        float* sv = (float*)shm;
        float* red = sv + 3 * 1024;
        for (int i = tid; i < 3 * 1024; i += 512) {
            const int j = i >> 10, k = i & 1023;
            const float v = (j < 2) ? p->c[j * 1024 + k] : p->c_ctx[k];
            sv[i] = silu_(v);
        }
        __syncthreads();
        const int n0 = blockIdx.x * 32, col = tid & 31, ks = tid >> 5;
        float a0 = 0.f, a1 = 0.f, a2 = 0.f;
        const float* wp = p->w_mod + (size_t)(ks * 64) * 6144 + n0 + col;
#pragma unroll
        for (int k = 0; k < 64; ++k) {
            const float w = wp[(size_t)k * 6144];
            a0 += sv[ks * 64 + k] * w; a1 += sv[1024 + ks * 64 + k] * w; a2 += sv[2048 + ks * 64 + k] * w;
        }
        red[(ks * 3 + 0) * 32 + col] = a0; red[(ks * 3 + 1) * 32 + col] = a1; red[(ks * 3 + 2) * 32 + col] = a2;
        __syncthreads();
        if (tid < 96) {
            const int j = tid >> 5, cc = tid & 31; float s = p->b_mod[n0 + cc];
            for (int k = 0; k < 16; ++k) s += red[(k * 3 + j) * 32 + cc];
            ((float*)(ws + WS_MOD))[j * 6144 + n0 + cc] = s;
        }
        __syncthreads();
    }
    if (blockIdx.x == 200) { for (int i = tid; i < 1024; i += 512) ((float*)(ws + WS_SP8))[i] = -8.0f * log1pf(expf(-p->lru_lam[i])); }
    if (blockIdx.x >= 192 && blockIdx.x < 200) {
        const int idx = (blockIdx.x - 192) * 512 + tid;
        const int pos = idx >> 4, i = idx & 15;
        const float inv = powf(10000.0f, -(float)i / 16.0f);
        const float ang = (float)pos * inv;
        ((float*)(ws + WS_ROPE))[idx] = cosf(ang);
        ((float*)(ws + WS_ROPE))[4096 + idx] = sinf(ang);
    }
}
__device__ __forceinline__ void transpose_phase(PP p, unsigned char* shm, int wv, int it_lo, int it_hi, int gw0, int NGW) {
    const int tid = tid_opaque(wv), lane = tid & 63, wave = wv;
    unsigned char* ws = p->ws;
    float* scr = (float*)(shm + 32768) + wave * (64 * 33);
    const int gw = gw0 + wave;
    constexpr int I_IN = (D / 64) * (DIN / 32), I_OUT = (D / 64) * (D / 32), I_UP = (D / 64) * (DUP / 32), I_DN = (DFF / 64) * (D / 32), I_LRU = 2 * 2 * 8 * 2;
    constexpr int NIT = I_IN + I_OUT + I_UP + I_DN + I_LRU;
    (void)NIT;
    for (int it = it_lo + gw; it < it_hi; it += NGW) {
        int r = it;
        if (r >= I_IN + I_OUT + I_UP + I_DN + I_LRU) continue;
        if (r < I_IN) { const int nb = DIN / 32, kb = r / nb, n0 = (r % nb) * 32; transpose_item(p->w_in, DIN, kb * 64, n0, (bf16_t*)(ws + WS_WIN) + (size_t)n0 * D, D, scr, lane); continue; } r -= I_IN;
        if (r < I_OUT) { const int nb = D / 32, kb = r / nb, n0 = (r % nb) * 32; transpose_item(p->w_out, D, kb * 64, n0, (bf16_t*)(ws + WS_WOUT) + (size_t)n0 * D, D, scr, lane); continue; } r -= I_OUT;
        if (r < I_UP) { const int nb = DUP / 32, kb = r / nb, n0 = (r % nb) * 32;
            const int isv = n0 >= DFF, nn = isv ? n0 - DFF : n0, drow = (nn / 128) * 256 + isv * 128 + (nn % 128);
            transpose_item(p->w_up, DUP, kb * 64, n0, (bf16_t*)(ws + WS_WUP) + (size_t)drow * D, D, scr, lane); continue; } r -= I_UP;
        if (r < I_DN) { const int nb = D / 32, kb = r / nb, n0 = (r % nb) * 32; transpose_item(p->w_down, D, kb * 64, n0, (bf16_t*)(ws + WS_WDN) + (size_t)n0 * DFF, DFF, scr, lane); continue; } r -= I_DN;
        {
            const int nh = r & 1, blk = (r >> 1) & 7, type = (r >> 4) & 1, dir = r >> 5;
            const float* src = (type ? p->lru_w_i : p->lru_w_a) + (size_t)(dir * 8 + blk) * 4096;
            bf16_t* dst = (bf16_t*)(ws + WS_LRU) + (size_t)((dir * 2 + type) * 8 + blk) * 4096 + (size_t)(nh * 32) * 64;
            transpose_item(src, 64, 0, nh * 32, dst, 64, scr, lane);
        }
    }
}

__device__ __forceinline__ void row_load(const float* src, int lane, f32x4 (&v)[4]) {
#pragma unroll
    for (int j = 0; j < 4; ++j) v[j] = *(const f32x4*)(src + 4 * lane + 256 * j);
}
__device__ __forceinline__ float row_rstd(const f32x4 (&v)[4]) {
    float ss = 0.f;
#pragma unroll
    for (int j = 0; j < 4; ++j) ss += v[j][0] * v[j][0] + v[j][1] * v[j][1] + v[j][2] * v[j][2] + v[j][3] * v[j][3];
    return rsqrtf(wave_sum(ss) * (1.0f / D) + EPS);
}
__device__ __forceinline__ void norm_mod_store(const f32x4 (&v)[4], float rstd, const float* g, const float* sh, const float* sc, bf16_t* dst, int lane) {
#pragma unroll
    for (int j = 0; j < 4; ++j) {
        const int c = 4 * lane + 256 * j;
        const f32x4 gg = *(const f32x4*)(g + c), s1 = *(const f32x4*)(sc + c), s0 = *(const f32x4*)(sh + c);
        const f32x4 o = (v[j] * rstd * gg) * (s1 + 1.0f) + s0;
        u32x2 w; w.x = pk2(o[0], o[1]); w.y = pk2(o[2], o[3]);
        *(u32x2*)(dst + c) = w;
    }
}
__device__ __forceinline__ void phase1(PP p, int wv) {
    const int tid_ = tid_opaque(wv), lane = tid_ & 63, gw = blockIdx.x * 8 + (tid_ >> 6), NGW = gridDim.x * 8;
    const float* mod = (const float*)(p->ws + WS_MOD);
    bf16_t* hb = (bf16_t*)(p->ws + WS_HB);
    int cur = -1; f32x4 gsc[4], gsh[4];
    for (int r0 = gw; r0 < MROWS; r0 += 4 * NGW) {
        f32x4 v[4][4];
#pragma unroll
        for (int q = 0; q < 4; ++q) {
            const int r = (r0 + q * NGW < MROWS) ? r0 + q * NGW : r0;
            row_load(r < NLAT ? p->x + (size_t)r * D : p->ctx + (size_t)(r - NLAT) * D, lane, v[q]);
        }
#pragma unroll
        for (int q = 0; q < 4; ++q) {
            const int r = r0 + q * NGW;
            if (r < MROWS) {
                const int mi = r < NLAT ? (r >> 14) : 2;
                if (mi != cur) {
                    cur = mi;
#pragma unroll
                    for (int j = 0; j < 4; ++j) {
                        const int c = 4 * lane + 256 * j;
                        gsc[j] = *(const f32x4*)(p->norm1_g + c) * (*(const f32x4*)(mod + mi * 6144 + 1024 + c) + 1.0f);
                        gsh[j] = *(const f32x4*)(mod + mi * 6144 + c);
                    }
                }
                const float rstd = row_rstd(v[q]);
#pragma unroll
                for (int j = 0; j < 4; ++j) {
                    const f32x4 o = v[q][j] * rstd * gsc[j] + gsh[j];
                    u32x2 w; w.x = pk2(o[0], o[1]); w.y = pk2(o[2], o[3]);
                    *(u32x2*)(hb + (size_t)r * D + 4 * lane + 256 * j) = w;
                }
            }
        }
    }
}

typedef float f32x16 __attribute__((ext_vector_type(16)));
__device__ __forceinline__ unsigned cvt_pk_bf16(float lo, float hi) { unsigned r; asm("v_cvt_pk_bf16_f32 %0, %1, %2" : "=v"(r) : "v"(lo), "v"(hi)); return r; }
__device__ __forceinline__ void attn_mfma(PP p, unsigned char* shm, int wv) {
    const int tid = tid_opaque(wv);
    const int lane = tid & 63, wave = wv, l31 = lane & 31, hl = lane >> 5;
    const bf16_t* proj = (const bf16_t*)(p->ws + WS_PROJ);
    bf16_t* att = (bf16_t*)(p->ws + WS_ATT);
    const float L2E = 1.4426950408889634f;
    const float SC2 = 0.125f * L2E;
    for (int item = blockIdx.x; item < 512; item += gridDim.x) {
        const int hk = item & 1, qb = (item >> 1) & 127, b = item >> 8;
        const int g = wave >> 1, qh = wave & 1, hq = hk * 4 + g;
        const int qrow0 = b * S + 128 * qb + 64 * qh;
        bf16x8 qf[2][4];
#pragma unroll
        for (int qi = 0; qi < 2; ++qi)
#pragma unroll
            for (int st = 0; st < 4; ++st) qf[qi][st] = *(const bf16x8*)(proj + (size_t)(qrow0 + 32 * qi + l31) * DIN + 1024 + 64 * hq + 16 * st + 8 * hl);
        const float sink2 = p->attn_sink[hq] * L2E;
        float mrun[2] = {sink2, sink2};
        float lrun[2] = {hl == 0 ? 1.f : 0.f, hl == 0 ? 1.f : 0.f};
        f32x16 oacc[2][2];
#pragma unroll
        for (int a = 0; a < 2; ++a)
#pragma unroll
            for (int c = 0; c < 2; ++c)
#pragma unroll
                for (int i = 0; i < 16; ++i) oacc[a][c][i] = 0.f;
        u32x4 kreg[2], vreg[2];
        int ci = (qb == 0) ? 1 : 0;
#define ATT_GLOAD(CI) do { const int _row0 = (CI) < 3 ? b * S + 128 * (qb - 1 + (CI)) : NLAT + b * LC + 128 * ((CI) - 3); \
        _Pragma("unroll") for (int _i = 0; _i < 2; ++_i) { const int _pi = tid + 512 * _i, _key = _pi >> 3, _part = _pi & 7; \
            const bf16_t* _src = proj + (size_t)(_row0 + _key) * DIN + 1536 + 64 * hk + 8 * _part; kreg[_i] = *(const u32x4*)_src; vreg[_i] = *(const u32x4*)(_src + 128); } } while (0)
#define ATT_STAGE(PAR) do { bf16_t* _K = (bf16_t*)(shm + (PAR) * 36864); bf16_t* _V = (bf16_t*)(shm + (PAR) * 36864 + 18432); \
        _Pragma("unroll") for (int i = 0; i < 2; ++i) { const int pi = tid + 512 * i, key = pi >> 3, part = pi & 7; \
            *(u32x4*)(_K + key * 72 + 8 * part) = kreg[i]; \
            _Pragma("unroll") for (int e = 0; e < 8; ++e) { const unsigned w = vreg[i][e >> 1]; _V[(8 * part + e) * 132 + key] = (bf16_t)((e & 1) ? (w >> 16) : (w & 0xFFFFu)); } } } while (0)
#define ATT_NEXT(C) (((C) + 1 == 2 && qb == 127) ? 3 : (C) + 1)
        ATT_GLOAD(ci);
        __syncthreads();
        ATT_STAGE(0);
        { const int c1 = ATT_NEXT(ci); if (c1 < 5) ATT_GLOAD(c1); }
        __syncthreads();
        int par = 0;
        while (ci < 5) {
            const int cn = ATT_NEXT(ci);
            if (cn < 5) { ATT_STAGE(par ^ 1); const int c2 = ATT_NEXT(cn); if (c2 < 5) ATT_GLOAD(c2); }
            const bf16_t* Ks = (const bf16_t*)(shm + par * 36864);
            const bf16_t* Vt = (const bf16_t*)(shm + par * 36864 + 18432);
            const int kt_lo = (ci == 0 && qh == 1) ? 2 : 0, kt_hi = (ci == 2 && qh == 0) ? 2 : 4;
#pragma unroll 1
            for (int kt = kt_lo; kt < kt_hi; ++kt) {
                bf16x8 kf[4];
#pragma unroll
                for (int st = 0; st < 4; ++st) kf[st] = *(const bf16x8*)(Ks + (32 * kt + l31) * 72 + 16 * st + 8 * hl);
                bf16x8 vf[2][2];
#pragma unroll
                for (int db = 0; db < 2; ++db)
#pragma unroll
                    for (int s2 = 0; s2 < 2; ++s2) {
                        const bf16_t* vp = Vt + (32 * db + l31) * 132 + 32 * kt + 16 * s2 + 4 * hl;
                        const u32x2 lo = *(const u32x2*)vp, hi = *(const u32x2*)(vp + 8);
                        u32x4 w; w.x = lo.x; w.y = lo.y; w.z = hi.x; w.w = hi.y;
                        vf[db][s2] = __builtin_bit_cast(bf16x8, w);
                    }
#pragma unroll
                for (int qi = 0; qi < 2; ++qi) {
                    f32x16 s;
#pragma unroll
                    for (int i = 0; i < 16; ++i) s[i] = 0.f;
#pragma unroll
                    for (int st = 0; st < 4; ++st) s = __builtin_amdgcn_mfma_f32_32x32x16_bf16(kf[st], qf[qi][st], s, 0, 0, 0);
                    if (ci == 0 || ci == 2) {
                        asm volatile("");
                        const int dl = (ci == 0) ? (32 * kt + 4 * hl - (64 * qh + 32 * qi + l31)) : ((64 * qh + 32 * qi + l31) - 32 * kt - 4 * hl);
#pragma unroll
                        for (int i = 0; i < 16; ++i) {
                            const int ki = 8 * (i >> 2) + (i & 3);
                            const bool ok = (ci == 0) ? (dl + ki >= 0) : (dl - ki >= 0);
                            s[i] = ok ? s[i] : -1e30f;
                        }
                    }
                    float mx = s[0];
#pragma unroll
                    for (int i = 1; i < 16; ++i) mx = fmaxf(mx, s[i]);
                    mx = fmaxf(mx, __shfl_xor(mx, 32));
                    const float mnew = fmaxf(mrun[qi], mx * SC2);
                    if (__builtin_amdgcn_ballot_w64(mnew > mrun[qi]) != 0ull) {
                        const float alpha = __builtin_amdgcn_exp2f(mrun[qi] - mnew);
                        lrun[qi] *= alpha;
#pragma unroll
                        for (int db = 0; db < 2; ++db)
#pragma unroll
                            for (int i = 0; i < 16; ++i) oacc[db][qi][i] *= alpha;
                        mrun[qi] = mnew;
                    }
                    float ls = 0.f;
#pragma unroll
                    for (int i = 0; i < 16; ++i) { s[i] = __builtin_amdgcn_exp2f(__builtin_fmaf(s[i], SC2, -mnew)); ls += s[i]; }
                    lrun[qi] += ls;
                    bf16x8 pf[2];
#pragma unroll
                    for (int s2 = 0; s2 < 2; ++s2) {
                        u32x4 w; w.x = cvt_pk_bf16(s[8 * s2 + 0], s[8 * s2 + 1]); w.y = cvt_pk_bf16(s[8 * s2 + 2], s[8 * s2 + 3]);
                        w.z = cvt_pk_bf16(s[8 * s2 + 4], s[8 * s2 + 5]); w.w = cvt_pk_bf16(s[8 * s2 + 6], s[8 * s2 + 7]);
                        pf[s2] = __builtin_bit_cast(bf16x8, w);
                    }
#pragma unroll
                    for (int db = 0; db < 2; ++db)
#pragma unroll
                        for (int s2 = 0; s2 < 2; ++s2) oacc[db][qi] = __builtin_amdgcn_mfma_f32_32x32x16_bf16(vf[db][s2], pf[s2], oacc[db][qi], 0, 0, 0);
                }
            }
            __syncthreads();
            ci = cn; par ^= 1;
        }
#undef ATT_STAGE
#undef ATT_NEXT
#undef ATT_GLOAD
#pragma unroll
        for (int qi = 0; qi < 2; ++qi) {
            const float lt = lrun[qi] + __shfl_xor(lrun[qi], 32);
            const float inv = 1.0f / lt;
            bf16_t* orow = att + (size_t)(qrow0 + 32 * qi + l31) * 512 + hq * 64;
#pragma unroll
            for (int db = 0; db < 2; ++db)
#pragma unroll
                for (int g4 = 0; g4 < 4; ++g4) {
                    u32x2 w; w.x = cvt_pk_bf16(oacc[db][qi][4 * g4] * inv, oacc[db][qi][4 * g4 + 1] * inv); w.y = cvt_pk_bf16(oacc[db][qi][4 * g4 + 2] * inv, oacc[db][qi][4 * g4 + 3] * inv);
                    *(u32x2*)(orow + 32 * db + 8 * g4 + 4 * hl) = w;
                }
        }
    }
    __syncthreads();
}


struct ScanW { bf16x8 wfa[4], wfi[4]; float ba, bi, sp8l2; };
__device__ __forceinline__ void scan_loadw(PP p, int dir, int n, int ct, int l31, int hl, ScanW& w) {
    unsigned chv = (unsigned)(32 * ct + l31); asm volatile("" : "+v"(chv));
    const unsigned ch = (unsigned)(dir * 512 + 64 * n) + chv;
    w.ba = p->lru_b_a[ch]; w.bi = p->lru_b_i[ch];
    w.sp8l2 = ((const float*)(p->ws + WS_SP8))[ch] * 1.4426950408889634f;
    const bf16_t* wa_b = (const bf16_t*)(p->ws + WS_LRU) + (size_t)((dir * 2 + 0) * 8 + n) * 4096;
    const bf16_t* wi_b = (const bf16_t*)(p->ws + WS_LRU) + (size_t)((dir * 2 + 1) * 8 + n) * 4096;
    const unsigned lo = chv * 64u + 8u * (unsigned)hl;
#pragma unroll
    for (int st = 0; st < 4; ++st) { w.wfa[st] = *(const bf16x8*)(wa_b + lo + 16 * st); w.wfi[st] = *(const bf16x8*)(wi_b + lo + 16 * st); }
}
template <int DIR>
__device__ __forceinline__ void scan_dir(PP p, const bf16_t* xs, const ScanW& w, ScanW& wn, int ndir, int nct, bool do_next, int n, int ct, int l31, int hl, int id, int rowbase, bool latent, float (&hf)[2][16]) {
    constexpr int XS = 520;
    const int ch = 64 * n + 32 * ct + l31;
    const float ba = w.ba, bi = w.bi, sp8l2 = w.sp8l2;
    const bf16x8 (&wfa)[4] = w.wfa; const bf16x8 (&wfi)[4] = w.wfi;
    float a[2][16], u[2][16];
#pragma unroll
    for (int rt = 0; rt < 2; ++rt) {
        bf16x8 af[4];
#pragma unroll
        for (int st = 0; st < 4; ++st) af[st] = *(const bf16x8*)(xs + (32 * rt + l31) * XS + 64 * n + 16 * st + 8 * hl);
        f32x16 ga, gi;
#pragma unroll
        for (int i = 0; i < 16; ++i) { ga[i] = 0.f; gi[i] = 0.f; }
#pragma unroll
        for (int st = 0; st < 4; ++st) { ga = __builtin_amdgcn_mfma_f32_32x32x16_bf16(af[st], wfa[st], ga, 0, 0, 0); gi = __builtin_amdgcn_mfma_f32_32x32x16_bf16(af[st], wfi[st], gi, 0, 0, 0); }
#pragma unroll
        for (int i = 0; i < 16; ++i) {
            const int token = 32 * rt + 8 * (i >> 2) + 4 * hl + (i & 3);
            const float xv = bf2f(xs[token * XS + ch]);
            const float rr = fast_sigmoid(ga[i] + ba), ii = fast_sigmoid(gi[i] + bi);
            const float la2 = rr * sp8l2;
            const float av = __builtin_amdgcn_exp2f(la2);
            const float t2 = la2 * 1.3862943611f;
            float em1p = t2 * (1.0f + t2 * (0.5f + t2 * (0.16666667f + t2 * (0.041666668f + t2 * 0.0083333333f)))), em1e = __builtin_fmaf(av, av, -1.0f);
            asm volatile("" : "+v"(em1p), "+v"(em1e));
            const float em1 = (t2 > -0.1f) ? em1p : em1e;
            a[rt][i] = av; u[rt][i] = __builtin_amdgcn_sqrtf(-em1) * (ii * xv);
        }
    }
    float Ao[8], Ho[8], Ap[8], Hp[8];
#pragma unroll
    for (int k = 0; k < 8; ++k) {
        const int rt = k >> 2, g = k & 3;
        float H = 0.f, A = 1.f;
#pragma unroll
        for (int jj = 0; jj < 4; ++jj) { const int j = DIR ? 3 - jj : jj; const float av = a[rt][4 * g + j]; H = av * H + u[rt][4 * g + j]; A *= av; }
        Ao[k] = A; Ho[k] = H; Ap[k] = __shfl_xor(A, 32); Hp[k] = __shfl_xor(H, 32);
    }
    float Sin[8], Pin[8]; float Sx = 0.f, Px = 1.f;
#pragma unroll
    for (int kk = 0; kk < 8; ++kk) {
        const int k = DIR ? 7 - kk : kk;
        const float A0 = hl ? Ap[k] : Ao[k], H0 = hl ? Hp[k] : Ho[k], A1 = hl ? Ao[k] : Ap[k], H1 = hl ? Ho[k] : Hp[k];
        float s0, p0, s1, p1;
        if (DIR == 0) { s0 = Sx; p0 = Px; Sx = A0 * Sx + H0; Px *= A0; s1 = Sx; p1 = Px; Sx = A1 * Sx + H1; Px *= A1; }
        else          { s1 = Sx; p1 = Px; Sx = A1 * Sx + H1; Px *= A1; s0 = Sx; p0 = Px; Sx = A0 * Sx + H0; Px *= A0; }
        Sin[k] = hl ? s1 : s0; Pin[k] = hl ? p1 : p0;
    }
    asm volatile("" ::: "memory");
    if (do_next) scan_loadw(p, ndir, n, nct, l31, hl, wn);
    bf16_t* yl = (bf16_t*)(p->ws + WS_YL) + (size_t)rowbase * 512; bf16_t* caf = (bf16_t*)(p->ws + WS_CAF) + (size_t)rowbase * 512; bf16_t* cab = (bf16_t*)(p->ws + WS_CAB) + (size_t)rowbase * 512;
    unsigned lo = (unsigned)ch; asm volatile("" : "+v"(lo));
#pragma unroll
    for (int k = 0; k < 8; ++k) {
        const int rt = k >> 2, g = k & 3;
        float h = Sin[k], P = Pin[k];
#pragma unroll
        for (int jj = 0; jj < 4; ++jj) {
            const int j = DIR ? 3 - jj : jj, idx = 4 * g + j;
            h = a[rt][idx] * h + u[rt][idx]; P *= a[rt][idx];
            const int token = 32 * rt + 8 * g + 4 * hl + j;
            const unsigned o = lo + (unsigned)token * 512u;
            if (DIR == 0) { hf[rt][idx] = h; if (latent) caf[o] = f2bf(P); }
            else if (latent) { yl[o] = f2bf(hf[rt][idx] + h); cab[o] = f2bf(P); }
        }
    }
    if (hl == 0) {
        float* sumb = (float*)(p->ws + WS_SUM);
        sumb[((size_t)(DIR * NCHUNK + id) * 2 + 0) * 512 + ch] = Px;
        sumb[((size_t)(DIR * NCHUNK + id) * 2 + 1) * 512 + ch] = Sx;
    }
}
__device__ __forceinline__ void scan_mfma(PP p, unsigned char* shm, int wv) {
    const int tid_ = tid_opaque(wv); const int tid = tid_;
    const int lane = tid & 63, n = wv, l31 = lane & 31, hl = lane >> 5;
    constexpr int XS = 520;
    bf16_t* xs = (bf16_t*)shm;
    const bf16_t* proj = (const bf16_t*)(p->ws + WS_PROJ);
    for (int item = blockIdx.x; item < 512 + 32; item += gridDim.x) {
        const int id = item < 512 ? item : 512 + ((item - 512) >> 2);
        const int quarter = item < 512 ? -1 : ((item - 512) & 3);
        int rowbase, t0, seqlen; bool latent;
        if (id < 512) { const int b = id >> 8, k = id & 255; t0 = 64 * k; rowbase = b * S + t0; seqlen = S; latent = true; }
        else { const int j = id - 512, b = j >> 2, k = j & 3; t0 = 64 * k; rowbase = NLAT + b * LC + t0; seqlen = LC; latent = false; }
        const int seqbase = rowbase - t0;
        ScanW w0, w1;
        if (quarter < 0) scan_loadw(p, 0, n, 0, l31, hl, w0);
        {
            const int tid = tid_opaque(wv);
            bf16_t* raw = (bf16_t*)(shm + 66560);
#pragma unroll
            for (int i = 0; i < 9; ++i) {
                const int piece = tid + 512 * i;
                if (piece < 67 * 64) {
                    const int row = piece >> 6, c8 = piece & 63, tt = t0 - 2 + row;
                    u32x4 v = {0u, 0u, 0u, 0u};
                    if (tt >= 0 && tt < seqlen) v = *(const u32x4*)(proj + (size_t)(seqbase + tt) * DIN + 8 * c8);
                    *(u32x4*)(raw + row * 512 + 8 * c8) = v;
                }
            }
            __syncthreads();
            const int cq = tid & 127, tq = tid >> 7, c4 = 4 * cq;
            const f32x4 k0 = *(const f32x4*)(p->rnn_conv_w + c4), k1 = *(const f32x4*)(p->rnn_conv_w + 512 + c4), k2 = *(const f32x4*)(p->rnn_conv_w + 1024 + c4),
                        k3 = *(const f32x4*)(p->rnn_conv_w + 1536 + c4), kb = *(const f32x4*)(p->rnn_conv_b + c4);
            auto ld4 = [&](int row) -> f32x4 { const u32x2 w = *(const u32x2*)(raw + row * 512 + c4); f32x4 r; r[0] = bflo(w.x); r[1] = bfhi(w.x); r[2] = bflo(w.y); r[3] = bfhi(w.y); return r; };
            f32x4 xm2 = ld4(16 * tq), xm1 = ld4(16 * tq + 1), x0 = ld4(16 * tq + 2);
#pragma unroll
            for (int t = 0; t < 16; ++t) {
                const f32x4 xp1 = ld4(16 * tq + t + 3);
                const f32x4 o = kb + k0 * xm2 + k1 * xm1 + k2 * x0 + k3 * xp1;
                u32x2 w; w.x = pk2(o[0], o[1]); w.y = pk2(o[2], o[3]);
                *(u32x2*)(xs + (16 * tq + t) * XS + c4) = w;
                xm2 = xm1; xm1 = x0; x0 = xp1;
            }
        }
        __syncthreads();
#pragma unroll 1
        for (int ct = 0; ct < 2; ++ct) {
            float hf[2][16];
            const bool run0 = quarter < 0 || quarter == 2 * ct, run1 = quarter < 0 || quarter == 2 * ct + 1;
            if (quarter >= 0) { if (run0) scan_loadw(p, 0, n, ct, l31, hl, w0); if (run1) scan_loadw(p, 1, n, ct, l31, hl, w1); }
            if (run0) scan_dir<0>(p, xs, w0, w1, 1, ct, quarter < 0, n, ct, l31, hl, id, rowbase, latent, hf);
            if (run1) scan_dir<1>(p, xs, w1, w0, 0, 1, quarter < 0 && ct == 0, n, ct, l31, hl, id, rowbase, latent, hf);
        }
        __syncthreads();
    }
}

__device__ __forceinline__ void carry_phase(PP p, unsigned char* shm, int wv) {
    if (blockIdx.x >= 128) return;
    const int tid = tid_opaque(wv), cl = tid & 15, sg = tid >> 4;
    const int b = blockIdx.x >> 6, dir = (blockIdx.x >> 5) & 1, c = (blockIdx.x & 31) * 16 + cl;
    const float* sumb = (const float*)(p->ws + WS_SUM) + (size_t)dir * NCHUNK * 1024;
    float* car = (float*)(p->ws + WS_CAR) + (size_t)dir * NCHUNK * 512;
    float* segA = (float*)shm; float* segH = segA + 512;
    float A[9], H[9]; int ids[9];
#pragma unroll
    for (int k = 0; k < 9; ++k) {
        const int s = sg * 9 + k;
        int id = -1;
        if (s < 260) { if (dir == 0) id = s < 4 ? 512 + 4 * b + s : 256 * b + (s - 4); else id = s < 4 ? 512 + 4 * b + (3 - s) : 256 * b + (255 - (s - 4)); }
        ids[k] = id;
        A[k] = id >= 0 ? sumb[(size_t)id * 1024 + c] : 1.f;
        H[k] = id >= 0 ? sumb[(size_t)id * 1024 + 512 + c] : 0.f;
    }
    float As = 1.f, Hs = 0.f;
#pragma unroll
    for (int k = 0; k < 9; ++k) { Hs = A[k] * Hs + H[k]; As *= A[k]; }
    segA[sg * 16 + cl] = As; segH[sg * 16 + cl] = Hs;
    __syncthreads();
    float h = 0.f;
    for (int j = 0; j < sg; ++j) h = segA[j * 16 + cl] * h + segH[j * 16 + cl];
#pragma unroll
    for (int k = 0; k < 9; ++k) { if (ids[k] >= 0) car[(size_t)ids[k] * 512 + c] = h; h = A[k] * h + H[k]; }
    __syncthreads();
}

struct MixRow { u32x4 vy, vf, vb, vg, va; f32x4 cf0, cf1, cb0, cb1; };
__device__ __forceinline__ void mix_load(PP p, int r, int c0, MixRow& m) {
    const bf16_t* proj = (const bf16_t*)(p->ws + WS_PROJ);
    const bf16_t* att = (const bf16_t*)(p->ws + WS_ATT);
    const bf16_t* yl = (const bf16_t*)(p->ws + WS_YL); const bf16_t* caf = (const bf16_t*)(p->ws + WS_CAF); const bf16_t* cab = (const bf16_t*)(p->ws + WS_CAB);
    const float* car = (const float*)(p->ws + WS_CAR);
    const int id = r >> 6;
    m.vy = *(const u32x4*)(yl + (size_t)r * 512 + c0); m.vf = *(const u32x4*)(caf + (size_t)r * 512 + c0); m.vb = *(const u32x4*)(cab + (size_t)r * 512 + c0);
    m.vg = *(const u32x4*)(proj + (size_t)r * DIN + 512 + c0); m.va = *(const u32x4*)(att + (size_t)r * 512 + c0);
    const float* cf = car + (size_t)id * 512 + c0; const float* cbk = car + (size_t)(NCHUNK + id) * 512 + c0;
    m.cf0 = *(const f32x4*)cf; m.cf1 = *(const f32x4*)(cf + 4); m.cb0 = *(const f32x4*)cbk; m.cb1 = *(const f32x4*)(cbk + 4);
}
__device__ __forceinline__ void mix_store(PP p, int r, int c0, const MixRow& m, const f32x4 (&gr)[2], const f32x4 (&ga)[2]) {
    bf16_t* mix = (bf16_t*)(p->ws + WS_HB);
    float rn[8], at[8]; float s1 = 0.f, s2 = 0.f;
#pragma unroll
    for (int e = 0; e < 8; ++e) {
        const unsigned wy = m.vy[e >> 1], wf = m.vf[e >> 1], wb = m.vb[e >> 1], wg = m.vg[e >> 1], wa = m.va[e >> 1];
        const float cfe = e < 4 ? m.cf0[e & 3] : m.cf1[e & 3], cbe = e < 4 ? m.cb0[e & 3] : m.cb1[e & 3];
        const float y = ((e & 1) ? bfhi(wy) : bflo(wy)) + ((e & 1) ? bfhi(wf) : bflo(wf)) * cfe + ((e & 1) ? bfhi(wb) : bflo(wb)) * cbe;
        const float xg = (e & 1) ? bfhi(wg) : bflo(wg);
        rn[e] = gelu_tanh_(xg) * y; s1 += rn[e] * rn[e];
        at[e] = (e & 1) ? bfhi(wa) : bflo(wa); s2 += at[e] * at[e];
    }
    const float r1 = rsqrtf(wave_sum(s1) * (1.0f / 512.0f) + EPS), r2 = rsqrtf(wave_sum(s2) * (1.0f / 512.0f) + EPS);
    u32x4 o1, o2;
#pragma unroll
    for (int e2 = 0; e2 < 4; ++e2) {
        o1[e2] = pk2(rn[2 * e2] * r1 * gr[e2 >> 1][(2 * e2) & 3], rn[2 * e2 + 1] * r1 * gr[e2 >> 1][(2 * e2 + 1) & 3]);
        o2[e2] = pk2(at[2 * e2] * r2 * ga[e2 >> 1][(2 * e2) & 3], at[2 * e2 + 1] * r2 * ga[e2 >> 1][(2 * e2 + 1) & 3]);
    }
    *(u32x4*)(mix + (size_t)r * D + c0) = o1; *(u32x4*)(mix + (size_t)r * D + 512 + c0) = o2;
}
__device__ __forceinline__ void mix_phase(PP p, int wv) {
    const int tid_ = tid_opaque(wv), lane = tid_ & 63, gw = blockIdx.x * 8 + (tid_ >> 6), NGW = gridDim.x * 8;
    const int c0 = 8 * lane;
    f32x4 gr[2], ga[2];
    gr[0] = *(const f32x4*)(p->gn_rnn + c0); gr[1] = *(const f32x4*)(p->gn_rnn + c0 + 4); ga[0] = *(const f32x4*)(p->gn_attn + c0); ga[1] = *(const f32x4*)(p->gn_attn + c0 + 4);
    for (int r = gw; r < NLAT; r += 2 * NGW) {
        const int rb = (r + NGW < NLAT) ? r + NGW : r;
        MixRow ma, mb;
        mix_load(p, r, c0, ma); mix_load(p, rb, c0, mb);
        mix_store(p, r, c0, ma, gr, ga);
        if (rb != r) mix_store(p, rb, c0, mb, gr, ga);
    }
}

__device__ __forceinline__ void phase7(PP p, int wv) {
    const int tid_ = tid_opaque(wv), lane = tid_ & 63, gw = blockIdx.x * 8 + (tid_ >> 6), NGW = gridDim.x * 8;
    const float* mod = (const float*)(p->ws + WS_MOD);
    bf16_t* hb = (bf16_t*)(p->ws + WS_HB);
    const bf16_t* o1 = (const bf16_t*)(p->ws + WS_O1);
    for (int r = gw; r < NLAT; r += 2 * NGW) {
        const int rb = r + NGW;
        f32x4 va[4], vb[4]; u32x2 da[4], db[4];
        row_load(p->x + (size_t)r * D, lane, va); row_load(p->x + (size_t)rb * D, lane, vb);
#pragma unroll
        for (int j = 0; j < 4; ++j) { da[j] = *(const u32x2*)(o1 + (size_t)r * D + 4 * lane + 256 * j); db[j] = *(const u32x2*)(o1 + (size_t)rb * D + 4 * lane + 256 * j); }
#pragma unroll
        for (int j = 0; j < 4; ++j) {
            va[j][0] += bflo(da[j].x); va[j][1] += bfhi(da[j].x); va[j][2] += bflo(da[j].y); va[j][3] += bfhi(da[j].y);
            vb[j][0] += bflo(db[j].x); vb[j][1] += bfhi(db[j].x); vb[j][2] += bflo(db[j].y); vb[j][3] += bfhi(db[j].y);
        }
        const float sa = row_rstd(va), sb = row_rstd(vb);
        const int ma = r >> 14, mb = rb >> 14;
        norm_mod_store(va, sa, p->norm2_g, mod + ma * 6144 + 3072, mod + ma * 6144 + 4096, hb + (size_t)(ma * H2_BSTRIDE + 1 + (r & (S - 1))) * D, lane);
        norm_mod_store(vb, sb, p->norm2_g, mod + mb * 6144 + 3072, mod + mb * 6144 + 4096, hb + (size_t)(mb * H2_BSTRIDE + 1 + (rb & (S - 1))) * D, lane);
    }
    for (int z = gw; z < 254; z += NGW) {
        const int R = z == 0 ? 0 : (z <= 126 ? S + z : 32895 + (z - 127));
        const u32x4 zz = {0u, 0u, 0u, 0u};
        *(u32x4*)(hb + (size_t)R * D + 8 * lane) = zz; *(u32x4*)(hb + (size_t)R * D + 512 + 8 * lane) = zz;
    }
}

__device__ __forceinline__ void final_phase(PP p, int wv) {
    const int tid_ = tid_opaque(wv), lane = tid_ & 63, gw = blockIdx.x * 8 + (tid_ >> 6), NGW = gridDim.x * 8;
    const bf16_t* o1 = (const bf16_t*)(p->ws + WS_O1); const bf16_t* o2 = (const bf16_t*)(p->ws + WS_O2);
    for (int r = gw; r < NLAT; r += 2 * NGW) {
        const int rb = r + NGW;
        f32x4 va[4], vb[4]; u32x2 da[4], db[4], ea[4], eb[4];
        row_load(p->x + (size_t)r * D, lane, va); row_load(p->x + (size_t)rb * D, lane, vb);
#pragma unroll
        for (int j = 0; j < 4; ++j) {
            da[j] = *(const u32x2*)(o1 + (size_t)r * D + 4 * lane + 256 * j); db[j] = *(const u32x2*)(o1 + (size_t)rb * D + 4 * lane + 256 * j);
            ea[j] = *(const u32x2*)(o2 + (size_t)r * D + 4 * lane + 256 * j); eb[j] = *(const u32x2*)(o2 + (size_t)rb * D + 4 * lane + 256 * j);
        }
#pragma unroll
        for (int j = 0; j < 4; ++j) {
            va[j][0] += bflo(da[j].x) + bflo(ea[j].x); va[j][1] += bfhi(da[j].x) + bfhi(ea[j].x); va[j][2] += bflo(da[j].y) + bflo(ea[j].y); va[j][3] += bfhi(da[j].y) + bfhi(ea[j].y);
            vb[j][0] += bflo(db[j].x) + bflo(eb[j].x); vb[j][1] += bfhi(db[j].x) + bfhi(eb[j].x); vb[j][2] += bflo(db[j].y) + bflo(eb[j].y); vb[j][3] += bfhi(db[j].y) + bfhi(eb[j].y);
        }
        const float sa = row_rstd(va), sb = row_rstd(vb);
        float* rowa = p->out + (size_t)r * D; float* rowb = p->out + (size_t)rb * D;
#pragma unroll
        for (int j = 0; j < 4; ++j) { const f32x4 gg = *(const f32x4*)(p->final_g + 4 * lane + 256 * j); *(f32x4*)(rowa + 4 * lane + 256 * j) = va[j] * sa * gg; *(f32x4*)(rowb + 4 * lane + 256 * j) = vb[j] * sb * gg; }
    }
}

__global__ void __launch_bounds__(512, 2) fwd_megakernel(Params p_arg) {
    extern __shared__ __attribute__((aligned(16))) unsigned char shm[];
    cg::grid_group grid = cg::this_grid();
    LAS unsigned char* lds = (LAS unsigned char*)shm;
    pg8::StaticOrder so;
    const int wv = __builtin_amdgcn_readfirstlane((int)(threadIdx.x >> 6));
    volatile LAS unsigned* xst = (volatile LAS unsigned*)(lds + LDS_XB);
    if (tid_opaque(wv) == 0) { xst[0] = 0u; xst[1] = 0u; }
    __syncthreads();
    (void)xcd_barrier_post((unsigned*)(kparams()->ws + WS_BAR), xst, wv);
#define XBAR() do { XcdBarrier _b; _b.bar = (unsigned*)(kparams()->ws + WS_BAR); _b.x = xb_xcc_id(); _b.st = (volatile LAS unsigned*)(lds + LDS_XB); xcd_barrier(_b, wv); } while (0)
    if (kparams()->out == nullptr) grid.sync();

    phase0(kparams(), shm, wv);
    {
        constexpr int T_IN = (D / 64) * (DIN / 32), T_B = (D / 64) * (D / 32) + (D / 64) * (DUP / 32) + (DFF / 64) * (D / 32), T_LRU = 64;
        const int nfree = (int)gridDim.x > 192 ? (int)gridDim.x - 192 : 0;
        const int first = nfree ? 192 : 0, nblk = nfree ? nfree : (int)gridDim.x;
        if ((int)blockIdx.x >= first) {
            transpose_phase(kparams(), shm, wv, 0, T_IN, ((int)blockIdx.x - first) * 8, nblk * 8);
            transpose_phase(kparams(), shm, wv, T_IN + T_B, T_IN + T_B + T_LRU, ((int)blockIdx.x - first) * 8, nblk * 8);
        }
    }
    XBAR();
    phase1(kparams(), wv);
    XBAR();
    {
        PP p = kparams(); unsigned char* ws = p->ws;
        pg8::Gemm g{(const bf16_t*)(ws + WS_HB), (const bf16_t*)(ws + WS_WIN), MROWS / 256, DIN / 256, D, 256};
        so.init(g.nM, g.nN, gridDim.x, blockIdx.x);
        EpiProj e{(bf16_t*)(ws + WS_PROJ), (const float*)(ws + WS_ROPE), (const float*)(ws + WS_ROPE) + 4096};
        pg8::gemm_phase(lds, g, so, e, wv);
        {
            constexpr int T_IN = (D / 64) * (DIN / 32), T_B = (D / 64) * (D / 32) + (D / 64) * (DUP / 32) + (DFF / 64) * (D / 32);
            const int G = (int)gridDim.x, rem = (g.nM * g.nN) % G;
            const int first = rem ? rem : 0, nblk = G - first;
            if ((int)blockIdx.x >= first) transpose_phase(p, shm, wv, T_IN, T_IN + T_B, ((int)blockIdx.x - first) * 8, nblk * 8);
        }
    }
    XBAR();
    scan_mfma(kparams(), shm, wv);
    attn_mfma(kparams(), shm, wv);
    XBAR();
    carry_phase(kparams(), shm, wv);
    XBAR();
    mix_phase(kparams(), wv);
    XBAR();
    {
        PP p = kparams(); unsigned char* ws = p->ws; const float* mod = (const float*)(ws + WS_MOD);
        pg8::Gemm g{(const bf16_t*)(ws + WS_HB), (const bf16_t*)(ws + WS_WOUT), NLAT / 256, D / 256, D, 256};
        so.init(g.nM, g.nN, gridDim.x, blockIdx.x);
        EpiDelta e{(bf16_t*)(ws + WS_O1), mod + 2048, mod + 6144 + 2048};
        pg8::gemm_phase(lds, g, so, e, wv);
    }
    XBAR();
    phase7(kparams(), wv);
    XBAR();
    {
        PP p = kparams(); unsigned char* ws = p->ws;
        pg8::Gemm g{(const bf16_t*)(ws + WS_HB), (const bf16_t*)(ws + WS_WUP), 130, DUP / 256, D, 254};
        so.init(g.nM, g.nN, gridDim.x, blockIdx.x);
        EpiConvGate e{(bf16_t*)(ws + WS_ACT), p->ffn_conv_w, p->ffn_conv_b, lds + 131072};
        pg8::gemm_phase(lds, g, so, e, wv);
    }
    XBAR();
    {
        PP p = kparams(); unsigned char* ws = p->ws; const float* mod = (const float*)(ws + WS_MOD);
        pg8::Gemm g{(const bf16_t*)(ws + WS_ACT), (const bf16_t*)(ws + WS_WDN), NLAT / 256, D / 256, DFF, 256};
        so.init(g.nM, g.nN, gridDim.x, blockIdx.x);
        EpiDelta e{(bf16_t*)(ws + WS_O2), mod + 5120, mod + 6144 + 5120};
        pg8::gemm_phase(lds, g, so, e, wv);
    }
    XBAR();
    final_phase(kparams(), wv);
}

extern "C" void kernel_launch(void* const* d_in, const int* in_sizes, int n_in, void* d_out, int out_size, void* d_ws, size_t ws_size, hipStream_t stream) {
    static int grid_blocks = 0;
    if (!grid_blocks) {
        int dev = 0, cus = 0, per_cu = 0;
        hipGetDevice(&dev);
        hipDeviceGetAttribute(&cus, hipDeviceAttributeMultiprocessorCount, dev);
        hipFuncSetAttribute((const void*)fwd_megakernel, hipFuncAttributeMaxDynamicSharedMemorySize, LDS_BYTES);
        hipOccupancyMaxActiveBlocksPerMultiprocessor(&per_cu, (const void*)fwd_megakernel, 512, LDS_BYTES);
        if (per_cu < 1) per_cu = 1;
        grid_blocks = cus * per_cu;
        if (ws_size < WS_END) fprintf(stderr, "kernel_launch: workspace too small: %zu < %zu\n", ws_size, (size_t)WS_END);
    }
    Params p{};
    const float** pp = (const float**)&p;
    for (int i = 0; i < 25; ++i) pp[i] = (const float*)d_in[i];
    p.out = (float*)d_out; p.ws = (unsigned char*)d_ws;
    hipMemsetAsync((unsigned char*)d_ws + WS_BAR, 0, 16384, stream);
    void* args[] = {&p};
    hipError_t e = hipLaunchCooperativeKernel((const void*)fwd_megakernel, dim3(grid_blocks), dim3(512), args, LDS_BYTES, stream);
    if (e != hipSuccess) fprintf(stderr, "cooperative launch failed: %s (grid %d)\n", hipGetErrorString(e), grid_blocks);
}
```

```cpp
#include <hip/hip_runtime.h>
#include <hip/hip_cooperative_groups.h>
#include <cstdio>
namespace cg = cooperative_groups;

#define LAS __attribute__((address_space(3)))
typedef unsigned short bf16_t;
typedef short bf16x8 __attribute__((ext_vector_type(8)));
typedef float f32x4 __attribute__((ext_vector_type(4)));
typedef unsigned u32x4 __attribute__((ext_vector_type(4)));
typedef unsigned u32x2 __attribute__((ext_vector_type(2)));

constexpr int D = 1024, NB = 2, S = 16384, LC = 256;
constexpr int NLAT = NB * S;
constexpr int NCTX = NB * LC;
constexpr int MROWS = NLAT + NCTX;
constexpr int DIN = 1792, DFF = 2816, DUP = 5632, DRNN = 512;
constexpr int NCHUNK = MROWS / 64;
constexpr float EPS = 1e-6f;

constexpr size_t AL(size_t x) { return (x + 255) & ~(size_t)255; }
constexpr size_t WS_WIN  = 0;
constexpr size_t WS_WOUT = WS_WIN  + AL((size_t)DIN * D * 2);
constexpr size_t WS_WUP  = WS_WOUT + AL((size_t)D * D * 2);
constexpr size_t WS_WDN  = WS_WUP  + AL((size_t)DUP * D * 2);
constexpr size_t WS_LRU  = WS_WDN  + AL((size_t)D * DFF * 2);
constexpr size_t WS_MOD  = WS_LRU  + AL((size_t)4 * 8 * 64 * 64 * 2);
constexpr size_t WS_ROPE = WS_MOD  + AL((size_t)3 * 6144 * 4);
constexpr size_t WS_SUM  = WS_ROPE + AL((size_t)2 * 256 * 16 * 4);
constexpr size_t WS_CAR  = WS_SUM  + AL((size_t)2 * NCHUNK * 2 * 512 * 4);
constexpr size_t WS_SP8  = WS_CAR  + AL((size_t)2 * NCHUNK * 512 * 4);
constexpr size_t WS_BAR  = WS_SP8  + 4096;
constexpr size_t WS_HB   = WS_BAR  + 16384;
constexpr size_t WS_R1   = WS_HB   + AL((size_t)MROWS * D * 2);
constexpr size_t WS_PROJ = WS_R1;
constexpr size_t WS_ATT  = WS_PROJ + AL((size_t)MROWS * DIN * 2);
constexpr size_t WS_YL   = WS_ATT  + AL((size_t)NLAT * 512 * 2);
constexpr size_t WS_CAF  = WS_YL   + AL((size_t)NLAT * 512 * 2);
constexpr size_t WS_CAB  = WS_CAF  + AL((size_t)NLAT * 512 * 2);
constexpr size_t WS_R1END = WS_CAB + AL((size_t)NLAT * 512 * 2);
constexpr size_t WS_ACT  = WS_R1;
constexpr size_t WS_O1   = WS_ACT + AL((size_t)NLAT * DFF * 2);
constexpr size_t WS_O2   = WS_HB;
constexpr size_t WS_END  = WS_R1END;
static_assert(WS_O1 + (size_t)NLAT * D * 2 <= WS_R1END, "o1");
static_assert(WS_ACT + (size_t)NLAT * DFF * 2 <= WS_R1END, "act");
constexpr int H2_BSTRIDE = 65 * 254;
constexpr int H2_ROWS = 130 * 254 + 2;
static_assert((size_t)H2_ROWS * D * 2 <= (size_t)MROWS * D * 2, "h2");

constexpr int LDS_BYTES = 131072 + 8192 + 256;
constexpr int LDS_XB = 131072 + 8192;

struct Params {
    const float *x, *c, *ctx, *c_ctx, *w_mod, *b_mod, *norm1_g, *w_in, *rnn_conv_w, *rnn_conv_b, *lru_w_a, *lru_b_a,
        *lru_w_i, *lru_b_i, *lru_lam, *attn_sink, *gn_rnn, *gn_attn, *w_out, *norm2_g, *w_up, *ffn_conv_w, *ffn_conv_b,
        *w_down, *final_g;
    float* out;
    unsigned char* ws;
};

typedef const Params __attribute__((address_space(4)))* PP;
__device__ __forceinline__ PP kparams() { PP k = (PP)__builtin_amdgcn_kernarg_segment_ptr(); asm volatile("" : "+s"(k)); return k; }
__device__ __forceinline__ int lane_fresh() { unsigned m = ~0u; asm volatile("" : "+s"(m)); return (int)__builtin_amdgcn_mbcnt_hi(m, __builtin_amdgcn_mbcnt_lo(m, 0u)); }
__device__ __forceinline__ int tid_opaque(int wv) { return wv * 64 + lane_fresh(); }
__device__ __forceinline__ bf16_t f2bf(float f) { unsigned u = __float_as_uint(f); u += 0x7FFFu + ((u >> 16) & 1u); return (bf16_t)(u >> 16); }
__device__ __forceinline__ float bf2f(bf16_t b) { return __uint_as_float(((unsigned)b) << 16); }
__device__ __forceinline__ unsigned pk2(float lo, float hi) { unsigned r; asm("v_cvt_pk_bf16_f32 %0, %1, %2" : "=v"(r) : "v"(lo), "v"(hi)); return r; }
__device__ __forceinline__ float bflo(unsigned w) { return __uint_as_float(w << 16); }
__device__ __forceinline__ float bfhi(unsigned w) { return __uint_as_float(w & 0xFFFF0000u); }
__device__ __forceinline__ float wave_sum(float v) {
#pragma unroll
    for (int o = 32; o >= 1; o >>= 1) v += __shfl_xor(v, o);
    return v;
}
__device__ __forceinline__ float wave_max(float v) {
#pragma unroll
    for (int o = 32; o >= 1; o >>= 1) v = fmaxf(v, __shfl_xor(v, o));
    return v;
}
__device__ __forceinline__ float sigmoidf_(float x) { return 1.0f / (1.0f + __expf(-x)); }
__device__ __forceinline__ float fast_sigmoid(float x) { return __builtin_amdgcn_rcpf(1.0f + __builtin_amdgcn_exp2f(-1.4426950408889634f * x)); }
__device__ __forceinline__ float silu_(float x) { return x * fast_sigmoid(x); }
__device__ __forceinline__ float gelu_tanh_(float x) {
    const float u = 0.7978845608028654f * (x + 0.044715f * x * x * x);
    const float e = __expf(2.0f * u);
    const float th = 1.0f - 2.0f / (e + 1.0f);
    return 0.5f * x * (1.0f + th);
}


#define XB_TMO      128
#define XB_XCNT(j)  (256  + 64 * (j))
#define XB_XSUB(j)  (1280 + 64 * (j))
#define XB_XGEN(j)  (2304 + 64 * (j))
#define XB_TOP      3328
#define XB_TOPGEN   3392
#define XCD_BAR_WORDS 3456
#define XB_SPIN_CAP (1u << 20)
__device__ __forceinline__ unsigned xb_ld(unsigned* p)              { return __hip_atomic_load(p, __ATOMIC_RELAXED, __HIP_MEMORY_SCOPE_AGENT); }
__device__ __forceinline__ unsigned xb_add(unsigned* p, unsigned v) { return __hip_atomic_fetch_add(p, v, __ATOMIC_RELAXED, __HIP_MEMORY_SCOPE_AGENT); }
__device__ __forceinline__ unsigned xb_xcc_id() { return (unsigned)__builtin_amdgcn_s_getreg((3 << 11) | 20) & 0xFu; }
#define XB_SPIN(cond, bar) do { unsigned _sp = 0; while (cond) { __builtin_amdgcn_s_sleep(1); \
    if ((++_sp & 255u) == 0u) { if (xb_ld(&(bar)[XB_TMO])) break; if (_sp > XB_SPIN_CAP) { atomicAdd(&(bar)[XB_TMO], 1u); break; } } } } while (0)
struct XcdBarrier { unsigned* bar; unsigned x; volatile LAS unsigned* st; };
__device__ __forceinline__ XcdBarrier xcd_barrier_post(unsigned* bar, volatile LAS unsigned* st, int wv) {
    XcdBarrier b; b.bar = bar; b.x = xb_xcc_id(); b.st = st;
    if (tid_opaque(wv) == 0) (void)xb_add(&bar[XB_XCNT(b.x)], 1u);
    return b;
}
__device__ __forceinline__ void xcd_barrier_complete(unsigned* bar, unsigned x, unsigned& nloc, unsigned& nx) {
    const unsigned G = gridDim.x * gridDim.y * gridDim.z;
    unsigned sum, cnt, mine, sp = 0u;
    for (;;) {
        sum = 0u; cnt = 0u; mine = 0u;
#pragma unroll
        for (unsigned j = 0; j < 16; ++j) { const unsigned c = xb_ld(&bar[XB_XCNT(j)]); sum += c; cnt += (c > 0u) ? 1u : 0u; mine = (j == x) ? c : mine; }
        if (sum == G) break;
        __builtin_amdgcn_s_sleep(1);
        if ((++sp & 255u) == 0u) { if (xb_ld(&bar[XB_TMO])) break; if (sp > XB_SPIN_CAP) { atomicAdd(&bar[XB_TMO], 1u); break; } }
    }
    nloc = mine > 0u ? mine : 1u; nx = cnt > 0u ? cnt : 1u;
}
__device__ __forceinline__ void xcd_barrier(const XcdBarrier& b, int wv) {
    asm volatile("s_waitcnt vmcnt(0)" ::: "memory");
    __syncthreads();
    if (tid_opaque(wv) == 0) {
        unsigned* bar = b.bar;
        __builtin_amdgcn_s_waitcnt(0);
        unsigned nloc = b.st[0], nx = b.st[1];
        if (nloc == 0u) { xcd_barrier_complete(bar, b.x, nloc, nx); b.st[0] = nloc; b.st[1] = nx; }
        const unsigned old = xb_add(&bar[XB_XSUB(b.x)], 1u);
        const unsigned gen = old / nloc;
        if (old + 1u == (gen + 1u) * nloc) {
            __builtin_amdgcn_fence(__ATOMIC_RELEASE, "agent");
            asm volatile("s_waitcnt vmcnt(0)" ::: "memory");
            const unsigned og = xb_add(&bar[XB_TOP], 1u);
            const unsigned tg = og / nx;
            if (og + 1u == (tg + 1u) * nx) xb_add(&bar[XB_TOPGEN], 1u);
            else XB_SPIN(xb_ld(&bar[XB_TOPGEN]) == tg, bar);
            __builtin_amdgcn_fence(__ATOMIC_ACQUIRE, "agent");
            xb_add(&bar[XB_XGEN(b.x)], 1u);
            asm volatile("s_waitcnt vmcnt(0)" ::: "memory");
        } else {
            XB_SPIN(xb_ld(&bar[XB_XGEN(b.x)]) == gen, bar);
            __builtin_amdgcn_fence(__ATOMIC_ACQUIRE, "agent");
            asm volatile("s_waitcnt vmcnt(0)" ::: "memory");
        }
    }
    __syncthreads();
}

namespace pg8 {
constexpr int BM = 256, BK = 64, HALF = 128, HTB = HALF * BK * 2, NXCD = 8, WGM = 8;
__host__ __device__ __forceinline__ int lds_byte(int r, int c) { const int st = (r >> 4) * 2 + (c >> 5), rr = r & 15, cc = c & 31, ob = rr * 64 + cc * 2; return st * 1024 + (ob ^ (((ob >> 9) & 1) << 5)); }
__host__ __device__ __forceinline__ void stage_rc(int b, int& R, int& C) { const int st = b / 1024, sb = b % 1024, swz = sb ^ (((sb >> 9) & 1) << 5); R = (st >> 1) * 16 + swz / 64; C = (st & 1) * 32 + (swz % 64) / 2; }
struct Unit { int pm, pn; };
struct Gemm { const bf16_t* A; const bf16_t* Bt; int nM, nN, K, a_tile_rows; };
struct StaticOrder {
    int nM, nN, nwg, G, c;
    __device__ void init(int nM_, int nN_, int G_, int c_) { nM = nM_; nN = nN_; nwg = nM * nN; G = G_; c = c_; }
    __device__ bool next(int i, Unit& u) const {
        const long L = (long)i * G + c; if (L >= nwg) return false;
        int wgid = (int)L; { const int q = nwg / NXCD, r = nwg % NXCD, xcd = wgid % NXCD, off = wgid / NXCD; wgid = (xcd < r ? xcd * (q + 1) : r * (q + 1) + (xcd - r) * q) + off; }
        const int nig = WGM * nN, gid = wgid / nig, fm = gid * WGM, gsz = (nM - fm) < WGM ? (nM - fm) : WGM;
        u.pm = fm + ((wgid % nig) % gsz); u.pn = (wgid % nig) / gsz; return true;
    }
};
template <class Epi>
__device__ __forceinline__ void gemm_phase(LAS unsigned char* lds, const Gemm g, const StaticOrder& S, const Epi& E, int wv) {
    const int tid = tid_opaque(wv);
    const int wid = __builtin_amdgcn_readfirstlane(tid >> 6), lane = tid & 63, wr = wid >> 2, wc = wid & 3, fr = lane & 15, fq = lane >> 4;
    const int K = g.K, nt = K / BK;
    unsigned voffA[2], voffB[2];
#pragma unroll
    for (int i = 0; i < 2; ++i) { int R, C; stage_rc(tid * 16 + i * 8192, R, C);
        const int Ra = (R & ~63) + 4 * (R & 15) + ((R >> 4) & 3);
        voffA[i] = (unsigned)(Ra * K + C) * 2u; voffB[i] = (unsigned)(R * K + C) * 2u; }
    const size_t kstep = (size_t)(BK * 2);
    const size_t hstep = (size_t)HALF * K * 2;
    const size_t tstepA = (size_t)g.a_tile_rows * K * 2;
    const size_t tstepB = 2 * hstep;
    const unsigned ldsw = (unsigned)wid * 1024u;
    const int aoff = lds_byte(wr * 64 + fr, fq * 8), boff = lds_byte(wc * 32 + fr, fq * 8);
#define PG8_SA(b, h) (((b) * 2 + (h)) * HTB)
#define PG8_SB(b, h) ((4 + (b) * 2 + (h)) * HTB)
#define PG8_STAGE(bufoff, gbase, voff) do { _Pragma("unroll") for (int _i = 0; _i < 2; ++_i) \
        __builtin_amdgcn_global_load_lds((const unsigned*)((const char*)(gbase) + (voff)[_i]), (LAS unsigned*)(lds + (bufoff) + ldsw + _i * 8192), 16, 0, 0); } while (0)
#define PG8_LDA(dst, b, h) do { _Pragma("unroll") for (int m = 0; m < 4; ++m) _Pragma("unroll") for (int k = 0; k < 2; ++k) dst[m][k] = *(const LAS bf16x8*)(lds + PG8_SA(b, h) + aoff + m * 2048 + k * 1024); } while (0)
#define PG8_LDB(dst, b, h) do { _Pragma("unroll") for (int n = 0; n < 2; ++n) _Pragma("unroll") for (int k = 0; k < 2; ++k) dst[n][k] = *(const LAS bf16x8*)(lds + PG8_SB(b, h) + boff + n * 2048 + k * 1024); } while (0)
#define PG8_MMA(ai, bj, At, Bt) do { __builtin_amdgcn_s_setprio(1); _Pragma("unroll") for (int m = 0; m < 4; ++m) _Pragma("unroll") for (int n = 0; n < 2; ++n) _Pragma("unroll") for (int k = 0; k < 2; ++k) \
        acc[ai][bj][m][n] = __builtin_amdgcn_mfma_f32_16x16x32_bf16(Bt[n][k], At[m][k], acc[ai][bj][m][n], 0, 0, 0); __builtin_amdgcn_s_setprio(0); } while (0)
#define PG8_WAIT_V(n) asm volatile("s_waitcnt vmcnt(" #n ")" ::: "memory")
#define PG8_WAIT_L(n) asm volatile("s_waitcnt lgkmcnt(" #n ")" ::: "memory")
#define PG8_BAR __builtin_amdgcn_s_barrier()
#define PG8_SCHED __builtin_amdgcn_sched_barrier(0)
    Unit cur, nxt; int ui = 0;
    if (!S.next(0, cur)) return;
    f32x4 acc[2][2][4][2];
#pragma unroll
    for (int a = 0; a < 2; ++a)
#pragma unroll
        for (int b = 0; b < 2; ++b)
#pragma unroll
            for (int m = 0; m < 4; ++m)
#pragma unroll
                for (int n = 0; n < 2; ++n) acc[a][b][m][n] = (f32x4){0.f, 0.f, 0.f, 0.f};
    bf16x8 At[4][2], B0[2][2], B1[2][2];
    const char* cA = (const char*)g.A + (size_t)cur.pm * tstepA; const char* cB = (const char*)g.Bt + (size_t)cur.pn * tstepB;
    PG8_STAGE(PG8_SB(0, 0), cB, voffB); PG8_STAGE(PG8_SA(0, 0), cA, voffA); PG8_STAGE(PG8_SB(0, 1), cB + hstep, voffB); PG8_STAGE(PG8_SA(0, 1), cA + hstep, voffA);
    if (wr == 1) PG8_BAR;
    PG8_WAIT_V(4); PG8_BAR;
    PG8_STAGE(PG8_SB(1, 0), cB + kstep, voffB); PG8_STAGE(PG8_SA(1, 0), cA + kstep, voffA); PG8_STAGE(PG8_SB(1, 1), cB + hstep + kstep, voffB);
    PG8_WAIT_V(6); PG8_BAR;
    for (;;) {
        const bool has_next = S.next(ui + 1, nxt);
        const char* nA = has_next ? (const char*)g.A + (size_t)nxt.pm * tstepA : cA; const char* nB = has_next ? (const char*)g.Bt + (size_t)nxt.pn * tstepB : cB;
        for (int t = 0; t < nt; t += 2) {
            const bool last = (t == nt - 2);
            const char* a1 = cA + (size_t)(t + 1) * kstep;
            const char* a2 = last ? nA : cA + (size_t)(t + 2) * kstep; const char* b2 = last ? nB : cB + (size_t)(t + 2) * kstep;
            const char* a3 = a2 + kstep; const char* b3 = b2 + kstep;
            PG8_LDB(B0, 0, 0); PG8_SCHED; PG8_LDA(At, 0, 0); PG8_STAGE(PG8_SA(1, 1), a1 + hstep, voffA);
            PG8_WAIT_L(8); PG8_BAR; PG8_WAIT_L(0); PG8_MMA(0, 0, At, B0); PG8_BAR; PG8_SCHED;
            PG8_LDB(B1, 0, 1); PG8_STAGE(PG8_SB(0, 0), b2, voffB);
            PG8_BAR; PG8_WAIT_L(0); PG8_MMA(0, 1, At, B1); PG8_BAR;
            PG8_LDA(At, 0, 1); PG8_STAGE(PG8_SA(0, 0), a2, voffA);
            PG8_BAR; PG8_WAIT_L(0); PG8_MMA(1, 0, At, B0); PG8_BAR; PG8_SCHED;
            PG8_STAGE(PG8_SB(0, 1), b2 + hstep, voffB);
            PG8_WAIT_V(6); PG8_BAR; PG8_MMA(1, 1, At, B1); PG8_BAR;
            PG8_LDB(B0, 1, 0); PG8_SCHED; PG8_LDA(At, 1, 0); PG8_STAGE(PG8_SA(0, 1), a2 + hstep, voffA);
            PG8_WAIT_L(8); PG8_BAR; PG8_WAIT_L(0); PG8_MMA(0, 0, At, B0); PG8_BAR; PG8_SCHED;
            PG8_LDB(B1, 1, 1); PG8_STAGE(PG8_SB(1, 0), b3, voffB);
            PG8_BAR; PG8_WAIT_L(0); PG8_MMA(0, 1, At, B1); PG8_BAR;
            PG8_LDA(At, 1, 1); PG8_STAGE(PG8_SA(1, 0), a3, voffA);
            PG8_BAR; PG8_WAIT_L(0); PG8_MMA(1, 0, At, B0); PG8_BAR; PG8_SCHED;
            PG8_STAGE(PG8_SB(1, 1), b3 + hstep, voffB);
            PG8_WAIT_V(6); PG8_BAR; PG8_MMA(1, 1, At, B1); PG8_BAR;
        }
        { const int ln2 = lane_fresh();
          E(acc, cur, wr, wc, ln2 & 15, ln2 >> 4); }
        if (!has_next) break;
#pragma unroll
        for (int a = 0; a < 2; ++a)
#pragma unroll
            for (int b = 0; b < 2; ++b)
#pragma unroll
                for (int m = 0; m < 4; ++m)
#pragma unroll
                    for (int n = 0; n < 2; ++n) acc[a][b][m][n] = (f32x4){0.f, 0.f, 0.f, 0.f};
        cur = nxt; cA = nA; cB = nB; ++ui;
    }
    PG8_WAIT_V(0);
    if (wr == 0) PG8_BAR;
    PG8_BAR;
#undef PG8_SA
#undef PG8_SB
#undef PG8_STAGE
#undef PG8_LDA
#undef PG8_LDB
#undef PG8_MMA
#undef PG8_WAIT_V
#undef PG8_WAIT_L
#undef PG8_BAR
#undef PG8_SCHED
}
}
using pg8::Unit;

struct EpiProj {
    bf16_t* O; const float* cosT; const float* sinT;
    __device__ __forceinline__ void operator()(const f32x4 (&acc)[2][2][4][2], const Unit& u, int wr, int wc, int fr, int fq) const {
        const bool latent = u.pm < 128;
#pragma unroll
        for (int ai = 0; ai < 2; ++ai)
#pragma unroll
            for (int m = 0; m < 4; ++m) {
                const int row = u.pm * 256 + ai * 128 + wr * 64 + 4 * fr + m;
                const int t = row & (S - 1);
                const int pos = (wc & 1) ? (t & 63) : (t >> 6);
#pragma unroll
                for (int bj = 0; bj < 2; ++bj) {
                    const int col = u.pn * 256 + bj * 128 + wc * 32 + 4 * fq;
                    f32x4 v0 = acc[ai][bj][m][0], v1 = acc[ai][bj][m][1];
                    const bool rope = latent && (u.pn == 4 || u.pn == 5 || (u.pn == 6 && bj == 0));
                    if (rope) {
                        const f32x4 cs = *(const f32x4*)(cosT + pos * 16 + 4 * fq), sn = *(const f32x4*)(sinT + pos * 16 + 4 * fq);
                        const f32x4 n0 = v0 * cs - v1 * sn, n1 = v1 * cs + v0 * sn; v0 = n0; v1 = n1;
                    }
                    bf16_t* p = O + (size_t)row * DIN + col;
                    u32x2 w0, w1; w0.x = pk2(v0[0], v0[1]); w0.y = pk2(v0[2], v0[3]); w1.x = pk2(v1[0], v1[1]); w1.y = pk2(v1[2], v1[3]);
                    *(u32x2*)p = w0; *(u32x2*)(p + 16) = w1;
                }
            }
    }
};
struct EpiDelta {
    bf16_t* O; const float* gate0; const float* gate1;
    __device__ __forceinline__ void operator()(const f32x4 (&acc)[2][2][4][2], const Unit& u, int wr, int wc, int fr, int fq) const {
        const float* gate = (u.pm >= 64) ? gate1 : gate0;
        f32x4 gv[2][2];
#pragma unroll
        for (int bj = 0; bj < 2; ++bj)
#pragma unroll
            for (int n = 0; n < 2; ++n) gv[bj][n] = *(const f32x4*)(gate + u.pn * 256 + bj * 128 + wc * 32 + n * 16 + 4 * fq);
#pragma unroll
        for (int ai = 0; ai < 2; ++ai)
#pragma unroll
            for (int m = 0; m < 4; ++m) {
                const size_t row = (size_t)u.pm * 256 + ai * 128 + wr * 64 + 4 * fr + m;
#pragma unroll
                for (int bj = 0; bj < 2; ++bj)
#pragma unroll
                    for (int n = 0; n < 2; ++n) {
                        const f32x4 v = gv[bj][n] * acc[ai][bj][m][n];
                        u32x2 w; w.x = pk2(v[0], v[1]); w.y = pk2(v[2], v[3]);
                        *(u32x2*)(O + row * D + u.pn * 256 + bj * 128 + wc * 32 + n * 16 + 4 * fq) = w;
                    }
            }
    }
};

__device__ __forceinline__ float dpp_ror1(float v)  { return __int_as_float(__builtin_amdgcn_update_dpp(0, __float_as_int(v), 0x121, 0xF, 0xF, true)); }
__device__ __forceinline__ float dpp_ror15(float v) { return __int_as_float(__builtin_amdgcn_update_dpp(0, __float_as_int(v), 0x12F, 0xF, 0xF, true)); }
__device__ __forceinline__ float dpp_shr1(float v)  { return __int_as_float(__builtin_amdgcn_update_dpp(0, __float_as_int(v), 0x111, 0xF, 0xF, true)); }
__device__ __forceinline__ float dpp_shl1(float v)  { return __int_as_float(__builtin_amdgcn_update_dpp(0, __float_as_int(v), 0x101, 0xF, 0xF, true)); }

#define DPP_FMAC4X2(C, SA, WA, CTRLA, SB, WB, CTRLB) do { float _c0 = (C)[0], _c1 = (C)[1], _c2 = (C)[2], _c3 = (C)[3]; \
    asm("s_nop 1\n\t" \
        "v_fmac_f32_dpp %0, %4, %8 " CTRLA " row_mask:0xf bank_mask:0xf bound_ctrl:1\n\t" \
        "v_fmac_f32_dpp %1, %5, %9 " CTRLA " row_mask:0xf bank_mask:0xf bound_ctrl:1\n\t" \
        "v_fmac_f32_dpp %2, %6, %10 " CTRLA " row_mask:0xf bank_mask:0xf bound_ctrl:1\n\t" \
        "v_fmac_f32_dpp %3, %7, %11 " CTRLA " row_mask:0xf bank_mask:0xf bound_ctrl:1\n\t" \
        "v_fmac_f32_dpp %0, %12, %16 " CTRLB " row_mask:0xf bank_mask:0xf bound_ctrl:1\n\t" \
        "v_fmac_f32_dpp %1, %13, %17 " CTRLB " row_mask:0xf bank_mask:0xf bound_ctrl:1\n\t" \
        "v_fmac_f32_dpp %2, %14, %18 " CTRLB " row_mask:0xf bank_mask:0xf bound_ctrl:1\n\t" \
        "v_fmac_f32_dpp %3, %15, %19 " CTRLB " row_mask:0xf bank_mask:0xf bound_ctrl:1" \
        : "+v"(_c0), "+v"(_c1), "+v"(_c2), "+v"(_c3) \
        : "v"((SA)[0]), "v"((SA)[1]), "v"((SA)[2]), "v"((SA)[3]), "v"((WA)[0]), "v"((WA)[1]), "v"((WA)[2]), "v"((WA)[3]), \
          "v"((SB)[0]), "v"((SB)[1]), "v"((SB)[2]), "v"((SB)[3]), "v"((WB)[0]), "v"((WB)[1]), "v"((WB)[2]), "v"((WB)[3])); \
    (C)[0] = _c0; (C)[1] = _c1; (C)[2] = _c2; (C)[3] = _c3; } while (0)
#define DPP_FMAC4(C, SA, WA, CTRLA) do { float _c0 = (C)[0], _c1 = (C)[1], _c2 = (C)[2], _c3 = (C)[3]; \
    asm("s_nop 1\n\t" \
        "v_fmac_f32_dpp %0, %4, %8 " CTRLA " row_mask:0xf bank_mask:0xf bound_ctrl:1\n\t" \
        "v_fmac_f32_dpp %1, %5, %9 " CTRLA " row_mask:0xf bank_mask:0xf bound_ctrl:1\n\t" \
        "v_fmac_f32_dpp %2, %6, %10 " CTRLA " row_mask:0xf bank_mask:0xf bound_ctrl:1\n\t" \
        "v_fmac_f32_dpp %3, %7, %11 " CTRLA " row_mask:0xf bank_mask:0xf bound_ctrl:1" \
        : "+v"(_c0), "+v"(_c1), "+v"(_c2), "+v"(_c3) \
        : "v"((SA)[0]), "v"((SA)[1]), "v"((SA)[2]), "v"((SA)[3]), "v"((WA)[0]), "v"((WA)[1]), "v"((WA)[2]), "v"((WA)[3])); \
    (C)[0] = _c0; (C)[1] = _c1; (C)[2] = _c2; (C)[3] = _c3; } while (0)
struct EpiConvGate {
    bf16_t* act; const float* cw; const float* cbias; LAS unsigned char* xl;
    __device__ __forceinline__ void operator()(const f32x4 (&acc)[2][2][4][2], const Unit& u, int wr, int wc, int fr, int fq) const {
        if (wr == 0) { __builtin_amdgcn_s_barrier(); } asm volatile("" ::: "memory");
        LAS float* X = (LAS float*)xl;
        f32x4 wq[2][2][4];
#define CG_LOADW(N) do { _Pragma("unroll") for (int bj = 0; bj < 2; ++bj) { const int ch = 128 * u.pn + 32 * wc + 16 * (N) + 4 * fq + bj * DFF; \
            wq[N][bj][0] = *(const f32x4*)(cw + ch); wq[N][bj][1] = *(const f32x4*)(cw + DUP + ch); wq[N][bj][2] = *(const f32x4*)(cw + 2 * DUP + ch); wq[N][bj][3] = *(const f32x4*)(cbias + ch); } } while (0)
        CG_LOADW(0);
#pragma unroll
        for (int ai = 0; ai < 2; ++ai) {
            const int s = 2 * ai + wr;
            if (fr == 0) {
#pragma unroll
                for (int bj = 0; bj < 2; ++bj)
#pragma unroll
                    for (int n = 0; n < 2; ++n) *(LAS f32x4*)(X + ((s * 2 + 0) * 2 + bj) * 128 + 32 * wc + 16 * n + 4 * fq) = acc[ai][bj][0][n];
            }
            if (fr == 15) {
#pragma unroll
                for (int bj = 0; bj < 2; ++bj)
#pragma unroll
                    for (int n = 0; n < 2; ++n) *(LAS f32x4*)(X + ((s * 2 + 1) * 2 + bj) * 128 + 32 * wc + 16 * n + 4 * fq) = acc[ai][bj][3][n];
            }
        }
        asm volatile("s_waitcnt lgkmcnt(0)" ::: "memory");
        __builtin_amdgcn_s_barrier(); asm volatile("" ::: "memory");
#pragma unroll
        for (int n = 0; n < 2; ++n) {
            const int chg = 128 * u.pn + 32 * wc + 16 * n + 4 * fq;
            if (n == 1) CG_LOADW(1);
            f32x4 w0[2], w1[2], w2[2], bb[2], w0m[2], w2m[2];
#pragma unroll
            for (int bj = 0; bj < 2; ++bj) {
                w0[bj] = wq[n][bj][0]; w1[bj] = wq[n][bj][1]; w2[bj] = wq[n][bj][2]; bb[bj] = wq[n][bj][3];
                w0m[bj] = (fr == 0) ? w0[bj] : (f32x4){0.f, 0.f, 0.f, 0.f}; w2m[bj] = (fr == 15) ? w2[bj] : (f32x4){0.f, 0.f, 0.f, 0.f};
            }
#pragma unroll
            for (int ai = 0; ai < 2; ++ai) {
                const int s = 2 * ai + wr;
                f32x4 xp[2], xn[2];
#pragma unroll
                for (int bj = 0; bj < 2; ++bj) {
                    xp[bj] = *(const LAS f32x4*)(X + ((((s + 3) & 3) * 2 + 1) * 2 + bj) * 128 + 32 * wc + 16 * n + 4 * fq);
                    xn[bj] = *(const LAS f32x4*)(X + ((((s + 1) & 3) * 2 + 0) * 2 + bj) * 128 + 32 * wc + 16 * n + 4 * fq);
                }
                f32x4 cvv[4][2];
#pragma unroll
                for (int bj = 0; bj < 2; ++bj) {
                    const f32x4 a0 = acc[ai][bj][0][n], a1 = acc[ai][bj][1][n], a2 = acc[ai][bj][2][n], a3 = acc[ai][bj][3][n];
                    f32x4 c0 = bb[bj] + w1[bj] * a0 + w2[bj] * a1 + w0m[bj] * xp[bj];
                    f32x4 c1 = bb[bj] + w1[bj] * a1 + w0[bj] * a0 + w2[bj] * a2;
                    f32x4 c2 = bb[bj] + w1[bj] * a2 + w0[bj] * a1 + w2[bj] * a3;
                    f32x4 c3 = bb[bj] + w1[bj] * a3 + w0[bj] * a2 + w2m[bj] * xn[bj];
                    DPP_FMAC4(c0, a3, w0[bj], "row_shr:1");
                    DPP_FMAC4(c3, a0, w2[bj], "row_shl:1");
                    cvv[0][bj] = c0; cvv[1][bj] = c1; cvv[2][bj] = c2; cvv[3][bj] = c3;
                }
#pragma unroll
                for (int m = 0; m < 4; ++m) {
                    const int lr = 128 * ai + 64 * wr + 4 * fr + m;
                    const int R = 254 * u.pm + lr;
                    const int b = R >= (H2_BSTRIDE + 1) ? 1 : 0;
                    const int t = R - 1 - H2_BSTRIDE * b;
                    const bool valid = lr >= 1 && lr <= 254 && t >= 0 && t < S;
                    if (valid) {
                        u32x2 w;
                        w.x = pk2(silu_(cvv[m][0][0]) * cvv[m][1][0], silu_(cvv[m][0][1]) * cvv[m][1][1]);
                        w.y = pk2(silu_(cvv[m][0][2]) * cvv[m][1][2], silu_(cvv[m][0][3]) * cvv[m][1][3]);
                        *(u32x2*)(act + (size_t)(b * S + t) * DFF + chg) = w;
                    }
                }
            }
        }
        asm volatile("" ::: "memory"); if (wr == 1) { __builtin_amdgcn_s_barrier(); }
    }
};

#undef CG_LOADW
__device__ __forceinline__ void transpose_item(const float* W, int N, int k0, int n0, bf16_t* dst, int Kd, float* scr, int lane) {
#pragma unroll 16
    for (int i = 0; i < 32; ++i) { const int kk = 2 * i + (lane >> 5); scr[kk * 33 + (lane & 31)] = __builtin_nontemporal_load(W + (size_t)(k0 + kk) * N + n0 + (lane & 31)); }
    __builtin_amdgcn_wave_barrier();
    const int c = lane & 7;
#pragma unroll
    for (int j = 0; j < 4; ++j) {
        const int n = (lane >> 3) + 8 * j; const float* s = scr + (8 * c) * 33 + n;
        u32x4 o; o.x = pk2(s[0], s[33]); o.y = pk2(s[2 * 33], s[3 * 33]); o.z = pk2(s[4 * 33], s[5 * 33]); o.w = pk2(s[6 * 33], s[7 * 33]);
        *(u32x4*)(dst + (size_t)n * Kd + k0 + 8 * c) = o;
    }
    __builtin_amdgcn_wave_barrier();
}

__device__ __forceinline__ void phase0(PP p, unsigned char* shm, int wv) {
    const int tid = tid_opaque(wv), lane = tid & 63, wave = tid >> 6;
    unsigned char* ws = p->ws;
    if (blockIdx.x < 192) {
        float* sv = (float*)shm;
        float* red = sv + 3 * 1024;
        for (int i = tid; i < 3 * 1024; i += 512) {
            const int j = i >> 10, k = i & 1023;
            const float v = (j < 2) ? p->c[j * 1024 + k] : p->c_ctx[k];
            sv[i] = silu_(v);
        }
        __syncthreads();
        const int n0 = blockIdx.x * 32, col = tid & 31, ks = tid >> 5;
        float a0 = 0.f, a1 = 0.f, a2 = 0.f;
        const float* wp = p->w_mod + (size_t)(ks * 64) * 6144 + n0 + col;
#pragma unroll
        for (int k = 0; k < 64; ++k) {
            const float w = __builtin_nontemporal_load(wp + (size_t)k * 6144);
            a0 += sv[ks * 64 + k] * w; a1 += sv[1024 + ks * 64 + k] * w; a2 += sv[2048 + ks * 64 + k] * w;
        }
        red[(ks * 3 + 0) * 32 + col] = a0; red[(ks * 3 + 1) * 32 + col] = a1; red[(ks * 3 + 2) * 32 + col] = a2;
        __syncthreads();
        if (tid < 96) {
            const int j = tid >> 5, cc = tid & 31; float s = p->b_mod[n0 + cc];
            for (int k = 0; k < 16; ++k) s += red[(k * 3 + j) * 32 + cc];
            ((float*)(ws + WS_MOD))[j * 6144 + n0 + cc] = s;
        }
        __syncthreads();
    }
    if (blockIdx.x == 200) { for (int i = tid; i < 1024; i += 512) ((float*)(ws + WS_SP8))[i] = -8.0f * log1pf(expf(-p->lru_lam[i])); }
    if (blockIdx.x >= 192 && blockIdx.x < 200) {
        const int idx = (blockIdx.x - 192) * 512 + tid;
        const int pos = idx >> 4, i = idx & 15;
        const float inv = powf(10000.0f, -(float)i / 16.0f);
        const float ang = (float)pos * inv;
        ((float*)(ws + WS_ROPE))[idx] = cosf(ang);
        ((float*)(ws + WS_ROPE))[4096 + idx] = sinf(ang);
    }
}
__device__ __forceinline__ void transpose_phase(PP p, unsigned char* shm, int wv, int it_lo, int it_hi, int gw0, int NGW) {
    const int tid = tid_opaque(wv), lane = tid & 63, wave = wv;
    unsigned char* ws = p->ws;
    float* scr = (float*)(shm + 32768) + wave * (64 * 33);
    const int gw = gw0 + wave;
    constexpr int I_IN = (D / 64) * (DIN / 32), I_OUT = (D / 64) * (D / 32), I_UP = (D / 64) * (DUP / 32), I_DN = (DFF / 64) * (D / 32), I_LRU = 2 * 2 * 8 * 2;
    constexpr int NIT = I_IN + I_OUT + I_UP + I_DN + I_LRU;
    (void)NIT;
    for (int it = it_lo + gw; it < it_hi; it += NGW) {
        int r = it;
        if (r >= I_IN + I_OUT + I_UP + I_DN + I_LRU) continue;
        if (r < I_IN) { const int nb = DIN / 32, kb = r / nb, n0 = (r % nb) * 32; transpose_item(p->w_in, DIN, kb * 64, n0, (bf16_t*)(ws + WS_WIN) + (size_t)n0 * D, D, scr, lane); continue; } r -= I_IN;
        if (r < I_OUT) { const int nb = D / 32, kb = r / nb, n0 = (r % nb) * 32; transpose_item(p->w_out, D, kb * 64, n0, (bf16_t*)(ws + WS_WOUT) + (size_t)n0 * D, D, scr, lane); continue; } r -= I_OUT;
        if (r < I_UP) { const int nb = DUP / 32, kb = r / nb, n0 = (r % nb) * 32;
            const int isv = n0 >= DFF, nn = isv ? n0 - DFF : n0, drow = (nn / 128) * 256 + isv * 128 + (nn % 128);
            transpose_item(p->w_up, DUP, kb * 64, n0, (bf16_t*)(ws + WS_WUP) + (size_t)drow * D, D, scr, lane); continue; } r -= I_UP;
        if (r < I_DN) { const int nb = D / 32, kb = r / nb, n0 = (r % nb) * 32; transpose_item(p->w_down, D, kb * 64, n0, (bf16_t*)(ws + WS_WDN) + (size_t)n0 * DFF, DFF, scr, lane); continue; } r -= I_DN;
        {
            const int nh = r & 1, blk = (r >> 1) & 7, type = (r >> 4) & 1, dir = r >> 5;
            const float* src = (type ? p->lru_w_i : p->lru_w_a) + (size_t)(dir * 8 + blk) * 4096;
            bf16_t* dst = (bf16_t*)(ws + WS_LRU) + (size_t)((dir * 2 + type) * 8 + blk) * 4096 + (size_t)(nh * 32) * 64;
            transpose_item(src, 64, 0, nh * 32, dst, 64, scr, lane);
        }
    }
}

__device__ __forceinline__ void row_load_nt(const float* src, int lane, f32x4 (&v)[4]) {
#pragma unroll
    for (int j = 0; j < 4; ++j) v[j] = __builtin_nontemporal_load((const f32x4*)(src + 4 * lane + 256 * j));
}
__device__ __forceinline__ void row_load(const float* src, int lane, f32x4 (&v)[4]) {
#pragma unroll
    for (int j = 0; j < 4; ++j) v[j] = *(const f32x4*)(src + 4 * lane + 256 * j);
}
__device__ __forceinline__ float row_rstd(const f32x4 (&v)[4]) {
    float ss = 0.f;
#pragma unroll
    for (int j = 0; j < 4; ++j) ss += v[j][0] * v[j][0] + v[j][1] * v[j][1] + v[j][2] * v[j][2] + v[j][3] * v[j][3];
    return rsqrtf(wave_sum(ss) * (1.0f / D) + EPS);
}
__device__ __forceinline__ void norm_mod_store(const f32x4 (&v)[4], float rstd, const float* g, const float* sh, const float* sc, bf16_t* dst, int lane) {
#pragma unroll
    for (int j = 0; j < 4; ++j) {
        const int c = 4 * lane + 256 * j;
        const f32x4 gg = *(const f32x4*)(g + c), s1 = *(const f32x4*)(sc + c), s0 = *(const f32x4*)(sh + c);
        const f32x4 o = (v[j] * rstd * gg) * (s1 + 1.0f) + s0;
        u32x2 w; w.x = pk2(o[0], o[1]); w.y = pk2(o[2], o[3]);
        *(u32x2*)(dst + c) = w;
    }
}
__device__ __forceinline__ void phase1(PP p, int wv) {
    const int tid_ = tid_opaque(wv), lane = tid_ & 63, gw = blockIdx.x * 8 + (tid_ >> 6), NGW = gridDim.x * 8;
    const float* mod = (const float*)(p->ws + WS_MOD);
    bf16_t* hb = (bf16_t*)(p->ws + WS_HB);
    int cur = -1; f32x4 gsc[4], gsh[4];
    for (int r0 = gw; r0 < MROWS; r0 += 4 * NGW) {
        f32x4 v[4][4];
#pragma unroll
        for (int q = 0; q < 4; ++q) {
            const int r = (r0 + q * NGW < MROWS) ? r0 + q * NGW : r0;
            row_load_nt(r < NLAT ? p->x + (size_t)r * D : p->ctx + (size_t)(r - NLAT) * D, lane, v[q]);
        }
#pragma unroll
        for (int q = 0; q < 4; ++q) {
            const int r = r0 + q * NGW;
            if (r < MROWS) {
                const int mi = r < NLAT ? (r >> 14) : 2;
                if (mi != cur) {
                    cur = mi;
#pragma unroll
                    for (int j = 0; j < 4; ++j) {
                        const int c = 4 * lane + 256 * j;
                        gsc[j] = *(const f32x4*)(p->norm1_g + c) * (*(const f32x4*)(mod + mi * 6144 + 1024 + c) + 1.0f);
                        gsh[j] = *(const f32x4*)(mod + mi * 6144 + c);
                    }
                }
                const float rstd = row_rstd(v[q]);
#pragma unroll
                for (int j = 0; j < 4; ++j) {
                    const f32x4 o = v[q][j] * rstd * gsc[j] + gsh[j];
                    u32x2 w; w.x = pk2(o[0], o[1]); w.y = pk2(o[2], o[3]);
                    *(u32x2*)(hb + (size_t)r * D + 4 * lane + 256 * j) = w;
                }
            }
        }
    }
}

typedef float f32x16 __attribute__((ext_vector_type(16)));
__device__ __forceinline__ unsigned cvt_pk_bf16(float lo, float hi) { unsigned r; asm("v_cvt_pk_bf16_f32 %0, %1, %2" : "=v"(r) : "v"(lo), "v"(hi)); return r; }
__device__ __forceinline__ void attn_mfma(PP p, unsigned char* shm, int wv) {
    const int tid = tid_opaque(wv);
    const int lane = tid & 63, wave = wv, l31 = lane & 31, hl = lane >> 5;
    const bf16_t* proj = (const bf16_t*)(p->ws + WS_PROJ);
    bf16_t* att = (bf16_t*)(p->ws + WS_ATT);
    const float L2E = 1.4426950408889634f;
    const float SC2 = 0.125f * L2E;
    for (int item = blockIdx.x; item < 512; item += gridDim.x) {
        const int hk = item & 1, qb = (item >> 1) & 127, b = item >> 8;
        const int g = wave >> 1, qh = wave & 1, hq = hk * 4 + g;
        const int qrow0 = b * S + 128 * qb + 64 * qh;
        bf16x8 qf[2][4];
#pragma unroll
        for (int qi = 0; qi < 2; ++qi)
#pragma unroll
            for (int st = 0; st < 4; ++st) qf[qi][st] = *(const bf16x8*)(proj + (size_t)(qrow0 + 32 * qi + l31) * DIN + 1024 + 64 * hq + 16 * st + 8 * hl);
        const float sink2 = p->attn_sink[hq] * L2E;
        float mrun[2] = {sink2, sink2};
        float lrun[2] = {hl == 0 ? 1.f : 0.f, hl == 0 ? 1.f : 0.f};
        f32x16 oacc[2][2];
#pragma unroll
        for (int a = 0; a < 2; ++a)
#pragma unroll
            for (int c = 0; c < 2; ++c)
#pragma unroll
                for (int i = 0; i < 16; ++i) oacc[a][c][i] = 0.f;
        u32x4 kreg[2], vreg[2];
        int ci = (qb == 0) ? 1 : 0;
#define ATT_GLOAD(CI) do { const int _row0 = (CI) < 3 ? b * S + 128 * (qb - 1 + (CI)) : NLAT + b * LC + 128 * ((CI) - 3); \
        _Pragma("unroll") for (int _i = 0; _i < 2; ++_i) { const int _pi = tid + 512 * _i, _key = _pi >> 3, _part = _pi & 7; \
            const bf16_t* _src = proj + (size_t)(_row0 + _key) * DIN + 1536 + 64 * hk + 8 * _part; kreg[_i] = *(const u32x4*)_src; vreg[_i] = *(const u32x4*)(_src + 128); } } while (0)
#define ATT_STAGE(PAR) do { bf16_t* _K = (bf16_t*)(shm + (PAR) * 36864); bf16_t* _V = (bf16_t*)(shm + (PAR) * 36864 + 18432); \
        _Pragma("unroll") for (int i = 0; i < 2; ++i) { const int pi = tid + 512 * i, key = pi >> 3, part = pi & 7; \
            *(u32x4*)(_K + key * 72 + 8 * part) = kreg[i]; \
            _Pragma("unroll") for (int e = 0; e < 8; ++e) { const unsigned w = vreg[i][e >> 1]; _V[(8 * part + e) * 132 + key] = (bf16_t)((e & 1) ? (w >> 16) : (w & 0xFFFFu)); } } } while (0)
#define ATT_NEXT(C) (((C) + 1 == 2 && qb == 127) ? 3 : (C) + 1)
        ATT_GLOAD(ci);
        __syncthreads();
        ATT_STAGE(0);
        { const int c1 = ATT_NEXT(ci); if (c1 < 5) ATT_GLOAD(c1); }
        __syncthreads();
        int par = 0;
        while (ci < 5) {
            const int cn = ATT_NEXT(ci);
            if (cn < 5) { ATT_STAGE(par ^ 1); const int c2 = ATT_NEXT(cn); if (c2 < 5) ATT_GLOAD(c2); }
            const bf16_t* Ks = (const bf16_t*)(shm + par * 36864);
            const bf16_t* Vt = (const bf16_t*)(shm + par * 36864 + 18432);
            const int kt_lo = (ci == 0 && qh == 1) ? 2 : 0, kt_hi = (ci == 2 && qh == 0) ? 2 : 4;
#pragma unroll 1
            for (int kt = kt_lo; kt < kt_hi; ++kt) {
                bf16x8 kf[4];
#pragma unroll
                for (int st = 0; st < 4; ++st) kf[st] = *(const bf16x8*)(Ks + (32 * kt + l31) * 72 + 16 * st + 8 * hl);
                bf16x8 vf[2][2];
#pragma unroll
                for (int db = 0; db < 2; ++db)
#pragma unroll
                    for (int s2 = 0; s2 < 2; ++s2) {
                        const bf16_t* vp = Vt + (32 * db + l31) * 132 + 32 * kt + 16 * s2 + 4 * hl;
                        const u32x2 lo = *(const u32x2*)vp, hi = *(const u32x2*)(vp + 8);
                        u32x4 w; w.x = lo.x; w.y = lo.y; w.z = hi.x; w.w = hi.y;
                        vf[db][s2] = __builtin_bit_cast(bf16x8, w);
                    }
#pragma unroll
                for (int qi = 0; qi < 2; ++qi) {
                    f32x16 s;
#pragma unroll
                    for (int i = 0; i < 16; ++i) s[i] = 0.f;
#pragma unroll
                    for (int st = 0; st < 4; ++st) s = __builtin_amdgcn_mfma_f32_32x32x16_bf16(kf[st], qf[qi][st], s, 0, 0, 0);
                    if (ci == 0 || ci == 2) {
                        asm volatile("");
                        const int dl = (ci == 0) ? (32 * kt + 4 * hl - (64 * qh + 32 * qi + l31)) : ((64 * qh + 32 * qi + l31) - 32 * kt - 4 * hl);
#pragma unroll
                        for (int i = 0; i < 16; ++i) {
                            const int ki = 8 * (i >> 2) + (i & 3);
                            const bool ok = (ci == 0) ? (dl + ki >= 0) : (dl - ki >= 0);
                            s[i] = ok ? s[i] : -1e30f;
                        }
                    }
                    float mx = s[0];
#pragma unroll
                    for (int i = 1; i < 16; ++i) mx = fmaxf(mx, s[i]);
                    mx = fmaxf(mx, __shfl_xor(mx, 32));
                    const float mnew = fmaxf(mrun[qi], mx * SC2);
                    if (__builtin_amdgcn_ballot_w64(mnew > mrun[qi]) != 0ull) {
                        const float alpha = __builtin_amdgcn_exp2f(mrun[qi] - mnew);
                        lrun[qi] *= alpha;
#pragma unroll
                        for (int db = 0; db < 2; ++db)
#pragma unroll
                            for (int i = 0; i < 16; ++i) oacc[db][qi][i] *= alpha;
                        mrun[qi] = mnew;
                    }
                    float ls = 0.f;
#pragma unroll
                    for (int i = 0; i < 16; ++i) { s[i] = __builtin_amdgcn_exp2f(__builtin_fmaf(s[i], SC2, -mnew)); ls += s[i]; }
                    lrun[qi] += ls;
                    bf16x8 pf[2];
#pragma unroll
                    for (int s2 = 0; s2 < 2; ++s2) {
                        u32x4 w; w.x = cvt_pk_bf16(s[8 * s2 + 0], s[8 * s2 + 1]); w.y = cvt_pk_bf16(s[8 * s2 + 2], s[8 * s2 + 3]);
                        w.z = cvt_pk_bf16(s[8 * s2 + 4], s[8 * s2 + 5]); w.w = cvt_pk_bf16(s[8 * s2 + 6], s[8 * s2 + 7]);
                        pf[s2] = __builtin_bit_cast(bf16x8, w);
                    }
#pragma unroll
                    for (int db = 0; db < 2; ++db)
#pragma unroll
                        for (int s2 = 0; s2 < 2; ++s2) oacc[db][qi] = __builtin_amdgcn_mfma_f32_32x32x16_bf16(vf[db][s2], pf[s2], oacc[db][qi], 0, 0, 0);
                }
            }
            __syncthreads();
            ci = cn; par ^= 1;
        }
#undef ATT_STAGE
#undef ATT_NEXT
#undef ATT_GLOAD
#pragma unroll
        for (int qi = 0; qi < 2; ++qi) {
            const float lt = lrun[qi] + __shfl_xor(lrun[qi], 32);
            const float inv = 1.0f / lt;
            bf16_t* orow = att + (size_t)(qrow0 + 32 * qi + l31) * 512 + hq * 64;
#pragma unroll
            for (int db = 0; db < 2; ++db)
#pragma unroll
                for (int g4 = 0; g4 < 4; ++g4) {
                    u32x2 w; w.x = cvt_pk_bf16(oacc[db][qi][4 * g4] * inv, oacc[db][qi][4 * g4 + 1] * inv); w.y = cvt_pk_bf16(oacc[db][qi][4 * g4 + 2] * inv, oacc[db][qi][4 * g4 + 3] * inv);
                    *(u32x2*)(orow + 32 * db + 8 * g4 + 4 * hl) = w;
                }
        }
    }
    __syncthreads();
}


struct ScanW { bf16x8 wfa[4], wfi[4]; float ba, bi, sp8l2; };
__device__ __forceinline__ void scan_loadw(PP p, int dir, int n, int ct, int l31, int hl, ScanW& w) {
    unsigned chv = (unsigned)(32 * ct + l31); asm volatile("" : "+v"(chv));
    const unsigned ch = (unsigned)(dir * 512 + 64 * n) + chv;
    w.ba = p->lru_b_a[ch]; w.bi = p->lru_b_i[ch];
    w.sp8l2 = ((const float*)(p->ws + WS_SP8))[ch] * 1.4426950408889634f;
    const bf16_t* wa_b = (const bf16_t*)(p->ws + WS_LRU) + (size_t)((dir * 2 + 0) * 8 + n) * 4096;
    const bf16_t* wi_b = (const bf16_t*)(p->ws + WS_LRU) + (size_t)((dir * 2 + 1) * 8 + n) * 4096;
    const unsigned lo = chv * 64u + 8u * (unsigned)hl;
#pragma unroll
    for (int st = 0; st < 4; ++st) { w.wfa[st] = *(const bf16x8*)(wa_b + lo + 16 * st); w.wfi[st] = *(const bf16x8*)(wi_b + lo + 16 * st); }
}
template <int DIR>
__device__ __forceinline__ void scan_dir(PP p, const bf16_t* xs, const ScanW& w, ScanW& wn, int ndir, int nct, bool do_next, int n, int ct, int l31, int hl, int id, int rowbase, bool latent, float (&hf)[2][16]) {
    constexpr int XS = 520;
    const int ch = 64 * n + 32 * ct + l31;
    const float ba = w.ba, bi = w.bi, sp8l2 = w.sp8l2;
    const bf16x8 (&wfa)[4] = w.wfa; const bf16x8 (&wfi)[4] = w.wfi;
    float a[2][16], u[2][16];
#pragma unroll
    for (int rt = 0; rt < 2; ++rt) {
        bf16x8 af[4];
#pragma unroll
        for (int st = 0; st < 4; ++st) af[st] = *(const bf16x8*)(xs + (32 * rt + l31) * XS + 64 * n + 16 * st + 8 * hl);
        f32x16 ga, gi;
#pragma unroll
        for (int i = 0; i < 16; ++i) { ga[i] = 0.f; gi[i] = 0.f; }
#pragma unroll
        for (int st = 0; st < 4; ++st) { ga = __builtin_amdgcn_mfma_f32_32x32x16_bf16(af[st], wfa[st], ga, 0, 0, 0); gi = __builtin_amdgcn_mfma_f32_32x32x16_bf16(af[st], wfi[st], gi, 0, 0, 0); }
#pragma unroll
        for (int i = 0; i < 16; ++i) {
            const int token = 32 * rt + 8 * (i >> 2) + 4 * hl + (i & 3);
            const float xv = bf2f(xs[token * XS + ch]);
            const float rr = fast_sigmoid(ga[i] + ba), ii = fast_sigmoid(gi[i] + bi);
            const float la2 = rr * sp8l2;
            const float av = __builtin_amdgcn_exp2f(la2);
            const float t2 = la2 * 1.3862943611f;
            float em1p = t2 * (1.0f + t2 * (0.5f + t2 * (0.16666667f + t2 * (0.041666668f + t2 * 0.0083333333f)))), em1e = __builtin_fmaf(av, av, -1.0f);
            asm volatile("" : "+v"(em1p), "+v"(em1e));
            const float em1 = (t2 > -0.1f) ? em1p : em1e;
            a[rt][i] = av; u[rt][i] = __builtin_amdgcn_sqrtf(-em1) * (ii * xv);
        }
    }
    float Ao[8], Ho[8], Ap[8], Hp[8];
#pragma unroll
    for (int k = 0; k < 8; ++k) {
        const int rt = k >> 2, g = k & 3;
        float H = 0.f, A = 1.f;
#pragma unroll
        for (int jj = 0; jj < 4; ++jj) { const int j = DIR ? 3 - jj : jj; const float av = a[rt][4 * g + j]; H = av * H + u[rt][4 * g + j]; A *= av; }
        Ao[k] = A; Ho[k] = H; Ap[k] = __shfl_xor(A, 32); Hp[k] = __shfl_xor(H, 32);
    }
    float Sin[8], Pin[8]; float Sx = 0.f, Px = 1.f;
#pragma unroll
    for (int kk = 0; kk < 8; ++kk) {
        const int k = DIR ? 7 - kk : kk;
        const float A0 = hl ? Ap[k] : Ao[k], H0 = hl ? Hp[k] : Ho[k], A1 = hl ? Ao[k] : Ap[k], H1 = hl ? Ho[k] : Hp[k];
        float s0, p0, s1, p1;
        if (DIR == 0) { s0 = Sx; p0 = Px; Sx = A0 * Sx + H0; Px *= A0; s1 = Sx; p1 = Px; Sx = A1 * Sx + H1; Px *= A1; }
        else          { s1 = Sx; p1 = Px; Sx = A1 * Sx + H1; Px *= A1; s0 = Sx; p0 = Px; Sx = A0 * Sx + H0; Px *= A0; }
        Sin[k] = hl ? s1 : s0; Pin[k] = hl ? p1 : p0;
    }
    asm volatile("" ::: "memory");
    if (do_next) scan_loadw(p, ndir, n, nct, l31, hl, wn);
    bf16_t* yl = (bf16_t*)(p->ws + WS_YL) + (size_t)rowbase * 512; bf16_t* caf = (bf16_t*)(p->ws + WS_CAF) + (size_t)rowbase * 512; bf16_t* cab = (bf16_t*)(p->ws + WS_CAB) + (size_t)rowbase * 512;
    unsigned lo = (unsigned)ch; asm volatile("" : "+v"(lo));
#pragma unroll
    for (int k = 0; k < 8; ++k) {
        const int rt = k >> 2, g = k & 3;
        float h = Sin[k], P = Pin[k];
#pragma unroll
        for (int jj = 0; jj < 4; ++jj) {
            const int j = DIR ? 3 - jj : jj, idx = 4 * g + j;
            h = a[rt][idx] * h + u[rt][idx]; P *= a[rt][idx];
            const int token = 32 * rt + 8 * g + 4 * hl + j;
            const unsigned o = lo + (unsigned)token * 512u;
            if (DIR == 0) { hf[rt][idx] = h; if (latent) caf[o] = f2bf(P); }
            else if (latent) { yl[o] = f2bf(hf[rt][idx] + h); cab[o] = f2bf(P); }
        }
    }
    if (hl == 0) {
        float* sumb = (float*)(p->ws + WS_SUM);
        sumb[((size_t)(DIR * NCHUNK + id) * 2 + 0) * 512 + ch] = Px;
        sumb[((size_t)(DIR * NCHUNK + id) * 2 + 1) * 512 + ch] = Sx;
    }
}
__device__ __forceinline__ void scan_mfma(PP p, unsigned char* shm, int wv) {
    const int tid_ = tid_opaque(wv); const int tid = tid_;
    const int lane = tid & 63, n = wv, l31 = lane & 31, hl = lane >> 5;
    constexpr int XS = 520;
    bf16_t* xs = (bf16_t*)shm;
    const bf16_t* proj = (const bf16_t*)(p->ws + WS_PROJ);
    for (int item = blockIdx.x; item < 512 + 32; item += gridDim.x) {
        const int id = item < 512 ? item : 512 + ((item - 512) >> 2);
        const int quarter = item < 512 ? -1 : ((item - 512) & 3);
        int rowbase, t0, seqlen; bool latent;
        if (id < 512) { const int b = id >> 8, k = id & 255; t0 = 64 * k; rowbase = b * S + t0; seqlen = S; latent = true; }
        else { const int j = id - 512, b = j >> 2, k = j & 3; t0 = 64 * k; rowbase = NLAT + b * LC + t0; seqlen = LC; latent = false; }
        const int seqbase = rowbase - t0;
        ScanW w0, w1;
        if (quarter < 0) scan_loadw(p, 0, n, 0, l31, hl, w0);
        {
            const int tid = tid_opaque(wv);
            bf16_t* raw = (bf16_t*)(shm + 66560);
#pragma unroll
            for (int i = 0; i < 9; ++i) {
                const int piece = tid + 512 * i;
                if (piece < 67 * 64) {
                    const int row = piece >> 6, c8 = piece & 63, tt = t0 - 2 + row;
                    u32x4 v = {0u, 0u, 0u, 0u};
                    if (tt >= 0 && tt < seqlen) v = *(const u32x4*)(proj + (size_t)(seqbase + tt) * DIN + 8 * c8);
                    *(u32x4*)(raw + row * 512 + 8 * c8) = v;
                }
            }
            __syncthreads();
            const int cq = tid & 127, tq = tid >> 7, c4 = 4 * cq;
            const f32x4 k0 = *(const f32x4*)(p->rnn_conv_w + c4), k1 = *(const f32x4*)(p->rnn_conv_w + 512 + c4), k2 = *(const f32x4*)(p->rnn_conv_w + 1024 + c4),
                        k3 = *(const f32x4*)(p->rnn_conv_w + 1536 + c4), kb = *(const f32x4*)(p->rnn_conv_b + c4);
            auto ld4 = [&](int row) -> f32x4 { const u32x2 w = *(const u32x2*)(raw + row * 512 + c4); f32x4 r; r[0] = bflo(w.x); r[1] = bfhi(w.x); r[2] = bflo(w.y); r[3] = bfhi(w.y); return r; };
            f32x4 xm2 = ld4(16 * tq), xm1 = ld4(16 * tq + 1), x0 = ld4(16 * tq + 2);
#pragma unroll
            for (int t = 0; t < 16; ++t) {
                const f32x4 xp1 = ld4(16 * tq + t + 3);
                const f32x4 o = kb + k0 * xm2 + k1 * xm1 + k2 * x0 + k3 * xp1;
                u32x2 w; w.x = pk2(o[0], o[1]); w.y = pk2(o[2], o[3]);
                *(u32x2*)(xs + (16 * tq + t) * XS + c4) = w;
                xm2 = xm1; xm1 = x0; x0 = xp1;
            }
        }
        __syncthreads();
#pragma unroll 1
        for (int ct = 0; ct < 2; ++ct) {
            float hf[2][16];
            const bool run0 = quarter < 0 || quarter == 2 * ct, run1 = quarter < 0 || quarter == 2 * ct + 1;
            if (quarter >= 0) { if (run0) scan_loadw(p, 0, n, ct, l31, hl, w0); if (run1) scan_loadw(p, 1, n, ct, l31, hl, w1); }
            if (run0) scan_dir<0>(p, xs, w0, w1, 1, ct, quarter < 0, n, ct, l31, hl, id, rowbase, latent, hf);
            if (run1) scan_dir<1>(p, xs, w1, w0, 0, 1, quarter < 0 && ct == 0, n, ct, l31, hl, id, rowbase, latent, hf);
        }
        __syncthreads();
    }
}

__device__ __forceinline__ void carry_phase(PP p, unsigned char* shm, int wv) {
    if (blockIdx.x >= 128) return;
    const int tid = tid_opaque(wv), cl = tid & 15, sg = tid >> 4;
    const int b = blockIdx.x >> 6, dir = (blockIdx.x >> 5) & 1, c = (blockIdx.x & 31) * 16 + cl;
    const float* sumb = (const float*)(p->ws + WS_SUM) + (size_t)dir * NCHUNK * 1024;
    float* car = (float*)(p->ws + WS_CAR) + (size_t)dir * NCHUNK * 512;
    float* segA = (float*)shm; float* segH = segA + 512;
    float A[9], H[9]; int ids[9];
#pragma unroll
    for (int k = 0; k < 9; ++k) {
        const int s = sg * 9 + k;
        int id = -1;
        if (s < 260) { if (dir == 0) id = s < 4 ? 512 + 4 * b + s : 256 * b + (s - 4); else id = s < 4 ? 512 + 4 * b + (3 - s) : 256 * b + (255 - (s - 4)); }
        ids[k] = id;
        A[k] = id >= 0 ? sumb[(size_t)id * 1024 + c] : 1.f;
        H[k] = id >= 0 ? sumb[(size_t)id * 1024 + 512 + c] : 0.f;
    }
    float As = 1.f, Hs = 0.f;
#pragma unroll
    for (int k = 0; k < 9; ++k) { Hs = A[k] * Hs + H[k]; As *= A[k]; }
    segA[sg * 16 + cl] = As; segH[sg * 16 + cl] = Hs;
    __syncthreads();
    float h = 0.f;
    for (int j = 0; j < sg; ++j) h = segA[j * 16 + cl] * h + segH[j * 16 + cl];
#pragma unroll
    for (int k = 0; k < 9; ++k) { if (ids[k] >= 0) car[(size_t)ids[k] * 512 + c] = h; h = A[k] * h + H[k]; }
    __syncthreads();
}

struct MixRow { u32x4 vy, vf, vb, vg, va; f32x4 cf0, cf1, cb0, cb1; };
__device__ __forceinline__ void mix_load(PP p, int r, int c0, MixRow& m) {
    const bf16_t* proj = (const bf16_t*)(p->ws + WS_PROJ);
    const bf16_t* att = (const bf16_t*)(p->ws + WS_ATT);
    const bf16_t* yl = (const bf16_t*)(p->ws + WS_YL); const bf16_t* caf = (const bf16_t*)(p->ws + WS_CAF); const bf16_t* cab = (const bf16_t*)(p->ws + WS_CAB);
    const float* car = (const float*)(p->ws + WS_CAR);
    const int id = r >> 6;
    m.vy = *(const u32x4*)(yl + (size_t)r * 512 + c0); m.vf = *(const u32x4*)(caf + (size_t)r * 512 + c0); m.vb = *(const u32x4*)(cab + (size_t)r * 512 + c0);
    m.vg = *(const u32x4*)(proj + (size_t)r * DIN + 512 + c0); m.va = *(const u32x4*)(att + (size_t)r * 512 + c0);
    const float* cf = car + (size_t)id * 512 + c0; const float* cbk = car + (size_t)(NCHUNK + id) * 512 + c0;
    m.cf0 = *(const f32x4*)cf; m.cf1 = *(const f32x4*)(cf + 4); m.cb0 = *(const f32x4*)cbk; m.cb1 = *(const f32x4*)(cbk + 4);
}
__device__ __forceinline__ void mix_store(PP p, int r, int c0, const MixRow& m, const f32x4 (&gr)[2], const f32x4 (&ga)[2]) {
    bf16_t* mix = (bf16_t*)(p->ws + WS_HB);
    float rn[8], at[8]; float s1 = 0.f, s2 = 0.f;
#pragma unroll
    for (int e = 0; e < 8; ++e) {
        const unsigned wy = m.vy[e >> 1], wf = m.vf[e >> 1], wb = m.vb[e >> 1], wg = m.vg[e >> 1], wa = m.va[e >> 1];
        const float cfe = e < 4 ? m.cf0[e & 3] : m.cf1[e & 3], cbe = e < 4 ? m.cb0[e & 3] : m.cb1[e & 3];
        const float y = ((e & 1) ? bfhi(wy) : bflo(wy)) + ((e & 1) ? bfhi(wf) : bflo(wf)) * cfe + ((e & 1) ? bfhi(wb) : bflo(wb)) * cbe;
        const float xg = (e & 1) ? bfhi(wg) : bflo(wg);
        rn[e] = gelu_tanh_(xg) * y; s1 += rn[e] * rn[e];
        at[e] = (e & 1) ? bfhi(wa) : bflo(wa); s2 += at[e] * at[e];
    }
    const float r1 = rsqrtf(wave_sum(s1) * (1.0f / 512.0f) + EPS), r2 = rsqrtf(wave_sum(s2) * (1.0f / 512.0f) + EPS);
    u32x4 o1, o2;
#pragma unroll
    for (int e2 = 0; e2 < 4; ++e2) {
        o1[e2] = pk2(rn[2 * e2] * r1 * gr[e2 >> 1][(2 * e2) & 3], rn[2 * e2 + 1] * r1 * gr[e2 >> 1][(2 * e2 + 1) & 3]);
        o2[e2] = pk2(at[2 * e2] * r2 * ga[e2 >> 1][(2 * e2) & 3], at[2 * e2 + 1] * r2 * ga[e2 >> 1][(2 * e2 + 1) & 3]);
    }
    *(u32x4*)(mix + (size_t)r * D + c0) = o1; *(u32x4*)(mix + (size_t)r * D + 512 + c0) = o2;
}
__device__ __forceinline__ void mix_phase(PP p, int wv) {
    const int tid_ = tid_opaque(wv), lane = tid_ & 63, gw = blockIdx.x * 8 + (tid_ >> 6), NGW = gridDim.x * 8;
    const int c0 = 8 * lane;
    f32x4 gr[2], ga[2];
    gr[0] = *(const f32x4*)(p->gn_rnn + c0); gr[1] = *(const f32x4*)(p->gn_rnn + c0 + 4); ga[0] = *(const f32x4*)(p->gn_attn + c0); ga[1] = *(const f32x4*)(p->gn_attn + c0 + 4);
    for (int r = gw; r < NLAT; r += 2 * NGW) {
        const int rb = (r + NGW < NLAT) ? r + NGW : r;
        MixRow ma, mb;
        mix_load(p, r, c0, ma); mix_load(p, rb, c0, mb);
        mix_store(p, r, c0, ma, gr, ga);
        if (rb != r) mix_store(p, rb, c0, mb, gr, ga);
    }
}

__device__ __forceinline__ void phase7(PP p, int wv) {
    const int tid_ = tid_opaque(wv), lane = tid_ & 63, gw = blockIdx.x * 8 + (tid_ >> 6), NGW = gridDim.x * 8;
    const float* mod = (const float*)(p->ws + WS_MOD);
    bf16_t* hb = (bf16_t*)(p->ws + WS_HB);
    const bf16_t* o1 = (const bf16_t*)(p->ws + WS_O1);
    for (int r = gw; r < NLAT; r += 2 * NGW) {
        const int rb = r + NGW;
        f32x4 va[4], vb[4]; u32x2 da[4], db[4];
        row_load_nt(p->x + (size_t)r * D, lane, va); row_load_nt(p->x + (size_t)rb * D, lane, vb);
#pragma unroll
        for (int j = 0; j < 4; ++j) { da[j] = *(const u32x2*)(o1 + (size_t)r * D + 4 * lane + 256 * j); db[j] = *(const u32x2*)(o1 + (size_t)rb * D + 4 * lane + 256 * j); }
#pragma unroll
        for (int j = 0; j < 4; ++j) {
            va[j][0] += bflo(da[j].x); va[j][1] += bfhi(da[j].x); va[j][2] += bflo(da[j].y); va[j][3] += bfhi(da[j].y);
            vb[j][0] += bflo(db[j].x); vb[j][1] += bfhi(db[j].x); vb[j][2] += bflo(db[j].y); vb[j][3] += bfhi(db[j].y);
        }
        const float sa = row_rstd(va), sb = row_rstd(vb);
        const int ma = r >> 14, mb = rb >> 14;
        norm_mod_store(va, sa, p->norm2_g, mod + ma * 6144 + 3072, mod + ma * 6144 + 4096, hb + (size_t)(ma * H2_BSTRIDE + 1 + (r & (S - 1))) * D, lane);
        norm_mod_store(vb, sb, p->norm2_g, mod + mb * 6144 + 3072, mod + mb * 6144 + 4096, hb + (size_t)(mb * H2_BSTRIDE + 1 + (rb & (S - 1))) * D, lane);
    }
    for (int z = gw; z < 254; z += NGW) {
        const int R = z == 0 ? 0 : (z <= 126 ? S + z : 32895 + (z - 127));
        const u32x4 zz = {0u, 0u, 0u, 0u};
        *(u32x4*)(hb + (size_t)R * D + 8 * lane) = zz; *(u32x4*)(hb + (size_t)R * D + 512 + 8 * lane) = zz;
    }
}

__device__ __forceinline__ void final_phase(PP p, int wv) {
    const int tid_ = tid_opaque(wv), lane = tid_ & 63, gw = blockIdx.x * 8 + (tid_ >> 6), NGW = gridDim.x * 8;
    const bf16_t* o1 = (const bf16_t*)(p->ws + WS_O1); const bf16_t* o2 = (const bf16_t*)(p->ws + WS_O2);
    for (int r = gw; r < NLAT; r += 2 * NGW) {
        const int rb = r + NGW;
        f32x4 va[4], vb[4]; u32x2 da[4], db[4], ea[4], eb[4];
        row_load_nt(p->x + (size_t)r * D, lane, va); row_load_nt(p->x + (size_t)rb * D, lane, vb);
#pragma unroll
        for (int j = 0; j < 4; ++j) {
            da[j] = *(const u32x2*)(o1 + (size_t)r * D + 4 * lane + 256 * j); db[j] = *(const u32x2*)(o1 + (size_t)rb * D + 4 * lane + 256 * j);
            ea[j] = *(const u32x2*)(o2 + (size_t)r * D + 4 * lane + 256 * j); eb[j] = *(const u32x2*)(o2 + (size_t)rb * D + 4 * lane + 256 * j);
        }
#pragma unroll
        for (int j = 0; j < 4; ++j) {
            va[j][0] += bflo(da[j].x) + bflo(ea[j].x); va[j][1] += bfhi(da[j].x) + bfhi(ea[j].x); va[j][2] += bflo(da[j].y) + bflo(ea[j].y); va[j][3] += bfhi(da[j].y) + bfhi(ea[j].y);
            vb[j][0] += bflo(db[j].x) + bflo(eb[j].x); vb[j][1] += bfhi(db[j].x) + bfhi(eb[j].x); vb[j][2] += bflo(db[j].y) + bflo(eb[j].y); vb[j][3] += bfhi(db[j].y) + bfhi(eb[j].y);
        }
        const float sa = row_rstd(va), sb = row_rstd(vb);
        float* rowa = p->out + (size_t)r * D; float* rowb = p->out + (size_t)rb * D;
#pragma unroll
        for (int j = 0; j < 4; ++j) { const f32x4 gg = *(const f32x4*)(p->final_g + 4 * lane + 256 * j); *(f32x4*)(rowa + 4 * lane + 256 * j) = va[j] * sa * gg; *(f32x4*)(rowb + 4 * lane + 256 * j) = vb[j] * sb * gg; }
    }
}

__global__ void __launch_bounds__(512, 2) fwd_megakernel(Params p_arg) {
    extern __shared__ __attribute__((aligned(16))) unsigned char shm[];
    cg::grid_group grid = cg::this_grid();
    LAS unsigned char* lds = (LAS unsigned char*)shm;
    pg8::StaticOrder so;
    const int wv = __builtin_amdgcn_readfirstlane((int)(threadIdx.x >> 6));
    volatile LAS unsigned* xst = (volatile LAS unsigned*)(lds + LDS_XB);
    if (tid_opaque(wv) == 0) { xst[0] = 0u; xst[1] = 0u; }
    __syncthreads();
    (void)xcd_barrier_post((unsigned*)(kparams()->ws + WS_BAR), xst, wv);
#define XBAR() do { XcdBarrier _b; _b.bar = (unsigned*)(kparams()->ws + WS_BAR); _b.x = xb_xcc_id(); _b.st = (volatile LAS unsigned*)(lds + LDS_XB); xcd_barrier(_b, wv); } while (0)
    if (kparams()->out == nullptr) grid.sync();

    phase0(kparams(), shm, wv);
    {
        constexpr int T_IN = (D / 64) * (DIN / 32), T_B = (D / 64) * (D / 32) + (D / 64) * (DUP / 32) + (DFF / 64) * (D / 32), T_LRU = 64;
        const int nfree = (int)gridDim.x > 192 ? (int)gridDim.x - 192 : 0;
        const int first = nfree ? 192 : 0, nblk = nfree ? nfree : (int)gridDim.x;
        if ((int)blockIdx.x >= first) {
            transpose_phase(kparams(), shm, wv, 0, T_IN, ((int)blockIdx.x - first) * 8, nblk * 8);
            transpose_phase(kparams(), shm, wv, T_IN + T_B, T_IN + T_B + T_LRU, ((int)blockIdx.x - first) * 8, nblk * 8);
        }
    }
    XBAR();
    phase1(kparams(), wv);
    XBAR();
    {
        PP p = kparams(); unsigned char* ws = p->ws;
        pg8::Gemm g{(const bf16_t*)(ws + WS_HB), (const bf16_t*)(ws + WS_WIN), MROWS / 256, DIN / 256, D, 256};
        so.init(g.nM, g.nN, gridDim.x, blockIdx.x);
        EpiProj e{(bf16_t*)(ws + WS_PROJ), (const float*)(ws + WS_ROPE), (const float*)(ws + WS_ROPE) + 4096};
        pg8::gemm_phase(lds, g, so, e, wv);
        {
            constexpr int T_IN = (D / 64) * (DIN / 32), T_B = (D / 64) * (D / 32) + (D / 64) * (DUP / 32) + (DFF / 64) * (D / 32);
            const int G = (int)gridDim.x, rem = (g.nM * g.nN) % G;
            const int first = rem ? rem : 0, nblk = G - first;
            if ((int)blockIdx.x >= first) transpose_phase(p, shm, wv, T_IN, T_IN + T_B, ((int)blockIdx.x - first) * 8, nblk * 8);
        }
    }
    XBAR();
    scan_mfma(kparams(), shm, wv);
    attn_mfma(kparams(), shm, wv);
    XBAR();
    carry_phase(kparams(), shm, wv);
    XBAR();
    mix_phase(kparams(), wv);
    XBAR();
    {
        PP p = kparams(); unsigned char* ws = p->ws; const float* mod = (const float*)(ws + WS_MOD);
        pg8::Gemm g{(const bf16_t*)(ws + WS_HB), (const bf16_t*)(ws + WS_WOUT), NLAT / 256, D / 256, D, 256};
        so.init(g.nM, g.nN, gridDim.x, blockIdx.x);
        EpiDelta e{(bf16_t*)(ws + WS_O1), mod + 2048, mod + 6144 + 2048};
        pg8::gemm_phase(lds, g, so, e, wv);
    }
    XBAR();
    phase7(kparams(), wv);
    XBAR();
    {
        PP p = kparams(); unsigned char* ws = p->ws;
        pg8::Gemm g{(const bf16_t*)(ws + WS_HB), (const bf16_t*)(ws + WS_WUP), 130, DUP / 256, D, 254};
        so.init(g.nM, g.nN, gridDim.x, blockIdx.x);
        EpiConvGate e{(bf16_t*)(ws + WS_ACT), p->ffn_conv_w, p->ffn_conv_b, lds + 131072};
        pg8::gemm_phase(lds, g, so, e, wv);
    }
    XBAR();
    {
        PP p = kparams(); unsigned char* ws = p->ws; const float* mod = (const float*)(ws + WS_MOD);
        pg8::Gemm g{(const bf16_t*)(ws + WS_ACT), (const bf16_t*)(ws + WS_WDN), NLAT / 256, D / 256, DFF, 256};
        so.init(g.nM, g.nN, gridDim.x, blockIdx.x);
        EpiDelta e{(bf16_t*)(ws + WS_O2), mod + 5120, mod + 6144 + 5120};
        pg8::gemm_phase(lds, g, so, e, wv);
    }
    XBAR();
    final_phase(kparams(), wv);
}

extern "C" void kernel_launch(void* const* d_in, const int* in_sizes, int n_in, void* d_out, int out_size, void* d_ws, size_t ws_size, hipStream_t stream) {
    static int grid_blocks = 0;
    if (!grid_blocks) {
        int dev = 0, cus = 0, per_cu = 0;
        hipGetDevice(&dev);
        hipDeviceGetAttribute(&cus, hipDeviceAttributeMultiprocessorCount, dev);
        hipFuncSetAttribute((const void*)fwd_megakernel, hipFuncAttributeMaxDynamicSharedMemorySize, LDS_BYTES);
        hipOccupancyMaxActiveBlocksPerMultiprocessor(&per_cu, (const void*)fwd_megakernel, 512, LDS_BYTES);
        if (per_cu < 1) per_cu = 1;
        grid_blocks = cus * per_cu;
        if (ws_size < WS_END) fprintf(stderr, "kernel_launch: workspace too small: %zu < %zu\n", ws_size, (size_t)WS_END);
    }
    Params p{};
    const float** pp = (const float**)&p;
    for (int i = 0; i < 25; ++i) pp[i] = (const float*)d_in[i];
    p.out = (float*)d_out; p.ws = (unsigned char*)d_ws;
    hipMemsetAsync((unsigned char*)d_ws + WS_BAR, 0, 16384, stream);
    void* args[] = {&p};
    hipError_t e = hipLaunchCooperativeKernel((const void*)fwd_megakernel, dim3(grid_blocks), dim3(512), args, LDS_BYTES, stream);
    if (e != hipSuccess) fprintf(stderr, "cooperative launch failed: %s (grid %d)\n", hipGetErrorString(e), grid_blocks);
}
```

```cpp
#include <hip/hip_runtime.h>
#include <hip/hip_cooperative_groups.h>
#include <cstdio>
namespace cg = cooperative_groups;

#define LAS __attribute__((address_space(3)))
typedef unsigned short bf16_t;
typedef short bf16x8 __attribute__((ext_vector_type(8)));
typedef float f32x4 __attribute__((ext_vector_type(4)));
typedef unsigned u32x4 __attribute__((ext_vector_type(4)));
typedef unsigned u32x2 __attribute__((ext_vector_type(2)));

constexpr int D = 1024, NB = 2, S = 16384, LC = 256;
constexpr int NLAT = NB * S;
constexpr int NCTX = NB * LC;
constexpr int MROWS = NLAT + NCTX;
constexpr int DIN = 1792, DFF = 2816, DUP = 5632, DRNN = 512;
constexpr int NCHUNK = MROWS / 64;
constexpr float EPS = 1e-6f;

constexpr size_t AL(size_t x) { return (x + 255) & ~(size_t)255; }
constexpr size_t WS_WIN  = 0;
constexpr size_t WS_WOUT = WS_WIN  + AL((size_t)DIN * D * 2);
constexpr size_t WS_WUP  = WS_WOUT + AL((size_t)D * D * 2);
constexpr size_t WS_WDN  = WS_WUP  + AL((size_t)DUP * D * 2);
constexpr size_t WS_LRU  = WS_WDN  + AL((size_t)D * DFF * 2);
constexpr size_t WS_MOD  = WS_LRU  + AL((size_t)4 * 8 * 64 * 64 * 2);
constexpr size_t WS_ROPE = WS_MOD  + AL((size_t)3 * 6144 * 4);
constexpr size_t WS_SUM  = WS_ROPE + AL((size_t)2 * 256 * 16 * 4);
constexpr size_t WS_CAR  = WS_SUM  + AL((size_t)2 * NCHUNK * 2 * 512 * 4);
constexpr size_t WS_SP8  = WS_CAR  + AL((size_t)2 * NCHUNK * 512 * 4);
constexpr size_t WS_BAR  = WS_SP8  + 4096;
constexpr size_t WS_HB   = WS_BAR  + 16384;
constexpr size_t WS_R1   = WS_HB   + AL((size_t)MROWS * D * 2);
constexpr size_t WS_PROJ = WS_R1;
constexpr size_t WS_ATT  = WS_PROJ + AL((size_t)MROWS * DIN * 2);
constexpr size_t WS_YL   = WS_ATT  + AL((size_t)NLAT * 512 * 2);
constexpr size_t WS_CAF  = WS_YL   + AL((size_t)NLAT * 512 * 2);
constexpr size_t WS_CAB  = WS_CAF  + AL((size_t)NLAT * 512 * 2);
constexpr size_t WS_R1END = WS_CAB + AL((size_t)NLAT * 512 * 2);
constexpr size_t WS_ACT  = WS_R1;
constexpr size_t WS_O1   = WS_ACT + AL((size_t)NLAT * DFF * 2);
constexpr size_t WS_O2   = WS_HB;
constexpr size_t WS_END  = WS_R1END;
static_assert(WS_O1 + (size_t)NLAT * D * 2 <= WS_R1END, "o1");
static_assert(WS_ACT + (size_t)NLAT * DFF * 2 <= WS_R1END, "act");
constexpr int H2_BSTRIDE = 65 * 254;
constexpr int H2_ROWS = 130 * 254 + 2;
static_assert((size_t)H2_ROWS * D * 2 <= (size_t)MROWS * D * 2, "h2");

constexpr int LDS_BYTES = 131072 + 8192 + 256;
constexpr int LDS_XB = 131072 + 8192;

struct Params {
    const float *x, *c, *ctx, *c_ctx, *w_mod, *b_mod, *norm1_g, *w_in, *rnn_conv_w, *rnn_conv_b, *lru_w_a, *lru_b_a,
        *lru_w_i, *lru_b_i, *lru_lam, *attn_sink, *gn_rnn, *gn_attn, *w_out, *norm2_g, *w_up, *ffn_conv_w, *ffn_conv_b,
        *w_down, *final_g;
    float* out;
    unsigned char* ws;
};

typedef const Params __attribute__((address_space(4)))* PP;
__device__ __forceinline__ PP kparams() { PP k = (PP)__builtin_amdgcn_kernarg_segment_ptr(); asm volatile("" : "+s"(k)); return k; }
__device__ __forceinline__ int lane_fresh() { unsigned m = ~0u; asm volatile("" : "+s"(m)); return (int)__builtin_amdgcn_mbcnt_hi(m, __builtin_amdgcn_mbcnt_lo(m, 0u)); }
__device__ __forceinline__ int tid_opaque(int wv) { return wv * 64 + lane_fresh(); }
__device__ __forceinline__ bf16_t f2bf(float f) { unsigned u = __float_as_uint(f); u += 0x7FFFu + ((u >> 16) & 1u); return (bf16_t)(u >> 16); }
__device__ __forceinline__ float bf2f(bf16_t b) { return __uint_as_float(((unsigned)b) << 16); }
__device__ __forceinline__ unsigned pk2(float lo, float hi) { unsigned r; asm("v_cvt_pk_bf16_f32 %0, %1, %2" : "=v"(r) : "v"(lo), "v"(hi)); return r; }
__device__ __forceinline__ float bflo(unsigned w) { return __uint_as_float(w << 16); }
__device__ __forceinline__ float bfhi(unsigned w) { return __uint_as_float(w & 0xFFFF0000u); }
__device__ __forceinline__ float wave_sum(float v) {
#pragma unroll
    for (int o = 32; o >= 1; o >>= 1) v += __shfl_xor(v, o);
    return v;
}
__device__ __forceinline__ float wave_max(float v) {
#pragma unroll
    for (int o = 32; o >= 1; o >>= 1) v = fmaxf(v, __shfl_xor(v, o));
    return v;
}
__device__ __forceinline__ float sigmoidf_(float x) { return 1.0f / (1.0f + __expf(-x)); }
__device__ __forceinline__ float fast_sigmoid(float x) { return __builtin_amdgcn_rcpf(1.0f + __builtin_amdgcn_exp2f(-1.4426950408889634f * x)); }
__device__ __forceinline__ float silu_(float x) { return x * fast_sigmoid(x); }
__device__ __forceinline__ float gelu_tanh_(float x) {
    const float u = 0.7978845608028654f * (x + 0.044715f * x * x * x);
    const float e = __expf(2.0f * u);
    const float th = 1.0f - 2.0f / (e + 1.0f);
    return 0.5f * x * (1.0f + th);
}


#define XB_TMO      128
#define XB_XCNT(j)  (256  + 64 * (j))
#define XB_XSUB(j)  (1280 + 64 * (j))
#define XB_XGEN(j)  (2304 + 64 * (j))
#define XB_TOP      3328
#define XB_TOPGEN   3392
#define XCD_BAR_WORDS 3456
#define XB_SPIN_CAP (1u << 20)
__device__ __forceinline__ unsigned xb_ld(unsigned* p)              { return __hip_atomic_load(p, __ATOMIC_RELAXED, __HIP_MEMORY_SCOPE_AGENT); }
__device__ __forceinline__ unsigned xb_add(unsigned* p, unsigned v) { return __hip_atomic_fetch_add(p, v, __ATOMIC_RELAXED, __HIP_MEMORY_SCOPE_AGENT); }
__device__ __forceinline__ unsigned xb_xcc_id() { return (unsigned)__builtin_amdgcn_s_getreg((3 << 11) | 20) & 0xFu; }
#define XB_SPIN(cond, bar) do { unsigned _sp = 0; while (cond) { __builtin_amdgcn_s_sleep(1); \
    if ((++_sp & 255u) == 0u) { if (xb_ld(&(bar)[XB_TMO])) break; if (_sp > XB_SPIN_CAP) { atomicAdd(&(bar)[XB_TMO], 1u); break; } } } } while (0)
struct XcdBarrier { unsigned* bar; unsigned x; volatile LAS unsigned* st; };
__device__ __forceinline__ XcdBarrier xcd_barrier_post(unsigned* bar, volatile LAS unsigned* st, int wv) {
    XcdBarrier b; b.bar = bar; b.x = xb_xcc_id(); b.st = st;
    if (tid_opaque(wv) == 0) (void)xb_add(&bar[XB_XCNT(b.x)], 1u);
    return b;
}
__device__ __forceinline__ void xcd_barrier_complete(unsigned* bar, unsigned x, unsigned& nloc, unsigned& nx) {
    const unsigned G = gridDim.x * gridDim.y * gridDim.z;
    unsigned sum, cnt, mine, sp = 0u;
    for (;;) {
        sum = 0u; cnt = 0u; mine = 0u;
#pragma unroll
        for (unsigned j = 0; j < 16; ++j) { const unsigned c = xb_ld(&bar[XB_XCNT(j)]); sum += c; cnt += (c > 0u) ? 1u : 0u; mine = (j == x) ? c : mine; }
        if (sum == G) break;
        __builtin_amdgcn_s_sleep(1);
        if ((++sp & 255u) == 0u) { if (xb_ld(&bar[XB_TMO])) break; if (sp > XB_SPIN_CAP) { atomicAdd(&bar[XB_TMO], 1u); break; } }
    }
    nloc = mine > 0u ? mine : 1u; nx = cnt > 0u ? cnt : 1u;
}
__device__ __forceinline__ void xcd_barrier(const XcdBarrier& b, int wv) {
    asm volatile("s_waitcnt vmcnt(0)" ::: "memory");
    __syncthreads();
    if (tid_opaque(wv) == 0) {
        unsigned* bar = b.bar;
        __builtin_amdgcn_s_waitcnt(0);
        unsigned nloc = b.st[0], nx = b.st[1];
        if (nloc == 0u) { xcd_barrier_complete(bar, b.x, nloc, nx); b.st[0] = nloc; b.st[1] = nx; }
        const unsigned old = xb_add(&bar[XB_XSUB(b.x)], 1u);
        const unsigned gen = old / nloc;
        if (old + 1u == (gen + 1u) * nloc) {
            __builtin_amdgcn_fence(__ATOMIC_RELEASE, "agent");
            asm volatile("s_waitcnt vmcnt(0)" ::: "memory");
            const unsigned og = xb_add(&bar[XB_TOP], 1u);
            const unsigned tg = og / nx;
            if (og + 1u == (tg + 1u) * nx) xb_add(&bar[XB_TOPGEN], 1u);
            else XB_SPIN(xb_ld(&bar[XB_TOPGEN]) == tg, bar);
            __builtin_amdgcn_fence(__ATOMIC_ACQUIRE, "agent");
            xb_add(&bar[XB_XGEN(b.x)], 1u);
            asm volatile("s_waitcnt vmcnt(0)" ::: "memory");
        } else {
            XB_SPIN(xb_ld(&bar[XB_XGEN(b.x)]) == gen, bar);
            __builtin_amdgcn_fence(__ATOMIC_ACQUIRE, "agent");
            asm volatile("s_waitcnt vmcnt(0)" ::: "memory");
        }
    }
    __syncthreads();
}

namespace pg8 {
constexpr int BM = 256, BK = 64, HALF = 128, HTB = HALF * BK * 2, NXCD = 8, WGM = 8;
__host__ __device__ __forceinline__ int lds_byte(int r, int c) { const int st = (r >> 4) * 2 + (c >> 5), rr = r & 15, cc = c & 31, ob = rr * 64 + cc * 2; return st * 1024 + (ob ^ (((ob >> 9) & 1) << 5)); }
__host__ __device__ __forceinline__ void stage_rc(int b, int& R, int& C) { const int st = b / 1024, sb = b % 1024, swz = sb ^ (((sb >> 9) & 1) << 5); R = (st >> 1) * 16 + swz / 64; C = (st & 1) * 32 + (swz % 64) / 2; }
struct Unit { int pm, pn; };
struct Gemm { const bf16_t* A; const bf16_t* Bt; int nM, nN, K, a_tile_rows; };
struct StaticOrder {
    int nM, nN, nwg, G, c;
    __device__ void init(int nM_, int nN_, int G_, int c_) { nM = nM_; nN = nN_; nwg = nM * nN; G = G_; c = c_; }
    __device__ bool next(int i, Unit& u) const {
        const long L = (long)i * G + c; if (L >= nwg) return false;
        int wgid = (int)L; { const int q = nwg / NXCD, r = nwg % NXCD, xcd = wgid % NXCD, off = wgid / NXCD; wgid = (xcd < r ? xcd * (q + 1) : r * (q + 1) + (xcd - r) * q) + off; }
        const int nig = WGM * nN, gid = wgid / nig, fm = gid * WGM, gsz = (nM - fm) < WGM ? (nM - fm) : WGM;
        u.pm = fm + ((wgid % nig) % gsz); u.pn = (wgid % nig) / gsz; return true;
    }
};
template <class Epi>
__device__ __forceinline__ void gemm_phase(LAS unsigned char* lds, const Gemm g, const StaticOrder& S, const Epi& E, int wv) {
    const int tid = tid_opaque(wv);
    const int wid = __builtin_amdgcn_readfirstlane(tid >> 6), lane = tid & 63, wr = wid >> 2, wc = wid & 3, fr = lane & 15, fq = lane >> 4;
    const int K = g.K, nt = K / BK;
    unsigned voffA[2], voffB[2];
#pragma unroll
    for (int i = 0; i < 2; ++i) { int R, C; stage_rc(tid * 16 + i * 8192, R, C);
        const int Ra = (R & ~63) + 4 * (R & 15) + ((R >> 4) & 3);
        voffA[i] = (unsigned)(Ra * K + C) * 2u; voffB[i] = (unsigned)(R * K + C) * 2u; }
    const size_t kstep = (size_t)(BK * 2);
    const size_t hstep = (size_t)HALF * K * 2;
    const size_t tstepA = (size_t)g.a_tile_rows * K * 2;
    const size_t tstepB = 2 * hstep;
    const unsigned ldsw = (unsigned)wid * 1024u;
    const int aoff = lds_byte(wr * 64 + fr, fq * 8), boff = lds_byte(wc * 32 + fr, fq * 8);
#define PG8_SA(b, h) (((b) * 2 + (h)) * HTB)
#define PG8_SB(b, h) ((4 + (b) * 2 + (h)) * HTB)
#define PG8_STAGE(bufoff, gbase, voff) do { _Pragma("unroll") for (int _i = 0; _i < 2; ++_i) \
        __builtin_amdgcn_global_load_lds((const unsigned*)((const char*)(gbase) + (voff)[_i]), (LAS unsigned*)(lds + (bufoff) + ldsw + _i * 8192), 16, 0, 0); } while (0)
#define PG8_LDA(dst, b, h) do { _Pragma("unroll") for (int m = 0; m < 4; ++m) _Pragma("unroll") for (int k = 0; k < 2; ++k) dst[m][k] = *(const LAS bf16x8*)(lds + PG8_SA(b, h) + aoff + m * 2048 + k * 1024); } while (0)
#define PG8_LDB(dst, b, h) do { _Pragma("unroll") for (int n = 0; n < 2; ++n) _Pragma("unroll") for (int k = 0; k < 2; ++k) dst[n][k] = *(const LAS bf16x8*)(lds + PG8_SB(b, h) + boff + n * 2048 + k * 1024); } while (0)
#define PG8_MMA(ai, bj, At, Bt) do { __builtin_amdgcn_s_setprio(1); _Pragma("unroll") for (int m = 0; m < 4; ++m) _Pragma("unroll") for (int n = 0; n < 2; ++n) _Pragma("unroll") for (int k = 0; k < 2; ++k) \
        acc[ai][bj][m][n] = __builtin_amdgcn_mfma_f32_16x16x32_bf16(Bt[n][k], At[m][k], acc[ai][bj][m][n], 0, 0, 0); __builtin_amdgcn_s_setprio(0); } while (0)
#define PG8_WAIT_V(n) asm volatile("s_waitcnt vmcnt(" #n ")" ::: "memory")
#define PG8_WAIT_L(n) asm volatile("s_waitcnt lgkmcnt(" #n ")" ::: "memory")
#define PG8_BAR __builtin_amdgcn_s_barrier()
#define PG8_SCHED __builtin_amdgcn_sched_barrier(0)
    Unit cur, nxt; int ui = 0;
    if (!S.next(0, cur)) return;
    f32x4 acc[2][2][4][2];
#pragma unroll
    for (int a = 0; a < 2; ++a)
#pragma unroll
        for (int b = 0; b < 2; ++b)
#pragma unroll
            for (int m = 0; m < 4; ++m)
#pragma unroll
                for (int n = 0; n < 2; ++n) acc[a][b][m][n] = (f32x4){0.f, 0.f, 0.f, 0.f};
    bf16x8 At[4][2], B0[2][2], B1[2][2];
    const char* cA = (const char*)g.A + (size_t)cur.pm * tstepA; const char* cB = (const char*)g.Bt + (size_t)cur.pn * tstepB;
    PG8_STAGE(PG8_SB(0, 0), cB, voffB); PG8_STAGE(PG8_SA(0, 0), cA, voffA); PG8_STAGE(PG8_SB(0, 1), cB + hstep, voffB); PG8_STAGE(PG8_SA(0, 1), cA + hstep, voffA);
    if (wr == 1) PG8_BAR;
    PG8_WAIT_V(4); PG8_BAR;
    PG8_STAGE(PG8_SB(1, 0), cB + kstep, voffB); PG8_STAGE(PG8_SA(1, 0), cA + kstep, voffA); PG8_STAGE(PG8_SB(1, 1), cB + hstep + kstep, voffB);
    PG8_WAIT_V(6); PG8_BAR;
    for (;;) {
        const bool has_next = S.next(ui + 1, nxt);
        const char* nA = has_next ? (const char*)g.A + (size_t)nxt.pm * tstepA : cA; const char* nB = has_next ? (const char*)g.Bt + (size_t)nxt.pn * tstepB : cB;
        for (int t = 0; t < nt; t += 2) {
            const bool last = (t == nt - 2);
            const char* a1 = cA + (size_t)(t + 1) * kstep;
            const char* a2 = last ? nA : cA + (size_t)(t + 2) * kstep; const char* b2 = last ? nB : cB + (size_t)(t + 2) * kstep;
            const char* a3 = a2 + kstep; const char* b3 = b2 + kstep;
            PG8_LDB(B0, 0, 0); PG8_SCHED; PG8_LDA(At, 0, 0); PG8_STAGE(PG8_SA(1, 1), a1 + hstep, voffA);
            PG8_WAIT_L(8); PG8_BAR; PG8_WAIT_L(0); PG8_MMA(0, 0, At, B0); PG8_BAR; PG8_SCHED;
            PG8_LDB(B1, 0, 1); PG8_STAGE(PG8_SB(0, 0), b2, voffB);
            PG8_BAR; PG8_WAIT_L(0); PG8_MMA(0, 1, At, B1); PG8_BAR;
            PG8_LDA(At, 0, 1); PG8_STAGE(PG8_SA(0, 0), a2, voffA);
            PG8_BAR; PG8_WAIT_L(0); PG8_MMA(1, 0, At, B0); PG8_BAR; PG8_SCHED;
            PG8_STAGE(PG8_SB(0, 1), b2 + hstep, voffB);
            PG8_WAIT_V(6); PG8_BAR; PG8_MMA(1, 1, At, B1); PG8_BAR;
            PG8_LDB(B0, 1, 0); PG8_SCHED; PG8_LDA(At, 1, 0); PG8_STAGE(PG8_SA(0, 1), a2 + hstep, voffA);
            PG8_WAIT_L(8); PG8_BAR; PG8_WAIT_L(0); PG8_MMA(0, 0, At, B0); PG8_BAR; PG8_SCHED;
            PG8_LDB(B1, 1, 1); PG8_STAGE(PG8_SB(1, 0), b3, voffB);
            PG8_BAR; PG8_WAIT_L(0); PG8_MMA(0, 1, At, B1); PG8_BAR;
            PG8_LDA(At, 1, 1); PG8_STAGE(PG8_SA(1, 0), a3, voffA);
            PG8_BAR; PG8_WAIT_L(0); PG8_MMA(1, 0, At, B0); PG8_BAR; PG8_SCHED;
            PG8_STAGE(PG8_SB(1, 1), b3 + hstep, voffB);
            PG8_WAIT_V(6); PG8_BAR; PG8_MMA(1, 1, At, B1); PG8_BAR;
        }
        { const int ln2 = lane_fresh();
          E(acc, cur, wr, wc, ln2 & 15, ln2 >> 4); }
        if (!has_next) break;
#pragma unroll
        for (int a = 0; a < 2; ++a)
#pragma unroll
            for (int b = 0; b < 2; ++b)
#pragma unroll
                for (int m = 0; m < 4; ++m)
#pragma unroll
                    for (int n = 0; n < 2; ++n) acc[a][b][m][n] = (f32x4){0.f, 0.f, 0.f, 0.f};
        cur = nxt; cA = nA; cB = nB; ++ui;
    }
    PG8_WAIT_V(0);
    if (wr == 0) PG8_BAR;
    PG8_BAR;
#undef PG8_SA
#undef PG8_SB
#undef PG8_STAGE
#undef PG8_LDA
#undef PG8_LDB
#undef PG8_MMA
#undef PG8_WAIT_V
#undef PG8_WAIT_L
#undef PG8_BAR
#undef PG8_SCHED
}
}
using pg8::Unit;

struct EpiProj {
    bf16_t* O; const float* cosT; const float* sinT;
    __device__ __forceinline__ void operator()(const f32x4 (&acc)[2][2][4][2], const Unit& u, int wr, int wc, int fr, int fq) const {
        const bool latent = u.pm < 128;
#pragma unroll
        for (int ai = 0; ai < 2; ++ai)
#pragma unroll
            for (int m = 0; m < 4; ++m) {
                const int row = u.pm * 256 + ai * 128 + wr * 64 + 4 * fr + m;
                const int t = row & (S - 1);
                const int pos = (wc & 1) ? (t & 63) : (t >> 6);
#pragma unroll
                for (int bj = 0; bj < 2; ++bj) {
                    const int col = u.pn * 256 + bj * 128 + wc * 32 + 4 * fq;
                    f32x4 v0 = acc[ai][bj][m][0], v1 = acc[ai][bj][m][1];
                    const bool rope = latent && (u.pn == 4 || u.pn == 5 || (u.pn == 6 && bj == 0));
                    if (rope) {
                        const f32x4 cs = *(const f32x4*)(cosT + pos * 16 + 4 * fq), sn = *(const f32x4*)(sinT + pos * 16 + 4 * fq);
                        const f32x4 n0 = v0 * cs - v1 * sn, n1 = v1 * cs + v0 * sn; v0 = n0; v1 = n1;
                    }
                    bf16_t* p = O + (size_t)row * DIN + col;
                    u32x2 w0, w1; w0.x = pk2(v0[0], v0[1]); w0.y = pk2(v0[2], v0[3]); w1.x = pk2(v1[0], v1[1]); w1.y = pk2(v1[2], v1[3]);
                    *(u32x2*)p = w0; *(u32x2*)(p + 16) = w1;
                }
            }
    }
};
struct EpiDelta {
    bf16_t* O; const float* gate0; const float* gate1;
    __device__ __forceinline__ void operator()(const f32x4 (&acc)[2][2][4][2], const Unit& u, int wr, int wc, int fr, int fq) const {
        const float* gate = (u.pm >= 64) ? gate1 : gate0;
        f32x4 gv[2][2];
#pragma unroll
        for (int bj = 0; bj < 2; ++bj)
#pragma unroll
            for (int n = 0; n < 2; ++n) gv[bj][n] = *(const f32x4*)(gate + u.pn * 256 + bj * 128 + wc * 32 + n * 16 + 4 * fq);
#pragma unroll
        for (int ai = 0; ai < 2; ++ai)
#pragma unroll
            for (int m = 0; m < 4; ++m) {
                const size_t row = (size_t)u.pm * 256 + ai * 128 + wr * 64 + 4 * fr + m;
#pragma unroll
                for (int bj = 0; bj < 2; ++bj)
#pragma unroll
                    for (int n = 0; n < 2; ++n) {
                        const f32x4 v = gv[bj][n] * acc[ai][bj][m][n];
                        u32x2 w; w.x = pk2(v[0], v[1]); w.y = pk2(v[2], v[3]);
                        *(u32x2*)(O + row * D + u.pn * 256 + bj * 128 + wc * 32 + n * 16 + 4 * fq) = w;
                    }
            }
    }
};

__device__ __forceinline__ float dpp_ror1(float v)  { return __int_as_float(__builtin_amdgcn_update_dpp(0, __float_as_int(v), 0x121, 0xF, 0xF, true)); }
__device__ __forceinline__ float dpp_ror15(float v) { return __int_as_float(__builtin_amdgcn_update_dpp(0, __float_as_int(v), 0x12F, 0xF, 0xF, true)); }
__device__ __forceinline__ float dpp_shr1(float v)  { return __int_as_float(__builtin_amdgcn_update_dpp(0, __float_as_int(v), 0x111, 0xF, 0xF, true)); }
__device__ __forceinline__ float dpp_shl1(float v)  { return __int_as_float(__builtin_amdgcn_update_dpp(0, __float_as_int(v), 0x101, 0xF, 0xF, true)); }

#define DPP_FMAC4X2(C, SA, WA, CTRLA, SB, WB, CTRLB) do { float _c0 = (C)[0], _c1 = (C)[1], _c2 = (C)[2], _c3 = (C)[3]; \
    asm("s_nop 1\n\t" \
        "v_fmac_f32_dpp %0, %4, %8 " CTRLA " row_mask:0xf bank_mask:0xf bound_ctrl:1\n\t" \
        "v_fmac_f32_dpp %1, %5, %9 " CTRLA " row_mask:0xf bank_mask:0xf bound_ctrl:1\n\t" \
        "v_fmac_f32_dpp %2, %6, %10 " CTRLA " row_mask:0xf bank_mask:0xf bound_ctrl:1\n\t" \
        "v_fmac_f32_dpp %3, %7, %11 " CTRLA " row_mask:0xf bank_mask:0xf bound_ctrl:1\n\t" \
        "v_fmac_f32_dpp %0, %12, %16 " CTRLB " row_mask:0xf bank_mask:0xf bound_ctrl:1\n\t" \
        "v_fmac_f32_dpp %1, %13, %17 " CTRLB " row_mask:0xf bank_mask:0xf bound_ctrl:1\n\t" \
        "v_fmac_f32_dpp %2, %14, %18 " CTRLB " row_mask:0xf bank_mask:0xf bound_ctrl:1\n\t" \
        "v_fmac_f32_dpp %3, %15, %19 " CTRLB " row_mask:0xf bank_mask:0xf bound_ctrl:1" \
        : "+v"(_c0), "+v"(_c1), "+v"(_c2), "+v"(_c3) \
        : "v"((SA)[0]), "v"((SA)[1]), "v"((SA)[2]), "v"((SA)[3]), "v"((WA)[0]), "v"((WA)[1]), "v"((WA)[2]), "v"((WA)[3]), \
          "v"((SB)[0]), "v"((SB)[1]), "v"((SB)[2]), "v"((SB)[3]), "v"((WB)[0]), "v"((WB)[1]), "v"((WB)[2]), "v"((WB)[3])); \
    (C)[0] = _c0; (C)[1] = _c1; (C)[2] = _c2; (C)[3] = _c3; } while (0)
#define DPP_FMAC4(C, SA, WA, CTRLA) do { float _c0 = (C)[0], _c1 = (C)[1], _c2 = (C)[2], _c3 = (C)[3]; \
    asm("s_nop 1\n\t" \
        "v_fmac_f32_dpp %0, %4, %8 " CTRLA " row_mask:0xf bank_mask:0xf bound_ctrl:1\n\t" \
        "v_fmac_f32_dpp %1, %5, %9 " CTRLA " row_mask:0xf bank_mask:0xf bound_ctrl:1\n\t" \
        "v_fmac_f32_dpp %2, %6, %10 " CTRLA " row_mask:0xf bank_mask:0xf bound_ctrl:1\n\t" \
        "v_fmac_f32_dpp %3, %7, %11 " CTRLA " row_mask:0xf bank_mask:0xf bound_ctrl:1" \
        : "+v"(_c0), "+v"(_c1), "+v"(_c2), "+v"(_c3) \
        : "v"((SA)[0]), "v"((SA)[1]), "v"((SA)[2]), "v"((SA)[3]), "v"((WA)[0]), "v"((WA)[1]), "v"((WA)[2]), "v"((WA)[3])); \
    (C)[0] = _c0; (C)[1] = _c1; (C)[2] = _c2; (C)[3] = _c3; } while (0)
struct EpiConvGate {
    bf16_t* act; const float* cw; const float* cbias; LAS unsigned char* xl;
    __device__ __forceinline__ void operator()(const f32x4 (&acc)[2][2][4][2], const Unit& u, int wr, int wc, int fr, int fq) const {
        if (wr == 0) { __builtin_amdgcn_s_barrier(); } asm volatile("" ::: "memory");
        LAS float* X = (LAS float*)xl;
        f32x4 wq[2][2][4];
#define CG_LOADW(N) do { _Pragma("unroll") for (int bj = 0; bj < 2; ++bj) { const int ch = 128 * u.pn + 32 * wc + 16 * (N) + 4 * fq + bj * DFF; \
            wq[N][bj][0] = *(const f32x4*)(cw + ch); wq[N][bj][1] = *(const f32x4*)(cw + DUP + ch); wq[N][bj][2] = *(const f32x4*)(cw + 2 * DUP + ch); wq[N][bj][3] = *(const f32x4*)(cbias + ch); } } while (0)
        CG_LOADW(0);
#pragma unroll
        for (int ai = 0; ai < 2; ++ai) {
            const int s = 2 * ai + wr;
            if (fr == 0) {
#pragma unroll
                for (int bj = 0; bj < 2; ++bj)
#pragma unroll
                    for (int n = 0; n < 2; ++n) *(LAS f32x4*)(X + ((s * 2 + 0) * 2 + bj) * 128 + 32 * wc + 16 * n + 4 * fq) = acc[ai][bj][0][n];
            }
            if (fr == 15) {
#pragma unroll
                for (int bj = 0; bj < 2; ++bj)
#pragma unroll
                    for (int n = 0; n < 2; ++n) *(LAS f32x4*)(X + ((s * 2 + 1) * 2 + bj) * 128 + 32 * wc + 16 * n + 4 * fq) = acc[ai][bj][3][n];
            }
        }
        asm volatile("s_waitcnt lgkmcnt(0)" ::: "memory");
        __builtin_amdgcn_s_barrier(); asm volatile("" ::: "memory");
#pragma unroll
        for (int n = 0; n < 2; ++n) {
            const int chg = 128 * u.pn + 32 * wc + 16 * n + 4 * fq;
            if (n == 1) CG_LOADW(1);
            f32x4 w0[2], w1[2], w2[2], bb[2], w0m[2], w2m[2];
#pragma unroll
            for (int bj = 0; bj < 2; ++bj) {
                w0[bj] = wq[n][bj][0]; w1[bj] = wq[n][bj][1]; w2[bj] = wq[n][bj][2]; bb[bj] = wq[n][bj][3];
                w0m[bj] = (fr == 0) ? w0[bj] : (f32x4){0.f, 0.f, 0.f, 0.f}; w2m[bj] = (fr == 15) ? w2[bj] : (f32x4){0.f, 0.f, 0.f, 0.f};
            }
#pragma unroll
            for (int ai = 0; ai < 2; ++ai) {
                const int s = 2 * ai + wr;
                f32x4 xp[2], xn[2];
#pragma unroll
                for (int bj = 0; bj < 2; ++bj) {
                    xp[bj] = *(const LAS f32x4*)(X + ((((s + 3) & 3) * 2 + 1) * 2 + bj) * 128 + 32 * wc + 16 * n + 4 * fq);
                    xn[bj] = *(const LAS f32x4*)(X + ((((s + 1) & 3) * 2 + 0) * 2 + bj) * 128 + 32 * wc + 16 * n + 4 * fq);
                }
                f32x4 cvv[4][2];
#pragma unroll
                for (int bj = 0; bj < 2; ++bj) {
                    const f32x4 a0 = acc[ai][bj][0][n], a1 = acc[ai][bj][1][n], a2 = acc[ai][bj][2][n], a3 = acc[ai][bj][3][n];
                    f32x4 c0 = bb[bj] + w1[bj] * a0 + w2[bj] * a1 + w0m[bj] * xp[bj];
                    f32x4 c1 = bb[bj] + w1[bj] * a1 + w0[bj] * a0 + w2[bj] * a2;
                    f32x4 c2 = bb[bj] + w1[bj] * a2 + w0[bj] * a1 + w2[bj] * a3;
                    f32x4 c3 = bb[bj] + w1[bj] * a3 + w0[bj] * a2 + w2m[bj] * xn[bj];
                    DPP_FMAC4(c0, a3, w0[bj], "row_shr:1");
                    DPP_FMAC4(c3, a0, w2[bj], "row_shl:1");
                    cvv[0][bj] = c0; cvv[1][bj] = c1; cvv[2][bj] = c2; cvv[3][bj] = c3;
                }
#pragma unroll
                for (int m = 0; m < 4; ++m) {
                    const int lr = 128 * ai + 64 * wr + 4 * fr + m;
                    const int R = 254 * u.pm + lr;
                    const int b = R >= (H2_BSTRIDE + 1) ? 1 : 0;
                    const int t = R - 1 - H2_BSTRIDE * b;
                    const bool valid = lr >= 1 && lr <= 254 && t >= 0 && t < S;
                    if (valid) {
                        u32x2 w;
                        w.x = pk2(silu_(cvv[m][0][0]) * cvv[m][1][0], silu_(cvv[m][0][1]) * cvv[m][1][1]);
                        w.y = pk2(silu_(cvv[m][0][2]) * cvv[m][1][2], silu_(cvv[m][0][3]) * cvv[m][1][3]);
                        *(u32x2*)(act + (size_t)(b * S + t) * DFF + chg) = w;
                    }
                }
            }
        }
        asm volatile("" ::: "memory"); if (wr == 1) { __builtin_amdgcn_s_barrier(); }
    }
};

#undef CG_LOADW
__device__ __forceinline__ void transpose_item(const float* W, int N, int k0, int n0, bf16_t* dst, int Kd, float* scr, int lane) {
#pragma unroll 16
    for (int i = 0; i < 32; ++i) { const int kk = 2 * i + (lane >> 5); scr[kk * 33 + (lane & 31)] = __builtin_nontemporal_load(W + (size_t)(k0 + kk) * N + n0 + (lane & 31)); }
    __builtin_amdgcn_wave_barrier();
    const int c = lane & 7;
#pragma unroll
    for (int j = 0; j < 4; ++j) {
        const int n = (lane >> 3) + 8 * j; const float* s = scr + (8 * c) * 33 + n;
        u32x4 o; o.x = pk2(s[0], s[33]); o.y = pk2(s[2 * 33], s[3 * 33]); o.z = pk2(s[4 * 33], s[5 * 33]); o.w = pk2(s[6 * 33], s[7 * 33]);
        *(u32x4*)(dst + (size_t)n * Kd + k0 + 8 * c) = o;
    }
    __builtin_amdgcn_wave_barrier();
}

__device__ __forceinline__ void phase0(PP p, unsigned char* shm, int wv) {
    const int tid = tid_opaque(wv), lane = tid & 63, wave = tid >> 6;
    unsigned char* ws = p->ws;
    if (blockIdx.x < 192) {
        float* sv = (float*)shm;
        float* red = sv + 3 * 1024;
        for (int i = tid; i < 3 * 1024; i += 512) {
            const int j = i >> 10, k = i & 1023;
            const float v = (j < 2) ? p->c[j * 1024 + k] : p->c_ctx[k];
            sv[i] = silu_(v);
        }
        __syncthreads();
        const int n0 = blockIdx.x * 32, col = tid & 31, ks = tid >> 5;
        float a0 = 0.f, a1 = 0.f, a2 = 0.f;
        const float* wp = p->w_mod + (size_t)(ks * 64) * 6144 + n0 + col;
#pragma unroll
        for (int k = 0; k < 64; ++k) {
            const float w = __builtin_nontemporal_load(wp + (size_t)k * 6144);
            a0 += sv[ks * 64 + k] * w; a1 += sv[1024 + ks * 64 + k] * w; a2 += sv[2048 + ks * 64 + k] * w;
        }
        red[(ks * 3 + 0) * 32 + col] = a0; red[(ks * 3 + 1) * 32 + col] = a1; red[(ks * 3 + 2) * 32 + col] = a2;
        __syncthreads();
        if (tid < 96) {
            const int j = tid >> 5, cc = tid & 31; float s = p->b_mod[n0 + cc];
            for (int k = 0; k < 16; ++k) s += red[(k * 3 + j) * 32 + cc];
            ((float*)(ws + WS_MOD))[j * 6144 + n0 + cc] = s;
        }
        __syncthreads();
    }
    if (blockIdx.x == 200) { for (int i = tid; i < 1024; i += 512) ((float*)(ws + WS_SP8))[i] = -8.0f * log1pf(expf(-p->lru_lam[i])); }
    if (blockIdx.x >= 192 && blockIdx.x < 200) {
        const int idx = (blockIdx.x - 192) * 512 + tid;
        const int pos = idx >> 4, i = idx & 15;
        const float inv = powf(10000.0f, -(float)i / 16.0f);
        const float ang = (float)pos * inv;
        ((float*)(ws + WS_ROPE))[idx] = cosf(ang);
        ((float*)(ws + WS_ROPE))[4096 + idx] = sinf(ang);
    }
}
__device__ __forceinline__ void transpose_phase(PP p, unsigned char* shm, int wv, int it_lo, int it_hi, int gw0, int NGW) {
    const int tid = tid_opaque(wv), lane = tid & 63, wave = wv;
    unsigned char* ws = p->ws;
    float* scr = (float*)(shm + 32768) + wave * (64 * 33);
    const int gw = gw0 + wave;
    constexpr int I_IN = (D / 64) * (DIN / 32), I_OUT = (D / 64) * (D / 32), I_UP = (D / 64) * (DUP / 32), I_DN = (DFF / 64) * (D / 32), I_LRU = 2 * 2 * 8 * 2;
    constexpr int NIT = I_IN + I_OUT + I_UP + I_DN + I_LRU;
    (void)NIT;
    for (int it = it_lo + gw; it < it_hi; it += NGW) {
        int r = it;
        if (r >= I_IN + I_OUT + I_UP + I_DN + I_LRU) continue;
        if (r < I_IN) { const int nb = DIN / 32, kb = r / nb, n0 = (r % nb) * 32; transpose_item(p->w_in, DIN, kb * 64, n0, (bf16_t*)(ws + WS_WIN) + (size_t)n0 * D, D, scr, lane); continue; } r -= I_IN;
        if (r < I_OUT) { const int nb = D / 32, kb = r / nb, n0 = (r % nb) * 32; transpose_item(p->w_out, D, kb * 64, n0, (bf16_t*)(ws + WS_WOUT) + (size_t)n0 * D, D, scr, lane); continue; } r -= I_OUT;
        if (r < I_UP) { const int nb = DUP / 32, kb = r / nb, n0 = (r % nb) * 32;
            const int isv = n0 >= DFF, nn = isv ? n0 - DFF : n0, drow = (nn / 128) * 256 + isv * 128 + (nn % 128);
            transpose_item(p->w_up, DUP, kb * 64, n0, (bf16_t*)(ws + WS_WUP) + (size_t)drow * D, D, scr, lane); continue; } r -= I_UP;
        if (r < I_DN) { const int nb = D / 32, kb = r / nb, n0 = (r % nb) * 32; transpose_item(p->w_down, D, kb * 64, n0, (bf16_t*)(ws + WS_WDN) + (size_t)n0 * DFF, DFF, scr, lane); continue; } r -= I_DN;
        {
            const int nh = r & 1, blk = (r >> 1) & 7, type = (r >> 4) & 1, dir = r >> 5;
            const float* src = (type ? p->lru_w_i : p->lru_w_a) + (size_t)(dir * 8 + blk) * 4096;
            bf16_t* dst = (bf16_t*)(ws + WS_LRU) + (size_t)((dir * 2 + type) * 8 + blk) * 4096 + (size_t)(nh * 32) * 64;
            transpose_item(src, 64, 0, nh * 32, dst, 64, scr, lane);
        }
    }
}

__device__ __forceinline__ void row_load_nt(const float* src, int lane, f32x4 (&v)[4]) {
#pragma unroll
    for (int j = 0; j < 4; ++j) v[j] = __builtin_nontemporal_load((const f32x4*)(src + 4 * lane + 256 * j));
}
__device__ __forceinline__ void row_load(const float* src, int lane, f32x4 (&v)[4]) {
#pragma unroll
    for (int j = 0; j < 4; ++j) v[j] = *(const f32x4*)(src + 4 * lane + 256 * j);
}
__device__ __forceinline__ float row_rstd(const f32x4 (&v)[4]) {
    float ss = 0.f;
#pragma unroll
    for (int j = 0; j < 4; ++j) ss += v[j][0] * v[j][0] + v[j][1] * v[j][1] + v[j][2] * v[j][2] + v[j][3] * v[j][3];
    return rsqrtf(wave_sum(ss) * (1.0f / D) + EPS);
}
__device__ __forceinline__ void norm_mod_store(const f32x4 (&v)[4], float rstd, const float* g, const float* sh, const float* sc, bf16_t* dst, int lane) {
#pragma unroll
    for (int j = 0; j < 4; ++j) {
        const int c = 4 * lane + 256 * j;
        const f32x4 gg = *(const f32x4*)(g + c), s1 = *(const f32x4*)(sc + c), s0 = *(const f32x4*)(sh + c);
        const f32x4 o = (v[j] * rstd * gg) * (s1 + 1.0f) + s0;
        u32x2 w; w.x = pk2(o[0], o[1]); w.y = pk2(o[2], o[3]);
        *(u32x2*)(dst + c) = w;
    }
}
__device__ __forceinline__ void phase1(PP p, int wv) {
    const int tid_ = tid_opaque(wv), lane = tid_ & 63, gw = blockIdx.x * 8 + (tid_ >> 6), NGW = gridDim.x * 8;
    const float* mod = (const float*)(p->ws + WS_MOD);
    bf16_t* hb = (bf16_t*)(p->ws + WS_HB);
    int cur = -1; f32x4 gsc[4], gsh[4];
    for (int r0 = gw; r0 < MROWS; r0 += 4 * NGW) {
        f32x4 v[4][4];
#pragma unroll
        for (int q = 0; q < 4; ++q) {
            const int r = (r0 + q * NGW < MROWS) ? r0 + q * NGW : r0;
            row_load_nt(r < NLAT ? p->x + (size_t)r * D : p->ctx + (size_t)(r - NLAT) * D, lane, v[q]);
        }
#pragma unroll
        for (int q = 0; q < 4; ++q) {
            const int r = r0 + q * NGW;
            if (r < MROWS) {
                const int mi = r < NLAT ? (r >> 14) : 2;
                if (mi != cur) {
                    cur = mi;
#pragma unroll
                    for (int j = 0; j < 4; ++j) {
                        const int c = 4 * lane + 256 * j;
                        gsc[j] = *(const f32x4*)(p->norm1_g + c) * (*(const f32x4*)(mod + mi * 6144 + 1024 + c) + 1.0f);
                        gsh[j] = *(const f32x4*)(mod + mi * 6144 + c);
                    }
                }
                const float rstd = row_rstd(v[q]);
#pragma unroll
                for (int j = 0; j < 4; ++j) {
                    const f32x4 o = v[q][j] * rstd * gsc[j] + gsh[j];
                    u32x2 w; w.x = pk2(o[0], o[1]); w.y = pk2(o[2], o[3]);
                    *(u32x2*)(hb + (size_t)r * D + 4 * lane + 256 * j) = w;
                }
            }
        }
    }
}

typedef float f32x16 __attribute__((ext_vector_type(16)));
__device__ __forceinline__ unsigned cvt_pk_bf16(float lo, float hi) { unsigned r; asm("v_cvt_pk_bf16_f32 %0, %1, %2" : "=v"(r) : "v"(lo), "v"(hi)); return r; }
__device__ __forceinline__ void attn_mfma(PP p, unsigned char* shm, int wv) {
    const int tid = tid_opaque(wv);
    const int lane = tid & 63, wave = wv, l31 = lane & 31, hl = lane >> 5;
    const bf16_t* proj = (const bf16_t*)(p->ws + WS_PROJ);
    bf16_t* att = (bf16_t*)(p->ws + WS_ATT);
    const float L2E = 1.4426950408889634f;
    const float SC2 = 0.125f * L2E;
    for (int item = blockIdx.x; item < 512; item += gridDim.x) {
        const int hk = item & 1, qb = (item >> 1) & 127, b = item >> 8;
        const int g = wave >> 1, qh = wave & 1, hq = hk * 4 + g;
        const int qrow0 = b * S + 128 * qb + 64 * qh;
        bf16x8 qf[2][4];
#pragma unroll
        for (int qi = 0; qi < 2; ++qi)
#pragma unroll
            for (int st = 0; st < 4; ++st) qf[qi][st] = *(const bf16x8*)(proj + (size_t)(qrow0 + 32 * qi + l31) * DIN + 1024 + 64 * hq + 16 * st + 8 * hl);
        const float sink2 = p->attn_sink[hq] * L2E;
        float mrun[2] = {sink2, sink2};
        float lrun[2] = {hl == 0 ? 1.f : 0.f, hl == 0 ? 1.f : 0.f};
        f32x16 oacc[2][2];
#pragma unroll
        for (int a = 0; a < 2; ++a)
#pragma unroll
            for (int c = 0; c < 2; ++c)
#pragma unroll
                for (int i = 0; i < 16; ++i) oacc[a][c][i] = 0.f;
        u32x4 kreg[2], vreg[2];
        int ci = (qb == 0) ? 1 : 0;
#define ATT_GLOAD(CI) do { const int _row0 = (CI) < 3 ? b * S + 128 * (qb - 1 + (CI)) : NLAT + b * LC + 128 * ((CI) - 3); \
        _Pragma("unroll") for (int _i = 0; _i < 2; ++_i) { const int _pi = tid + 512 * _i, _key = _pi >> 3, _part = _pi & 7; \
            const bf16_t* _src = proj + (size_t)(_row0 + _key) * DIN + 1536 + 64 * hk + 8 * _part; kreg[_i] = *(const u32x4*)_src; vreg[_i] = *(const u32x4*)(_src + 128); } } while (0)
#define ATT_STAGE(PAR) do { bf16_t* _K = (bf16_t*)(shm + (PAR) * 36864); bf16_t* _V = (bf16_t*)(shm + (PAR) * 36864 + 18432); \
        _Pragma("unroll") for (int i = 0; i < 2; ++i) { const int pi = tid + 512 * i, key = pi >> 3, part = pi & 7; \
            *(u32x4*)(_K + key * 72 + 8 * part) = kreg[i]; \
            _Pragma("unroll") for (int e = 0; e < 8; ++e) { const unsigned w = vreg[i][e >> 1]; _V[(8 * part + e) * 132 + key] = (bf16_t)((e & 1) ? (w >> 16) : (w & 0xFFFFu)); } } } while (0)
#define ATT_NEXT(C) (((C) + 1 == 2 && qb == 127) ? 3 : (C) + 1)
        ATT_GLOAD(ci);
        __syncthreads();
        ATT_STAGE(0);
        { const int c1 = ATT_NEXT(ci); if (c1 < 5) ATT_GLOAD(c1); }
        __syncthreads();
        int par = 0;
        while (ci < 5) {
            const int cn = ATT_NEXT(ci);
            if (cn < 5) { ATT_STAGE(par ^ 1); const int c2 = ATT_NEXT(cn); if (c2 < 5) ATT_GLOAD(c2); }
            const bf16_t* Ks = (const bf16_t*)(shm + par * 36864);
            const bf16_t* Vt = (const bf16_t*)(shm + par * 36864 + 18432);
            const int kt_lo = (ci == 0 && qh == 1) ? 2 : 0, kt_hi = (ci == 2 && qh == 0) ? 2 : 4;
#pragma unroll 1
            for (int kt = kt_lo; kt < kt_hi; ++kt) {
                bf16x8 kf[4];
#pragma unroll
                for (int st = 0; st < 4; ++st) kf[st] = *(const bf16x8*)(Ks + (32 * kt + l31) * 72 + 16 * st + 8 * hl);
                bf16x8 vf[2][2];
#pragma unroll
                for (int db = 0; db < 2; ++db)
#pragma unroll
                    for (int s2 = 0; s2 < 2; ++s2) {
                        const bf16_t* vp = Vt + (32 * db + l31) * 132 + 32 * kt + 16 * s2 + 4 * hl;
                        const u32x2 lo = *(const u32x2*)vp, hi = *(const u32x2*)(vp + 8);
                        u32x4 w; w.x = lo.x; w.y = lo.y; w.z = hi.x; w.w = hi.y;
                        vf[db][s2] = __builtin_bit_cast(bf16x8, w);
                    }
#pragma unroll
                for (int qi = 0; qi < 2; ++qi) {
                    f32x16 s;
#pragma unroll
                    for (int i = 0; i < 16; ++i) s[i] = 0.f;
#pragma unroll
                    for (int st = 0; st < 4; ++st) s = __builtin_amdgcn_mfma_f32_32x32x16_bf16(kf[st], qf[qi][st], s, 0, 0, 0);
                    if (ci == 0 || ci == 2) {
                        asm volatile("");
                        const int dl = (ci == 0) ? (32 * kt + 4 * hl - (64 * qh + 32 * qi + l31)) : ((64 * qh + 32 * qi + l31) - 32 * kt - 4 * hl);
#pragma unroll
                        for (int i = 0; i < 16; ++i) {
                            const int ki = 8 * (i >> 2) + (i & 3);
                            const bool ok = (ci == 0) ? (dl + ki >= 0) : (dl - ki >= 0);
                            s[i] = ok ? s[i] : -1e30f;
                        }
                    }
                    float mx = s[0];
#pragma unroll
                    for (int i = 1; i < 16; ++i) mx = fmaxf(mx, s[i]);
                    mx = fmaxf(mx, __shfl_xor(mx, 32));
                    const float mnew = fmaxf(mrun[qi], mx * SC2);
                    if (__builtin_amdgcn_ballot_w64(mnew > mrun[qi]) != 0ull) {
                        const float alpha = __builtin_amdgcn_exp2f(mrun[qi] - mnew);
                        lrun[qi] *= alpha;
#pragma unroll
                        for (int db = 0; db < 2; ++db)
#pragma unroll
                            for (int i = 0; i < 16; ++i) oacc[db][qi][i] *= alpha;
                        mrun[qi] = mnew;
                    }
                    float ls = 0.f;
#pragma unroll
                    for (int i = 0; i < 16; ++i) { s[i] = __builtin_amdgcn_exp2f(__builtin_fmaf(s[i], SC2, -mnew)); ls += s[i]; }
                    lrun[qi] += ls;
                    bf16x8 pf[2];
#pragma unroll
                    for (int s2 = 0; s2 < 2; ++s2) {
                        u32x4 w; w.x = cvt_pk_bf16(s[8 * s2 + 0], s[8 * s2 + 1]); w.y = cvt_pk_bf16(s[8 * s2 + 2], s[8 * s2 + 3]);
                        w.z = cvt_pk_bf16(s[8 * s2 + 4], s[8 * s2 + 5]); w.w = cvt_pk_bf16(s[8 * s2 + 6], s[8 * s2 + 7]);
                        pf[s2] = __builtin_bit_cast(bf16x8, w);
                    }
#pragma unroll
                    for (int db = 0; db < 2; ++db)
#pragma unroll
                        for (int s2 = 0; s2 < 2; ++s2) oacc[db][qi] = __builtin_amdgcn_mfma_f32_32x32x16_bf16(vf[db][s2], pf[s2], oacc[db][qi], 0, 0, 0);
                }
            }
            __syncthreads();
            ci = cn; par ^= 1;
        }
#undef ATT_STAGE
#undef ATT_NEXT
#undef ATT_GLOAD
#pragma unroll
        for (int qi = 0; qi < 2; ++qi) {
            const float lt = lrun[qi] + __shfl_xor(lrun[qi], 32);
            const float inv = 1.0f / lt;
            bf16_t* orow = att + (size_t)(qrow0 + 32 * qi + l31) * 512 + hq * 64;
#pragma unroll
            for (int db = 0; db < 2; ++db)
#pragma unroll
                for (int g4 = 0; g4 < 4; ++g4) {
                    u32x2 w; w.x = cvt_pk_bf16(oacc[db][qi][4 * g4] * inv, oacc[db][qi][4 * g4 + 1] * inv); w.y = cvt_pk_bf16(oacc[db][qi][4 * g4 + 2] * inv, oacc[db][qi][4 * g4 + 3] * inv);
                    *(u32x2*)(orow + 32 * db + 8 * g4 + 4 * hl) = w;
                }
        }
    }
    __syncthreads();
}


struct ScanW { bf16x8 wfa[4], wfi[4]; float ba, bi, sp8l2; };
__device__ __forceinline__ void scan_loadw(PP p, int dir, int n, int ct, int l31, int hl, ScanW& w) {
    unsigned chv = (unsigned)(32 * ct + l31); asm volatile("" : "+v"(chv));
    const unsigned ch = (unsigned)(dir * 512 + 64 * n) + chv;
    w.ba = p->lru_b_a[ch]; w.bi = p->lru_b_i[ch];
    w.sp8l2 = ((const float*)(p->ws + WS_SP8))[ch] * 1.4426950408889634f;
    const bf16_t* wa_b = (const bf16_t*)(p->ws + WS_LRU) + (size_t)((dir * 2 + 0) * 8 + n) * 4096;
    const bf16_t* wi_b = (const bf16_t*)(p->ws + WS_LRU) + (size_t)((dir * 2 + 1) * 8 + n) * 4096;
    const unsigned lo = chv * 64u + 8u * (unsigned)hl;
#pragma unroll
    for (int st = 0; st < 4; ++st) { w.wfa[st] = *(const bf16x8*)(wa_b + lo + 16 * st); w.wfi[st] = *(const bf16x8*)(wi_b + lo + 16 * st); }
}
template <int DIR>
__device__ __forceinline__ void scan_dir(PP p, const bf16_t* xs, const ScanW& w, ScanW& wn, int ndir, int nct, bool do_next, int n, int ct, int l31, int hl, int id, int rowbase, bool latent, float (&hf)[2][16]) {
    constexpr int XS = 520;
    const int ch = 64 * n + 32 * ct + l31;
    const float ba = w.ba, bi = w.bi, sp8l2 = w.sp8l2;
    const bf16x8 (&wfa)[4] = w.wfa; const bf16x8 (&wfi)[4] = w.wfi;
    float a[2][16], u[2][16];
#pragma unroll
    for (int rt = 0; rt < 2; ++rt) {
        bf16x8 af[4];
#pragma unroll
        for (int st = 0; st < 4; ++st) af[st] = *(const bf16x8*)(xs + (32 * rt + l31) * XS + 64 * n + 16 * st + 8 * hl);
        f32x16 ga, gi;
#pragma unroll
        for (int i = 0; i < 16; ++i) { ga[i] = 0.f; gi[i] = 0.f; }
#pragma unroll
        for (int st = 0; st < 4; ++st) { ga = __builtin_amdgcn_mfma_f32_32x32x16_bf16(af[st], wfa[st], ga, 0, 0, 0); gi = __builtin_amdgcn_mfma_f32_32x32x16_bf16(af[st], wfi[st], gi, 0, 0, 0); }
#pragma unroll
        for (int i = 0; i < 16; ++i) {
            const int token = 32 * rt + 8 * (i >> 2) + 4 * hl + (i & 3);
            const float xv = bf2f(xs[token * XS + ch]);
            const float rr = fast_sigmoid(ga[i] + ba), ii = fast_sigmoid(gi[i] + bi);
            const float la2 = rr * sp8l2;
            const float av = __builtin_amdgcn_exp2f(la2);
            const float t2 = la2 * 1.3862943611f;
            float em1p = t2 * (1.0f + t2 * (0.5f + t2 * (0.16666667f + t2 * (0.041666668f + t2 * 0.0083333333f)))), em1e = __builtin_fmaf(av, av, -1.0f);
            asm volatile("" : "+v"(em1p), "+v"(em1e));
            const float em1 = (t2 > -0.1f) ? em1p : em1e;
            a[rt][i] = av; u[rt][i] = __builtin_amdgcn_sqrtf(-em1) * (ii * xv);
        }
    }
    float Ao[8], Ho[8], Ap[8], Hp[8];
#pragma unroll
    for (int k = 0; k < 8; ++k) {
        const int rt = k >> 2, g = k & 3;
        float H = 0.f, A = 1.f;
#pragma unroll
        for (int jj = 0; jj < 4; ++jj) { const int j = DIR ? 3 - jj : jj; const float av = a[rt][4 * g + j]; H = av * H + u[rt][4 * g + j]; A *= av; }
        Ao[k] = A; Ho[k] = H; Ap[k] = __shfl_xor(A, 32); Hp[k] = __shfl_xor(H, 32);
    }
    float Sin[8], Pin[8]; float Sx = 0.f, Px = 1.f;
#pragma unroll
    for (int kk = 0; kk < 8; ++kk) {
        const int k = DIR ? 7 - kk : kk;
        const float A0 = hl ? Ap[k] : Ao[k], H0 = hl ? Hp[k] : Ho[k], A1 = hl ? Ao[k] : Ap[k], H1 = hl ? Ho[k] : Hp[k];
        float s0, p0, s1, p1;
        if (DIR == 0) { s0 = Sx; p0 = Px; Sx = A0 * Sx + H0; Px *= A0; s1 = Sx; p1 = Px; Sx = A1 * Sx + H1; Px *= A1; }
        else          { s1 = Sx; p1 = Px; Sx = A1 * Sx + H1; Px *= A1; s0 = Sx; p0 = Px; Sx = A0 * Sx + H0; Px *= A0; }
        Sin[k] = hl ? s1 : s0; Pin[k] = hl ? p1 : p0;
    }
    asm volatile("" ::: "memory");
    if (do_next) scan_loadw(p, ndir, n, nct, l31, hl, wn);
    bf16_t* yl = (bf16_t*)(p->ws + WS_YL) + (size_t)rowbase * 512; bf16_t* caf = (bf16_t*)(p->ws + WS_CAF) + (size_t)rowbase * 512; bf16_t* cab = (bf16_t*)(p->ws + WS_CAB) + (size_t)rowbase * 512;
    unsigned lo = (unsigned)ch; asm volatile("" : "+v"(lo));
#pragma unroll
    for (int k = 0; k < 8; ++k) {
        const int rt = k >> 2, g = k & 3;
        float h = Sin[k], P = Pin[k];
#pragma unroll
        for (int jj = 0; jj < 4; ++jj) {
            const int j = DIR ? 3 - jj : jj, idx = 4 * g + j;
            h = a[rt][idx] * h + u[rt][idx]; P *= a[rt][idx];
            const int token = 32 * rt + 8 * g + 4 * hl + j;
            const unsigned o = lo + (unsigned)token * 512u;
            if (DIR == 0) { hf[rt][idx] = h; if (latent) caf[o] = f2bf(P); }
            else if (latent) { yl[o] = f2bf(hf[rt][idx] + h); cab[o] = f2bf(P); }
        }
    }
    if (hl == 0) {
        float* sumb = (float*)(p->ws + WS_SUM);
        sumb[((size_t)(DIR * NCHUNK + id) * 2 + 0) * 512 + ch] = Px;
        sumb[((size_t)(DIR * NCHUNK + id) * 2 + 1) * 512 + ch] = Sx;
    }
}
__device__ __forceinline__ void scan_mfma(PP p, unsigned char* shm, int wv) {
    const int tid_ = tid_opaque(wv); const int tid = tid_;
    const int lane = tid & 63, n = wv, l31 = lane & 31, hl = lane >> 5;
    constexpr int XS = 520;
    bf16_t* xs = (bf16_t*)shm;
    const bf16_t* proj = (const bf16_t*)(p->ws + WS_PROJ);
    for (int item = blockIdx.x; item < 512 + 32; item += gridDim.x) {
        const int id = item < 512 ? item : 512 + ((item - 512) >> 2);
        const int quarter = item < 512 ? -1 : ((item - 512) & 3);
        int rowbase, t0, seqlen; bool latent;
        if (id < 512) { const int b = id >> 8, k = id & 255; t0 = 64 * k; rowbase = b * S + t0; seqlen = S; latent = true; }
        else { const int j = id - 512, b = j >> 2, k = j & 3; t0 = 64 * k; rowbase = NLAT + b * LC + t0; seqlen = LC; latent = false; }
        const int seqbase = rowbase - t0;
        ScanW w0, w1;
        if (quarter < 0) scan_loadw(p, 0, n, 0, l31, hl, w0);
        {
            const int tid = tid_opaque(wv);
            bf16_t* raw = (bf16_t*)(shm + 66560);
#pragma unroll
            for (int i = 0; i < 9; ++i) {
                const int piece = tid + 512 * i;
                if (piece < 67 * 64) {
                    const int row = piece >> 6, c8 = piece & 63, tt = t0 - 2 + row;
                    u32x4 v = {0u, 0u, 0u, 0u};
                    if (tt >= 0 && tt < seqlen) v = *(const u32x4*)(proj + (size_t)(seqbase + tt) * DIN + 8 * c8);
                    *(u32x4*)(raw + row * 512 + 8 * c8) = v;
                }
            }
            __syncthreads();
            const int cq = tid & 127, tq = tid >> 7, c4 = 4 * cq;
            const f32x4 k0 = *(const f32x4*)(p->rnn_conv_w + c4), k1 = *(const f32x4*)(p->rnn_conv_w + 512 + c4), k2 = *(const f32x4*)(p->rnn_conv_w + 1024 + c4),
                        k3 = *(const f32x4*)(p->rnn_conv_w + 1536 + c4), kb = *(const f32x4*)(p->rnn_conv_b + c4);
            auto ld4 = [&](int row) -> f32x4 { const u32x2 w = *(const u32x2*)(raw + row * 512 + c4); f32x4 r; r[0] = bflo(w.x); r[1] = bfhi(w.x); r[2] = bflo(w.y); r[3] = bfhi(w.y); return r; };
            f32x4 xm2 = ld4(16 * tq), xm1 = ld4(16 * tq + 1), x0 = ld4(16 * tq + 2);
#pragma unroll
            for (int t = 0; t < 16; ++t) {
                const f32x4 xp1 = ld4(16 * tq + t + 3);
                const f32x4 o = kb + k0 * xm2 + k1 * xm1 + k2 * x0 + k3 * xp1;
                u32x2 w; w.x = pk2(o[0], o[1]); w.y = pk2(o[2], o[3]);
                *(u32x2*)(xs + (16 * tq + t) * XS + c4) = w;
                xm2 = xm1; xm1 = x0; x0 = xp1;
            }
        }
        __syncthreads();
#pragma unroll 1
        for (int ct = 0; ct < 2; ++ct) {
            float hf[2][16];
            const bool run0 = quarter < 0 || quarter == 2 * ct, run1 = quarter < 0 || quarter == 2 * ct + 1;
            if (quarter >= 0) { if (run0) scan_loadw(p, 0, n, ct, l31, hl, w0); if (run1) scan_loadw(p, 1, n, ct, l31, hl, w1); }
            if (run0) scan_dir<0>(p, xs, w0, w1, 1, ct, quarter < 0, n, ct, l31, hl, id, rowbase, latent, hf);
            if (run1) scan_dir<1>(p, xs, w1, w0, 0, 1, quarter < 0 && ct == 0, n, ct, l31, hl, id, rowbase, latent, hf);
        }
        __syncthreads();
    }
}

__device__ __forceinline__ void carry_phase(PP p, unsigned char* shm, int wv) {
    if (blockIdx.x >= 128) return;
    const int tid = tid_opaque(wv), cl = tid & 15, sg = tid >> 4;
    const int b = blockIdx.x >> 6, dir = (blockIdx.x >> 5) & 1, c = (blockIdx.x & 31) * 16 + cl;
    const float* sumb = (const float*)(p->ws + WS_SUM) + (size_t)dir * NCHUNK * 1024;
    float* car = (float*)(p->ws + WS_CAR) + (size_t)dir * NCHUNK * 512;
    float* segA = (float*)shm; float* segH = segA + 512;
    float A[9], H[9]; int ids[9];
#pragma unroll
    for (int k = 0; k < 9; ++k) {
        const int s = sg * 9 + k;
        int id = -1;
        if (s < 260) { if (dir == 0) id = s < 4 ? 512 + 4 * b + s : 256 * b + (s - 4); else id = s < 4 ? 512 + 4 * b + (3 - s) : 256 * b + (255 - (s - 4)); }
        ids[k] = id;
        A[k] = id >= 0 ? sumb[(size_t)id * 1024 + c] : 1.f;
        H[k] = id >= 0 ? sumb[(size_t)id * 1024 + 512 + c] : 0.f;
    }
    float As = 1.f, Hs = 0.f;
#pragma unroll
    for (int k = 0; k < 9; ++k) { Hs = A[k] * Hs + H[k]; As *= A[k]; }
    segA[sg * 16 + cl] = As; segH[sg * 16 + cl] = Hs;
    __syncthreads();
    float h = 0.f;
    for (int j = 0; j < sg; ++j) h = segA[j * 16 + cl] * h + segH[j * 16 + cl];
#pragma unroll
    for (int k = 0; k < 9; ++k) { if (ids[k] >= 0) car[(size_t)ids[k] * 512 + c] = h; h = A[k] * h + H[k]; }
    __syncthreads();
}

struct MixRow { u32x4 vy, vf, vb, vg, va; f32x4 cf0, cf1, cb0, cb1; };
__device__ __forceinline__ void mix_load(PP p, int r, int c0, MixRow& m) {
    const bf16_t* proj = (const bf16_t*)(p->ws + WS_PROJ);
    const bf16_t* att = (const bf16_t*)(p->ws + WS_ATT);
    const bf16_t* yl = (const bf16_t*)(p->ws + WS_YL); const bf16_t* caf = (const bf16_t*)(p->ws + WS_CAF); const bf16_t* cab = (const bf16_t*)(p->ws + WS_CAB);
    const float* car = (const float*)(p->ws + WS_CAR);
    const int id = r >> 6;
    m.vy = *(const u32x4*)(yl + (size_t)r * 512 + c0); m.vf = *(const u32x4*)(caf + (size_t)r * 512 + c0); m.vb = *(const u32x4*)(cab + (size_t)r * 512 + c0);
    m.vg = *(const u32x4*)(proj + (size_t)r * DIN + 512 + c0); m.va = *(const u32x4*)(att + (size_t)r * 512 + c0);
    const float* cf = car + (size_t)id * 512 + c0; const float* cbk = car + (size_t)(NCHUNK + id) * 512 + c0;
    m.cf0 = *(const f32x4*)cf; m.cf1 = *(const f32x4*)(cf + 4); m.cb0 = *(const f32x4*)cbk; m.cb1 = *(const f32x4*)(cbk + 4);
}
__device__ __forceinline__ void mix_store(PP p, int r, int c0, const MixRow& m, const f32x4 (&gr)[2], const f32x4 (&ga)[2]) {
    bf16_t* mix = (bf16_t*)(p->ws + WS_HB);
    float rn[8], at[8]; float s1 = 0.f, s2 = 0.f;
#pragma unroll
    for (int e = 0; e < 8; ++e) {
        const unsigned wy = m.vy[e >> 1], wf = m.vf[e >> 1], wb = m.vb[e >> 1], wg = m.vg[e >> 1], wa = m.va[e >> 1];
        const float cfe = e < 4 ? m.cf0[e & 3] : m.cf1[e & 3], cbe = e < 4 ? m.cb0[e & 3] : m.cb1[e & 3];
        const float y = ((e & 1) ? bfhi(wy) : bflo(wy)) + ((e & 1) ? bfhi(wf) : bflo(wf)) * cfe + ((e & 1) ? bfhi(wb) : bflo(wb)) * cbe;
        const float xg = (e & 1) ? bfhi(wg) : bflo(wg);
        rn[e] = gelu_tanh_(xg) * y; s1 += rn[e] * rn[e];
        at[e] = (e & 1) ? bfhi(wa) : bflo(wa); s2 += at[e] * at[e];
    }
    const float r1 = rsqrtf(wave_sum(s1) * (1.0f / 512.0f) + EPS), r2 = rsqrtf(wave_sum(s2) * (1.0f / 512.0f) + EPS);
    u32x4 o1, o2;
#pragma unroll
    for (int e2 = 0; e2 < 4; ++e2) {
        o1[e2] = pk2(rn[2 * e2] * r1 * gr[e2 >> 1][(2 * e2) & 3], rn[2 * e2 + 1] * r1 * gr[e2 >> 1][(2 * e2 + 1) & 3]);
        o2[e2] = pk2(at[2 * e2] * r2 * ga[e2 >> 1][(2 * e2) & 3], at[2 * e2 + 1] * r2 * ga[e2 >> 1][(2 * e2 + 1) & 3]);
    }
    *(u32x4*)(mix + (size_t)r * D + c0) = o1; *(u32x4*)(mix + (size_t)r * D + 512 + c0) = o2;
}
__device__ __forceinline__ void mix_phase(PP p, int wv) {
    const int tid_ = tid_opaque(wv), lane = tid_ & 63, gw = blockIdx.x * 8 + (tid_ >> 6), NGW = gridDim.x * 8;
    const int c0 = 8 * lane;
    f32x4 gr[2], ga[2];
    gr[0] = *(const f32x4*)(p->gn_rnn + c0); gr[1] = *(const f32x4*)(p->gn_rnn + c0 + 4); ga[0] = *(const f32x4*)(p->gn_attn + c0); ga[1] = *(const f32x4*)(p->gn_attn + c0 + 4);
    for (int r = gw; r < NLAT; r += 2 * NGW) {
        const int rb = (r + NGW < NLAT) ? r + NGW : r;
        MixRow ma, mb;
        mix_load(p, r, c0, ma); mix_load(p, rb, c0, mb);
        mix_store(p, r, c0, ma, gr, ga);
        if (rb != r) mix_store(p, rb, c0, mb, gr, ga);
    }
}

__device__ __forceinline__ void phase7(PP p, int wv) {
    const int tid_ = tid_opaque(wv), lane = tid_ & 63, gw = blockIdx.x * 8 + (tid_ >> 6), NGW = gridDim.x * 8;
    const float* mod = (const float*)(p->ws + WS_MOD);
    bf16_t* hb = (bf16_t*)(p->ws + WS_HB);
    const bf16_t* o1 = (const bf16_t*)(p->ws + WS_O1);
    for (int r = gw; r < NLAT; r += 2 * NGW) {
        const int rb = r + NGW;
        f32x4 va[4], vb[4]; u32x2 da[4], db[4];
        row_load_nt(p->x + (size_t)r * D, lane, va); row_load_nt(p->x + (size_t)rb * D, lane, vb);
#pragma unroll
        for (int j = 0; j < 4; ++j) { da[j] = *(const u32x2*)(o1 + (size_t)r * D + 4 * lane + 256 * j); db[j] = *(const u32x2*)(o1 + (size_t)rb * D + 4 * lane + 256 * j); }
#pragma unroll
        for (int j = 0; j < 4; ++j) {
            va[j][0] += bflo(da[j].x); va[j][1] += bfhi(da[j].x); va[j][2] += bflo(da[j].y); va[j][3] += bfhi(da[j].y);
            vb[j][0] += bflo(db[j].x); vb[j][1] += bfhi(db[j].x); vb[j][2] += bflo(db[j].y); vb[j][3] += bfhi(db[j].y);
        }
        const float sa = row_rstd(va), sb = row_rstd(vb);
        const int ma = r >> 14, mb = rb >> 14;
        norm_mod_store(va, sa, p->norm2_g, mod + ma * 6144 + 3072, mod + ma * 6144 + 4096, hb + (size_t)(ma * H2_BSTRIDE + 1 + (r & (S - 1))) * D, lane);
        norm_mod_store(vb, sb, p->norm2_g, mod + mb * 6144 + 3072, mod + mb * 6144 + 4096, hb + (size_t)(mb * H2_BSTRIDE + 1 + (rb & (S - 1))) * D, lane);
    }
    for (int z = gw; z < 254; z += NGW) {
        const int R = z == 0 ? 0 : (z <= 126 ? S + z : 32895 + (z - 127));
        const u32x4 zz = {0u, 0u, 0u, 0u};
        *(u32x4*)(hb + (size_t)R * D + 8 * lane) = zz; *(u32x4*)(hb + (size_t)R * D + 512 + 8 * lane) = zz;
    }
}

__device__ __forceinline__ void final_phase(PP p, int wv) {
    const int tid_ = tid_opaque(wv), lane = tid_ & 63, gw = blockIdx.x * 8 + (tid_ >> 6), NGW = gridDim.x * 8;
    const bf16_t* o1 = (const bf16_t*)(p->ws + WS_O1); const bf16_t* o2 = (const bf16_t*)(p->ws + WS_O2);
    for (int r = gw; r < NLAT; r += 2 * NGW) {
        const int rb = r + NGW;
        f32x4 va[4], vb[4]; u32x2 da[4], db[4], ea[4], eb[4];
        row_load_nt(p->x + (size_t)r * D, lane, va); row_load_nt(p->x + (size_t)rb * D, lane, vb);
#pragma unroll
        for (int j = 0; j < 4; ++j) {
            da[j] = *(const u32x2*)(o1 + (size_t)r * D + 4 * lane + 256 * j); db[j] = *(const u32x2*)(o1 + (size_t)rb * D + 4 * lane + 256 * j);
            ea[j] = *(const u32x2*)(o2 + (size_t)r * D + 4 * lane + 256 * j); eb[j] = *(const u32x2*)(o2 + (size_t)rb * D + 4 * lane + 256 * j);
        }
#pragma unroll
        for (int j = 0; j < 4; ++j) {
            va[j][0] += bflo(da[j].x) + bflo(ea[j].x); va[j][1] += bfhi(da[j].x) + bfhi(ea[j].x); va[j][2] += bflo(da[j].y) + bflo(ea[j].y); va[j][3] += bfhi(da[j].y) + bfhi(ea[j].y);
            vb[j][0] += bflo(db[j].x) + bflo(eb[j].x); vb[j][1] += bfhi(db[j].x) + bfhi(eb[j].x); vb[j][2] += bflo(db[j].y) + bflo(eb[j].y); vb[j][3] += bfhi(db[j].y) + bfhi(eb[j].y);
        }
        const float sa = row_rstd(va), sb = row_rstd(vb);
        float* rowa = p->out + (size_t)r * D; float* rowb = p->out + (size_t)rb * D;
#pragma unroll
        for (int j = 0; j < 4; ++j) { const f32x4 gg = *(const f32x4*)(p->final_g + 4 * lane + 256 * j); *(f32x4*)(rowa + 4 * lane + 256 * j) = va[j] * sa * gg; *(f32x4*)(rowb + 4 * lane + 256 * j) = vb[j] * sb * gg; }
    }
}

__global__ void __launch_bounds__(512, 2) fwd_megakernel(Params p_arg) {
    extern __shared__ __attribute__((aligned(16))) unsigned char shm[];
    cg::grid_group grid = cg::this_grid();
    LAS unsigned char* lds = (LAS unsigned char*)shm;
    pg8::StaticOrder so;
    const int wv = __builtin_amdgcn_readfirstlane((int)(threadIdx.x >> 6));
    volatile LAS unsigned* xst = (volatile LAS unsigned*)(lds + LDS_XB);
    if (tid_opaque(wv) == 0) { xst[0] = 0u; xst[1] = 0u; }
    __syncthreads();
    (void)xcd_barrier_post((unsigned*)(kparams()->ws + WS_BAR), xst, wv);
#define XBAR() do { XcdBarrier _b; _b.bar = (unsigned*)(kparams()->ws + WS_BAR); _b.x = xb_xcc_id(); _b.st = (volatile LAS unsigned*)(lds + LDS_XB); xcd_barrier(_b, wv); } while (0)
    if (kparams()->out == nullptr) grid.sync();

    phase0(kparams(), shm, wv);
    {
        constexpr int T_IN = (D / 64) * (DIN / 32), T_B = (D / 64) * (D / 32) + (D / 64) * (DUP / 32) + (DFF / 64) * (D / 32), T_LRU = 64;
        const int nfree = (int)gridDim.x > 192 ? (int)gridDim.x - 192 : 0;
        const int first = nfree ? 192 : 0, nblk = nfree ? nfree : (int)gridDim.x;
        if ((int)blockIdx.x >= first) {
            transpose_phase(kparams(), shm, wv, 0, T_IN, ((int)blockIdx.x - first) * 8, nblk * 8);
            transpose_phase(kparams(), shm, wv, T_IN + T_B, T_IN + T_B + T_LRU, ((int)blockIdx.x - first) * 8, nblk * 8);
        }
    }
    XBAR();
    phase1(kparams(), wv);
    XBAR();
    {
        PP p = kparams(); unsigned char* ws = p->ws;
        pg8::Gemm g{(const bf16_t*)(ws + WS_HB), (const bf16_t*)(ws + WS_WIN), MROWS / 256, DIN / 256, D, 256};
        so.init(g.nM, g.nN, gridDim.x, blockIdx.x);
        EpiProj e{(bf16_t*)(ws + WS_PROJ), (const float*)(ws + WS_ROPE), (const float*)(ws + WS_ROPE) + 4096};
        pg8::gemm_phase(lds, g, so, e, wv);
        {
            constexpr int T_IN = (D / 64) * (DIN / 32), T_B = (D / 64) * (D / 32) + (D / 64) * (DUP / 32) + (DFF / 64) * (D / 32);
            const int G = (int)gridDim.x, rem = (g.nM * g.nN) % G;
            const int first = rem ? rem : 0, nblk = G - first;
            if ((int)blockIdx.x >= first) transpose_phase(p, shm, wv, T_IN, T_IN + T_B, ((int)blockIdx.x - first) * 8, nblk * 8);
        }
    }
    XBAR();
    scan_mfma(kparams(), shm, wv);
    attn_mfma(kparams(), shm, wv);
    XBAR();
    carry_phase(kparams(), shm, wv);
    XBAR();
    mix_phase(kparams(), wv);
    XBAR();
    {
        PP p = kparams(); unsigned char* ws = p->ws; const float* mod = (const float*)(ws + WS_MOD);
        pg8::Gemm g{(const bf16_t*)(ws + WS_HB), (const bf16_t*)(ws + WS_WOUT), NLAT / 256, D / 256, D, 256};
        so.init(g.nM, g.nN, gridDim.x, blockIdx.x);
        EpiDelta e{(bf16_t*)(ws + WS_O1), mod + 2048, mod + 6144 + 2048};
        pg8::gemm_phase(lds, g, so, e, wv);
    }
    XBAR();
    phase7(kparams(), wv);
    XBAR();
    {
        PP p = kparams(); unsigned char* ws = p->ws;
        pg8::Gemm g{(const bf16_t*)(ws + WS_HB), (const bf16_t*)(ws + WS_WUP), 130, DUP / 256, D, 254};
        so.init(g.nM, g.nN, gridDim.x, blockIdx.x);
        EpiConvGate e{(bf16_t*)(ws + WS_ACT), p->ffn_conv_w, p->ffn_conv_b, lds + 131072};
        pg8::gemm_phase(lds, g, so, e, wv);
    }
    XBAR();
    {
        PP p = kparams(); unsigned char* ws = p->ws; const float* mod = (const float*)(ws + WS_MOD);
        pg8::Gemm g{(const bf16_t*)(ws + WS_ACT), (const bf16_t*)(ws + WS_WDN), NLAT / 256, D / 256, DFF, 256};
        so.init(g.nM, g.nN, gridDim.x, blockIdx.x);
        EpiDelta e{(bf16_t*)(ws + WS_O2), mod + 5120, mod + 6144 + 5120};
        pg8::gemm_phase(lds, g, so, e, wv);
    }
    XBAR();
    final_phase(kparams(), wv);
}

extern "C" void kernel_launch(void* const* d_in, const int* in_sizes, int n_in, void* d_out, int out_size, void* d_ws, size_t ws_size, hipStream_t stream) {
    static int grid_blocks = 0;
    if (!grid_blocks) {
        int dev = 0, cus = 0, per_cu = 0;
        hipGetDevice(&dev);
        hipDeviceGetAttribute(&cus, hipDeviceAttributeMultiprocessorCount, dev);
        hipFuncSetAttribute((const void*)fwd_megakernel, hipFuncAttributeMaxDynamicSharedMemorySize, LDS_BYTES);
        hipOccupancyMaxActiveBlocksPerMultiprocessor(&per_cu, (const void*)fwd_megakernel, 512, LDS_BYTES);
        if (per_cu < 1) per_cu = 1;
        grid_blocks = cus * per_cu;
        if (ws_size < WS_END) fprintf(stderr, "kernel_launch: workspace too small: %zu < %zu\n", ws_size, (size_t)WS_END);
    }
    Params p{};
    const float** pp = (const float**)&p;
    for (int i = 0; i < 25; ++i) pp[i] = (const float*)d_in[i];
    const size_t ws_off = ws_size > WS_END ? ((ws_size - WS_END) & ~(size_t)4095) : 0;
    p.out = (float*)d_out; p.ws = (unsigned char*)d_ws + ws_off;
    hipMemsetAsync((unsigned char*)d_ws + ws_off + WS_BAR, 0, 16384, stream);
    void* args[] = {&p};
    hipError_t e = hipLaunchCooperativeKernel((const void*)fwd_megakernel, dim3(grid_blocks), dim3(512), args, LDS_BYTES, stream);
    if (e != hipSuccess) fprintf(stderr, "cooperative launch failed: %s (grid %d)\n", hipGetErrorString(e), grid_blocks);
}
```

```cpp
#include <hip/hip_runtime.h>
#include <hip/hip_cooperative_groups.h>
#include <cstdio>
namespace cg = cooperative_groups;

#define LAS __attribute__((address_space(3)))
typedef unsigned short bf16_t;
typedef short bf16x8 __attribute__((ext_vector_type(8)));
typedef float f32x4 __attribute__((ext_vector_type(4)));
typedef unsigned u32x4 __attribute__((ext_vector_type(4)));
typedef unsigned u32x2 __attribute__((ext_vector_type(2)));

constexpr int D = 1024, NB = 2, S = 16384, LC = 256;
constexpr int NLAT = NB * S;
constexpr int NCTX = NB * LC;
constexpr int MROWS = NLAT + NCTX;
constexpr int DIN = 1792, DFF = 2816, DUP = 5632, DRNN = 512;
constexpr int NCHUNK = MROWS / 64;
constexpr float EPS = 1e-6f;

constexpr size_t AL(size_t x) { return (x + 255) & ~(size_t)255; }
constexpr size_t WS_WIN  = 0;
constexpr size_t WS_WOUT = WS_WIN  + AL((size_t)DIN * D * 2);
constexpr size_t WS_WUP  = WS_WOUT + AL((size_t)D * D * 2);
constexpr size_t WS_WDN  = WS_WUP  + AL((size_t)DUP * D * 2);
constexpr size_t WS_LRU  = WS_WDN  + AL((size_t)D * DFF * 2);
constexpr size_t WS_MOD  = WS_LRU  + AL((size_t)4 * 8 * 64 * 64 * 2);
constexpr size_t WS_ROPE = WS_MOD  + AL((size_t)3 * 6144 * 4);
constexpr size_t WS_SUM  = WS_ROPE + AL((size_t)2 * 256 * 16 * 4);
constexpr size_t WS_CAR  = WS_SUM  + AL((size_t)2 * NCHUNK * 2 * 512 * 4);
constexpr size_t WS_SP8  = WS_CAR  + AL((size_t)2 * NCHUNK * 512 * 4);
constexpr size_t WS_BAR  = WS_SP8  + 4096;
constexpr size_t WS_R1   = WS_BAR  + 16384;
constexpr size_t WS_ATT  = WS_R1;
constexpr size_t WS_YL   = WS_ATT  + AL((size_t)NLAT * 512 * 2);
constexpr size_t WS_CAF  = WS_YL   + AL((size_t)NLAT * 512 * 2);
constexpr size_t WS_CAB  = WS_CAF  + AL((size_t)NLAT * 512 * 2);
constexpr size_t WS_PROJ = WS_CAB  + AL((size_t)NLAT * 512 * 2);
constexpr size_t WS_R1END = WS_PROJ + AL((size_t)MROWS * DIN * 2);
constexpr size_t WS_HB   = WS_R1END;
constexpr size_t WS_HBEND = WS_HB + AL((size_t)MROWS * D * 2);
constexpr size_t WS_ACT  = WS_R1;
constexpr size_t WS_O1   = WS_ACT + AL((size_t)NLAT * DFF * 2);
constexpr size_t WS_O2   = WS_HB;
constexpr size_t WS_END  = WS_HBEND;
static_assert(WS_O1 + (size_t)NLAT * D * 2 <= WS_R1END, "o1");
static_assert(WS_ACT + (size_t)NLAT * DFF * 2 <= WS_R1END, "act");
constexpr int H2_BSTRIDE = 65 * 254;
constexpr int H2_ROWS = 130 * 254 + 2;
static_assert((size_t)H2_ROWS * D * 2 <= (size_t)MROWS * D * 2, "h2");

constexpr int LDS_BYTES = 131072 + 8192 + 256;
constexpr int LDS_XB = 131072 + 8192;

struct Params {
    const float *x, *c, *ctx, *c_ctx, *w_mod, *b_mod, *norm1_g, *w_in, *rnn_conv_w, *rnn_conv_b, *lru_w_a, *lru_b_a,
        *lru_w_i, *lru_b_i, *lru_lam, *attn_sink, *gn_rnn, *gn_attn, *w_out, *norm2_g, *w_up, *ffn_conv_w, *ffn_conv_b,
        *w_down, *final_g;
    float* out;
    unsigned char* ws;
};

typedef const Params __attribute__((address_space(4)))* PP;
__device__ __forceinline__ PP kparams() { PP k = (PP)__builtin_amdgcn_kernarg_segment_ptr(); asm volatile("" : "+s"(k)); return k; }
__device__ __forceinline__ int lane_fresh() { unsigned m = ~0u; asm volatile("" : "+s"(m)); return (int)__builtin_amdgcn_mbcnt_hi(m, __builtin_amdgcn_mbcnt_lo(m, 0u)); }
__device__ __forceinline__ int tid_opaque(int wv) { return wv * 64 + lane_fresh(); }
__device__ __forceinline__ bf16_t f2bf(float f) { unsigned u = __float_as_uint(f); u += 0x7FFFu + ((u >> 16) & 1u); return (bf16_t)(u >> 16); }
__device__ __forceinline__ float bf2f(bf16_t b) { return __uint_as_float(((unsigned)b) << 16); }
__device__ __forceinline__ unsigned pk2(float lo, float hi) { unsigned r; asm("v_cvt_pk_bf16_f32 %0, %1, %2" : "=v"(r) : "v"(lo), "v"(hi)); return r; }
__device__ __forceinline__ float bflo(unsigned w) { return __uint_as_float(w << 16); }
__device__ __forceinline__ float bfhi(unsigned w) { return __uint_as_float(w & 0xFFFF0000u); }
__device__ __forceinline__ float wave_sum(float v) {
#pragma unroll
    for (int o = 32; o >= 1; o >>= 1) v += __shfl_xor(v, o);
    return v;
}
__device__ __forceinline__ float wave_max(float v) {
#pragma unroll
    for (int o = 32; o >= 1; o >>= 1) v = fmaxf(v, __shfl_xor(v, o));
    return v;
}
__device__ __forceinline__ float sigmoidf_(float x) { return 1.0f / (1.0f + __expf(-x)); }
__device__ __forceinline__ float fast_sigmoid(float x) { return __builtin_amdgcn_rcpf(1.0f + __builtin_amdgcn_exp2f(-1.4426950408889634f * x)); }
__device__ __forceinline__ float silu_(float x) { return x * fast_sigmoid(x); }
__device__ __forceinline__ float gelu_tanh_(float x) {
    const float u = 0.7978845608028654f * (x + 0.044715f * x * x * x);
    const float e = __expf(2.0f * u);
    const float th = 1.0f - 2.0f / (e + 1.0f);
    return 0.5f * x * (1.0f + th);
}


#define XB_TMO      128
#define XB_XCNT(j)  (256  + 64 * (j))
#define XB_XSUB(j)  (1280 + 64 * (j))
#define XB_XGEN(j)  (2304 + 64 * (j))
#define XB_TOP      3328
#define XB_TOPGEN   3392
#define XCD_BAR_WORDS 3456
#define XB_SPIN_CAP (1u << 20)
__device__ __forceinline__ unsigned xb_ld(unsigned* p)              { return __hip_atomic_load(p, __ATOMIC_RELAXED, __HIP_MEMORY_SCOPE_AGENT); }
__device__ __forceinline__ unsigned xb_add(unsigned* p, unsigned v) { return __hip_atomic_fetch_add(p, v, __ATOMIC_RELAXED, __HIP_MEMORY_SCOPE_AGENT); }
__device__ __forceinline__ unsigned xb_xcc_id() { return (unsigned)__builtin_amdgcn_s_getreg((3 << 11) | 20) & 0xFu; }
#define XB_SPIN(cond, bar) do { unsigned _sp = 0; while (cond) { __builtin_amdgcn_s_sleep(1); \
    if ((++_sp & 255u) == 0u) { if (xb_ld(&(bar)[XB_TMO])) break; if (_sp > XB_SPIN_CAP) { atomicAdd(&(bar)[XB_TMO], 1u); break; } } } } while (0)
struct XcdBarrier { unsigned* bar; unsigned x; volatile LAS unsigned* st; };
__device__ __forceinline__ XcdBarrier xcd_barrier_post(unsigned* bar, volatile LAS unsigned* st, int wv) {
    XcdBarrier b; b.bar = bar; b.x = xb_xcc_id(); b.st = st;
    if (tid_opaque(wv) == 0) (void)xb_add(&bar[XB_XCNT(b.x)], 1u);
    return b;
}
__device__ __forceinline__ void xcd_barrier_complete(unsigned* bar, unsigned x, unsigned& nloc, unsigned& nx) {
    const unsigned G = gridDim.x * gridDim.y * gridDim.z;
    unsigned sum, cnt, mine, sp = 0u;
    for (;;) {
        sum = 0u; cnt = 0u; mine = 0u;
#pragma unroll
        for (unsigned j = 0; j < 16; ++j) { const unsigned c = xb_ld(&bar[XB_XCNT(j)]); sum += c; cnt += (c > 0u) ? 1u : 0u; mine = (j == x) ? c : mine; }
        if (sum == G) break;
        __builtin_amdgcn_s_sleep(1);
        if ((++sp & 255u) == 0u) { if (xb_ld(&bar[XB_TMO])) break; if (sp > XB_SPIN_CAP) { atomicAdd(&bar[XB_TMO], 1u); break; } }
    }
    nloc = mine > 0u ? mine : 1u; nx = cnt > 0u ? cnt : 1u;
}
__device__ __forceinline__ void xcd_barrier(const XcdBarrier& b, int wv) {
    asm volatile("s_waitcnt vmcnt(0)" ::: "memory");
    __syncthreads();
    if (tid_opaque(wv) == 0) {
        unsigned* bar = b.bar;
        __builtin_amdgcn_s_waitcnt(0);
        unsigned nloc = b.st[0], nx = b.st[1];
        if (nloc == 0u) { xcd_barrier_complete(bar, b.x, nloc, nx); b.st[0] = nloc; b.st[1] = nx; }
        const unsigned old = xb_add(&bar[XB_XSUB(b.x)], 1u);
        const unsigned gen = old / nloc;
        if (old + 1u == (gen + 1u) * nloc) {
            __builtin_amdgcn_fence(__ATOMIC_RELEASE, "agent");
            asm volatile("s_waitcnt vmcnt(0)" ::: "memory");
            const unsigned og = xb_add(&bar[XB_TOP], 1u);
            const unsigned tg = og / nx;
            if (og + 1u == (tg + 1u) * nx) xb_add(&bar[XB_TOPGEN], 1u);
            else XB_SPIN(xb_ld(&bar[XB_TOPGEN]) == tg, bar);
            __builtin_amdgcn_fence(__ATOMIC_ACQUIRE, "agent");
            xb_add(&bar[XB_XGEN(b.x)], 1u);
            asm volatile("s_waitcnt vmcnt(0)" ::: "memory");
        } else {
            XB_SPIN(xb_ld(&bar[XB_XGEN(b.x)]) == gen, bar);
            __builtin_amdgcn_fence(__ATOMIC_ACQUIRE, "agent");
            asm volatile("s_waitcnt vmcnt(0)" ::: "memory");
        }
    }
    __syncthreads();
}

namespace pg8 {
constexpr int BM = 256, BK = 64, HALF = 128, HTB = HALF * BK * 2, NXCD = 8, WGM = 8;
__host__ __device__ __forceinline__ int lds_byte(int r, int c) { const int st = (r >> 4) * 2 + (c >> 5), rr = r & 15, cc = c & 31, ob = rr * 64 + cc * 2; return st * 1024 + (ob ^ (((ob >> 9) & 1) << 5)); }
__host__ __device__ __forceinline__ void stage_rc(int b, int& R, int& C) { const int st = b / 1024, sb = b % 1024, swz = sb ^ (((sb >> 9) & 1) << 5); R = (st >> 1) * 16 + swz / 64; C = (st & 1) * 32 + (swz % 64) / 2; }
struct Unit { int pm, pn; };
struct Gemm { const bf16_t* A; const bf16_t* Bt; int nM, nN, K, a_tile_rows; };
struct StaticOrder {
    int nM, nN, nwg, G, c;
    __device__ void init(int nM_, int nN_, int G_, int c_) { nM = nM_; nN = nN_; nwg = nM * nN; G = G_; c = c_; }
    __device__ bool next(int i, Unit& u) const {
        const long L = (long)i * G + c; if (L >= nwg) return false;
        int wgid = (int)L; { const int q = nwg / NXCD, r = nwg % NXCD, xcd = wgid % NXCD, off = wgid / NXCD; wgid = (xcd < r ? xcd * (q + 1) : r * (q + 1) + (xcd - r) * q) + off; }
        const int nig = WGM * nN, gid = wgid / nig, fm = gid * WGM, gsz = (nM - fm) < WGM ? (nM - fm) : WGM;
        u.pm = fm + ((wgid % nig) % gsz); u.pn = (wgid % nig) / gsz; return true;
    }
};
template <class Epi>
__device__ __forceinline__ void gemm_phase(LAS unsigned char* lds, const Gemm g, const StaticOrder& S, const Epi& E, int wv) {
    const int tid = tid_opaque(wv);
    const int wid = __builtin_amdgcn_readfirstlane(tid >> 6), lane = tid & 63, wr = wid >> 2, wc = wid & 3, fr = lane & 15, fq = lane >> 4;
    const int K = g.K, nt = K / BK;
    unsigned voffA[2], voffB[2];
#pragma unroll
    for (int i = 0; i < 2; ++i) { int R, C; stage_rc(tid * 16 + i * 8192, R, C);
        const int Ra = (R & ~63) + 4 * (R & 15) + ((R >> 4) & 3);
        voffA[i] = (unsigned)(Ra * K + C) * 2u; voffB[i] = (unsigned)(R * K + C) * 2u; }
    const size_t kstep = (size_t)(BK * 2);
    const size_t hstep = (size_t)HALF * K * 2;
    const size_t tstepA = (size_t)g.a_tile_rows * K * 2;
    const size_t tstepB = 2 * hstep;
    const unsigned ldsw = (unsigned)wid * 1024u;
    const int aoff = lds_byte(wr * 64 + fr, fq * 8), boff = lds_byte(wc * 32 + fr, fq * 8);
#define PG8_SA(b, h) (((b) * 2 + (h)) * HTB)
#define PG8_SB(b, h) ((4 + (b) * 2 + (h)) * HTB)
#define PG8_STAGE(bufoff, gbase, voff) do { _Pragma("unroll") for (int _i = 0; _i < 2; ++_i) \
        __builtin_amdgcn_global_load_lds((const unsigned*)((const char*)(gbase) + (voff)[_i]), (LAS unsigned*)(lds + (bufoff) + ldsw + _i * 8192), 16, 0, 0); } while (0)
#define PG8_LDA(dst, b, h) do { _Pragma("unroll") for (int m = 0; m < 4; ++m) _Pragma("unroll") for (int k = 0; k < 2; ++k) dst[m][k] = *(const LAS bf16x8*)(lds + PG8_SA(b, h) + aoff + m * 2048 + k * 1024); } while (0)
#define PG8_LDB(dst, b, h) do { _Pragma("unroll") for (int n = 0; n < 2; ++n) _Pragma("unroll") for (int k = 0; k < 2; ++k) dst[n][k] = *(const LAS bf16x8*)(lds + PG8_SB(b, h) + boff + n * 2048 + k * 1024); } while (0)
#define PG8_MMA(ai, bj, At, Bt) do { __builtin_amdgcn_s_setprio(1); _Pragma("unroll") for (int m = 0; m < 4; ++m) _Pragma("unroll") for (int n = 0; n < 2; ++n) _Pragma("unroll") for (int k = 0; k < 2; ++k) \
        acc[ai][bj][m][n] = __builtin_amdgcn_mfma_f32_16x16x32_bf16(Bt[n][k], At[m][k], acc[ai][bj][m][n], 0, 0, 0); __builtin_amdgcn_s_setprio(0); } while (0)
#define PG8_WAIT_V(n) asm volatile("s_waitcnt vmcnt(" #n ")" ::: "memory")
#define PG8_WAIT_L(n) asm volatile("s_waitcnt lgkmcnt(" #n ")" ::: "memory")
#define PG8_BAR __builtin_amdgcn_s_barrier()
#define PG8_SCHED __builtin_amdgcn_sched_barrier(0)
    Unit cur, nxt; int ui = 0;
    if (!S.next(0, cur)) return;
    f32x4 acc[2][2][4][2];
#pragma unroll
    for (int a = 0; a < 2; ++a)
#pragma unroll
        for (int b = 0; b < 2; ++b)
#pragma unroll
            for (int m = 0; m < 4; ++m)
#pragma unroll
                for (int n = 0; n < 2; ++n) acc[a][b][m][n] = (f32x4){0.f, 0.f, 0.f, 0.f};
    bf16x8 At[4][2], B0[2][2], B1[2][2];
    const char* cA = (const char*)g.A + (size_t)cur.pm * tstepA; const char* cB = (const char*)g.Bt + (size_t)cur.pn * tstepB;
    PG8_STAGE(PG8_SB(0, 0), cB, voffB); PG8_STAGE(PG8_SA(0, 0), cA, voffA); PG8_STAGE(PG8_SB(0, 1), cB + hstep, voffB); PG8_STAGE(PG8_SA(0, 1), cA + hstep, voffA);
    if (wr == 1) PG8_BAR;
    PG8_WAIT_V(4); PG8_BAR;
    PG8_STAGE(PG8_SB(1, 0), cB + kstep, voffB); PG8_STAGE(PG8_SA(1, 0), cA + kstep, voffA); PG8_STAGE(PG8_SB(1, 1), cB + hstep + kstep, voffB);
    PG8_WAIT_V(6); PG8_BAR;
    for (;;) {
        const bool has_next = S.next(ui + 1, nxt);
        const char* nA = has_next ? (const char*)g.A + (size_t)nxt.pm * tstepA : cA; const char* nB = has_next ? (const char*)g.Bt + (size_t)nxt.pn * tstepB : cB;
        for (int t = 0; t < nt; t += 2) {
            const bool last = (t == nt - 2);
            const char* a1 = cA + (size_t)(t + 1) * kstep;
            const char* a2 = last ? nA : cA + (size_t)(t + 2) * kstep; const char* b2 = last ? nB : cB + (size_t)(t + 2) * kstep;
            const char* a3 = a2 + kstep; const char* b3 = b2 + kstep;
            PG8_LDB(B0, 0, 0); PG8_SCHED; PG8_LDA(At, 0, 0); PG8_STAGE(PG8_SA(1, 1), a1 + hstep, voffA);
            PG8_WAIT_L(8); PG8_BAR; PG8_WAIT_L(0); PG8_MMA(0, 0, At, B0); PG8_BAR; PG8_SCHED;
            PG8_LDB(B1, 0, 1); PG8_STAGE(PG8_SB(0, 0), b2, voffB);
            PG8_BAR; PG8_WAIT_L(0); PG8_MMA(0, 1, At, B1); PG8_BAR;
            PG8_LDA(At, 0, 1); PG8_STAGE(PG8_SA(0, 0), a2, voffA);
            PG8_BAR; PG8_WAIT_L(0); PG8_MMA(1, 0, At, B0); PG8_BAR; PG8_SCHED;
            PG8_STAGE(PG8_SB(0, 1), b2 + hstep, voffB);
            PG8_WAIT_V(6); PG8_BAR; PG8_MMA(1, 1, At, B1); PG8_BAR;
            PG8_LDB(B0, 1, 0); PG8_SCHED; PG8_LDA(At, 1, 0); PG8_STAGE(PG8_SA(0, 1), a2 + hstep, voffA);
            PG8_WAIT_L(8); PG8_BAR; PG8_WAIT_L(0); PG8_MMA(0, 0, At, B0); PG8_BAR; PG8_SCHED;
            PG8_LDB(B1, 1, 1); PG8_STAGE(PG8_SB(1, 0), b3, voffB);
            PG8_BAR; PG8_WAIT_L(0); PG8_MMA(0, 1, At, B1); PG8_BAR;
            PG8_LDA(At, 1, 1); PG8_STAGE(PG8_SA(1, 0), a3, voffA);
            PG8_BAR; PG8_WAIT_L(0); PG8_MMA(1, 0, At, B0); PG8_BAR; PG8_SCHED;
            PG8_STAGE(PG8_SB(1, 1), b3 + hstep, voffB);
            PG8_WAIT_V(6); PG8_BAR; PG8_MMA(1, 1, At, B1); PG8_BAR;
        }
        { const int ln2 = lane_fresh();
          E(acc, cur, wr, wc, ln2 & 15, ln2 >> 4); }
        if (!has_next) break;
#pragma unroll
        for (int a = 0; a < 2; ++a)
#pragma unroll
            for (int b = 0; b < 2; ++b)
#pragma unroll
                for (int m = 0; m < 4; ++m)
#pragma unroll
                    for (int n = 0; n < 2; ++n) acc[a][b][m][n] = (f32x4){0.f, 0.f, 0.f, 0.f};
        cur = nxt; cA = nA; cB = nB; ++ui;
    }
    PG8_WAIT_V(0);
    if (wr == 0) PG8_BAR;
    PG8_BAR;
#undef PG8_SA
#undef PG8_SB
#undef PG8_STAGE
#undef PG8_LDA
#undef PG8_LDB
#undef PG8_MMA
#undef PG8_WAIT_V
#undef PG8_WAIT_L
#undef PG8_BAR
#undef PG8_SCHED
}
}
using pg8::Unit;

struct EpiProj {
    bf16_t* O; const float* cosT; const float* sinT;
    __device__ __forceinline__ void operator()(const f32x4 (&acc)[2][2][4][2], const Unit& u, int wr, int wc, int fr, int fq) const {
        const bool latent = u.pm < 128;
#pragma unroll
        for (int ai = 0; ai < 2; ++ai)
#pragma unroll
            for (int m = 0; m < 4; ++m) {
                const int row = u.pm * 256 + ai * 128 + wr * 64 + 4 * fr + m;
                const int t = row & (S - 1);
                const int pos = (wc & 1) ? (t & 63) : (t >> 6);
#pragma unroll
                for (int bj = 0; bj < 2; ++bj) {
                    const int col = u.pn * 256 + bj * 128 + wc * 32 + 4 * fq;
                    f32x4 v0 = acc[ai][bj][m][0], v1 = acc[ai][bj][m][1];
                    const bool rope = latent && (u.pn == 4 || u.pn == 5 || (u.pn == 6 && bj == 0));
                    if (rope) {
                        const f32x4 cs = *(const f32x4*)(cosT + pos * 16 + 4 * fq), sn = *(const f32x4*)(sinT + pos * 16 + 4 * fq);
                        const f32x4 n0 = v0 * cs - v1 * sn, n1 = v1 * cs + v0 * sn; v0 = n0; v1 = n1;
                    }
                    bf16_t* p = O + (size_t)row * DIN + col;
                    u32x2 w0, w1; w0.x = pk2(v0[0], v0[1]); w0.y = pk2(v0[2], v0[3]); w1.x = pk2(v1[0], v1[1]); w1.y = pk2(v1[2], v1[3]);
                    *(u32x2*)p = w0; *(u32x2*)(p + 16) = w1;
                }
            }
    }
};
struct EpiDelta {
    bf16_t* O; const float* gate0; const float* gate1;
    __device__ __forceinline__ void operator()(const f32x4 (&acc)[2][2][4][2], const Unit& u, int wr, int wc, int fr, int fq) const {
        const float* gate = (u.pm >= 64) ? gate1 : gate0;
        f32x4 gv[2][2];
#pragma unroll
        for (int bj = 0; bj < 2; ++bj)
#pragma unroll
            for (int n = 0; n < 2; ++n) gv[bj][n] = *(const f32x4*)(gate + u.pn * 256 + bj * 128 + wc * 32 + n * 16 + 4 * fq);
#pragma unroll
        for (int ai = 0; ai < 2; ++ai)
#pragma unroll
            for (int m = 0; m < 4; ++m) {
                const size_t row = (size_t)u.pm * 256 + ai * 128 + wr * 64 + 4 * fr + m;
#pragma unroll
                for (int bj = 0; bj < 2; ++bj)
#pragma unroll
                    for (int n = 0; n < 2; ++n) {
                        const f32x4 v = gv[bj][n] * acc[ai][bj][m][n];
                        u32x2 w; w.x = pk2(v[0], v[1]); w.y = pk2(v[2], v[3]);
                        *(u32x2*)(O + row * D + u.pn * 256 + bj * 128 + wc * 32 + n * 16 + 4 * fq) = w;
                    }
            }
    }
};

__device__ __forceinline__ float dpp_ror1(float v)  { return __int_as_float(__builtin_amdgcn_update_dpp(0, __float_as_int(v), 0x121, 0xF, 0xF, true)); }
__device__ __forceinline__ float dpp_ror15(float v) { return __int_as_float(__builtin_amdgcn_update_dpp(0, __float_as_int(v), 0x12F, 0xF, 0xF, true)); }
__device__ __forceinline__ float dpp_shr1(float v)  { return __int_as_float(__builtin_amdgcn_update_dpp(0, __float_as_int(v), 0x111, 0xF, 0xF, true)); }
__device__ __forceinline__ float dpp_shl1(float v)  { return __int_as_float(__builtin_amdgcn_update_dpp(0, __float_as_int(v), 0x101, 0xF, 0xF, true)); }

#define DPP_FMAC4X2(C, SA, WA, CTRLA, SB, WB, CTRLB) do { float _c0 = (C)[0], _c1 = (C)[1], _c2 = (C)[2], _c3 = (C)[3]; \
    asm("s_nop 1\n\t" \
        "v_fmac_f32_dpp %0, %4, %8 " CTRLA " row_mask:0xf bank_mask:0xf bound_ctrl:1\n\t" \
        "v_fmac_f32_dpp %1, %5, %9 " CTRLA " row_mask:0xf bank_mask:0xf bound_ctrl:1\n\t" \
        "v_fmac_f32_dpp %2, %6, %10 " CTRLA " row_mask:0xf bank_mask:0xf bound_ctrl:1\n\t" \
        "v_fmac_f32_dpp %3, %7, %11 " CTRLA " row_mask:0xf bank_mask:0xf bound_ctrl:1\n\t" \
        "v_fmac_f32_dpp %0, %12, %16 " CTRLB " row_mask:0xf bank_mask:0xf bound_ctrl:1\n\t" \
        "v_fmac_f32_dpp %1, %13, %17 " CTRLB " row_mask:0xf bank_mask:0xf bound_ctrl:1\n\t" \
        "v_fmac_f32_dpp %2, %14, %18 " CTRLB " row_mask:0xf bank_mask:0xf bound_ctrl:1\n\t" \
        "v_fmac_f32_dpp %3, %15, %19 " CTRLB " row_mask:0xf bank_mask:0xf bound_ctrl:1" \
        : "+v"(_c0), "+v"(_c1), "+v"(_c2), "+v"(_c3) \
        : "v"((SA)[0]), "v"((SA)[1]), "v"((SA)[2]), "v"((SA)[3]), "v"((WA)[0]), "v"((WA)[1]), "v"((WA)[2]), "v"((WA)[3]), \
          "v"((SB)[0]), "v"((SB)[1]), "v"((SB)[2]), "v"((SB)[3]), "v"((WB)[0]), "v"((WB)[1]), "v"((WB)[2]), "v"((WB)[3])); \
    (C)[0] = _c0; (C)[1] = _c1; (C)[2] = _c2; (C)[3] = _c3; } while (0)
#define DPP_FMAC4(C, SA, WA, CTRLA) do { float _c0 = (C)[0], _c1 = (C)[1], _c2 = (C)[2], _c3 = (C)[3]; \
    asm("s_nop 1\n\t" \
        "v_fmac_f32_dpp %0, %4, %8 " CTRLA " row_mask:0xf bank_mask:0xf bound_ctrl:1\n\t" \
        "v_fmac_f32_dpp %1, %5, %9 " CTRLA " row_mask:0xf bank_mask:0xf bound_ctrl:1\n\t" \
        "v_fmac_f32_dpp %2, %6, %10 " CTRLA " row_mask:0xf bank_mask:0xf bound_ctrl:1\n\t" \
        "v_fmac_f32_dpp %3, %7, %11 " CTRLA " row_mask:0xf bank_mask:0xf bound_ctrl:1" \
        : "+v"(_c0), "+v"(_c1), "+v"(_c2), "+v"(_c3) \
        : "v"((SA)[0]), "v"((SA)[1]), "v"((SA)[2]), "v"((SA)[3]), "v"((WA)[0]), "v"((WA)[1]), "v"((WA)[2]), "v"((WA)[3])); \
    (C)[0] = _c0; (C)[1] = _c1; (C)[2] = _c2; (C)[3] = _c3; } while (0)
struct EpiConvGate {
    bf16_t* act; const float* cw; const float* cbias; LAS unsigned char* xl;
    __device__ __forceinline__ void operator()(const f32x4 (&acc)[2][2][4][2], const Unit& u, int wr, int wc, int fr, int fq) const {
        if (wr == 0) { __builtin_amdgcn_s_barrier(); } asm volatile("" ::: "memory");
        LAS float* X = (LAS float*)xl;
        f32x4 wq[2][2][4];
#define CG_LOADW(N) do { _Pragma("unroll") for (int bj = 0; bj < 2; ++bj) { const int ch = 128 * u.pn + 32 * wc + 16 * (N) + 4 * fq + bj * DFF; \
            wq[N][bj][0] = *(const f32x4*)(cw + ch); wq[N][bj][1] = *(const f32x4*)(cw + DUP + ch); wq[N][bj][2] = *(const f32x4*)(cw + 2 * DUP + ch); wq[N][bj][3] = *(const f32x4*)(cbias + ch); } } while (0)
        CG_LOADW(0);
#pragma unroll
        for (int ai = 0; ai < 2; ++ai) {
            const int s = 2 * ai + wr;
            if (fr == 0) {
#pragma unroll
                for (int bj = 0; bj < 2; ++bj)
#pragma unroll
                    for (int n = 0; n < 2; ++n) *(LAS f32x4*)(X + ((s * 2 + 0) * 2 + bj) * 128 + 32 * wc + 16 * n + 4 * fq) = acc[ai][bj][0][n];
            }
            if (fr == 15) {
#pragma unroll
                for (int bj = 0; bj < 2; ++bj)
#pragma unroll
                    for (int n = 0; n < 2; ++n) *(LAS f32x4*)(X + ((s * 2 + 1) * 2 + bj) * 128 + 32 * wc + 16 * n + 4 * fq) = acc[ai][bj][3][n];
            }
        }
        asm volatile("s_waitcnt lgkmcnt(0)" ::: "memory");
        __builtin_amdgcn_s_barrier(); asm volatile("" ::: "memory");
#pragma unroll
        for (int n = 0; n < 2; ++n) {
            const int chg = 128 * u.pn + 32 * wc + 16 * n + 4 * fq;
            if (n == 1) CG_LOADW(1);
            f32x4 w0[2], w1[2], w2[2], bb[2], w0m[2], w2m[2];
#pragma unroll
            for (int bj = 0; bj < 2; ++bj) {
                w0[bj] = wq[n][bj][0]; w1[bj] = wq[n][bj][1]; w2[bj] = wq[n][bj][2]; bb[bj] = wq[n][bj][3];
                w0m[bj] = (fr == 0) ? w0[bj] : (f32x4){0.f, 0.f, 0.f, 0.f}; w2m[bj] = (fr == 15) ? w2[bj] : (f32x4){0.f, 0.f, 0.f, 0.f};
            }
#pragma unroll
            for (int ai = 0; ai < 2; ++ai) {
                const int s = 2 * ai + wr;
                f32x4 xp[2], xn[2];
#pragma unroll
                for (int bj = 0; bj < 2; ++bj) {
                    xp[bj] = *(const LAS f32x4*)(X + ((((s + 3) & 3) * 2 + 1) * 2 + bj) * 128 + 32 * wc + 16 * n + 4 * fq);
                    xn[bj] = *(const LAS f32x4*)(X + ((((s + 1) & 3) * 2 + 0) * 2 + bj) * 128 + 32 * wc + 16 * n + 4 * fq);
                }
                f32x4 cvv[4][2];
#pragma unroll
                for (int bj = 0; bj < 2; ++bj) {
                    const f32x4 a0 = acc[ai][bj][0][n], a1 = acc[ai][bj][1][n], a2 = acc[ai][bj][2][n], a3 = acc[ai][bj][3][n];
                    f32x4 c0 = bb[bj] + w1[bj] * a0 + w2[bj] * a1 + w0m[bj] * xp[bj];
                    f32x4 c1 = bb[bj] + w1[bj] * a1 + w0[bj] * a0 + w2[bj] * a2;
                    f32x4 c2 = bb[bj] + w1[bj] * a2 + w0[bj] * a1 + w2[bj] * a3;
                    f32x4 c3 = bb[bj] + w1[bj] * a3 + w0[bj] * a2 + w2m[bj] * xn[bj];
                    DPP_FMAC4(c0, a3, w0[bj], "row_shr:1");
                    DPP_FMAC4(c3, a0, w2[bj], "row_shl:1");
                    cvv[0][bj] = c0; cvv[1][bj] = c1; cvv[2][bj] = c2; cvv[3][bj] = c3;
                }
#pragma unroll
                for (int m = 0; m < 4; ++m) {
                    const int lr = 128 * ai + 64 * wr + 4 * fr + m;
                    const int R = 254 * u.pm + lr;
                    const int b = R >= (H2_BSTRIDE + 1) ? 1 : 0;
                    const int t = R - 1 - H2_BSTRIDE * b;
                    const bool valid = lr >= 1 && lr <= 254 && t >= 0 && t < S;
                    if (valid) {
                        u32x2 w;
                        w.x = pk2(silu_(cvv[m][0][0]) * cvv[m][1][0], silu_(cvv[m][0][1]) * cvv[m][1][1]);
                        w.y = pk2(silu_(cvv[m][0][2]) * cvv[m][1][2], silu_(cvv[m][0][3]) * cvv[m][1][3]);
                        *(u32x2*)(act + (size_t)(b * S + t) * DFF + chg) = w;
                    }
                }
            }
        }
        asm volatile("" ::: "memory"); if (wr == 1) { __builtin_amdgcn_s_barrier(); }
    }
};

#undef CG_LOADW
__device__ __forceinline__ void transpose_item(const float* W, int N, int k0, int n0, bf16_t* dst, int Kd, float* scr, int lane) {
#pragma unroll 16
    for (int i = 0; i < 32; ++i) { const int kk = 2 * i + (lane >> 5); scr[kk * 33 + (lane & 31)] = __builtin_nontemporal_load(W + (size_t)(k0 + kk) * N + n0 + (lane & 31)); }
    __builtin_amdgcn_wave_barrier();
    const int c = lane & 7;
#pragma unroll
    for (int j = 0; j < 4; ++j) {
        const int n = (lane >> 3) + 8 * j; const float* s = scr + (8 * c) * 33 + n;
        u32x4 o; o.x = pk2(s[0], s[33]); o.y = pk2(s[2 * 33], s[3 * 33]); o.z = pk2(s[4 * 33], s[5 * 33]); o.w = pk2(s[6 * 33], s[7 * 33]);
        *(u32x4*)(dst + (size_t)n * Kd + k0 + 8 * c) = o;
    }
    __builtin_amdgcn_wave_barrier();
}

__device__ __forceinline__ void phase0(PP p, unsigned char* shm, int wv) {
    const int tid = tid_opaque(wv), lane = tid & 63, wave = tid >> 6;
    unsigned char* ws = p->ws;
    if (blockIdx.x < 192) {
        float* sv = (float*)shm;
        float* red = sv + 3 * 1024;
        for (int i = tid; i < 3 * 1024; i += 512) {
            const int j = i >> 10, k = i & 1023;
            const float v = (j < 2) ? p->c[j * 1024 + k] : p->c_ctx[k];
            sv[i] = silu_(v);
        }
        __syncthreads();
        const int n0 = blockIdx.x * 32, col = tid & 31, ks = tid >> 5;
        float a0 = 0.f, a1 = 0.f, a2 = 0.f;
        const float* wp = p->w_mod + (size_t)(ks * 64) * 6144 + n0 + col;
#pragma unroll
        for (int k = 0; k < 64; ++k) {
            const float w = __builtin_nontemporal_load(wp + (size_t)k * 6144);
            a0 += sv[ks * 64 + k] * w; a1 += sv[1024 + ks * 64 + k] * w; a2 += sv[2048 + ks * 64 + k] * w;
        }
        red[(ks * 3 + 0) * 32 + col] = a0; red[(ks * 3 + 1) * 32 + col] = a1; red[(ks * 3 + 2) * 32 + col] = a2;
        __syncthreads();
        if (tid < 96) {
            const int j = tid >> 5, cc = tid & 31; float s = p->b_mod[n0 + cc];
            for (int k = 0; k < 16; ++k) s += red[(k * 3 + j) * 32 + cc];
            ((float*)(ws + WS_MOD))[j * 6144 + n0 + cc] = s;
        }
        __syncthreads();
    }
    if (blockIdx.x == 200) { for (int i = tid; i < 1024; i += 512) ((float*)(ws + WS_SP8))[i] = -8.0f * log1pf(expf(-p->lru_lam[i])); }
    if (blockIdx.x >= 192 && blockIdx.x < 200) {
        const int idx = (blockIdx.x - 192) * 512 + tid;
        const int pos = idx >> 4, i = idx & 15;
        const float inv = powf(10000.0f, -(float)i / 16.0f);
        const float ang = (float)pos * inv;
        ((float*)(ws + WS_ROPE))[idx] = cosf(ang);
        ((float*)(ws + WS_ROPE))[4096 + idx] = sinf(ang);
    }
}
__device__ __forceinline__ void transpose_phase(PP p, unsigned char* shm, int wv, int it_lo, int it_hi, int gw0, int NGW) {
    const int tid = tid_opaque(wv), lane = tid & 63, wave = wv;
    unsigned char* ws = p->ws;
    float* scr = (float*)(shm + 32768) + wave * (64 * 33);
    const int gw = gw0 + wave;
    constexpr int I_IN = (D / 64) * (DIN / 32), I_OUT = (D / 64) * (D / 32), I_UP = (D / 64) * (DUP / 32), I_DN = (DFF / 64) * (D / 32), I_LRU = 2 * 2 * 8 * 2;
    constexpr int NIT = I_IN + I_OUT + I_UP + I_DN + I_LRU;
    (void)NIT;
    for (int it = it_lo + gw; it < it_hi; it += NGW) {
        int r = it;
        if (r >= I_IN + I_OUT + I_UP + I_DN + I_LRU) continue;
        if (r < I_IN) { const int nb = DIN / 32, kb = r / nb, n0 = (r % nb) * 32; transpose_item(p->w_in, DIN, kb * 64, n0, (bf16_t*)(ws + WS_WIN) + (size_t)n0 * D, D, scr, lane); continue; } r -= I_IN;
        if (r < I_OUT) { const int nb = D / 32, kb = r / nb, n0 = (r % nb) * 32; transpose_item(p->w_out, D, kb * 64, n0, (bf16_t*)(ws + WS_WOUT) + (size_t)n0 * D, D, scr, lane); continue; } r -= I_OUT;
        if (r < I_UP) { const int nb = DUP / 32, kb = r / nb, n0 = (r % nb) * 32;
            const int isv = n0 >= DFF, nn = isv ? n0 - DFF : n0, drow = (nn / 128) * 256 + isv * 128 + (nn % 128);
            transpose_item(p->w_up, DUP, kb * 64, n0, (bf16_t*)(ws + WS_WUP) + (size_t)drow * D, D, scr, lane); continue; } r -= I_UP;
        if (r < I_DN) { const int nb = D / 32, kb = r / nb, n0 = (r % nb) * 32; transpose_item(p->w_down, D, kb * 64, n0, (bf16_t*)(ws + WS_WDN) + (size_t)n0 * DFF, DFF, scr, lane); continue; } r -= I_DN;
        {
            const int nh = r & 1, blk = (r >> 1) & 7, type = (r >> 4) & 1, dir = r >> 5;
            const float* src = (type ? p->lru_w_i : p->lru_w_a) + (size_t)(dir * 8 + blk) * 4096;
            bf16_t* dst = (bf16_t*)(ws + WS_LRU) + (size_t)((dir * 2 + type) * 8 + blk) * 4096 + (size_t)(nh * 32) * 64;
            transpose_item(src, 64, 0, nh * 32, dst, 64, scr, lane);
        }
    }
}

__device__ __forceinline__ void row_load_nt(const float* src, int lane, f32x4 (&v)[4]) {
#pragma unroll
    for (int j = 0; j < 4; ++j) v[j] = __builtin_nontemporal_load((const f32x4*)(src + 4 * lane + 256 * j));
}
__device__ __forceinline__ void row_load(const float* src, int lane, f32x4 (&v)[4]) {
#pragma unroll
    for (int j = 0; j < 4; ++j) v[j] = *(const f32x4*)(src + 4 * lane + 256 * j);
}
__device__ __forceinline__ float row_rstd(const f32x4 (&v)[4]) {
    float ss = 0.f;
#pragma unroll
    for (int j = 0; j < 4; ++j) ss += v[j][0] * v[j][0] + v[j][1] * v[j][1] + v[j][2] * v[j][2] + v[j][3] * v[j][3];
    return rsqrtf(wave_sum(ss) * (1.0f / D) + EPS);
}
__device__ __forceinline__ void norm_mod_store(const f32x4 (&v)[4], float rstd, const float* g, const float* sh, const float* sc, bf16_t* dst, int lane) {
#pragma unroll
    for (int j = 0; j < 4; ++j) {
        const int c = 4 * lane + 256 * j;
        const f32x4 gg = *(const f32x4*)(g + c), s1 = *(const f32x4*)(sc + c), s0 = *(const f32x4*)(sh + c);
        const f32x4 o = (v[j] * rstd * gg) * (s1 + 1.0f) + s0;
        u32x2 w; w.x = pk2(o[0], o[1]); w.y = pk2(o[2], o[3]);
        *(u32x2*)(dst + c) = w;
    }
}
__device__ __forceinline__ void phase1(PP p, int wv) {
    const int tid_ = tid_opaque(wv), lane = tid_ & 63, gw = blockIdx.x * 8 + (tid_ >> 6), NGW = gridDim.x * 8;
    const float* mod = (const float*)(p->ws + WS_MOD);
    bf16_t* hb = (bf16_t*)(p->ws + WS_HB);
    int cur = -1; f32x4 gsc[4], gsh[4];
    for (int r0 = gw; r0 < MROWS; r0 += 4 * NGW) {
        f32x4 v[4][4];
#pragma unroll
        for (int q = 0; q < 4; ++q) {
            const int r = (r0 + q * NGW < MROWS) ? r0 + q * NGW : r0;
            row_load_nt(r < NLAT ? p->x + (size_t)r * D : p->ctx + (size_t)(r - NLAT) * D, lane, v[q]);
        }
#pragma unroll
        for (int q = 0; q < 4; ++q) {
            const int r = r0 + q * NGW;
            if (r < MROWS) {
                const int mi = r < NLAT ? (r >> 14) : 2;
                if (mi != cur) {
                    cur = mi;
#pragma unroll
                    for (int j = 0; j < 4; ++j) {
                        const int c = 4 * lane + 256 * j;
                        gsc[j] = *(const f32x4*)(p->norm1_g + c) * (*(const f32x4*)(mod + mi * 6144 + 1024 + c) + 1.0f);
                        gsh[j] = *(const f32x4*)(mod + mi * 6144 + c);
                    }
                }
                const float rstd = row_rstd(v[q]);
#pragma unroll
                for (int j = 0; j < 4; ++j) {
                    const f32x4 o = v[q][j] * rstd * gsc[j] + gsh[j];
                    u32x2 w; w.x = pk2(o[0], o[1]); w.y = pk2(o[2], o[3]);
                    *(u32x2*)(hb + (size_t)r * D + 4 * lane + 256 * j) = w;
                }
            }
        }
    }
}

typedef float f32x16 __attribute__((ext_vector_type(16)));
__device__ __forceinline__ unsigned cvt_pk_bf16(float lo, float hi) { unsigned r; asm("v_cvt_pk_bf16_f32 %0, %1, %2" : "=v"(r) : "v"(lo), "v"(hi)); return r; }
__device__ __forceinline__ void attn_mfma(PP p, unsigned char* shm, int wv) {
    const int tid = tid_opaque(wv);
    const int lane = tid & 63, wave = wv, l31 = lane & 31, hl = lane >> 5;
    const bf16_t* proj = (const bf16_t*)(p->ws + WS_PROJ);
    bf16_t* att = (bf16_t*)(p->ws + WS_ATT);
    const float L2E = 1.4426950408889634f;
    const float SC2 = 0.125f * L2E;
    for (int item = blockIdx.x; item < 512; item += gridDim.x) {
        const int hk = item & 1, qb = (item >> 1) & 127, b = item >> 8;
        const int g = wave >> 1, qh = wave & 1, hq = hk * 4 + g;
        const int qrow0 = b * S + 128 * qb + 64 * qh;
        bf16x8 qf[2][4];
#pragma unroll
        for (int qi = 0; qi < 2; ++qi)
#pragma unroll
            for (int st = 0; st < 4; ++st) qf[qi][st] = *(const bf16x8*)(proj + (size_t)(qrow0 + 32 * qi + l31) * DIN + 1024 + 64 * hq + 16 * st + 8 * hl);
        const float sink2 = p->attn_sink[hq] * L2E;
        float mrun[2] = {sink2, sink2};
        float lrun[2] = {hl == 0 ? 1.f : 0.f, hl == 0 ? 1.f : 0.f};
        f32x16 oacc[2][2];
#pragma unroll
        for (int a = 0; a < 2; ++a)
#pragma unroll
            for (int c = 0; c < 2; ++c)
#pragma unroll
                for (int i = 0; i < 16; ++i) oacc[a][c][i] = 0.f;
        u32x4 kreg[2], vreg[2];
        int ci = (qb == 0) ? 1 : 0;
#define ATT_GLOAD(CI) do { const int _row0 = (CI) < 3 ? b * S + 128 * (qb - 1 + (CI)) : NLAT + b * LC + 128 * ((CI) - 3); \
        _Pragma("unroll") for (int _i = 0; _i < 2; ++_i) { const int _pi = tid + 512 * _i, _key = _pi >> 3, _part = _pi & 7; \
            const bf16_t* _src = proj + (size_t)(_row0 + _key) * DIN + 1536 + 64 * hk + 8 * _part; kreg[_i] = *(const u32x4*)_src; vreg[_i] = *(const u32x4*)(_src + 128); } } while (0)
#define ATT_STAGE(PAR) do { bf16_t* _K = (bf16_t*)(shm + (PAR) * 36864); bf16_t* _V = (bf16_t*)(shm + (PAR) * 36864 + 18432); \
        _Pragma("unroll") for (int i = 0; i < 2; ++i) { const int pi = tid + 512 * i, key = pi >> 3, part = pi & 7; \
            *(u32x4*)(_K + key * 72 + 8 * part) = kreg[i]; \
            _Pragma("unroll") for (int e = 0; e < 8; ++e) { const unsigned w = vreg[i][e >> 1]; _V[(8 * part + e) * 132 + key] = (bf16_t)((e & 1) ? (w >> 16) : (w & 0xFFFFu)); } } } while (0)
#define ATT_NEXT(C) (((C) + 1 == 2 && qb == 127) ? 3 : (C) + 1)
        ATT_GLOAD(ci);
        __syncthreads();
        ATT_STAGE(0);
        { const int c1 = ATT_NEXT(ci); if (c1 < 5) ATT_GLOAD(c1); }
        __syncthreads();
        int par = 0;
        while (ci < 5) {
            const int cn = ATT_NEXT(ci);
            if (cn < 5) { ATT_STAGE(par ^ 1); const int c2 = ATT_NEXT(cn); if (c2 < 5) ATT_GLOAD(c2); }
            const bf16_t* Ks = (const bf16_t*)(shm + par * 36864);
            const bf16_t* Vt = (const bf16_t*)(shm + par * 36864 + 18432);
            const int kt_lo = (ci == 0 && qh == 1) ? 2 : 0, kt_hi = (ci == 2 && qh == 0) ? 2 : 4;
#pragma unroll 1
            for (int kt = kt_lo; kt < kt_hi; ++kt) {
                bf16x8 kf[4];
#pragma unroll
                for (int st = 0; st < 4; ++st) kf[st] = *(const bf16x8*)(Ks + (32 * kt + l31) * 72 + 16 * st + 8 * hl);
                bf16x8 vf[2][2];
#pragma unroll
                for (int db = 0; db < 2; ++db)
#pragma unroll
                    for (int s2 = 0; s2 < 2; ++s2) {
                        const bf16_t* vp = Vt + (32 * db + l31) * 132 + 32 * kt + 16 * s2 + 4 * hl;
                        const u32x2 lo = *(const u32x2*)vp, hi = *(const u32x2*)(vp + 8);
                        u32x4 w; w.x = lo.x; w.y = lo.y; w.z = hi.x; w.w = hi.y;
                        vf[db][s2] = __builtin_bit_cast(bf16x8, w);
                    }
#pragma unroll
                for (int qi = 0; qi < 2; ++qi) {
                    f32x16 s;
#pragma unroll
                    for (int i = 0; i < 16; ++i) s[i] = 0.f;
#pragma unroll
                    for (int st = 0; st < 4; ++st) s = __builtin_amdgcn_mfma_f32_32x32x16_bf16(kf[st], qf[qi][st], s, 0, 0, 0);
                    if (ci == 0 || ci == 2) {
                        asm volatile("");
                        const int dl = (ci == 0) ? (32 * kt + 4 * hl - (64 * qh + 32 * qi + l31)) : ((64 * qh + 32 * qi + l31) - 32 * kt - 4 * hl);
#pragma unroll
                        for (int i = 0; i < 16; ++i) {
                            const int ki = 8 * (i >> 2) + (i & 3);
                            const bool ok = (ci == 0) ? (dl + ki >= 0) : (dl - ki >= 0);
                            s[i] = ok ? s[i] : -1e30f;
                        }
                    }
                    float mx = s[0];
#pragma unroll
                    for (int i = 1; i < 16; ++i) mx = fmaxf(mx, s[i]);
                    mx = fmaxf(mx, __shfl_xor(mx, 32));
                    const float mnew = fmaxf(mrun[qi], mx * SC2);
                    if (__builtin_amdgcn_ballot_w64(mnew > mrun[qi]) != 0ull) {
                        const float alpha = __builtin_amdgcn_exp2f(mrun[qi] - mnew);
                        lrun[qi] *= alpha;
#pragma unroll
                        for (int db = 0; db < 2; ++db)
#pragma unroll
                            for (int i = 0; i < 16; ++i) oacc[db][qi][i] *= alpha;
                        mrun[qi] = mnew;
                    }
                    float ls = 0.f;
#pragma unroll
                    for (int i = 0; i < 16; ++i) { s[i] = __builtin_amdgcn_exp2f(__builtin_fmaf(s[i], SC2, -mnew)); ls += s[i]; }
                    lrun[qi] += ls;
                    bf16x8 pf[2];
#pragma unroll
                    for (int s2 = 0; s2 < 2; ++s2) {
                        u32x4 w; w.x = cvt_pk_bf16(s[8 * s2 + 0], s[8 * s2 + 1]); w.y = cvt_pk_bf16(s[8 * s2 + 2], s[8 * s2 + 3]);
                        w.z = cvt_pk_bf16(s[8 * s2 + 4], s[8 * s2 + 5]); w.w = cvt_pk_bf16(s[8 * s2 + 6], s[8 * s2 + 7]);
                        pf[s2] = __builtin_bit_cast(bf16x8, w);
                    }
#pragma unroll
                    for (int db = 0; db < 2; ++db)
#pragma unroll
                        for (int s2 = 0; s2 < 2; ++s2) oacc[db][qi] = __builtin_amdgcn_mfma_f32_32x32x16_bf16(vf[db][s2], pf[s2], oacc[db][qi], 0, 0, 0);
                }
            }
            __syncthreads();
            ci = cn; par ^= 1;
        }
#undef ATT_STAGE
#undef ATT_NEXT
#undef ATT_GLOAD
#pragma unroll
        for (int qi = 0; qi < 2; ++qi) {
            const float lt = lrun[qi] + __shfl_xor(lrun[qi], 32);
            const float inv = 1.0f / lt;
            bf16_t* orow = att + (size_t)(qrow0 + 32 * qi + l31) * 512 + hq * 64;
#pragma unroll
            for (int db = 0; db < 2; ++db)
#pragma unroll
                for (int g4 = 0; g4 < 4; ++g4) {
                    u32x2 w; w.x = cvt_pk_bf16(oacc[db][qi][4 * g4] * inv, oacc[db][qi][4 * g4 + 1] * inv); w.y = cvt_pk_bf16(oacc[db][qi][4 * g4 + 2] * inv, oacc[db][qi][4 * g4 + 3] * inv);
                    *(u32x2*)(orow + 32 * db + 8 * g4 + 4 * hl) = w;
                }
        }
    }
    __syncthreads();
}


struct ScanW { bf16x8 wfa[4], wfi[4]; float ba, bi, sp8l2; };
__device__ __forceinline__ void scan_loadw(PP p, int dir, int n, int ct, int l31, int hl, ScanW& w) {
    unsigned chv = (unsigned)(32 * ct + l31); asm volatile("" : "+v"(chv));
    const unsigned ch = (unsigned)(dir * 512 + 64 * n) + chv;
    w.ba = p->lru_b_a[ch]; w.bi = p->lru_b_i[ch];
    w.sp8l2 = ((const float*)(p->ws + WS_SP8))[ch] * 1.4426950408889634f;
    const bf16_t* wa_b = (const bf16_t*)(p->ws + WS_LRU) + (size_t)((dir * 2 + 0) * 8 + n) * 4096;
    const bf16_t* wi_b = (const bf16_t*)(p->ws + WS_LRU) + (size_t)((dir * 2 + 1) * 8 + n) * 4096;
    const unsigned lo = chv * 64u + 8u * (unsigned)hl;
#pragma unroll
    for (int st = 0; st < 4; ++st) { w.wfa[st] = *(const bf16x8*)(wa_b + lo + 16 * st); w.wfi[st] = *(const bf16x8*)(wi_b + lo + 16 * st); }
}
template <int DIR>
__device__ __forceinline__ void scan_dir(PP p, const bf16_t* xs, const ScanW& w, ScanW& wn, int ndir, int nct, bool do_next, int n, int ct, int l31, int hl, int id, int rowbase, bool latent, float (&hf)[2][16]) {
    constexpr int XS = 520;
    const int ch = 64 * n + 32 * ct + l31;
    const float ba = w.ba, bi = w.bi, sp8l2 = w.sp8l2;
    const bf16x8 (&wfa)[4] = w.wfa; const bf16x8 (&wfi)[4] = w.wfi;
    float a[2][16], u[2][16];
#pragma unroll
    for (int rt = 0; rt < 2; ++rt) {
        bf16x8 af[4];
#pragma unroll
        for (int st = 0; st < 4; ++st) af[st] = *(const bf16x8*)(xs + (32 * rt + l31) * XS + 64 * n + 16 * st + 8 * hl);
        f32x16 ga, gi;
#pragma unroll
        for (int i = 0; i < 16; ++i) { ga[i] = 0.f; gi[i] = 0.f; }
#pragma unroll
        for (int st = 0; st < 4; ++st) { ga = __builtin_amdgcn_mfma_f32_32x32x16_bf16(af[st], wfa[st], ga, 0, 0, 0); gi = __builtin_amdgcn_mfma_f32_32x32x16_bf16(af[st], wfi[st], gi, 0, 0, 0); }
#pragma unroll
        for (int i = 0; i < 16; ++i) {
            const int token = 32 * rt + 8 * (i >> 2) + 4 * hl + (i & 3);
            const float xv = bf2f(xs[token * XS + ch]);
            const float rr = fast_sigmoid(ga[i] + ba), ii = fast_sigmoid(gi[i] + bi);
            const float la2 = rr * sp8l2;
            const float av = __builtin_amdgcn_exp2f(la2);
            const float t2 = la2 * 1.3862943611f;
            float em1p = t2 * (1.0f + t2 * (0.5f + t2 * (0.16666667f + t2 * (0.041666668f + t2 * 0.0083333333f)))), em1e = __builtin_fmaf(av, av, -1.0f);
            asm volatile("" : "+v"(em1p), "+v"(em1e));
            const float em1 = (t2 > -0.1f) ? em1p : em1e;
            a[rt][i] = av; u[rt][i] = __builtin_amdgcn_sqrtf(-em1) * (ii * xv);
        }
    }
    float Ao[8], Ho[8], Ap[8], Hp[8];
#pragma unroll
    for (int k = 0; k < 8; ++k) {
        const int rt = k >> 2, g = k & 3;
        float H = 0.f, A = 1.f;
#pragma unroll
        for (int jj = 0; jj < 4; ++jj) { const int j = DIR ? 3 - jj : jj; const float av = a[rt][4 * g + j]; H = av * H + u[rt][4 * g + j]; A *= av; }
        Ao[k] = A; Ho[k] = H; Ap[k] = __shfl_xor(A, 32); Hp[k] = __shfl_xor(H, 32);
    }
    float Sin[8], Pin[8]; float Sx = 0.f, Px = 1.f;
#pragma unroll
    for (int kk = 0; kk < 8; ++kk) {
        const int k = DIR ? 7 - kk : kk;
        const float A0 = hl ? Ap[k] : Ao[k], H0 = hl ? Hp[k] : Ho[k], A1 = hl ? Ao[k] : Ap[k], H1 = hl ? Ho[k] : Hp[k];
        float s0, p0, s1, p1;
        if (DIR == 0) { s0 = Sx; p0 = Px; Sx = A0 * Sx + H0; Px *= A0; s1 = Sx; p1 = Px; Sx = A1 * Sx + H1; Px *= A1; }
        else          { s1 = Sx; p1 = Px; Sx = A1 * Sx + H1; Px *= A1; s0 = Sx; p0 = Px; Sx = A0 * Sx + H0; Px *= A0; }
        Sin[k] = hl ? s1 : s0; Pin[k] = hl ? p1 : p0;
    }
    asm volatile("" ::: "memory");
    if (do_next) scan_loadw(p, ndir, n, nct, l31, hl, wn);
    bf16_t* yl = (bf16_t*)(p->ws + WS_YL) + (size_t)rowbase * 512; bf16_t* caf = (bf16_t*)(p->ws + WS_CAF) + (size_t)rowbase * 512; bf16_t* cab = (bf16_t*)(p->ws + WS_CAB) + (size_t)rowbase * 512;
    unsigned lo = (unsigned)ch; asm volatile("" : "+v"(lo));
#pragma unroll
    for (int k = 0; k < 8; ++k) {
        const int rt = k >> 2, g = k & 3;
        float h = Sin[k], P = Pin[k];
#pragma unroll
        for (int jj = 0; jj < 4; ++jj) {
            const int j = DIR ? 3 - jj : jj, idx = 4 * g + j;
            h = a[rt][idx] * h + u[rt][idx]; P *= a[rt][idx];
            const int token = 32 * rt + 8 * g + 4 * hl + j;
            const unsigned o = lo + (unsigned)token * 512u;
            if (DIR == 0) { hf[rt][idx] = h; if (latent) caf[o] = f2bf(P); }
            else if (latent) { yl[o] = f2bf(hf[rt][idx] + h); cab[o] = f2bf(P); }
        }
    }
    if (hl == 0) {
        float* sumb = (float*)(p->ws + WS_SUM);
        sumb[((size_t)(DIR * NCHUNK + id) * 2 + 0) * 512 + ch] = Px;
        sumb[((size_t)(DIR * NCHUNK + id) * 2 + 1) * 512 + ch] = Sx;
    }
}
__device__ __forceinline__ void scan_mfma(PP p, unsigned char* shm, int wv) {
    const int tid_ = tid_opaque(wv); const int tid = tid_;
    const int lane = tid & 63, n = wv, l31 = lane & 31, hl = lane >> 5;
    constexpr int XS = 520;
    bf16_t* xs = (bf16_t*)shm;
    const bf16_t* proj = (const bf16_t*)(p->ws + WS_PROJ);
    for (int item = blockIdx.x; item < 512 + 32; item += gridDim.x) {
        const int id = item < 512 ? item : 512 + ((item - 512) >> 2);
        const int quarter = item < 512 ? -1 : ((item - 512) & 3);
        int rowbase, t0, seqlen; bool latent;
        if (id < 512) { const int b = id >> 8, k = id & 255; t0 = 64 * k; rowbase = b * S + t0; seqlen = S; latent = true; }
        else { const int j = id - 512, b = j >> 2, k = j & 3; t0 = 64 * k; rowbase = NLAT + b * LC + t0; seqlen = LC; latent = false; }
        const int seqbase = rowbase - t0;
        ScanW w0, w1;
        if (quarter < 0) scan_loadw(p, 0, n, 0, l31, hl, w0);
        {
            const int tid = tid_opaque(wv);
            bf16_t* raw = (bf16_t*)(shm + 66560);
#pragma unroll
            for (int i = 0; i < 9; ++i) {
                const int piece = tid + 512 * i;
                if (piece < 67 * 64) {
                    const int row = piece >> 6, c8 = piece & 63, tt = t0 - 2 + row;
                    u32x4 v = {0u, 0u, 0u, 0u};
                    if (tt >= 0 && tt < seqlen) v = *(const u32x4*)(proj + (size_t)(seqbase + tt) * DIN + 8 * c8);
                    *(u32x4*)(raw + row * 512 + 8 * c8) = v;
                }
            }
            __syncthreads();
            const int cq = tid & 127, tq = tid >> 7, c4 = 4 * cq;
            const f32x4 k0 = *(const f32x4*)(p->rnn_conv_w + c4), k1 = *(const f32x4*)(p->rnn_conv_w + 512 + c4), k2 = *(const f32x4*)(p->rnn_conv_w + 1024 + c4),
                        k3 = *(const f32x4*)(p->rnn_conv_w + 1536 + c4), kb = *(const f32x4*)(p->rnn_conv_b + c4);
            auto ld4 = [&](int row) -> f32x4 { const u32x2 w = *(const u32x2*)(raw + row * 512 + c4); f32x4 r; r[0] = bflo(w.x); r[1] = bfhi(w.x); r[2] = bflo(w.y); r[3] = bfhi(w.y); return r; };
            f32x4 xm2 = ld4(16 * tq), xm1 = ld4(16 * tq + 1), x0 = ld4(16 * tq + 2);
#pragma unroll
            for (int t = 0; t < 16; ++t) {
                const f32x4 xp1 = ld4(16 * tq + t + 3);
                const f32x4 o = kb + k0 * xm2 + k1 * xm1 + k2 * x0 + k3 * xp1;
                u32x2 w; w.x = pk2(o[0], o[1]); w.y = pk2(o[2], o[3]);
                *(u32x2*)(xs + (16 * tq + t) * XS + c4) = w;
                xm2 = xm1; xm1 = x0; x0 = xp1;
            }
        }
        __syncthreads();
#pragma unroll 1
        for (int ct = 0; ct < 2; ++ct) {
            float hf[2][16];
            const bool run0 = quarter < 0 || quarter == 2 * ct, run1 = quarter < 0 || quarter == 2 * ct + 1;
            if (quarter >= 0) { if (run0) scan_loadw(p, 0, n, ct, l31, hl, w0); if (run1) scan_loadw(p, 1, n, ct, l31, hl, w1); }
            if (run0) scan_dir<0>(p, xs, w0, w1, 1, ct, quarter < 0, n, ct, l31, hl, id, rowbase, latent, hf);
            if (run1) scan_dir<1>(p, xs, w1, w0, 0, 1, quarter < 0 && ct == 0, n, ct, l31, hl, id, rowbase, latent, hf);
        }
        __syncthreads();
    }
}

__device__ __forceinline__ void carry_phase(PP p, unsigned char* shm, int wv) {
    if (blockIdx.x >= 128) return;
    const int tid = tid_opaque(wv), cl = tid & 15, sg = tid >> 4;
    const int b = blockIdx.x >> 6, dir = (blockIdx.x >> 5) & 1, c = (blockIdx.x & 31) * 16 + cl;
    const float* sumb = (const float*)(p->ws + WS_SUM) + (size_t)dir * NCHUNK * 1024;
    float* car = (float*)(p->ws + WS_CAR) + (size_t)dir * NCHUNK * 512;
    float* segA = (float*)shm; float* segH = segA + 512;
    float A[9], H[9]; int ids[9];
#pragma unroll
    for (int k = 0; k < 9; ++k) {
        const int s = sg * 9 + k;
        int id = -1;
        if (s < 260) { if (dir == 0) id = s < 4 ? 512 + 4 * b + s : 256 * b + (s - 4); else id = s < 4 ? 512 + 4 * b + (3 - s) : 256 * b + (255 - (s - 4)); }
        ids[k] = id;
        A[k] = id >= 0 ? sumb[(size_t)id * 1024 + c] : 1.f;
        H[k] = id >= 0 ? sumb[(size_t)id * 1024 + 512 + c] : 0.f;
    }
    float As = 1.f, Hs = 0.f;
#pragma unroll
    for (int k = 0; k < 9; ++k) { Hs = A[k] * Hs + H[k]; As *= A[k]; }
    segA[sg * 16 + cl] = As; segH[sg * 16 + cl] = Hs;
    __syncthreads();
    float h = 0.f;
    for (int j = 0; j < sg; ++j) h = segA[j * 16 + cl] * h + segH[j * 16 + cl];
#pragma unroll
    for (int k = 0; k < 9; ++k) { if (ids[k] >= 0) car[(size_t)ids[k] * 512 + c] = h; h = A[k] * h + H[k]; }
    __syncthreads();
}

struct MixRow { u32x4 vy, vf, vb, vg, va; f32x4 cf0, cf1, cb0, cb1; };
__device__ __forceinline__ void mix_load(PP p, int r, int c0, MixRow& m) {
    const bf16_t* proj = (const bf16_t*)(p->ws + WS_PROJ);
    const bf16_t* att = (const bf16_t*)(p->ws + WS_ATT);
    const bf16_t* yl = (const bf16_t*)(p->ws + WS_YL); const bf16_t* caf = (const bf16_t*)(p->ws + WS_CAF); const bf16_t* cab = (const bf16_t*)(p->ws + WS_CAB);
    const float* car = (const float*)(p->ws + WS_CAR);
    const int id = r >> 6;
    m.vy = *(const u32x4*)(yl + (size_t)r * 512 + c0); m.vf = *(const u32x4*)(caf + (size_t)r * 512 + c0); m.vb = *(const u32x4*)(cab + (size_t)r * 512 + c0);
    m.vg = *(const u32x4*)(proj + (size_t)r * DIN + 512 + c0); m.va = *(const u32x4*)(att + (size_t)r * 512 + c0);
    const float* cf = car + (size_t)id * 512 + c0; const float* cbk = car + (size_t)(NCHUNK + id) * 512 + c0;
    m.cf0 = *(const f32x4*)cf; m.cf1 = *(const f32x4*)(cf + 4); m.cb0 = *(const f32x4*)cbk; m.cb1 = *(const f32x4*)(cbk + 4);
}
__device__ __forceinline__ void mix_store(PP p, int r, int c0, const MixRow& m, const f32x4 (&gr)[2], const f32x4 (&ga)[2]) {
    bf16_t* mix = (bf16_t*)(p->ws + WS_HB);
    float rn[8], at[8]; float s1 = 0.f, s2 = 0.f;
#pragma unroll
    for (int e = 0; e < 8; ++e) {
        const unsigned wy = m.vy[e >> 1], wf = m.vf[e >> 1], wb = m.vb[e >> 1], wg = m.vg[e >> 1], wa = m.va[e >> 1];
        const float cfe = e < 4 ? m.cf0[e & 3] : m.cf1[e & 3], cbe = e < 4 ? m.cb0[e & 3] : m.cb1[e & 3];
        const float y = ((e & 1) ? bfhi(wy) : bflo(wy)) + ((e & 1) ? bfhi(wf) : bflo(wf)) * cfe + ((e & 1) ? bfhi(wb) : bflo(wb)) * cbe;
        const float xg = (e & 1) ? bfhi(wg) : bflo(wg);
        rn[e] = gelu_tanh_(xg) * y; s1 += rn[e] * rn[e];
        at[e] = (e & 1) ? bfhi(wa) : bflo(wa); s2 += at[e] * at[e];
    }
    const float r1 = rsqrtf(wave_sum(s1) * (1.0f / 512.0f) + EPS), r2 = rsqrtf(wave_sum(s2) * (1.0f / 512.0f) + EPS);
    u32x4 o1, o2;
#pragma unroll
    for (int e2 = 0; e2 < 4; ++e2) {
        o1[e2] = pk2(rn[2 * e2] * r1 * gr[e2 >> 1][(2 * e2) & 3], rn[2 * e2 + 1] * r1 * gr[e2 >> 1][(2 * e2 + 1) & 3]);
        o2[e2] = pk2(at[2 * e2] * r2 * ga[e2 >> 1][(2 * e2) & 3], at[2 * e2 + 1] * r2 * ga[e2 >> 1][(2 * e2 + 1) & 3]);
    }
    *(u32x4*)(mix + (size_t)r * D + c0) = o1; *(u32x4*)(mix + (size_t)r * D + 512 + c0) = o2;
}
__device__ __forceinline__ void mix_phase(PP p, int wv) {
    const int tid_ = tid_opaque(wv), lane = tid_ & 63, gw = blockIdx.x * 8 + (tid_ >> 6), NGW = gridDim.x * 8;
    const int c0 = 8 * lane;
    f32x4 gr[2], ga[2];
    gr[0] = *(const f32x4*)(p->gn_rnn + c0); gr[1] = *(const f32x4*)(p->gn_rnn + c0 + 4); ga[0] = *(const f32x4*)(p->gn_attn + c0); ga[1] = *(const f32x4*)(p->gn_attn + c0 + 4);
    for (int r = gw; r < NLAT; r += 2 * NGW) {
        const int rb = (r + NGW < NLAT) ? r + NGW : r;
        MixRow ma, mb;
        mix_load(p, r, c0, ma); mix_load(p, rb, c0, mb);
        mix_store(p, r, c0, ma, gr, ga);
        if (rb != r) mix_store(p, rb, c0, mb, gr, ga);
    }
}

__device__ __forceinline__ void phase7(PP p, int wv) {
    const int tid_ = tid_opaque(wv), lane = tid_ & 63, gw = blockIdx.x * 8 + (tid_ >> 6), NGW = gridDim.x * 8;
    const float* mod = (const float*)(p->ws + WS_MOD);
    bf16_t* hb = (bf16_t*)(p->ws + WS_HB);
    const bf16_t* o1 = (const bf16_t*)(p->ws + WS_O1);
    for (int r = gw; r < NLAT; r += 2 * NGW) {
        const int rb = r + NGW;
        f32x4 va[4], vb[4]; u32x2 da[4], db[4];
        row_load_nt(p->x + (size_t)r * D, lane, va); row_load_nt(p->x + (size_t)rb * D, lane, vb);
#pragma unroll
        for (int j = 0; j < 4; ++j) { da[j] = *(const u32x2*)(o1 + (size_t)r * D + 4 * lane + 256 * j); db[j] = *(const u32x2*)(o1 + (size_t)rb * D + 4 * lane + 256 * j); }
#pragma unroll
        for (int j = 0; j < 4; ++j) {
            va[j][0] += bflo(da[j].x); va[j][1] += bfhi(da[j].x); va[j][2] += bflo(da[j].y); va[j][3] += bfhi(da[j].y);
            vb[j][0] += bflo(db[j].x); vb[j][1] += bfhi(db[j].x); vb[j][2] += bflo(db[j].y); vb[j][3] += bfhi(db[j].y);
        }
        const float sa = row_rstd(va), sb = row_rstd(vb);
        const int ma = r >> 14, mb = rb >> 14;
        norm_mod_store(va, sa, p->norm2_g, mod + ma * 6144 + 3072, mod + ma * 6144 + 4096, hb + (size_t)(ma * H2_BSTRIDE + 1 + (r & (S - 1))) * D, lane);
        norm_mod_store(vb, sb, p->norm2_g, mod + mb * 6144 + 3072, mod + mb * 6144 + 4096, hb + (size_t)(mb * H2_BSTRIDE + 1 + (rb & (S - 1))) * D, lane);
    }
    for (int z = gw; z < 254; z += NGW) {
        const int R = z == 0 ? 0 : (z <= 126 ? S + z : 32895 + (z - 127));
        const u32x4 zz = {0u, 0u, 0u, 0u};
        *(u32x4*)(hb + (size_t)R * D + 8 * lane) = zz; *(u32x4*)(hb + (size_t)R * D + 512 + 8 * lane) = zz;
    }
}

__device__ __forceinline__ void final_phase(PP p, int wv) {
    const int tid_ = tid_opaque(wv), lane = tid_ & 63, gw = blockIdx.x * 8 + (tid_ >> 6), NGW = gridDim.x * 8;
    const bf16_t* o1 = (const bf16_t*)(p->ws + WS_O1); const bf16_t* o2 = (const bf16_t*)(p->ws + WS_O2);
    for (int r = gw; r < NLAT; r += 2 * NGW) {
        const int rb = r + NGW;
        f32x4 va[4], vb[4]; u32x2 da[4], db[4], ea[4], eb[4];
        row_load_nt(p->x + (size_t)r * D, lane, va); row_load_nt(p->x + (size_t)rb * D, lane, vb);
#pragma unroll
        for (int j = 0; j < 4; ++j) {
            da[j] = *(const u32x2*)(o1 + (size_t)r * D + 4 * lane + 256 * j); db[j] = *(const u32x2*)(o1 + (size_t)rb * D + 4 * lane + 256 * j);
            ea[j] = *(const u32x2*)(o2 + (size_t)r * D + 4 * lane + 256 * j); eb[j] = *(const u32x2*)(o2 + (size_t)rb * D + 4 * lane + 256 * j);
        }
#pragma unroll
        for (int j = 0; j < 4; ++j) {
            va[j][0] += bflo(da[j].x) + bflo(ea[j].x); va[j][1] += bfhi(da[j].x) + bfhi(ea[j].x); va[j][2] += bflo(da[j].y) + bflo(ea[j].y); va[j][3] += bfhi(da[j].y) + bfhi(ea[j].y);
            vb[j][0] += bflo(db[j].x) + bflo(eb[j].x); vb[j][1] += bfhi(db[j].x) + bfhi(eb[j].x); vb[j][2] += bflo(db[j].y) + bflo(eb[j].y); vb[j][3] += bfhi(db[j].y) + bfhi(eb[j].y);
        }
        const float sa = row_rstd(va), sb = row_rstd(vb);
        float* rowa = p->out + (size_t)r * D; float* rowb = p->out + (size_t)rb * D;
#pragma unroll
        for (int j = 0; j < 4; ++j) { const f32x4 gg = *(const f32x4*)(p->final_g + 4 * lane + 256 * j); *(f32x4*)(rowa + 4 * lane + 256 * j) = va[j] * sa * gg; *(f32x4*)(rowb + 4 * lane + 256 * j) = vb[j] * sb * gg; }
    }
}

__global__ void __launch_bounds__(512, 2) fwd_megakernel(Params p_arg) {
    extern __shared__ __attribute__((aligned(16))) unsigned char shm[];
    cg::grid_group grid = cg::this_grid();
    LAS unsigned char* lds = (LAS unsigned char*)shm;
    pg8::StaticOrder so;
    const int wv = __builtin_amdgcn_readfirstlane((int)(threadIdx.x >> 6));
    volatile LAS unsigned* xst = (volatile LAS unsigned*)(lds + LDS_XB);
    if (tid_opaque(wv) == 0) { xst[0] = 0u; xst[1] = 0u; }
    __syncthreads();
    (void)xcd_barrier_post((unsigned*)(kparams()->ws + WS_BAR), xst, wv);
#define XBAR() do { XcdBarrier _b; _b.bar = (unsigned*)(kparams()->ws + WS_BAR); _b.x = xb_xcc_id(); _b.st = (volatile LAS unsigned*)(lds + LDS_XB); xcd_barrier(_b, wv); } while (0)
    if (kparams()->out == nullptr) grid.sync();

    phase0(kparams(), shm, wv);
    {
        constexpr int T_IN = (D / 64) * (DIN / 32), T_B = (D / 64) * (D / 32) + (D / 64) * (DUP / 32) + (DFF / 64) * (D / 32), T_LRU = 64;
        const int nfree = (int)gridDim.x > 192 ? (int)gridDim.x - 192 : 0;
        const int first = nfree ? 192 : 0, nblk = nfree ? nfree : (int)gridDim.x;
        if ((int)blockIdx.x >= first) {
            transpose_phase(kparams(), shm, wv, 0, T_IN, ((int)blockIdx.x - first) * 8, nblk * 8);
            transpose_phase(kparams(), shm, wv, T_IN + T_B, T_IN + T_B + T_LRU, ((int)blockIdx.x - first) * 8, nblk * 8);
        }
    }
    XBAR();
    phase1(kparams(), wv);
    XBAR();
    {
        PP p = kparams(); unsigned char* ws = p->ws;
        pg8::Gemm g{(const bf16_t*)(ws + WS_HB), (const bf16_t*)(ws + WS_WIN), MROWS / 256, DIN / 256, D, 256};
        so.init(g.nM, g.nN, gridDim.x, blockIdx.x);
        EpiProj e{(bf16_t*)(ws + WS_PROJ), (const float*)(ws + WS_ROPE), (const float*)(ws + WS_ROPE) + 4096};
        pg8::gemm_phase(lds, g, so, e, wv);
        {
            constexpr int T_IN = (D / 64) * (DIN / 32), T_B = (D / 64) * (D / 32) + (D / 64) * (DUP / 32) + (DFF / 64) * (D / 32);
            const int G = (int)gridDim.x, rem = (g.nM * g.nN) % G;
            const int first = rem ? rem : 0, nblk = G - first;
            if ((int)blockIdx.x >= first) transpose_phase(p, shm, wv, T_IN, T_IN + T_B, ((int)blockIdx.x - first) * 8, nblk * 8);
        }
    }
    XBAR();
    scan_mfma(kparams(), shm, wv);
    attn_mfma(kparams(), shm, wv);
    XBAR();
    carry_phase(kparams(), shm, wv);
    XBAR();
    mix_phase(kparams(), wv);
    XBAR();
    {
        PP p = kparams(); unsigned char* ws = p->ws; const float* mod = (const float*)(ws + WS_MOD);
        pg8::Gemm g{(const bf16_t*)(ws + WS_HB), (const bf16_t*)(ws + WS_WOUT), NLAT / 256, D / 256, D, 256};
        so.init(g.nM, g.nN, gridDim.x, blockIdx.x);
        EpiDelta e{(bf16_t*)(ws + WS_O1), mod + 2048, mod + 6144 + 2048};
        pg8::gemm_phase(lds, g, so, e, wv);
    }
    XBAR();
    phase7(kparams(), wv);
    XBAR();
    {
        PP p = kparams(); unsigned char* ws = p->ws;
        pg8::Gemm g{(const bf16_t*)(ws + WS_HB), (const bf16_t*)(ws + WS_WUP), 130, DUP / 256, D, 254};
        so.init(g.nM, g.nN, gridDim.x, blockIdx.x);
        EpiConvGate e{(bf16_t*)(ws + WS_ACT), p->ffn_conv_w, p->ffn_conv_b, lds + 131072};
        pg8::gemm_phase(lds, g, so, e, wv);
    }
    XBAR();
    {
        PP p = kparams(); unsigned char* ws = p->ws; const float* mod = (const float*)(ws + WS_MOD);
        pg8::Gemm g{(const bf16_t*)(ws + WS_ACT), (const bf16_t*)(ws + WS_WDN), NLAT / 256, D / 256, DFF, 256};
        so.init(g.nM, g.nN, gridDim.x, blockIdx.x);
        EpiDelta e{(bf16_t*)(ws + WS_O2), mod + 5120, mod + 6144 + 5120};
        pg8::gemm_phase(lds, g, so, e, wv);
    }
    XBAR();
    final_phase(kparams(), wv);
}

extern "C" void kernel_launch(void* const* d_in, const int* in_sizes, int n_in, void* d_out, int out_size, void* d_ws, size_t ws_size, hipStream_t stream) {
    static int grid_blocks = 0;
    if (!grid_blocks) {
        int dev = 0, cus = 0, per_cu = 0;
        hipGetDevice(&dev);
        hipDeviceGetAttribute(&cus, hipDeviceAttributeMultiprocessorCount, dev);
        hipFuncSetAttribute((const void*)fwd_megakernel, hipFuncAttributeMaxDynamicSharedMemorySize, LDS_BYTES);
        hipOccupancyMaxActiveBlocksPerMultiprocessor(&per_cu, (const void*)fwd_megakernel, 512, LDS_BYTES);
        if (per_cu < 1) per_cu = 1;
        grid_blocks = cus * per_cu;
        if (ws_size < WS_END) fprintf(stderr, "kernel_launch: workspace too small: %zu < %zu\n", ws_size, (size_t)WS_END);
    }
    Params p{};
    const float** pp = (const float**)&p;
    for (int i = 0; i < 25; ++i) pp[i] = (const float*)d_in[i];
    const size_t ws_off = ws_size > WS_END ? ((ws_size - WS_END) & ~(size_t)4095) : 0;
    p.out = (float*)d_out; p.ws = (unsigned char*)d_ws + ws_off;
    hipMemsetAsync((unsigned char*)d_ws + ws_off + WS_BAR, 0, 16384, stream);
    void* args[] = {&p};
    hipError_t e = hipLaunchCooperativeKernel((const void*)fwd_megakernel, dim3(grid_blocks), dim3(512), args, LDS_BYTES, stream);
    if (e != hipSuccess) fprintf(stderr, "cooperative launch failed: %s (grid %d)\n", hipGetErrorString(e), grid_blocks);
}
```

```cpp
#include <hip/hip_runtime.h>
#include <hip/hip_cooperative_groups.h>
#include <cstdio>
namespace cg = cooperative_groups;

#define LAS __attribute__((address_space(3)))
typedef unsigned short bf16_t;
typedef short bf16x8 __attribute__((ext_vector_type(8)));
typedef float f32x4 __attribute__((ext_vector_type(4)));
typedef unsigned u32x4 __attribute__((ext_vector_type(4)));
typedef unsigned u32x2 __attribute__((ext_vector_type(2)));

constexpr int D = 1024, NB = 2, S = 16384, LC = 256;
constexpr int NLAT = NB * S;
constexpr int NCTX = NB * LC;
constexpr int MROWS = NLAT + NCTX;
constexpr int DIN = 1792, DFF = 2816, DUP = 5632, DRNN = 512;
constexpr int NCHUNK = MROWS / 64;
constexpr float EPS = 1e-6f;

constexpr size_t AL(size_t x) { return (x + 255) & ~(size_t)255; }
constexpr size_t WS_WIN  = 0;
constexpr size_t WS_WOUT = WS_WIN  + AL((size_t)DIN * D * 2);
constexpr size_t WS_WUP  = WS_WOUT + AL((size_t)D * D * 2);
constexpr size_t WS_WDN  = WS_WUP  + AL((size_t)DUP * D * 2);
constexpr size_t WS_LRU  = WS_WDN  + AL((size_t)D * DFF * 2);
constexpr size_t WS_MOD  = WS_LRU  + AL((size_t)4 * 8 * 64 * 64 * 2);
constexpr size_t WS_ROPE = WS_MOD  + AL((size_t)3 * 6144 * 4);
constexpr size_t WS_SUM  = WS_ROPE + AL((size_t)2 * 256 * 16 * 4);
constexpr size_t WS_CAR  = WS_SUM  + AL((size_t)2 * NCHUNK * 2 * 512 * 4);
constexpr size_t WS_SP8  = WS_CAR  + AL((size_t)2 * NCHUNK * 512 * 4);
constexpr size_t WS_BAR  = WS_SP8  + 4096;
constexpr size_t WS_R1   = WS_BAR  + 16384;
constexpr size_t WS_ATT  = WS_R1;
constexpr size_t WS_YL   = WS_ATT  + AL((size_t)NLAT * 512 * 2);
constexpr size_t WS_CAF  = WS_YL   + AL((size_t)NLAT * 512 * 2);
constexpr size_t WS_CAB  = WS_CAF  + AL((size_t)NLAT * 512 * 2);
constexpr size_t WS_PROJ = WS_CAB  + AL((size_t)NLAT * 512 * 2);
constexpr size_t WS_R1END = WS_PROJ + AL((size_t)MROWS * DIN * 2);
constexpr size_t WS_HB   = WS_R1END;
constexpr size_t WS_HBEND = WS_HB + AL((size_t)MROWS * D * 2);
constexpr size_t WS_ACT  = WS_R1;
constexpr size_t WS_O1   = WS_ACT + AL((size_t)NLAT * DFF * 2);
constexpr size_t WS_O2   = WS_HB;
constexpr size_t WS_END  = WS_HBEND;
static_assert(WS_O1 + (size_t)NLAT * D * 2 <= WS_R1END, "o1");
static_assert(WS_ACT + (size_t)NLAT * DFF * 2 <= WS_R1END, "act");
constexpr int H2_BSTRIDE = 65 * 254;
constexpr int H2_ROWS = 130 * 254 + 2;
static_assert((size_t)H2_ROWS * D * 2 <= (size_t)MROWS * D * 2, "h2");

constexpr int LDS_BYTES = 131072 + 8192 + 256;
constexpr int LDS_XB = 131072 + 8192;

struct Params {
    const float *x, *c, *ctx, *c_ctx, *w_mod, *b_mod, *norm1_g, *w_in, *rnn_conv_w, *rnn_conv_b, *lru_w_a, *lru_b_a,
        *lru_w_i, *lru_b_i, *lru_lam, *attn_sink, *gn_rnn, *gn_attn, *w_out, *norm2_g, *w_up, *ffn_conv_w, *ffn_conv_b,
        *w_down, *final_g;
    float* out;
    unsigned char* ws;
};

typedef const Params __attribute__((address_space(4)))* PP;
__device__ __forceinline__ PP kparams() { PP k = (PP)__builtin_amdgcn_kernarg_segment_ptr(); asm volatile("" : "+s"(k)); return k; }
__device__ __forceinline__ int lane_fresh() { unsigned m = ~0u; asm volatile("" : "+s"(m)); return (int)__builtin_amdgcn_mbcnt_hi(m, __builtin_amdgcn_mbcnt_lo(m, 0u)); }
__device__ __forceinline__ int tid_opaque(int wv) { return wv * 64 + lane_fresh(); }
__device__ __forceinline__ bf16_t f2bf(float f) { unsigned u = __float_as_uint(f); u += 0x7FFFu + ((u >> 16) & 1u); return (bf16_t)(u >> 16); }
__device__ __forceinline__ float bf2f(bf16_t b) { return __uint_as_float(((unsigned)b) << 16); }
__device__ __forceinline__ unsigned pk2(float lo, float hi) { unsigned r; asm("v_cvt_pk_bf16_f32 %0, %1, %2" : "=v"(r) : "v"(lo), "v"(hi)); return r; }
__device__ __forceinline__ float bflo(unsigned w) { return __uint_as_float(w << 16); }
__device__ __forceinline__ float bfhi(unsigned w) { return __uint_as_float(w & 0xFFFF0000u); }
__device__ __forceinline__ float wave_sum(float v) {
#pragma unroll
    for (int o = 32; o >= 1; o >>= 1) v += __shfl_xor(v, o);
    return v;
}
__device__ __forceinline__ float wave_max(float v) {
#pragma unroll
    for (int o = 32; o >= 1; o >>= 1) v = fmaxf(v, __shfl_xor(v, o));
    return v;
}
__device__ __forceinline__ float sigmoidf_(float x) { return 1.0f / (1.0f + __expf(-x)); }
__device__ __forceinline__ float fast_sigmoid(float x) { return __builtin_amdgcn_rcpf(1.0f + __builtin_amdgcn_exp2f(-1.4426950408889634f * x)); }
__device__ __forceinline__ float silu_(float x) { return x * fast_sigmoid(x); }
__device__ __forceinline__ float gelu_tanh_(float x) {
    const float u = 0.7978845608028654f * (x + 0.044715f * x * x * x);
    const float e = __expf(2.0f * u);
    const float th = 1.0f - 2.0f / (e + 1.0f);
    return 0.5f * x * (1.0f + th);
}


#define XB_TMO      128
#define XB_XCNT(j)  (256  + 64 * (j))
#define XB_XSUB(j)  (1280 + 64 * (j))
#define XB_XGEN(j)  (2304 + 64 * (j))
#define XB_TOP      3328
#define XB_TOPGEN   3392
#define XCD_BAR_WORDS 3456
#define XB_SPIN_CAP (1u << 20)
__device__ __forceinline__ unsigned xb_ld(unsigned* p)              { return __hip_atomic_load(p, __ATOMIC_RELAXED, __HIP_MEMORY_SCOPE_AGENT); }
__device__ __forceinline__ unsigned xb_add(unsigned* p, unsigned v) { return __hip_atomic_fetch_add(p, v, __ATOMIC_RELAXED, __HIP_MEMORY_SCOPE_AGENT); }
__device__ __forceinline__ unsigned xb_xcc_id() { return (unsigned)__builtin_amdgcn_s_getreg((3 << 11) | 20) & 0xFu; }
#define XB_SPIN(cond, bar) do { unsigned _sp = 0; while (cond) { __builtin_amdgcn_s_sleep(1); \
    if ((++_sp & 255u) == 0u) { if (xb_ld(&(bar)[XB_TMO])) break; if (_sp > XB_SPIN_CAP) { atomicAdd(&(bar)[XB_TMO], 1u); break; } } } } while (0)
struct XcdBarrier { unsigned* bar; unsigned x; volatile LAS unsigned* st; };
__device__ __forceinline__ XcdBarrier xcd_barrier_post(unsigned* bar, volatile LAS unsigned* st, int wv) {
    XcdBarrier b; b.bar = bar; b.x = xb_xcc_id(); b.st = st;
    if (tid_opaque(wv) == 0) (void)xb_add(&bar[XB_XCNT(b.x)], 1u);
    return b;
}
__device__ __forceinline__ void xcd_barrier_complete(unsigned* bar, unsigned x, unsigned& nloc, unsigned& nx) {
    const unsigned G = gridDim.x * gridDim.y * gridDim.z;
    unsigned sum, cnt, mine, sp = 0u;
    for (;;) {
        sum = 0u; cnt = 0u; mine = 0u;
#pragma unroll
        for (unsigned j = 0; j < 16; ++j) { const unsigned c = xb_ld(&bar[XB_XCNT(j)]); sum += c; cnt += (c > 0u) ? 1u : 0u; mine = (j == x) ? c : mine; }
        if (sum == G) break;
        __builtin_amdgcn_s_sleep(1);
        if ((++sp & 255u) == 0u) { if (xb_ld(&bar[XB_TMO])) break; if (sp > XB_SPIN_CAP) { atomicAdd(&bar[XB_TMO], 1u); break; } }
    }
    nloc = mine > 0u ? mine : 1u; nx = cnt > 0u ? cnt : 1u;
}
__device__ __forceinline__ void xcd_barrier(const XcdBarrier& b, int wv) {
    asm volatile("s_waitcnt vmcnt(0)" ::: "memory");
    __syncthreads();
    if (tid_opaque(wv) == 0) {
        unsigned* bar = b.bar;
        __builtin_amdgcn_s_waitcnt(0);
        unsigned nloc = b.st[0], nx = b.st[1];
        if (nloc == 0u) { xcd_barrier_complete(bar, b.x, nloc, nx); b.st[0] = nloc; b.st[1] = nx; }
        const unsigned old = xb_add(&bar[XB_XSUB(b.x)], 1u);
        const unsigned gen = old / nloc;
        if (old + 1u == (gen + 1u) * nloc) {
            __builtin_amdgcn_fence(__ATOMIC_RELEASE, "agent");
            asm volatile("s_waitcnt vmcnt(0)" ::: "memory");
            const unsigned og = xb_add(&bar[XB_TOP], 1u);
            const unsigned tg = og / nx;
            if (og + 1u == (tg + 1u) * nx) xb_add(&bar[XB_TOPGEN], 1u);
            else XB_SPIN(xb_ld(&bar[XB_TOPGEN]) == tg, bar);
            __builtin_amdgcn_fence(__ATOMIC_ACQUIRE, "agent");
            xb_add(&bar[XB_XGEN(b.x)], 1u);
            asm volatile("s_waitcnt vmcnt(0)" ::: "memory");
        } else {
            XB_SPIN(xb_ld(&bar[XB_XGEN(b.x)]) == gen, bar);
            __builtin_amdgcn_fence(__ATOMIC_ACQUIRE, "agent");
            asm volatile("s_waitcnt vmcnt(0)" ::: "memory");
        }
    }
    __syncthreads();
}

namespace pg8 {
constexpr int BM = 256, BK = 64, HALF = 128, HTB = HALF * BK * 2, NXCD = 8, WGM = 8;
__host__ __device__ __forceinline__ int lds_byte(int r, int c) { const int st = (r >> 4) * 2 + (c >> 5), rr = r & 15, cc = c & 31, ob = rr * 64 + cc * 2; return st * 1024 + (ob ^ (((ob >> 9) & 1) << 5)); }
__host__ __device__ __forceinline__ void stage_rc(int b, int& R, int& C) { const int st = b / 1024, sb = b % 1024, swz = sb ^ (((sb >> 9) & 1) << 5); R = (st >> 1) * 16 + swz / 64; C = (st & 1) * 32 + (swz % 64) / 2; }
struct Unit { int pm, pn; };
struct Gemm { const bf16_t* A; const bf16_t* Bt; int nM, nN, K, a_tile_rows; };
struct StaticOrder {
    int nM, nN, nwg, G, c;
    __device__ void init(int nM_, int nN_, int G_, int c_) { nM = nM_; nN = nN_; nwg = nM * nN; G = G_; c = c_; }
    __device__ bool next(int i, Unit& u) const {
        const long L = (long)i * G + c; if (L >= nwg) return false;
        int wgid = (int)L; { const int q = nwg / NXCD, r = nwg % NXCD, xcd = wgid % NXCD, off = wgid / NXCD; wgid = (xcd < r ? xcd * (q + 1) : r * (q + 1) + (xcd - r) * q) + off; }
        const int nig = WGM * nN, gid = wgid / nig, fm = gid * WGM, gsz = (nM - fm) < WGM ? (nM - fm) : WGM;
        u.pm = fm + ((wgid % nig) % gsz); u.pn = (wgid % nig) / gsz; return true;
    }
};
template <class Epi>
__device__ __forceinline__ void gemm_phase(LAS unsigned char* lds, const Gemm g, const StaticOrder& S, const Epi& E, int wv) {
    const int tid = tid_opaque(wv);
    const int wid = __builtin_amdgcn_readfirstlane(tid >> 6), lane = tid & 63, wr = wid >> 2, wc = wid & 3, fr = lane & 15, fq = lane >> 4;
    const int K = g.K, nt = K / BK;
    unsigned voffA[2], voffB[2];
#pragma unroll
    for (int i = 0; i < 2; ++i) { int R, C; stage_rc(tid * 16 + i * 8192, R, C);
        const int Ra = (R & ~63) + 4 * (R & 15) + ((R >> 4) & 3);
        voffA[i] = (unsigned)(Ra * K + C) * 2u; voffB[i] = (unsigned)(R * K + C) * 2u; }
    const size_t kstep = (size_t)(BK * 2);
    const size_t hstep = (size_t)HALF * K * 2;
    const size_t tstepA = (size_t)g.a_tile_rows * K * 2;
    const size_t tstepB = 2 * hstep;
    const unsigned ldsw = (unsigned)wid * 1024u;
    const int aoff = lds_byte(wr * 64 + fr, fq * 8), boff = lds_byte(wc * 32 + fr, fq * 8);
#define PG8_SA(b, h) (((b) * 2 + (h)) * HTB)
#define PG8_SB(b, h) ((4 + (b) * 2 + (h)) * HTB)
#define PG8_STAGE(bufoff, gbase, voff) do { _Pragma("unroll") for (int _i = 0; _i < 2; ++_i) \
        __builtin_amdgcn_global_load_lds((const unsigned*)((const char*)(gbase) + (voff)[_i]), (LAS unsigned*)(lds + (bufoff) + ldsw + _i * 8192), 16, 0, 0); } while (0)
#define PG8_LDA(dst, b, h) do { _Pragma("unroll") for (int m = 0; m < 4; ++m) _Pragma("unroll") for (int k = 0; k < 2; ++k) dst[m][k] = *(const LAS bf16x8*)(lds + PG8_SA(b, h) + aoff + m * 2048 + k * 1024); } while (0)
#define PG8_LDB(dst, b, h) do { _Pragma("unroll") for (int n = 0; n < 2; ++n) _Pragma("unroll") for (int k = 0; k < 2; ++k) dst[n][k] = *(const LAS bf16x8*)(lds + PG8_SB(b, h) + boff + n * 2048 + k * 1024); } while (0)
#define PG8_MMA(ai, bj, At, Bt) do { __builtin_amdgcn_s_setprio(1); _Pragma("unroll") for (int m = 0; m < 4; ++m) _Pragma("unroll") for (int n = 0; n < 2; ++n) _Pragma("unroll") for (int k = 0; k < 2; ++k) \
        acc[ai][bj][m][n] = __builtin_amdgcn_mfma_f32_16x16x32_bf16(Bt[n][k], At[m][k], acc[ai][bj][m][n], 0, 0, 0); __builtin_amdgcn_s_setprio(0); } while (0)
#define PG8_WAIT_V(n) asm volatile("s_waitcnt vmcnt(" #n ")" ::: "memory")
#define PG8_WAIT_L(n) asm volatile("s_waitcnt lgkmcnt(" #n ")" ::: "memory")
#define PG8_BAR __builtin_amdgcn_s_barrier()
#define PG8_SCHED __builtin_amdgcn_sched_barrier(0)
    Unit cur, nxt; int ui = 0;
    if (!S.next(0, cur)) return;
    f32x4 acc[2][2][4][2];
#pragma unroll
    for (int a = 0; a < 2; ++a)
#pragma unroll
        for (int b = 0; b < 2; ++b)
#pragma unroll
            for (int m = 0; m < 4; ++m)
#pragma unroll
                for (int n = 0; n < 2; ++n) acc[a][b][m][n] = (f32x4){0.f, 0.f, 0.f, 0.f};
    bf16x8 At[4][2], B0[2][2], B1[2][2];
    const char* cA = (const char*)g.A + (size_t)cur.pm * tstepA; const char* cB = (const char*)g.Bt + (size_t)cur.pn * tstepB;
    PG8_STAGE(PG8_SB(0, 0), cB, voffB); PG8_STAGE(PG8_SA(0, 0), cA, voffA); PG8_STAGE(PG8_SB(0, 1), cB + hstep, voffB); PG8_STAGE(PG8_SA(0, 1), cA + hstep, voffA);
    if (wr == 1) PG8_BAR;
    PG8_WAIT_V(4); PG8_BAR;
    PG8_STAGE(PG8_SB(1, 0), cB + kstep, voffB); PG8_STAGE(PG8_SA(1, 0), cA + kstep, voffA); PG8_STAGE(PG8_SB(1, 1), cB + hstep + kstep, voffB);
    PG8_WAIT_V(6); PG8_BAR;
    for (;;) {
        const bool has_next = S.next(ui + 1, nxt);
        const char* nA = has_next ? (const char*)g.A + (size_t)nxt.pm * tstepA : cA; const char* nB = has_next ? (const char*)g.Bt + (size_t)nxt.pn * tstepB : cB;
        for (int t = 0; t < nt; t += 2) {
            const bool last = (t == nt - 2);
            const char* a1 = cA + (size_t)(t + 1) * kstep;
            const char* a2 = last ? nA : cA + (size_t)(t + 2) * kstep; const char* b2 = last ? nB : cB + (size_t)(t + 2) * kstep;
            const char* a3 = a2 + kstep; const char* b3 = b2 + kstep;
            PG8_LDB(B0, 0, 0); PG8_SCHED; PG8_LDA(At, 0, 0); PG8_STAGE(PG8_SA(1, 1), a1 + hstep, voffA);
            PG8_WAIT_L(8); PG8_BAR; PG8_WAIT_L(0); PG8_MMA(0, 0, At, B0); PG8_BAR; PG8_SCHED;
            PG8_LDB(B1, 0, 1); PG8_STAGE(PG8_SB(0, 0), b2, voffB);
            PG8_BAR; PG8_WAIT_L(0); PG8_MMA(0, 1, At, B1); PG8_BAR;
            PG8_LDA(At, 0, 1); PG8_STAGE(PG8_SA(0, 0), a2, voffA);
            PG8_BAR; PG8_WAIT_L(0); PG8_MMA(1, 0, At, B0); PG8_BAR; PG8_SCHED;
            PG8_STAGE(PG8_SB(0, 1), b2 + hstep, voffB);
            PG8_WAIT_V(6); PG8_BAR; PG8_MMA(1, 1, At, B1); PG8_BAR;
            PG8_LDB(B0, 1, 0); PG8_SCHED; PG8_LDA(At, 1, 0); PG8_STAGE(PG8_SA(0, 1), a2 + hstep, voffA);
            PG8_WAIT_L(8); PG8_BAR; PG8_WAIT_L(0); PG8_MMA(0, 0, At, B0); PG8_BAR; PG8_SCHED;
            PG8_LDB(B1, 1, 1); PG8_STAGE(PG8_SB(1, 0), b3, voffB);
            PG8_BAR; PG8_WAIT_L(0); PG8_MMA(0, 1, At, B1); PG8_BAR;
            PG8_LDA(At, 1, 1); PG8_STAGE(PG8_SA(1, 0), a3, voffA);
            PG8_BAR; PG8_WAIT_L(0); PG8_MMA(1, 0, At, B0); PG8_BAR; PG8_SCHED;
            PG8_STAGE(PG8_SB(1, 1), b3 + hstep, voffB);
            PG8_WAIT_V(6); PG8_BAR; PG8_MMA(1, 1, At, B1); PG8_BAR;
        }
        { const int ln2 = lane_fresh();
          E(acc, cur, wr, wc, ln2 & 15, ln2 >> 4); }
        if (!has_next) break;
#pragma unroll
        for (int a = 0; a < 2; ++a)
#pragma unroll
            for (int b = 0; b < 2; ++b)
#pragma unroll
                for (int m = 0; m < 4; ++m)
#pragma unroll
                    for (int n = 0; n < 2; ++n) acc[a][b][m][n] = (f32x4){0.f, 0.f, 0.f, 0.f};
        cur = nxt; cA = nA; cB = nB; ++ui;
    }
    PG8_WAIT_V(0);
    if (wr == 0) PG8_BAR;
    PG8_BAR;
#undef PG8_SA
#undef PG8_SB
#undef PG8_STAGE
#undef PG8_LDA
#undef PG8_LDB
#undef PG8_MMA
#undef PG8_WAIT_V
#undef PG8_WAIT_L
#undef PG8_BAR
#undef PG8_SCHED
}
}
using pg8::Unit;

struct EpiProj {
    bf16_t* O; const float* cosT; const float* sinT;
    __device__ __forceinline__ void operator()(const f32x4 (&acc)[2][2][4][2], const Unit& u, int wr, int wc, int fr, int fq) const {
        const bool latent = u.pm < 128;
#pragma unroll
        for (int ai = 0; ai < 2; ++ai)
#pragma unroll
            for (int m = 0; m < 4; ++m) {
                const int row = u.pm * 256 + ai * 128 + wr * 64 + 4 * fr + m;
                const int t = row & (S - 1);
                const int pos = (wc & 1) ? (t & 63) : (t >> 6);
#pragma unroll
                for (int bj = 0; bj < 2; ++bj) {
                    const int col = u.pn * 256 + bj * 128 + wc * 32 + 4 * fq;
                    f32x4 v0 = acc[ai][bj][m][0], v1 = acc[ai][bj][m][1];
                    const bool rope = latent && (u.pn == 4 || u.pn == 5 || (u.pn == 6 && bj == 0));
                    if (rope) {
                        const f32x4 cs = *(const f32x4*)(cosT + pos * 16 + 4 * fq), sn = *(const f32x4*)(sinT + pos * 16 + 4 * fq);
                        const f32x4 n0 = v0 * cs - v1 * sn, n1 = v1 * cs + v0 * sn; v0 = n0; v1 = n1;
                    }
                    bf16_t* p = O + (size_t)row * DIN + col;
                    u32x2 w0, w1; w0.x = pk2(v0[0], v0[1]); w0.y = pk2(v0[2], v0[3]); w1.x = pk2(v1[0], v1[1]); w1.y = pk2(v1[2], v1[3]);
                    *(u32x2*)p = w0; *(u32x2*)(p + 16) = w1;
                }
            }
    }
};
struct EpiDelta {
    bf16_t* O; const float* gate0; const float* gate1;
    __device__ __forceinline__ void operator()(const f32x4 (&acc)[2][2][4][2], const Unit& u, int wr, int wc, int fr, int fq) const {
        const float* gate = (u.pm >= 64) ? gate1 : gate0;
        f32x4 gv[2][2];
#pragma unroll
        for (int bj = 0; bj < 2; ++bj)
#pragma unroll
            for (int n = 0; n < 2; ++n) gv[bj][n] = *(const f32x4*)(gate + u.pn * 256 + bj * 128 + wc * 32 + n * 16 + 4 * fq);
#pragma unroll
        for (int ai = 0; ai < 2; ++ai)
#pragma unroll
            for (int m = 0; m < 4; ++m) {
                const size_t row = (size_t)u.pm * 256 + ai * 128 + wr * 64 + 4 * fr + m;
#pragma unroll
                for (int bj = 0; bj < 2; ++bj)
#pragma unroll
                    for (int n = 0; n < 2; ++n) {
                        const f32x4 v = gv[bj][n] * acc[ai][bj][m][n];
                        u32x2 w; w.x = pk2(v[0], v[1]); w.y = pk2(v[2], v[3]);
                        *(u32x2*)(O + row * D + u.pn * 256 + bj * 128 + wc * 32 + n * 16 + 4 * fq) = w;
                    }
            }
    }
};

__device__ __forceinline__ float dpp_ror1(float v)  { return __int_as_float(__builtin_amdgcn_update_dpp(0, __float_as_int(v), 0x121, 0xF, 0xF, true)); }
__device__ __forceinline__ float dpp_ror15(float v) { return __int_as_float(__builtin_amdgcn_update_dpp(0, __float_as_int(v), 0x12F, 0xF, 0xF, true)); }
__device__ __forceinline__ float dpp_shr1(float v)  { return __int_as_float(__builtin_amdgcn_update_dpp(0, __float_as_int(v), 0x111, 0xF, 0xF, true)); }
__device__ __forceinline__ float dpp_shl1(float v)  { return __int_as_float(__builtin_amdgcn_update_dpp(0, __float_as_int(v), 0x101, 0xF, 0xF, true)); }

#define DPP_FMAC4X2(C, SA, WA, CTRLA, SB, WB, CTRLB) do { float _c0 = (C)[0], _c1 = (C)[1], _c2 = (C)[2], _c3 = (C)[3]; \
    asm("s_nop 1\n\t" \
        "v_fmac_f32_dpp %0, %4, %8 " CTRLA " row_mask:0xf bank_mask:0xf bound_ctrl:1\n\t" \
        "v_fmac_f32_dpp %1, %5, %9 " CTRLA " row_mask:0xf bank_mask:0xf bound_ctrl:1\n\t" \
        "v_fmac_f32_dpp %2, %6, %10 " CTRLA " row_mask:0xf bank_mask:0xf bound_ctrl:1\n\t" \
        "v_fmac_f32_dpp %3, %7, %11 " CTRLA " row_mask:0xf bank_mask:0xf bound_ctrl:1\n\t" \
        "v_fmac_f32_dpp %0, %12, %16 " CTRLB " row_mask:0xf bank_mask:0xf bound_ctrl:1\n\t" \
        "v_fmac_f32_dpp %1, %13, %17 " CTRLB " row_mask:0xf bank_mask:0xf bound_ctrl:1\n\t" \
        "v_fmac_f32_dpp %2, %14, %18 " CTRLB " row_mask:0xf bank_mask:0xf bound_ctrl:1\n\t" \
        "v_fmac_f32_dpp %3, %15, %19 " CTRLB " row_mask:0xf bank_mask:0xf bound_ctrl:1" \
        : "+v"(_c0), "+v"(_c1), "+v"(_c2), "+v"(_c3) \
        : "v"((SA)[0]), "v"((SA)[1]), "v"((SA)[2]), "v"((SA)[3]), "v"((WA)[0]), "v"((WA)[1]), "v"((WA)[2]), "v"((WA)[3]), \
          "v"((SB)[0]), "v"((SB)[1]), "v"((SB)[2]), "v"((SB)[3]), "v"((WB)[0]), "v"((WB)[1]), "v"((WB)[2]), "v"((WB)[3])); \
    (C)[0] = _c0; (C)[1] = _c1; (C)[2] = _c2; (C)[3] = _c3; } while (0)
#define DPP_FMAC4(C, SA, WA, CTRLA) do { float _c0 = (C)[0], _c1 = (C)[1], _c2 = (C)[2], _c3 = (C)[3]; \
    asm("s_nop 1\n\t" \
        "v_fmac_f32_dpp %0, %4, %8 " CTRLA " row_mask:0xf bank_mask:0xf bound_ctrl:1\n\t" \
        "v_fmac_f32_dpp %1, %5, %9 " CTRLA " row_mask:0xf bank_mask:0xf bound_ctrl:1\n\t" \
        "v_fmac_f32_dpp %2, %6, %10 " CTRLA " row_mask:0xf bank_mask:0xf bound_ctrl:1\n\t" \
        "v_fmac_f32_dpp %3, %7, %11 " CTRLA " row_mask:0xf bank_mask:0xf bound_ctrl:1" \
        : "+v"(_c0), "+v"(_c1), "+v"(_c2), "+v"(_c3) \
        : "v"((SA)[0]), "v"((SA)[1]), "v"((SA)[2]), "v"((SA)[3]), "v"((WA)[0]), "v"((WA)[1]), "v"((WA)[2]), "v"((WA)[3])); \
    (C)[0] = _c0; (C)[1] = _c1; (C)[2] = _c2; (C)[3] = _c3; } while (0)
struct EpiConvGate {
    bf16_t* act; const float* cw; const float* cbias; LAS unsigned char* xl;
    __device__ __forceinline__ void operator()(const f32x4 (&acc)[2][2][4][2], const Unit& u, int wr, int wc, int fr, int fq) const {
        if (wr == 0) { __builtin_amdgcn_s_barrier(); } asm volatile("" ::: "memory");
        LAS float* X = (LAS float*)xl;
        f32x4 wq[2][2][4];
#define CG_LOADW(N) do { _Pragma("unroll") for (int bj = 0; bj < 2; ++bj) { const int ch = 128 * u.pn + 32 * wc + 16 * (N) + 4 * fq + bj * DFF; \
            wq[N][bj][0] = *(const f32x4*)(cw + ch); wq[N][bj][1] = *(const f32x4*)(cw + DUP + ch); wq[N][bj][2] = *(const f32x4*)(cw + 2 * DUP + ch); wq[N][bj][3] = *(const f32x4*)(cbias + ch); } } while (0)
        CG_LOADW(0);
#pragma unroll
        for (int ai = 0; ai < 2; ++ai) {
            const int s = 2 * ai + wr;
            if (fr == 0) {
#pragma unroll
                for (int bj = 0; bj < 2; ++bj)
#pragma unroll
                    for (int n = 0; n < 2; ++n) *(LAS f32x4*)(X + ((s * 2 + 0) * 2 + bj) * 128 + 32 * wc + 16 * n + 4 * fq) = acc[ai][bj][0][n];
            }
            if (fr == 15) {
#pragma unroll
                for (int bj = 0; bj < 2; ++bj)
#pragma unroll
                    for (int n = 0; n < 2; ++n) *(LAS f32x4*)(X + ((s * 2 + 1) * 2 + bj) * 128 + 32 * wc + 16 * n + 4 * fq) = acc[ai][bj][3][n];
            }
        }
        asm volatile("s_waitcnt lgkmcnt(0)" ::: "memory");
        __builtin_amdgcn_s_barrier(); asm volatile("" ::: "memory");
#pragma unroll
        for (int n = 0; n < 2; ++n) {
            const int chg = 128 * u.pn + 32 * wc + 16 * n + 4 * fq;
            if (n == 1) CG_LOADW(1);
            f32x4 w0[2], w1[2], w2[2], bb[2], w0m[2], w2m[2];
#pragma unroll
            for (int bj = 0; bj < 2; ++bj) {
                w0[bj] = wq[n][bj][0]; w1[bj] = wq[n][bj][1]; w2[bj] = wq[n][bj][2]; bb[bj] = wq[n][bj][3];
                w0m[bj] = (fr == 0) ? w0[bj] : (f32x4){0.f, 0.f, 0.f, 0.f}; w2m[bj] = (fr == 15) ? w2[bj] : (f32x4){0.f, 0.f, 0.f, 0.f};
            }
#pragma unroll
            for (int ai = 0; ai < 2; ++ai) {
                const int s = 2 * ai + wr;
                f32x4 xp[2], xn[2];
#pragma unroll
                for (int bj = 0; bj < 2; ++bj) {
                    xp[bj] = *(const LAS f32x4*)(X + ((((s + 3) & 3) * 2 + 1) * 2 + bj) * 128 + 32 * wc + 16 * n + 4 * fq);
                    xn[bj] = *(const LAS f32x4*)(X + ((((s + 1) & 3) * 2 + 0) * 2 + bj) * 128 + 32 * wc + 16 * n + 4 * fq);
                }
                f32x4 cvv[4][2];
#pragma unroll
                for (int bj = 0; bj < 2; ++bj) {
                    const f32x4 a0 = acc[ai][bj][0][n], a1 = acc[ai][bj][1][n], a2 = acc[ai][bj][2][n], a3 = acc[ai][bj][3][n];
                    f32x4 c0 = bb[bj] + w1[bj] * a0 + w2[bj] * a1 + w0m[bj] * xp[bj];
                    f32x4 c1 = bb[bj] + w1[bj] * a1 + w0[bj] * a0 + w2[bj] * a2;
                    f32x4 c2 = bb[bj] + w1[bj] * a2 + w0[bj] * a1 + w2[bj] * a3;
                    f32x4 c3 = bb[bj] + w1[bj] * a3 + w0[bj] * a2 + w2m[bj] * xn[bj];
                    DPP_FMAC4(c0, a3, w0[bj], "row_shr:1");
                    DPP_FMAC4(c3, a0, w2[bj], "row_shl:1");
                    cvv[0][bj] = c0; cvv[1][bj] = c1; cvv[2][bj] = c2; cvv[3][bj] = c3;
                }
#pragma unroll
                for (int m = 0; m < 4; ++m) {
                    const int lr = 128 * ai + 64 * wr + 4 * fr + m;
                    const int R = 254 * u.pm + lr;
                    const int b = R >= (H2_BSTRIDE + 1) ? 1 : 0;
                    const int t = R - 1 - H2_BSTRIDE * b;
                    const bool valid = lr >= 1 && lr <= 254 && t >= 0 && t < S;
                    if (valid) {
                        u32x2 w;
                        w.x = pk2(silu_(cvv[m][0][0]) * cvv[m][1][0], silu_(cvv[m][0][1]) * cvv[m][1][1]);
                        w.y = pk2(silu_(cvv[m][0][2]) * cvv[m][1][2], silu_(cvv[m][0][3]) * cvv[m][1][3]);
                        *(u32x2*)(act + (size_t)(b * S + t) * DFF + chg) = w;
                    }
                }
            }
        }
        asm volatile("" ::: "memory"); if (wr == 1) { __builtin_amdgcn_s_barrier(); }
    }
};

#undef CG_LOADW
__device__ __forceinline__ void transpose_item(const float* W, int N, int k0, int n0, bf16_t* dst, int Kd, float* scr, int lane) {
#pragma unroll 16
    for (int i = 0; i < 32; ++i) { const int kk = 2 * i + (lane >> 5); scr[kk * 33 + (lane & 31)] = __builtin_nontemporal_load(W + (size_t)(k0 + kk) * N + n0 + (lane & 31)); }
    __builtin_amdgcn_wave_barrier();
    const int c = lane & 7;
#pragma unroll
    for (int j = 0; j < 4; ++j) {
        const int n = (lane >> 3) + 8 * j; const float* s = scr + (8 * c) * 33 + n;
        u32x4 o; o.x = pk2(s[0], s[33]); o.y = pk2(s[2 * 33], s[3 * 33]); o.z = pk2(s[4 * 33], s[5 * 33]); o.w = pk2(s[6 * 33], s[7 * 33]);
        *(u32x4*)(dst + (size_t)n * Kd + k0 + 8 * c) = o;
    }
    __builtin_amdgcn_wave_barrier();
}

__device__ __forceinline__ void phase0(PP p, unsigned char* shm, int wv) {
    const int tid = tid_opaque(wv), lane = tid & 63, wave = tid >> 6;
    unsigned char* ws = p->ws;
    if (blockIdx.x < 192) {
        float* sv = (float*)shm;
        float* red = sv + 3 * 1024;
        for (int i = tid; i < 3 * 1024; i += 512) {
            const int j = i >> 10, k = i & 1023;
            const float v = (j < 2) ? p->c[j * 1024 + k] : p->c_ctx[k];
            sv[i] = silu_(v);
        }
        __syncthreads();
        const int n0 = blockIdx.x * 32, col = tid & 31, ks = tid >> 5;
        float a0 = 0.f, a1 = 0.f, a2 = 0.f;
        const float* wp = p->w_mod + (size_t)(ks * 64) * 6144 + n0 + col;
#pragma unroll
        for (int k = 0; k < 64; ++k) {
            const float w = __builtin_nontemporal_load(wp + (size_t)k * 6144);
            a0 += sv[ks * 64 + k] * w; a1 += sv[1024 + ks * 64 + k] * w; a2 += sv[2048 + ks * 64 + k] * w;
        }
        red[(ks * 3 + 0) * 32 + col] = a0; red[(ks * 3 + 1) * 32 + col] = a1; red[(ks * 3 + 2) * 32 + col] = a2;
        __syncthreads();
        if (tid < 96) {
            const int j = tid >> 5, cc = tid & 31; float s = p->b_mod[n0 + cc];
            for (int k = 0; k < 16; ++k) s += red[(k * 3 + j) * 32 + cc];
            ((float*)(ws + WS_MOD))[j * 6144 + n0 + cc] = s;
        }
        __syncthreads();
    }
    if (blockIdx.x == 200) { for (int i = tid; i < 1024; i += 512) ((float*)(ws + WS_SP8))[i] = -8.0f * log1pf(expf(-p->lru_lam[i])); }
    if (blockIdx.x >= 192 && blockIdx.x < 200) {
        const int idx = (blockIdx.x - 192) * 512 + tid;
        const int pos = idx >> 4, i = idx & 15;
        const float inv = powf(10000.0f, -(float)i / 16.0f);
        const float ang = (float)pos * inv;
        ((float*)(ws + WS_ROPE))[idx] = cosf(ang);
        ((float*)(ws + WS_ROPE))[4096 + idx] = sinf(ang);
    }
}
__device__ __forceinline__ void transpose_phase(PP p, unsigned char* shm, int wv, int it_lo, int it_hi, int gw0, int NGW) {
    const int tid = tid_opaque(wv), lane = tid & 63, wave = wv;
    unsigned char* ws = p->ws;
    float* scr = (float*)(shm + 32768) + wave * (64 * 33);
    const int gw = gw0 + wave;
    constexpr int I_IN = (D / 64) * (DIN / 32), I_OUT = (D / 64) * (D / 32), I_UP = (D / 64) * (DUP / 32), I_DN = (DFF / 64) * (D / 32), I_LRU = 2 * 2 * 8 * 2;
    constexpr int NIT = I_IN + I_OUT + I_UP + I_DN + I_LRU;
    (void)NIT;
    for (int it = it_lo + gw; it < it_hi; it += NGW) {
        int r = it;
        if (r >= I_IN + I_OUT + I_UP + I_DN + I_LRU) continue;
        if (r < I_IN) { const int nb = DIN / 32, kb = r / nb, n0 = (r % nb) * 32; transpose_item(p->w_in, DIN, kb * 64, n0, (bf16_t*)(ws + WS_WIN) + (size_t)n0 * D, D, scr, lane); continue; } r -= I_IN;
        if (r < I_OUT) { const int nb = D / 32, kb = r / nb, n0 = (r % nb) * 32; transpose_item(p->w_out, D, kb * 64, n0, (bf16_t*)(ws + WS_WOUT) + (size_t)n0 * D, D, scr, lane); continue; } r -= I_OUT;
        if (r < I_UP) { const int nb = DUP / 32, kb = r / nb, n0 = (r % nb) * 32;
            const int isv = n0 >= DFF, nn = isv ? n0 - DFF : n0, drow = (nn / 128) * 256 + isv * 128 + (nn % 128);
            transpose_item(p->w_up, DUP, kb * 64, n0, (bf16_t*)(ws + WS_WUP) + (size_t)drow * D, D, scr, lane); continue; } r -= I_UP;
        if (r < I_DN) { const int nb = D / 32, kb = r / nb, n0 = (r % nb) * 32; transpose_item(p->w_down, D, kb * 64, n0, (bf16_t*)(ws + WS_WDN) + (size_t)n0 * DFF, DFF, scr, lane); continue; } r -= I_DN;
        {
            const int nh = r & 1, blk = (r >> 1) & 7, type = (r >> 4) & 1, dir = r >> 5;
            const float* src = (type ? p->lru_w_i : p->lru_w_a) + (size_t)(dir * 8 + blk) * 4096;
            bf16_t* dst = (bf16_t*)(ws + WS_LRU) + (size_t)((dir * 2 + type) * 8 + blk) * 4096 + (size_t)(nh * 32) * 64;
            transpose_item(src, 64, 0, nh * 32, dst, 64, scr, lane);
        }
    }
}

__device__ __forceinline__ void row_load_nt(const float* src, int lane, f32x4 (&v)[4]) {
#pragma unroll
    for (int j = 0; j < 4; ++j) v[j] = __builtin_nontemporal_load((const f32x4*)(src + 4 * lane + 256 * j));
}
__device__ __forceinline__ void row_load(const float* src, int lane, f32x4 (&v)[4]) {
#pragma unroll
    for (int j = 0; j < 4; ++j) v[j] = *(const f32x4*)(src + 4 * lane + 256 * j);
}
__device__ __forceinline__ float row_rstd(const f32x4 (&v)[4]) {
    float ss = 0.f;
#pragma unroll
    for (int j = 0; j < 4; ++j) ss += v[j][0] * v[j][0] + v[j][1] * v[j][1] + v[j][2] * v[j][2] + v[j][3] * v[j][3];
    return rsqrtf(wave_sum(ss) * (1.0f / D) + EPS);
}
__device__ __forceinline__ void norm_mod_store(const f32x4 (&v)[4], float rstd, const float* g, const float* sh, const float* sc, bf16_t* dst, int lane) {
#pragma unroll
    for (int j = 0; j < 4; ++j) {
        const int c = 4 * lane + 256 * j;
        const f32x4 gg = *(const f32x4*)(g + c), s1 = *(const f32x4*)(sc + c), s0 = *(const f32x4*)(sh + c);
        const f32x4 o = (v[j] * rstd * gg) * (s1 + 1.0f) + s0;
        u32x2 w; w.x = pk2(o[0], o[1]); w.y = pk2(o[2], o[3]);
        *(u32x2*)(dst + c) = w;
    }
}
__device__ __forceinline__ void phase1(PP p, int wv) {
    const int tid_ = tid_opaque(wv), lane = tid_ & 63, gw = blockIdx.x * 8 + (tid_ >> 6), NGW = gridDim.x * 8;
    const float* mod = (const float*)(p->ws + WS_MOD);
    bf16_t* hb = (bf16_t*)(p->ws + WS_HB);
    int cur = -1; f32x4 gsc[4], gsh[4];
    for (int r0 = gw; r0 < MROWS; r0 += 4 * NGW) {
        f32x4 v[4][4];
#pragma unroll
        for (int q = 0; q < 4; ++q) {
            const int r = (r0 + q * NGW < MROWS) ? r0 + q * NGW : r0;
            row_load_nt(r < NLAT ? p->x + (size_t)r * D : p->ctx + (size_t)(r - NLAT) * D, lane, v[q]);
        }
#pragma unroll
        for (int q = 0; q < 4; ++q) {
            const int r = r0 + q * NGW;
            if (r < MROWS) {
                const int mi = r < NLAT ? (r >> 14) : 2;
                if (mi != cur) {
                    cur = mi;
#pragma unroll
                    for (int j = 0; j < 4; ++j) {
                        const int c = 4 * lane + 256 * j;
                        gsc[j] = *(const f32x4*)(p->norm1_g + c) * (*(const f32x4*)(mod + mi * 6144 + 1024 + c) + 1.0f);
                        gsh[j] = *(const f32x4*)(mod + mi * 6144 + c);
                    }
                }
                const float rstd = row_rstd(v[q]);
#pragma unroll
                for (int j = 0; j < 4; ++j) {
                    const f32x4 o = v[q][j] * rstd * gsc[j] + gsh[j];
                    u32x2 w; w.x = pk2(o[0], o[1]); w.y = pk2(o[2], o[3]);
                    *(u32x2*)(hb + (size_t)r * D + 4 * lane + 256 * j) = w;
                }
            }
        }
    }
}

typedef float f32x16 __attribute__((ext_vector_type(16)));
__device__ __forceinline__ unsigned cvt_pk_bf16(float lo, float hi) { unsigned r; asm("v_cvt_pk_bf16_f32 %0, %1, %2" : "=v"(r) : "v"(lo), "v"(hi)); return r; }
__device__ __forceinline__ void attn_mfma(PP p, unsigned char* shm, int wv) {
    const int tid = tid_opaque(wv);
    const int lane = tid & 63, wave = wv, l31 = lane & 31, hl = lane >> 5;
    const bf16_t* proj = (const bf16_t*)(p->ws + WS_PROJ);
    bf16_t* att = (bf16_t*)(p->ws + WS_ATT);
    const float L2E = 1.4426950408889634f;
    const float SC2 = 0.125f * L2E;
    for (int item = blockIdx.x; item < 512; item += gridDim.x) {
        const int hk = item & 1, qb = (item >> 1) & 127, b = item >> 8;
        const int g = wave >> 1, qh = wave & 1, hq = hk * 4 + g;
        const int qrow0 = b * S + 128 * qb + 64 * qh;
        bf16x8 qf[2][4];
#pragma unroll
        for (int qi = 0; qi < 2; ++qi)
#pragma unroll
            for (int st = 0; st < 4; ++st) qf[qi][st] = *(const bf16x8*)(proj + (size_t)(qrow0 + 32 * qi + l31) * DIN + 1024 + 64 * hq + 16 * st + 8 * hl);
        const float sink2 = p->attn_sink[hq] * L2E;
        float mrun[2] = {sink2, sink2};
        float lrun[2] = {hl == 0 ? 1.f : 0.f, hl == 0 ? 1.f : 0.f};
        f32x16 oacc[2][2];
#pragma unroll
        for (int a = 0; a < 2; ++a)
#pragma unroll
            for (int c = 0; c < 2; ++c)
#pragma unroll
                for (int i = 0; i < 16; ++i) oacc[a][c][i] = 0.f;
        u32x4 kreg[2], vreg[2];
        int ci = (qb == 0) ? 1 : 0;
#define ATT_GLOAD(CI) do { const int _row0 = (CI) < 3 ? b * S + 128 * (qb - 1 + (CI)) : NLAT + b * LC + 128 * ((CI) - 3); \
        _Pragma("unroll") for (int _i = 0; _i < 2; ++_i) { const int _pi = tid + 512 * _i, _key = _pi >> 3, _part = _pi & 7; \
            const bf16_t* _src = proj + (size_t)(_row0 + _key) * DIN + 1536 + 64 * hk + 8 * _part; kreg[_i] = *(const u32x4*)_src; vreg[_i] = *(const u32x4*)(_src + 128); } } while (0)
#define ATT_STAGE(PAR) do { bf16_t* _K = (bf16_t*)(shm + (PAR) * 36864); bf16_t* _V = (bf16_t*)(shm + (PAR) * 36864 + 18432); \
        _Pragma("unroll") for (int i = 0; i < 2; ++i) { const int pi = tid + 512 * i, key = pi >> 3, part = pi & 7; \
            *(u32x4*)(_K + key * 72 + 8 * part) = kreg[i]; \
            _Pragma("unroll") for (int e = 0; e < 8; ++e) { const unsigned w = vreg[i][e >> 1]; _V[(8 * part + e) * 132 + key] = (bf16_t)((e & 1) ? (w >> 16) : (w & 0xFFFFu)); } } } while (0)
#define ATT_NEXT(C) (((C) + 1 == 2 && qb == 127) ? 3 : (C) + 1)
        ATT_GLOAD(ci);
        __syncthreads();
        ATT_STAGE(0);
        { const int c1 = ATT_NEXT(ci); if (c1 < 5) ATT_GLOAD(c1); }
        __syncthreads();
        int par = 0;
        while (ci < 5) {
            const int cn = ATT_NEXT(ci);
            if (cn < 5) { ATT_STAGE(par ^ 1); const int c2 = ATT_NEXT(cn); if (c2 < 5) ATT_GLOAD(c2); }
            const bf16_t* Ks = (const bf16_t*)(shm + par * 36864);
            const bf16_t* Vt = (const bf16_t*)(shm + par * 36864 + 18432);
            const int kt_lo = (ci == 0 && qh == 1) ? 2 : 0, kt_hi = (ci == 2 && qh == 0) ? 2 : 4;
#pragma unroll 1
            for (int kt = kt_lo; kt < kt_hi; ++kt) {
                bf16x8 kf[4];
#pragma unroll
                for (int st = 0; st < 4; ++st) kf[st] = *(const bf16x8*)(Ks + (32 * kt + l31) * 72 + 16 * st + 8 * hl);
                bf16x8 vf[2][2];
#pragma unroll
                for (int db = 0; db < 2; ++db)
#pragma unroll
                    for (int s2 = 0; s2 < 2; ++s2) {
                        const bf16_t* vp = Vt + (32 * db + l31) * 132 + 32 * kt + 16 * s2 + 4 * hl;
                        const u32x2 lo = *(const u32x2*)vp, hi = *(const u32x2*)(vp + 8);
                        u32x4 w; w.x = lo.x; w.y = lo.y; w.z = hi.x; w.w = hi.y;
                        vf[db][s2] = __builtin_bit_cast(bf16x8, w);
                    }
#pragma unroll
                for (int qi = 0; qi < 2; ++qi) {
                    f32x16 s;
#pragma unroll
                    for (int i = 0; i < 16; ++i) s[i] = 0.f;
#pragma unroll
                    for (int st = 0; st < 4; ++st) s = __builtin_amdgcn_mfma_f32_32x32x16_bf16(kf[st], qf[qi][st], s, 0, 0, 0);
                    if (ci == 0 || ci == 2) {
                        asm volatile("");
                        const int dl = (ci == 0) ? (32 * kt + 4 * hl - (64 * qh + 32 * qi + l31)) : ((64 * qh + 32 * qi + l31) - 32 * kt - 4 * hl);
#pragma unroll
                        for (int i = 0; i < 16; ++i) {
                            const int ki = 8 * (i >> 2) + (i & 3);
                            const bool ok = (ci == 0) ? (dl + ki >= 0) : (dl - ki >= 0);
                            s[i] = ok ? s[i] : -1e30f;
                        }
                    }
                    float mx = s[0];
#pragma unroll
                    for (int i = 1; i < 16; ++i) mx = fmaxf(mx, s[i]);
                    mx = fmaxf(mx, __shfl_xor(mx, 32));
                    const float mnew = fmaxf(mrun[qi], mx * SC2);
                    if (__builtin_amdgcn_ballot_w64(mnew > mrun[qi]) != 0ull) {
                        const float alpha = __builtin_amdgcn_exp2f(mrun[qi] - mnew);
                        lrun[qi] *= alpha;
#pragma unroll
                        for (int db = 0; db < 2; ++db)
#pragma unroll
                            for (int i = 0; i < 16; ++i) oacc[db][qi][i] *= alpha;
                        mrun[qi] = mnew;
                    }
                    float ls = 0.f;
#pragma unroll
                    for (int i = 0; i < 16; ++i) { s[i] = __builtin_amdgcn_exp2f(__builtin_fmaf(s[i], SC2, -mnew)); ls += s[i]; }
                    lrun[qi] += ls;
                    bf16x8 pf[2];
#pragma unroll
                    for (int s2 = 0; s2 < 2; ++s2) {
                        u32x4 w; w.x = cvt_pk_bf16(s[8 * s2 + 0], s[8 * s2 + 1]); w.y = cvt_pk_bf16(s[8 * s2 + 2], s[8 * s2 + 3]);
                        w.z = cvt_pk_bf16(s[8 * s2 + 4], s[8 * s2 + 5]); w.w = cvt_pk_bf16(s[8 * s2 + 6], s[8 * s2 + 7]);
                        pf[s2] = __builtin_bit_cast(bf16x8, w);
                    }
#pragma unroll
                    for (int db = 0; db < 2; ++db)
#pragma unroll
                        for (int s2 = 0; s2 < 2; ++s2) oacc[db][qi] = __builtin_amdgcn_mfma_f32_32x32x16_bf16(vf[db][s2], pf[s2], oacc[db][qi], 0, 0, 0);
                }
            }
            __syncthreads();
            ci = cn; par ^= 1;
        }
#undef ATT_STAGE
#undef ATT_NEXT
#undef ATT_GLOAD
#pragma unroll
        for (int qi = 0; qi < 2; ++qi) {
            const float lt = lrun[qi] + __shfl_xor(lrun[qi], 32);
            const float inv = 1.0f / lt;
            bf16_t* orow = att + (size_t)(qrow0 + 32 * qi + l31) * 512 + hq * 64;
#pragma unroll
            for (int db = 0; db < 2; ++db)
#pragma unroll
                for (int g4 = 0; g4 < 4; ++g4) {
                    u32x2 w; w.x = cvt_pk_bf16(oacc[db][qi][4 * g4] * inv, oacc[db][qi][4 * g4 + 1] * inv); w.y = cvt_pk_bf16(oacc[db][qi][4 * g4 + 2] * inv, oacc[db][qi][4 * g4 + 3] * inv);
                    *(u32x2*)(orow + 32 * db + 8 * g4 + 4 * hl) = w;
                }
        }
    }
    __syncthreads();
}


struct ScanW { bf16x8 wfa[4], wfi[4]; float ba, bi, sp8l2; };
__device__ __forceinline__ void scan_loadw(PP p, int dir, int n, int ct, int l31, int hl, ScanW& w) {
    unsigned chv = (unsigned)(32 * ct + l31); asm volatile("" : "+v"(chv));
    const unsigned ch = (unsigned)(dir * 512 + 64 * n) + chv;
    w.ba = p->lru_b_a[ch]; w.bi = p->lru_b_i[ch];
    w.sp8l2 = ((const float*)(p->ws + WS_SP8))[ch] * 1.4426950408889634f;
    const bf16_t* wa_b = (const bf16_t*)(p->ws + WS_LRU) + (size_t)((dir * 2 + 0) * 8 + n) * 4096;
    const bf16_t* wi_b = (const bf16_t*)(p->ws + WS_LRU) + (size_t)((dir * 2 + 1) * 8 + n) * 4096;
    const unsigned lo = chv * 64u + 8u * (unsigned)hl;
#pragma unroll
    for (int st = 0; st < 4; ++st) { w.wfa[st] = *(const bf16x8*)(wa_b + lo + 16 * st); w.wfi[st] = *(const bf16x8*)(wi_b + lo + 16 * st); }
}
template <int DIR>
__device__ __forceinline__ void scan_dir(PP p, const bf16_t* xs, const ScanW& w, ScanW& wn, int ndir, int nct, bool do_next, int n, int ct, int l31, int hl, int id, int rowbase, bool latent, float (&hf)[2][16]) {
    constexpr int XS = 520;
    const int ch = 64 * n + 32 * ct + l31;
    const float ba = w.ba, bi = w.bi, sp8l2 = w.sp8l2;
    const bf16x8 (&wfa)[4] = w.wfa; const bf16x8 (&wfi)[4] = w.wfi;
    float a[2][16], u[2][16];
#pragma unroll
    for (int rt = 0; rt < 2; ++rt) {
        bf16x8 af[4];
#pragma unroll
        for (int st = 0; st < 4; ++st) af[st] = *(const bf16x8*)(xs + (32 * rt + l31) * XS + 64 * n + 16 * st + 8 * hl);
        f32x16 ga, gi;
#pragma unroll
        for (int i = 0; i < 16; ++i) { ga[i] = 0.f; gi[i] = 0.f; }
#pragma unroll
        for (int st = 0; st < 4; ++st) { ga = __builtin_amdgcn_mfma_f32_32x32x16_bf16(af[st], wfa[st], ga, 0, 0, 0); gi = __builtin_amdgcn_mfma_f32_32x32x16_bf16(af[st], wfi[st], gi, 0, 0, 0); }
#pragma unroll
        for (int i = 0; i < 16; ++i) {
            const int token = 32 * rt + 8 * (i >> 2) + 4 * hl + (i & 3);
            const float xv = bf2f(xs[token * XS + ch]);
            const float rr = fast_sigmoid(ga[i] + ba), ii = fast_sigmoid(gi[i] + bi);
            const float la2 = rr * sp8l2;
            const float av = __builtin_amdgcn_exp2f(la2);
            const float t2 = la2 * 1.3862943611f;
            float em1p = t2 * (1.0f + t2 * (0.5f + t2 * (0.16666667f + t2 * (0.041666668f + t2 * 0.0083333333f)))), em1e = __builtin_fmaf(av, av, -1.0f);
            asm volatile("" : "+v"(em1p), "+v"(em1e));
            const float em1 = (t2 > -0.1f) ? em1p : em1e;
            a[rt][i] = av; u[rt][i] = __builtin_amdgcn_sqrtf(-em1) * (ii * xv);
        }
    }
    float Ao[8], Ho[8], Ap[8], Hp[8];
#pragma unroll
    for (int k = 0; k < 8; ++k) {
        const int rt = k >> 2, g = k & 3;
        float H = 0.f, A = 1.f;
#pragma unroll
        for (int jj = 0; jj < 4; ++jj) { const int j = DIR ? 3 - jj : jj; const float av = a[rt][4 * g + j]; H = av * H + u[rt][4 * g + j]; A *= av; }
        Ao[k] = A; Ho[k] = H; Ap[k] = __shfl_xor(A, 32); Hp[k] = __shfl_xor(H, 32);
    }
    float Sin[8], Pin[8]; float Sx = 0.f, Px = 1.f;
#pragma unroll
    for (int kk = 0; kk < 8; ++kk) {
        const int k = DIR ? 7 - kk : kk;
        const float A0 = hl ? Ap[k] : Ao[k], H0 = hl ? Hp[k] : Ho[k], A1 = hl ? Ao[k] : Ap[k], H1 = hl ? Ho[k] : Hp[k];
        float s0, p0, s1, p1;
        if (DIR == 0) { s0 = Sx; p0 = Px; Sx = A0 * Sx + H0; Px *= A0; s1 = Sx; p1 = Px; Sx = A1 * Sx + H1; Px *= A1; }
        else          { s1 = Sx; p1 = Px; Sx = A1 * Sx + H1; Px *= A1; s0 = Sx; p0 = Px; Sx = A0 * Sx + H0; Px *= A0; }
        Sin[k] = hl ? s1 : s0; Pin[k] = hl ? p1 : p0;
    }
    asm volatile("" ::: "memory");
    if (do_next) scan_loadw(p, ndir, n, nct, l31, hl, wn);
    bf16_t* yl = (bf16_t*)(p->ws + WS_YL) + (size_t)rowbase * 512; bf16_t* caf = (bf16_t*)(p->ws + WS_CAF) + (size_t)rowbase * 512; bf16_t* cab = (bf16_t*)(p->ws + WS_CAB) + (size_t)rowbase * 512;
    unsigned lo = (unsigned)ch; asm volatile("" : "+v"(lo));
#pragma unroll
    for (int k = 0; k < 8; ++k) {
        const int rt = k >> 2, g = k & 3;
        float h = Sin[k], P = Pin[k];
#pragma unroll
        for (int jj = 0; jj < 4; ++jj) {
            const int j = DIR ? 3 - jj : jj, idx = 4 * g + j;
            h = a[rt][idx] * h + u[rt][idx]; P *= a[rt][idx];
            const int token = 32 * rt + 8 * g + 4 * hl + j;
            const unsigned o = lo + (unsigned)token * 512u;
            if (DIR == 0) { hf[rt][idx] = h; if (latent) caf[o] = f2bf(P); }
            else if (latent) { yl[o] = f2bf(hf[rt][idx] + h); cab[o] = f2bf(P); }
        }
    }
    if (hl == 0) {
        float* sumb = (float*)(p->ws + WS_SUM);
        sumb[((size_t)(DIR * NCHUNK + id) * 2 + 0) * 512 + ch] = Px;
        sumb[((size_t)(DIR * NCHUNK + id) * 2 + 1) * 512 + ch] = Sx;
    }
}
__device__ __forceinline__ void scan_mfma(PP p, unsigned char* shm, int wv) {
    const int tid_ = tid_opaque(wv); const int tid = tid_;
    const int lane = tid & 63, n = wv, l31 = lane & 31, hl = lane >> 5;
    constexpr int XS = 520;
    bf16_t* xs = (bf16_t*)shm;
    const bf16_t* proj = (const bf16_t*)(p->ws + WS_PROJ);
    for (int item = blockIdx.x; item < 512 + 32; item += gridDim.x) {
        const int id = item < 512 ? item : 512 + ((item - 512) >> 2);
        const int quarter = item < 512 ? -1 : ((item - 512) & 3);
        int rowbase, t0, seqlen; bool latent;
        if (id < 512) { const int b = id >> 8, k = id & 255; t0 = 64 * k; rowbase = b * S + t0; seqlen = S; latent = true; }
        else { const int j = id - 512, b = j >> 2, k = j & 3; t0 = 64 * k; rowbase = NLAT + b * LC + t0; seqlen = LC; latent = false; }
        const int seqbase = rowbase - t0;
        ScanW w0, w1;
        if (quarter < 0) scan_loadw(p, 0, n, 0, l31, hl, w0);
        {
            const int tid = tid_opaque(wv);
            bf16_t* raw = (bf16_t*)(shm + 66560);
#pragma unroll
            for (int i = 0; i < 9; ++i) {
                const int piece = tid + 512 * i;
                if (piece < 67 * 64) {
                    const int row = piece >> 6, c8 = piece & 63, tt = t0 - 2 + row;
                    u32x4 v = {0u, 0u, 0u, 0u};
                    if (tt >= 0 && tt < seqlen) v = *(const u32x4*)(proj + (size_t)(seqbase + tt) * DIN + 8 * c8);
                    *(u32x4*)(raw + row * 512 + 8 * c8) = v;
                }
            }
            __syncthreads();
            const int cq = tid & 127, tq = tid >> 7, c4 = 4 * cq;
            const f32x4 k0 = *(const f32x4*)(p->rnn_conv_w + c4), k1 = *(const f32x4*)(p->rnn_conv_w + 512 + c4), k2 = *(const f32x4*)(p->rnn_conv_w + 1024 + c4),
                        k3 = *(const f32x4*)(p->rnn_conv_w + 1536 + c4), kb = *(const f32x4*)(p->rnn_conv_b + c4);
            auto ld4 = [&](int row) -> f32x4 { const u32x2 w = *(const u32x2*)(raw + row * 512 + c4); f32x4 r; r[0] = bflo(w.x); r[1] = bfhi(w.x); r[2] = bflo(w.y); r[3] = bfhi(w.y); return r; };
            f32x4 xm2 = ld4(16 * tq), xm1 = ld4(16 * tq + 1), x0 = ld4(16 * tq + 2);
#pragma unroll
            for (int t = 0; t < 16; ++t) {
                const f32x4 xp1 = ld4(16 * tq + t + 3);
                const f32x4 o = kb + k0 * xm2 + k1 * xm1 + k2 * x0 + k3 * xp1;
                u32x2 w; w.x = pk2(o[0], o[1]); w.y = pk2(o[2], o[3]);
                *(u32x2*)(xs + (16 * tq + t) * XS + c4) = w;
                xm2 = xm1; xm1 = x0; x0 = xp1;
            }
        }
        __syncthreads();
#pragma unroll 1
        for (int ct = 0; ct < 2; ++ct) {
            float hf[2][16];
            const bool run0 = quarter < 0 || quarter == 2 * ct, run1 = quarter < 0 || quarter == 2 * ct + 1;
            if (quarter >= 0) { if (run0) scan_loadw(p, 0, n, ct, l31, hl, w0); if (run1) scan_loadw(p, 1, n, ct, l31, hl, w1); }
            if (run0) scan_dir<0>(p, xs, w0, w1, 1, ct, quarter < 0, n, ct, l31, hl, id, rowbase, latent, hf);
            if (run1) scan_dir<1>(p, xs, w1, w0, 0, 1, quarter < 0 && ct == 0, n, ct, l31, hl, id, rowbase, latent, hf);
        }
        __syncthreads();
    }
}

__device__ __forceinline__ void carry_phase(PP p, unsigned char* shm, int wv) {
    if (blockIdx.x >= 128) return;
    const int tid = tid_opaque(wv), cl = tid & 15, sg = tid >> 4;
    const int b = blockIdx.x >> 6, dir = (blockIdx.x >> 5) & 1, c = (blockIdx.x & 31) * 16 + cl;
    const float* sumb = (const float*)(p->ws + WS_SUM) + (size_t)dir * NCHUNK * 1024;
    float* car = (float*)(p->ws + WS_CAR) + (size_t)dir * NCHUNK * 512;
    float* segA = (float*)shm; float* segH = segA + 512;
    float A[9], H[9]; int ids[9];
#pragma unroll
    for (int k = 0; k < 9; ++k) {
        const int s = sg * 9 + k;
        int id = -1;
        if (s < 260) { if (dir == 0) id = s < 4 ? 512 + 4 * b + s : 256 * b + (s - 4); else id = s < 4 ? 512 + 4 * b + (3 - s) : 256 * b + (255 - (s - 4)); }
        ids[k] = id;
        A[k] = id >= 0 ? sumb[(size_t)id * 1024 + c] : 1.f;
        H[k] = id >= 0 ? sumb[(size_t)id * 1024 + 512 + c] : 0.f;
    }
    float As = 1.f, Hs = 0.f;
#pragma unroll
    for (int k = 0; k < 9; ++k) { Hs = A[k] * Hs + H[k]; As *= A[k]; }
    segA[sg * 16 + cl] = As; segH[sg * 16 + cl] = Hs;
    __syncthreads();
    float h = 0.f;
    for (int j = 0; j < sg; ++j) h = segA[j * 16 + cl] * h + segH[j * 16 + cl];
#pragma unroll
    for (int k = 0; k < 9; ++k) { if (ids[k] >= 0) car[(size_t)ids[k] * 512 + c] = h; h = A[k] * h + H[k]; }
    __syncthreads();
}

struct MixRow { u32x4 vy, vf, vb, vg, va; f32x4 cf0, cf1, cb0, cb1; };
__device__ __forceinline__ void mix_load(PP p, int r, int c0, MixRow& m) {
    const bf16_t* proj = (const bf16_t*)(p->ws + WS_PROJ);
    const bf16_t* att = (const bf16_t*)(p->ws + WS_ATT);
    const bf16_t* yl = (const bf16_t*)(p->ws + WS_YL); const bf16_t* caf = (const bf16_t*)(p->ws + WS_CAF); const bf16_t* cab = (const bf16_t*)(p->ws + WS_CAB);
    const float* car = (const float*)(p->ws + WS_CAR);
    const int id = r >> 6;
    m.vy = *(const u32x4*)(yl + (size_t)r * 512 + c0); m.vf = *(const u32x4*)(caf + (size_t)r * 512 + c0); m.vb = *(const u32x4*)(cab + (size_t)r * 512 + c0);
    m.vg = *(const u32x4*)(proj + (size_t)r * DIN + 512 + c0); m.va = *(const u32x4*)(att + (size_t)r * 512 + c0);
    const float* cf = car + (size_t)id * 512 + c0; const float* cbk = car + (size_t)(NCHUNK + id) * 512 + c0;
    m.cf0 = *(const f32x4*)cf; m.cf1 = *(const f32x4*)(cf + 4); m.cb0 = *(const f32x4*)cbk; m.cb1 = *(const f32x4*)(cbk + 4);
}
__device__ __forceinline__ void mix_store(PP p, int r, int c0, const MixRow& m, const f32x4 (&gr)[2], const f32x4 (&ga)[2]) {
    bf16_t* mix = (bf16_t*)(p->ws + WS_HB);
    float rn[8], at[8]; float s1 = 0.f, s2 = 0.f;
#pragma unroll
    for (int e = 0; e < 8; ++e) {
        const unsigned wy = m.vy[e >> 1], wf = m.vf[e >> 1], wb = m.vb[e >> 1], wg = m.vg[e >> 1], wa = m.va[e >> 1];
        const float cfe = e < 4 ? m.cf0[e & 3] : m.cf1[e & 3], cbe = e < 4 ? m.cb0[e & 3] : m.cb1[e & 3];
        const float y = ((e & 1) ? bfhi(wy) : bflo(wy)) + ((e & 1) ? bfhi(wf) : bflo(wf)) * cfe + ((e & 1) ? bfhi(wb) : bflo(wb)) * cbe;
        const float xg = (e & 1) ? bfhi(wg) : bflo(wg);
        rn[e] = gelu_tanh_(xg) * y; s1 += rn[e] * rn[e];
        at[e] = (e & 1) ? bfhi(wa) : bflo(wa); s2 += at[e] * at[e];
    }
    const float r1 = rsqrtf(wave_sum(s1) * (1.0f / 512.0f) + EPS), r2 = rsqrtf(wave_sum(s2) * (1.0f / 512.0f) + EPS);
    u32x4 o1, o2;
#pragma unroll
    for (int e2 = 0; e2 < 4; ++e2) {
        o1[e2] = pk2(rn[2 * e2] * r1 * gr[e2 >> 1][(2 * e2) & 3], rn[2 * e2 + 1] * r1 * gr[e2 >> 1][(2 * e2 + 1) & 3]);
        o2[e2] = pk2(at[2 * e2] * r2 * ga[e2 >> 1][(2 * e2) & 3], at[2 * e2 + 1] * r2 * ga[e2 >> 1][(2 * e2 + 1) & 3]);
    }
    *(u32x4*)(mix + (size_t)r * D + c0) = o1; *(u32x4*)(mix + (size_t)r * D + 512 + c0) = o2;
}
__device__ __forceinline__ void mix_phase(PP p, int wv) {
    const int tid_ = tid_opaque(wv), lane = tid_ & 63, gw = blockIdx.x * 8 + (tid_ >> 6), NGW = gridDim.x * 8;
    const int c0 = 8 * lane;
    f32x4 gr[2], ga[2];
    gr[0] = *(const f32x4*)(p->gn_rnn + c0); gr[1] = *(const f32x4*)(p->gn_rnn + c0 + 4); ga[0] = *(const f32x4*)(p->gn_attn + c0); ga[1] = *(const f32x4*)(p->gn_attn + c0 + 4);
    for (int r = gw; r < NLAT; r += 2 * NGW) {
        const int rb = (r + NGW < NLAT) ? r + NGW : r;
        MixRow ma, mb;
        mix_load(p, r, c0, ma); mix_load(p, rb, c0, mb);
        mix_store(p, r, c0, ma, gr, ga);
        if (rb != r) mix_store(p, rb, c0, mb, gr, ga);
    }
}

__device__ __forceinline__ void phase7(PP p, int wv) {
    const int tid_ = tid_opaque(wv), lane = tid_ & 63, gw = blockIdx.x * 8 + (tid_ >> 6), NGW = gridDim.x * 8;
    const float* mod = (const float*)(p->ws + WS_MOD);
    bf16_t* hb = (bf16_t*)(p->ws + WS_HB);
    const bf16_t* o1 = (const bf16_t*)(p->ws + WS_O1);
    int cur = -1; f32x4 gsc[4], gsh[4];
    for (int r = gw; r < NLAT; r += 2 * NGW) {
        const int rb = r + NGW;
        f32x4 va[4], vb[4]; u32x2 da[4], db[4];
        row_load_nt(p->x + (size_t)r * D, lane, va); row_load_nt(p->x + (size_t)rb * D, lane, vb);
#pragma unroll
        for (int j = 0; j < 4; ++j) { da[j] = *(const u32x2*)(o1 + (size_t)r * D + 4 * lane + 256 * j); db[j] = *(const u32x2*)(o1 + (size_t)rb * D + 4 * lane + 256 * j); }
#pragma unroll
        for (int j = 0; j < 4; ++j) {
            va[j][0] += bflo(da[j].x); va[j][1] += bfhi(da[j].x); va[j][2] += bflo(da[j].y); va[j][3] += bfhi(da[j].y);
            vb[j][0] += bflo(db[j].x); vb[j][1] += bfhi(db[j].x); vb[j][2] += bflo(db[j].y); vb[j][3] += bfhi(db[j].y);
        }
        const float sa = row_rstd(va), sb = row_rstd(vb);
        const int ma = r >> 14;
        if (ma != cur) {
            cur = ma;
#pragma unroll
            for (int j = 0; j < 4; ++j) {
                const int c = 4 * lane + 256 * j;
                gsc[j] = *(const f32x4*)(p->norm2_g + c) * (*(const f32x4*)(mod + ma * 6144 + 4096 + c) + 1.0f);
                gsh[j] = *(const f32x4*)(mod + ma * 6144 + 3072 + c);
            }
        }
        bf16_t* da_ = hb + (size_t)(ma * H2_BSTRIDE + 1 + (r & (S - 1))) * D; bf16_t* db_ = hb + (size_t)((rb >> 14) * H2_BSTRIDE + 1 + (rb & (S - 1))) * D;
#pragma unroll
        for (int j = 0; j < 4; ++j) {
            const f32x4 oa = va[j] * sa * gsc[j] + gsh[j], ob = vb[j] * sb * gsc[j] + gsh[j];
            u32x2 wa; wa.x = pk2(oa[0], oa[1]); wa.y = pk2(oa[2], oa[3]); u32x2 wb; wb.x = pk2(ob[0], ob[1]); wb.y = pk2(ob[2], ob[3]);
            *(u32x2*)(da_ + 4 * lane + 256 * j) = wa; if ((rb >> 14) == ma) *(u32x2*)(db_ + 4 * lane + 256 * j) = wb;
        }
        if ((rb >> 14) != ma) { const int mb = rb >> 14; norm_mod_store(vb, sb, p->norm2_g, mod + mb * 6144 + 3072, mod + mb * 6144 + 4096, db_, lane); }
    }
    for (int z = gw; z < 254; z += NGW) {
        const int R = z == 0 ? 0 : (z <= 126 ? S + z : 32895 + (z - 127));
        const u32x4 zz = {0u, 0u, 0u, 0u};
        *(u32x4*)(hb + (size_t)R * D + 8 * lane) = zz; *(u32x4*)(hb + (size_t)R * D + 512 + 8 * lane) = zz;
    }
}

__device__ __forceinline__ void final_phase(PP p, int wv) {
    const int tid_ = tid_opaque(wv), lane = tid_ & 63, gw = blockIdx.x * 8 + (tid_ >> 6), NGW = gridDim.x * 8;
    const bf16_t* o1 = (const bf16_t*)(p->ws + WS_O1); const bf16_t* o2 = (const bf16_t*)(p->ws + WS_O2);
    f32x4 fg[4];
#pragma unroll
    for (int j = 0; j < 4; ++j) fg[j] = *(const f32x4*)(p->final_g + 4 * lane + 256 * j);
    for (int r = gw; r < NLAT; r += 2 * NGW) {
        const int rb = r + NGW;
        f32x4 va[4], vb[4]; u32x2 da[4], db[4], ea[4], eb[4];
        row_load_nt(p->x + (size_t)r * D, lane, va); row_load_nt(p->x + (size_t)rb * D, lane, vb);
#pragma unroll
        for (int j = 0; j < 4; ++j) {
            da[j] = *(const u32x2*)(o1 + (size_t)r * D + 4 * lane + 256 * j); db[j] = *(const u32x2*)(o1 + (size_t)rb * D + 4 * lane + 256 * j);
            ea[j] = *(const u32x2*)(o2 + (size_t)r * D + 4 * lane + 256 * j); eb[j] = *(const u32x2*)(o2 + (size_t)rb * D + 4 * lane + 256 * j);
        }
#pragma unroll
        for (int j = 0; j < 4; ++j) {
            va[j][0] += bflo(da[j].x) + bflo(ea[j].x); va[j][1] += bfhi(da[j].x) + bfhi(ea[j].x); va[j][2] += bflo(da[j].y) + bflo(ea[j].y); va[j][3] += bfhi(da[j].y) + bfhi(ea[j].y);
            vb[j][0] += bflo(db[j].x) + bflo(eb[j].x); vb[j][1] += bfhi(db[j].x) + bfhi(eb[j].x); vb[j][2] += bflo(db[j].y) + bflo(eb[j].y); vb[j][3] += bfhi(db[j].y) + bfhi(eb[j].y);
        }
        const float sa = row_rstd(va), sb = row_rstd(vb);
        float* rowa = p->out + (size_t)r * D; float* rowb = p->out + (size_t)rb * D;
#pragma unroll
        for (int j = 0; j < 4; ++j) { const f32x4 gg = fg[j]; *(f32x4*)(rowa + 4 * lane + 256 * j) = va[j] * sa * gg; *(f32x4*)(rowb + 4 * lane + 256 * j) = vb[j] * sb * gg; }
    }
}

__global__ void __launch_bounds__(512, 2) fwd_megakernel(Params p_arg) {
    extern __shared__ __attribute__((aligned(16))) unsigned char shm[];
    cg::grid_group grid = cg::this_grid();
    LAS unsigned char* lds = (LAS unsigned char*)shm;
    pg8::StaticOrder so;
    const int wv = __builtin_amdgcn_readfirstlane((int)(threadIdx.x >> 6));
    volatile LAS unsigned* xst = (volatile LAS unsigned*)(lds + LDS_XB);
    if (tid_opaque(wv) == 0) { xst[0] = 0u; xst[1] = 0u; }
    __syncthreads();
    (void)xcd_barrier_post((unsigned*)(kparams()->ws + WS_BAR), xst, wv);
#define XBAR() do { XcdBarrier _b; _b.bar = (unsigned*)(kparams()->ws + WS_BAR); _b.x = xb_xcc_id(); _b.st = (volatile LAS unsigned*)(lds + LDS_XB); xcd_barrier(_b, wv); } while (0)
    if (kparams()->out == nullptr) grid.sync();

    phase0(kparams(), shm, wv);
    {
        constexpr int T_IN = (D / 64) * (DIN / 32), T_B = (D / 64) * (D / 32) + (D / 64) * (DUP / 32) + (DFF / 64) * (D / 32), T_LRU = 64;
        const int nfree = (int)gridDim.x > 192 ? (int)gridDim.x - 192 : 0;
        const int first = nfree ? 192 : 0, nblk = nfree ? nfree : (int)gridDim.x;
        if ((int)blockIdx.x >= first) {
            transpose_phase(kparams(), shm, wv, 0, T_IN, ((int)blockIdx.x - first) * 8, nblk * 8);
            transpose_phase(kparams(), shm, wv, T_IN + T_B, T_IN + T_B + T_LRU, ((int)blockIdx.x - first) * 8, nblk * 8);
        }
    }
    XBAR();
    phase1(kparams(), wv);
    XBAR();
    {
        PP p = kparams(); unsigned char* ws = p->ws;
        pg8::Gemm g{(const bf16_t*)(ws + WS_HB), (const bf16_t*)(ws + WS_WIN), MROWS / 256, DIN / 256, D, 256};
        so.init(g.nM, g.nN, gridDim.x, blockIdx.x);
        EpiProj e{(bf16_t*)(ws + WS_PROJ), (const float*)(ws + WS_ROPE), (const float*)(ws + WS_ROPE) + 4096};
        pg8::gemm_phase(lds, g, so, e, wv);
        {
            constexpr int T_IN = (D / 64) * (DIN / 32), T_B = (D / 64) * (D / 32) + (D / 64) * (DUP / 32) + (DFF / 64) * (D / 32);
            const int G = (int)gridDim.x, rem = (g.nM * g.nN) % G;
            const int first = rem ? rem : 0, nblk = G - first;
            if ((int)blockIdx.x >= first) transpose_phase(p, shm, wv, T_IN, T_IN + T_B, ((int)blockIdx.x - first) * 8, nblk * 8);
        }
    }
    XBAR();
    scan_mfma(kparams(), shm, wv);
    attn_mfma(kparams(), shm, wv);
    XBAR();
    carry_phase(kparams(), shm, wv);
    XBAR();
    mix_phase(kparams(), wv);
    XBAR();
    {
        PP p = kparams(); unsigned char* ws = p->ws; const float* mod = (const float*)(ws + WS_MOD);
        pg8::Gemm g{(const bf16_t*)(ws + WS_HB), (const bf16_t*)(ws + WS_WOUT), NLAT / 256, D / 256, D, 256};
        so.init(g.nM, g.nN, gridDim.x, blockIdx.x);
        EpiDelta e{(bf16_t*)(ws + WS_O1), mod + 2048, mod + 6144 + 2048};
        pg8::gemm_phase(lds, g, so, e, wv);
    }
    XBAR();
    phase7(kparams(), wv);
    XBAR();
    {
        PP p = kparams(); unsigned char* ws = p->ws;
        pg8::Gemm g{(const bf16_t*)(ws + WS_HB), (const bf16_t*)(ws + WS_WUP), 130, DUP / 256, D, 254};
        so.init(g.nM, g.nN, gridDim.x, blockIdx.x);
        EpiConvGate e{(bf16_t*)(ws + WS_ACT), p->ffn_conv_w, p->ffn_conv_b, lds + 131072};
        pg8::gemm_phase(lds, g, so, e, wv);
    }
    XBAR();
    {
        PP p = kparams(); unsigned char* ws = p->ws; const float* mod = (const float*)(ws + WS_MOD);
        pg8::Gemm g{(const bf16_t*)(ws + WS_ACT), (const bf16_t*)(ws + WS_WDN), NLAT / 256, D / 256, DFF, 256};
        so.init(g.nM, g.nN, gridDim.x, blockIdx.x);
        EpiDelta e{(bf16_t*)(ws + WS_O2), mod + 5120, mod + 6144 + 5120};
        pg8::gemm_phase(lds, g, so, e, wv);
    }
    XBAR();
    final_phase(kparams(), wv);
}

extern "C" void kernel_launch(void* const* d_in, const int* in_sizes, int n_in, void* d_out, int out_size, void* d_ws, size_t ws_size, hipStream_t stream) {
    static int grid_blocks = 0;
    if (!grid_blocks) {
        int dev = 0, cus = 0, per_cu = 0;
        hipGetDevice(&dev);
        hipDeviceGetAttribute(&cus, hipDeviceAttributeMultiprocessorCount, dev);
        hipFuncSetAttribute((const void*)fwd_megakernel, hipFuncAttributeMaxDynamicSharedMemorySize, LDS_BYTES);
        hipOccupancyMaxActiveBlocksPerMultiprocessor(&per_cu, (const void*)fwd_megakernel, 512, LDS_BYTES);
        if (per_cu < 1) per_cu = 1;
        grid_blocks = cus * per_cu;
        if (ws_size < WS_END) fprintf(stderr, "kernel_launch: workspace too small: %zu < %zu\n", ws_size, (size_t)WS_END);
    }
    Params p{};
    const float** pp = (const float**)&p;
    for (int i = 0; i < 25; ++i) pp[i] = (const float*)d_in[i];
    const size_t ws_off = ws_size > WS_END ? ((ws_size - WS_END) & ~(size_t)4095) : 0;
    p.out = (float*)d_out; p.ws = (unsigned char*)d_ws + ws_off;
    hipMemsetAsync((unsigned char*)d_ws + ws_off + WS_BAR, 0, 16384, stream);
    void* args[] = {&p};
    hipError_t e = hipLaunchCooperativeKernel((const void*)fwd_megakernel, dim3(grid_blocks), dim3(512), args, LDS_BYTES, stream);
    if (e != hipSuccess) fprintf(stderr, "cooperative launch failed: %s (grid %d)\n", hipGetErrorString(e), grid_blocks);
}
```

```cpp
#include <hip/hip_runtime.h>
#include <hip/hip_cooperative_groups.h>
#include <cstdio>
namespace cg = cooperative_groups;

#define LAS __attribute__((address_space(3)))
typedef unsigned short bf16_t;
typedef short bf16x8 __attribute__((ext_vector_type(8)));
typedef float f32x4 __attribute__((ext_vector_type(4)));
typedef unsigned u32x4 __attribute__((ext_vector_type(4)));
typedef unsigned u32x2 __attribute__((ext_vector_type(2)));

constexpr int D = 1024, NB = 2, S = 16384, LC = 256;
constexpr int NLAT = NB * S;
constexpr int NCTX = NB * LC;
constexpr int MROWS = NLAT + NCTX;
constexpr int DIN = 1792, DFF = 2816, DUP = 5632, DRNN = 512;
constexpr int NCHUNK = MROWS / 64;
constexpr float EPS = 1e-6f;

constexpr size_t AL(size_t x) { return (x + 255) & ~(size_t)255; }
constexpr size_t WS_WIN  = 0;
constexpr size_t WS_WOUT = WS_WIN  + AL((size_t)DIN * D * 2);
constexpr size_t WS_WUP  = WS_WOUT + AL((size_t)D * D * 2);
constexpr size_t WS_WDN  = WS_WUP  + AL((size_t)DUP * D * 2);
constexpr size_t WS_LRU  = WS_WDN  + AL((size_t)D * DFF * 2);
constexpr size_t WS_MOD  = WS_LRU  + AL((size_t)4 * 8 * 64 * 64 * 2);
constexpr size_t WS_ROPE = WS_MOD  + AL((size_t)3 * 6144 * 4);
constexpr size_t WS_SUM  = WS_ROPE + AL((size_t)2 * 256 * 16 * 4);
constexpr size_t WS_CAR  = WS_SUM  + AL((size_t)2 * NCHUNK * 2 * 512 * 4);
constexpr size_t WS_SP8  = WS_CAR  + AL((size_t)2 * NCHUNK * 512 * 4);
constexpr size_t WS_BAR  = WS_SP8  + 4096;
constexpr size_t WS_R1   = WS_BAR  + 16384;
constexpr size_t WS_ATT  = WS_R1;
constexpr size_t WS_YL   = WS_ATT  + AL((size_t)NLAT * 512 * 2);
constexpr size_t WS_CAF  = WS_YL   + AL((size_t)NLAT * 512 * 2);
constexpr size_t WS_CAB  = WS_CAF  + AL((size_t)NLAT * 512 * 2);
constexpr size_t WS_PROJ = WS_CAB  + AL((size_t)NLAT * 512 * 2);
constexpr size_t WS_R1END = WS_PROJ + AL((size_t)MROWS * DIN * 2);
constexpr size_t WS_HB   = WS_R1END;
constexpr size_t WS_HBEND = WS_HB + AL((size_t)MROWS * D * 2);
constexpr size_t WS_ACT  = WS_R1;
constexpr size_t WS_O1   = WS_ACT + AL((size_t)NLAT * DFF * 2);
constexpr size_t WS_O2   = WS_HB;
constexpr size_t WS_END  = WS_HBEND;
static_assert(WS_O1 + (size_t)NLAT * D * 2 <= WS_R1END, "o1");
static_assert(WS_ACT + (size_t)NLAT * DFF * 2 <= WS_R1END, "act");
constexpr int H2_BSTRIDE = 65 * 254;
constexpr int H2_ROWS = 130 * 254 + 2;
static_assert((size_t)H2_ROWS * D * 2 <= (size_t)MROWS * D * 2, "h2");

constexpr int LDS_BYTES = 131072 + 8192 + 256;
constexpr int LDS_XB = 131072 + 8192;

struct Params {
    const float *x, *c, *ctx, *c_ctx, *w_mod, *b_mod, *norm1_g, *w_in, *rnn_conv_w, *rnn_conv_b, *lru_w_a, *lru_b_a,
        *lru_w_i, *lru_b_i, *lru_lam, *attn_sink, *gn_rnn, *gn_attn, *w_out, *norm2_g, *w_up, *ffn_conv_w, *ffn_conv_b,
        *w_down, *final_g;
    float* out;
    unsigned char* ws;
};

typedef const Params __attribute__((address_space(4)))* PP;
__device__ __forceinline__ PP kparams() { PP k = (PP)__builtin_amdgcn_kernarg_segment_ptr(); asm volatile("" : "+s"(k)); return k; }
__device__ __forceinline__ int lane_fresh() { unsigned m = ~0u; asm volatile("" : "+s"(m)); return (int)__builtin_amdgcn_mbcnt_hi(m, __builtin_amdgcn_mbcnt_lo(m, 0u)); }
__device__ __forceinline__ int tid_opaque(int wv) { return wv * 64 + lane_fresh(); }
__device__ __forceinline__ bf16_t f2bf(float f) { unsigned u = __float_as_uint(f); u += 0x7FFFu + ((u >> 16) & 1u); return (bf16_t)(u >> 16); }
__device__ __forceinline__ float bf2f(bf16_t b) { return __uint_as_float(((unsigned)b) << 16); }
__device__ __forceinline__ unsigned pk2(float lo, float hi) { unsigned r; asm("v_cvt_pk_bf16_f32 %0, %1, %2" : "=v"(r) : "v"(lo), "v"(hi)); return r; }
__device__ __forceinline__ float bflo(unsigned w) { return __uint_as_float(w << 16); }
__device__ __forceinline__ float bfhi(unsigned w) { return __uint_as_float(w & 0xFFFF0000u); }
__device__ __forceinline__ float wave_sum(float v) {
#pragma unroll
    for (int o = 32; o >= 1; o >>= 1) v += __shfl_xor(v, o);
    return v;
}
__device__ __forceinline__ float wave_max(float v) {
#pragma unroll
    for (int o = 32; o >= 1; o >>= 1) v = fmaxf(v, __shfl_xor(v, o));
    return v;
}
__device__ __forceinline__ float sigmoidf_(float x) { return 1.0f / (1.0f + __expf(-x)); }
__device__ __forceinline__ float fast_sigmoid(float x) { return __builtin_amdgcn_rcpf(1.0f + __builtin_amdgcn_exp2f(-1.4426950408889634f * x)); }
__device__ __forceinline__ float silu_(float x) { return x * fast_sigmoid(x); }
__device__ __forceinline__ float gelu_tanh_(float x) {
    const float u = 0.7978845608028654f * (x + 0.044715f * x * x * x);
    const float e = __builtin_amdgcn_exp2f(2.8853900817779268f * u);
    const float th = 1.0f - 2.0f * __builtin_amdgcn_rcpf(e + 1.0f);
    return 0.5f * x * (1.0f + th);
}


#define XB_TMO      128
#define XB_XCNT(j)  (256  + 64 * (j))
#define XB_XSUB(j)  (1280 + 64 * (j))
#define XB_XGEN(j)  (2304 + 64 * (j))
#define XB_TOP      3328
#define XB_TOPGEN   3392
#define XCD_BAR_WORDS 3456
#define XB_SPIN_CAP (1u << 20)
__device__ __forceinline__ unsigned xb_ld(unsigned* p)              { return __hip_atomic_load(p, __ATOMIC_RELAXED, __HIP_MEMORY_SCOPE_AGENT); }
__device__ __forceinline__ unsigned xb_add(unsigned* p, unsigned v) { return __hip_atomic_fetch_add(p, v, __ATOMIC_RELAXED, __HIP_MEMORY_SCOPE_AGENT); }
__device__ __forceinline__ unsigned xb_xcc_id() { return (unsigned)__builtin_amdgcn_s_getreg((3 << 11) | 20) & 0xFu; }
#define XB_SPIN(cond, bar) do { unsigned _sp = 0; while (cond) { __builtin_amdgcn_s_sleep(1); \
    if ((++_sp & 255u) == 0u) { if (xb_ld(&(bar)[XB_TMO])) break; if (_sp > XB_SPIN_CAP) { atomicAdd(&(bar)[XB_TMO], 1u); break; } } } } while (0)
struct XcdBarrier { unsigned* bar; unsigned x; volatile LAS unsigned* st; };
__device__ __forceinline__ XcdBarrier xcd_barrier_post(unsigned* bar, volatile LAS unsigned* st, int wv) {
    XcdBarrier b; b.bar = bar; b.x = xb_xcc_id(); b.st = st;
    if (tid_opaque(wv) == 0) (void)xb_add(&bar[XB_XCNT(b.x)], 1u);
    return b;
}
__device__ __forceinline__ void xcd_barrier_complete(unsigned* bar, unsigned x, unsigned& nloc, unsigned& nx) {
    const unsigned G = gridDim.x * gridDim.y * gridDim.z;
    unsigned sum, cnt, mine, sp = 0u;
    for (;;) {
        sum = 0u; cnt = 0u; mine = 0u;
#pragma unroll
        for (unsigned j = 0; j < 16; ++j) { const unsigned c = xb_ld(&bar[XB_XCNT(j)]); sum += c; cnt += (c > 0u) ? 1u : 0u; mine = (j == x) ? c : mine; }
        if (sum == G) break;
        __builtin_amdgcn_s_sleep(1);
        if ((++sp & 255u) == 0u) { if (xb_ld(&bar[XB_TMO])) break; if (sp > XB_SPIN_CAP) { atomicAdd(&bar[XB_TMO], 1u); break; } }
    }
    nloc = mine > 0u ? mine : 1u; nx = cnt > 0u ? cnt : 1u;
}
__device__ __forceinline__ void xcd_barrier(const XcdBarrier& b, int wv) {
    asm volatile("s_waitcnt vmcnt(0)" ::: "memory");
    __syncthreads();
    if (tid_opaque(wv) == 0) {
        unsigned* bar = b.bar;
        __builtin_amdgcn_s_waitcnt(0);
        unsigned nloc = b.st[0], nx = b.st[1];
        if (nloc == 0u) { xcd_barrier_complete(bar, b.x, nloc, nx); b.st[0] = nloc; b.st[1] = nx; }
        const unsigned old = xb_add(&bar[XB_XSUB(b.x)], 1u);
        const unsigned gen = old / nloc;
        if (old + 1u == (gen + 1u) * nloc) {
            __builtin_amdgcn_fence(__ATOMIC_RELEASE, "agent");
            asm volatile("s_waitcnt vmcnt(0)" ::: "memory");
            const unsigned og = xb_add(&bar[XB_TOP], 1u);
            const unsigned tg = og / nx;
            if (og + 1u == (tg + 1u) * nx) xb_add(&bar[XB_TOPGEN], 1u);
            else XB_SPIN(xb_ld(&bar[XB_TOPGEN]) == tg, bar);
            __builtin_amdgcn_fence(__ATOMIC_ACQUIRE, "agent");
            xb_add(&bar[XB_XGEN(b.x)], 1u);
            asm volatile("s_waitcnt vmcnt(0)" ::: "memory");
        } else {
            XB_SPIN(xb_ld(&bar[XB_XGEN(b.x)]) == gen, bar);
            __builtin_amdgcn_fence(__ATOMIC_ACQUIRE, "agent");
            asm volatile("s_waitcnt vmcnt(0)" ::: "memory");
        }
    }
    __syncthreads();
}

namespace pg8 {
constexpr int BM = 256, BK = 64, HALF = 128, HTB = HALF * BK * 2, NXCD = 8, WGM = 8;
__host__ __device__ __forceinline__ int lds_byte(int r, int c) { const int st = (r >> 4) * 2 + (c >> 5), rr = r & 15, cc = c & 31, ob = rr * 64 + cc * 2; return st * 1024 + (ob ^ (((ob >> 9) & 1) << 5)); }
__host__ __device__ __forceinline__ void stage_rc(int b, int& R, int& C) { const int st = b / 1024, sb = b % 1024, swz = sb ^ (((sb >> 9) & 1) << 5); R = (st >> 1) * 16 + swz / 64; C = (st & 1) * 32 + (swz % 64) / 2; }
struct Unit { int pm, pn; };
struct Gemm { const bf16_t* A; const bf16_t* Bt; int nM, nN, K, a_tile_rows; };
struct StaticOrder {
    int nM, nN, nwg, G, c;
    __device__ void init(int nM_, int nN_, int G_, int c_) { nM = nM_; nN = nN_; nwg = nM * nN; G = G_; c = c_; }
    __device__ bool next(int i, Unit& u) const {
        const long L = (long)i * G + c; if (L >= nwg) return false;
        int wgid = (int)L; { const int q = nwg / NXCD, r = nwg % NXCD, xcd = wgid % NXCD, off = wgid / NXCD; wgid = (xcd < r ? xcd * (q + 1) : r * (q + 1) + (xcd - r) * q) + off; }
        const int nig = WGM * nN, gid = wgid / nig, fm = gid * WGM, gsz = (nM - fm) < WGM ? (nM - fm) : WGM;
        u.pm = fm + ((wgid % nig) % gsz); u.pn = (wgid % nig) / gsz; return true;
    }
};
template <class Epi>
__device__ __forceinline__ void gemm_phase(LAS unsigned char* lds, const Gemm g, const StaticOrder& S, const Epi& E, int wv) {
    const int tid = tid_opaque(wv);
    const int wid = __builtin_amdgcn_readfirstlane(tid >> 6), lane = tid & 63, wr = wid >> 2, wc = wid & 3, fr = lane & 15, fq = lane >> 4;
    const int K = g.K, nt = K / BK;
    unsigned voffA[2], voffB[2];
#pragma unroll
    for (int i = 0; i < 2; ++i) { int R, C; stage_rc(tid * 16 + i * 8192, R, C);
        const int Ra = (R & ~63) + 4 * (R & 15) + ((R >> 4) & 3);
        voffA[i] = (unsigned)(Ra * K + C) * 2u; voffB[i] = (unsigned)(R * K + C) * 2u; }
    const size_t kstep = (size_t)(BK * 2);
    const size_t hstep = (size_t)HALF * K * 2;
    const size_t tstepA = (size_t)g.a_tile_rows * K * 2;
    const size_t tstepB = 2 * hstep;
    const unsigned ldsw = (unsigned)wid * 1024u;
    const int aoff = lds_byte(wr * 64 + fr, fq * 8), boff = lds_byte(wc * 32 + fr, fq * 8);
#define PG8_SA(b, h) (((b) * 2 + (h)) * HTB)
#define PG8_SB(b, h) ((4 + (b) * 2 + (h)) * HTB)
#define PG8_STAGE(bufoff, gbase, voff) do { _Pragma("unroll") for (int _i = 0; _i < 2; ++_i) \
        __builtin_amdgcn_global_load_lds((const unsigned*)((const char*)(gbase) + (voff)[_i]), (LAS unsigned*)(lds + (bufoff) + ldsw + _i * 8192), 16, 0, 0); } while (0)
#define PG8_LDA(dst, b, h) do { _Pragma("unroll") for (int m = 0; m < 4; ++m) _Pragma("unroll") for (int k = 0; k < 2; ++k) dst[m][k] = *(const LAS bf16x8*)(lds + PG8_SA(b, h) + aoff + m * 2048 + k * 1024); } while (0)
#define PG8_LDB(dst, b, h) do { _Pragma("unroll") for (int n = 0; n < 2; ++n) _Pragma("unroll") for (int k = 0; k < 2; ++k) dst[n][k] = *(const LAS bf16x8*)(lds + PG8_SB(b, h) + boff + n * 2048 + k * 1024); } while (0)
#define PG8_MMA(ai, bj, At, Bt) do { __builtin_amdgcn_s_setprio(1); _Pragma("unroll") for (int m = 0; m < 4; ++m) _Pragma("unroll") for (int n = 0; n < 2; ++n) _Pragma("unroll") for (int k = 0; k < 2; ++k) \
        acc[ai][bj][m][n] = __builtin_amdgcn_mfma_f32_16x16x32_bf16(Bt[n][k], At[m][k], acc[ai][bj][m][n], 0, 0, 0); __builtin_amdgcn_s_setprio(0); } while (0)
#define PG8_WAIT_V(n) asm volatile("s_waitcnt vmcnt(" #n ")" ::: "memory")
#define PG8_WAIT_L(n) asm volatile("s_waitcnt lgkmcnt(" #n ")" ::: "memory")
#define PG8_BAR __builtin_amdgcn_s_barrier()
#define PG8_SCHED __builtin_amdgcn_sched_barrier(0)
    Unit cur, nxt; int ui = 0;
    if (!S.next(0, cur)) return;
    f32x4 acc[2][2][4][2];
#pragma unroll
    for (int a = 0; a < 2; ++a)
#pragma unroll
        for (int b = 0; b < 2; ++b)
#pragma unroll
            for (int m = 0; m < 4; ++m)
#pragma unroll
                for (int n = 0; n < 2; ++n) acc[a][b][m][n] = (f32x4){0.f, 0.f, 0.f, 0.f};
    bf16x8 At[4][2], B0[2][2], B1[2][2];
    const char* cA = (const char*)g.A + (size_t)cur.pm * tstepA; const char* cB = (const char*)g.Bt + (size_t)cur.pn * tstepB;
    PG8_STAGE(PG8_SB(0, 0), cB, voffB); PG8_STAGE(PG8_SA(0, 0), cA, voffA); PG8_STAGE(PG8_SB(0, 1), cB + hstep, voffB); PG8_STAGE(PG8_SA(0, 1), cA + hstep, voffA);
    if (wr == 1) PG8_BAR;
    PG8_WAIT_V(4); PG8_BAR;
    PG8_STAGE(PG8_SB(1, 0), cB + kstep, voffB); PG8_STAGE(PG8_SA(1, 0), cA + kstep, voffA); PG8_STAGE(PG8_SB(1, 1), cB + hstep + kstep, voffB);
    PG8_WAIT_V(6); PG8_BAR;
    for (;;) {
        const bool has_next = S.next(ui + 1, nxt);
        const char* nA = has_next ? (const char*)g.A + (size_t)nxt.pm * tstepA : cA; const char* nB = has_next ? (const char*)g.Bt + (size_t)nxt.pn * tstepB : cB;
        for (int t = 0; t < nt; t += 2) {
            const bool last = (t == nt - 2);
            const char* a1 = cA + (size_t)(t + 1) * kstep;
            const char* a2 = last ? nA : cA + (size_t)(t + 2) * kstep; const char* b2 = last ? nB : cB + (size_t)(t + 2) * kstep;
            const char* a3 = a2 + kstep; const char* b3 = b2 + kstep;
            PG8_LDB(B0, 0, 0); PG8_SCHED; PG8_LDA(At, 0, 0); PG8_STAGE(PG8_SA(1, 1), a1 + hstep, voffA);
            PG8_WAIT_L(8); PG8_BAR; PG8_WAIT_L(0); PG8_MMA(0, 0, At, B0); PG8_BAR; PG8_SCHED;
            PG8_LDB(B1, 0, 1); PG8_STAGE(PG8_SB(0, 0), b2, voffB);
            PG8_BAR; PG8_WAIT_L(0); PG8_MMA(0, 1, At, B1); PG8_BAR;
            PG8_LDA(At, 0, 1); PG8_STAGE(PG8_SA(0, 0), a2, voffA);
            PG8_BAR; PG8_WAIT_L(0); PG8_MMA(1, 0, At, B0); PG8_BAR; PG8_SCHED;
            PG8_STAGE(PG8_SB(0, 1), b2 + hstep, voffB);
            PG8_WAIT_V(6); PG8_BAR; PG8_MMA(1, 1, At, B1); PG8_BAR;
            PG8_LDB(B0, 1, 0); PG8_SCHED; PG8_LDA(At, 1, 0); PG8_STAGE(PG8_SA(0, 1), a2 + hstep, voffA);
            PG8_WAIT_L(8); PG8_BAR; PG8_WAIT_L(0); PG8_MMA(0, 0, At, B0); PG8_BAR; PG8_SCHED;
            PG8_LDB(B1, 1, 1); PG8_STAGE(PG8_SB(1, 0), b3, voffB);
            PG8_BAR; PG8_WAIT_L(0); PG8_MMA(0, 1, At, B1); PG8_BAR;
            PG8_LDA(At, 1, 1); PG8_STAGE(PG8_SA(1, 0), a3, voffA);
            PG8_BAR; PG8_WAIT_L(0); PG8_MMA(1, 0, At, B0); PG8_BAR; PG8_SCHED;
            PG8_STAGE(PG8_SB(1, 1), b3 + hstep, voffB);
            PG8_WAIT_V(6); PG8_BAR; PG8_MMA(1, 1, At, B1); PG8_BAR;
        }
        { const int ln2 = lane_fresh();
          E(acc, cur, wr, wc, ln2 & 15, ln2 >> 4); }
        if (!has_next) break;
#pragma unroll
        for (int a = 0; a < 2; ++a)
#pragma unroll
            for (int b = 0; b < 2; ++b)
#pragma unroll
                for (int m = 0; m < 4; ++m)
#pragma unroll
                    for (int n = 0; n < 2; ++n) acc[a][b][m][n] = (f32x4){0.f, 0.f, 0.f, 0.f};
        cur = nxt; cA = nA; cB = nB; ++ui;
    }
    PG8_WAIT_V(0);
    if (wr == 0) PG8_BAR;
    PG8_BAR;
#undef PG8_SA
#undef PG8_SB
#undef PG8_STAGE
#undef PG8_LDA
#undef PG8_LDB
#undef PG8_MMA
#undef PG8_WAIT_V
#undef PG8_WAIT_L
#undef PG8_BAR
#undef PG8_SCHED
}
}
using pg8::Unit;

struct EpiProj {
    bf16_t* O; const float* cosT; const float* sinT;
    __device__ __forceinline__ void operator()(const f32x4 (&acc)[2][2][4][2], const Unit& u, int wr, int wc, int fr, int fq) const {
        const bool latent = u.pm < 128;
#pragma unroll
        for (int ai = 0; ai < 2; ++ai)
#pragma unroll
            for (int m = 0; m < 4; ++m) {
                const int row = u.pm * 256 + ai * 128 + wr * 64 + 4 * fr + m;
                const int t = row & (S - 1);
                const int pos = (wc & 1) ? (t & 63) : (t >> 6);
#pragma unroll
                for (int bj = 0; bj < 2; ++bj) {
                    const int col = u.pn * 256 + bj * 128 + wc * 32 + 4 * fq;
                    f32x4 v0 = acc[ai][bj][m][0], v1 = acc[ai][bj][m][1];
                    const bool rope = latent && (u.pn == 4 || u.pn == 5 || (u.pn == 6 && bj == 0));
                    if (rope) {
                        const f32x4 cs = *(const f32x4*)(cosT + pos * 16 + 4 * fq), sn = *(const f32x4*)(sinT + pos * 16 + 4 * fq);
                        const f32x4 n0 = v0 * cs - v1 * sn, n1 = v1 * cs + v0 * sn; v0 = n0; v1 = n1;
                    }
                    bf16_t* p = O + (size_t)row * DIN + col;
                    u32x2 w0, w1; w0.x = pk2(v0[0], v0[1]); w0.y = pk2(v0[2], v0[3]); w1.x = pk2(v1[0], v1[1]); w1.y = pk2(v1[2], v1[3]);
                    *(u32x2*)p = w0; *(u32x2*)(p + 16) = w1;
                }
            }
    }
};
struct EpiDelta {
    bf16_t* O; const float* gate0; const float* gate1;
    __device__ __forceinline__ void operator()(const f32x4 (&acc)[2][2][4][2], const Unit& u, int wr, int wc, int fr, int fq) const {
        const float* gate = (u.pm >= 64) ? gate1 : gate0;
        f32x4 gv[2][2];
#pragma unroll
        for (int bj = 0; bj < 2; ++bj)
#pragma unroll
            for (int n = 0; n < 2; ++n) gv[bj][n] = *(const f32x4*)(gate + u.pn * 256 + bj * 128 + wc * 32 + n * 16 + 4 * fq);
#pragma unroll
        for (int ai = 0; ai < 2; ++ai)
#pragma unroll
            for (int m = 0; m < 4; ++m) {
                const size_t row = (size_t)u.pm * 256 + ai * 128 + wr * 64 + 4 * fr + m;
#pragma unroll
                for (int bj = 0; bj < 2; ++bj)
#pragma unroll
                    for (int n = 0; n < 2; ++n) {
                        const f32x4 v = gv[bj][n] * acc[ai][bj][m][n];
                        u32x2 w; w.x = pk2(v[0], v[1]); w.y = pk2(v[2], v[3]);
                        *(u32x2*)(O + row * D + u.pn * 256 + bj * 128 + wc * 32 + n * 16 + 4 * fq) = w;
                    }
            }
    }
};

__device__ __forceinline__ float dpp_ror1(float v)  { return __int_as_float(__builtin_amdgcn_update_dpp(0, __float_as_int(v), 0x121, 0xF, 0xF, true)); }
__device__ __forceinline__ float dpp_ror15(float v) { return __int_as_float(__builtin_amdgcn_update_dpp(0, __float_as_int(v), 0x12F, 0xF, 0xF, true)); }
__device__ __forceinline__ float dpp_shr1(float v)  { return __int_as_float(__builtin_amdgcn_update_dpp(0, __float_as_int(v), 0x111, 0xF, 0xF, true)); }
__device__ __forceinline__ float dpp_shl1(float v)  { return __int_as_float(__builtin_amdgcn_update_dpp(0, __float_as_int(v), 0x101, 0xF, 0xF, true)); }

#define DPP_FMAC4X2(C, SA, WA, CTRLA, SB, WB, CTRLB) do { float _c0 = (C)[0], _c1 = (C)[1], _c2 = (C)[2], _c3 = (C)[3]; \
    asm("s_nop 1\n\t" \
        "v_fmac_f32_dpp %0, %4, %8 " CTRLA " row_mask:0xf bank_mask:0xf bound_ctrl:1\n\t" \
        "v_fmac_f32_dpp %1, %5, %9 " CTRLA " row_mask:0xf bank_mask:0xf bound_ctrl:1\n\t" \
        "v_fmac_f32_dpp %2, %6, %10 " CTRLA " row_mask:0xf bank_mask:0xf bound_ctrl:1\n\t" \
        "v_fmac_f32_dpp %3, %7, %11 " CTRLA " row_mask:0xf bank_mask:0xf bound_ctrl:1\n\t" \
        "v_fmac_f32_dpp %0, %12, %16 " CTRLB " row_mask:0xf bank_mask:0xf bound_ctrl:1\n\t" \
        "v_fmac_f32_dpp %1, %13, %17 " CTRLB " row_mask:0xf bank_mask:0xf bound_ctrl:1\n\t" \
        "v_fmac_f32_dpp %2, %14, %18 " CTRLB " row_mask:0xf bank_mask:0xf bound_ctrl:1\n\t" \
        "v_fmac_f32_dpp %3, %15, %19 " CTRLB " row_mask:0xf bank_mask:0xf bound_ctrl:1" \
        : "+v"(_c0), "+v"(_c1), "+v"(_c2), "+v"(_c3) \
        : "v"((SA)[0]), "v"((SA)[1]), "v"((SA)[2]), "v"((SA)[3]), "v"((WA)[0]), "v"((WA)[1]), "v"((WA)[2]), "v"((WA)[3]), \
          "v"((SB)[0]), "v"((SB)[1]), "v"((SB)[2]), "v"((SB)[3]), "v"((WB)[0]), "v"((WB)[1]), "v"((WB)[2]), "v"((WB)[3])); \
    (C)[0] = _c0; (C)[1] = _c1; (C)[2] = _c2; (C)[3] = _c3; } while (0)
#define DPP_FMAC4(C, SA, WA, CTRLA) do { float _c0 = (C)[0], _c1 = (C)[1], _c2 = (C)[2], _c3 = (C)[3]; \
    asm("s_nop 1\n\t" \
        "v_fmac_f32_dpp %0, %4, %8 " CTRLA " row_mask:0xf bank_mask:0xf bound_ctrl:1\n\t" \
        "v_fmac_f32_dpp %1, %5, %9 " CTRLA " row_mask:0xf bank_mask:0xf bound_ctrl:1\n\t" \
        "v_fmac_f32_dpp %2, %6, %10 " CTRLA " row_mask:0xf bank_mask:0xf bound_ctrl:1\n\t" \
        "v_fmac_f32_dpp %3, %7, %11 " CTRLA " row_mask:0xf bank_mask:0xf bound_ctrl:1" \
        : "+v"(_c0), "+v"(_c1), "+v"(_c2), "+v"(_c3) \
        : "v"((SA)[0]), "v"((SA)[1]), "v"((SA)[2]), "v"((SA)[3]), "v"((WA)[0]), "v"((WA)[1]), "v"((WA)[2]), "v"((WA)[3])); \
    (C)[0] = _c0; (C)[1] = _c1; (C)[2] = _c2; (C)[3] = _c3; } while (0)
struct EpiConvGate {
    bf16_t* act; const float* cw; const float* cbias; LAS unsigned char* xl;
    __device__ __forceinline__ void operator()(const f32x4 (&acc)[2][2][4][2], const Unit& u, int wr, int wc, int fr, int fq) const {
        if (wr == 0) { __builtin_amdgcn_s_barrier(); } asm volatile("" ::: "memory");
        LAS float* X = (LAS float*)xl;
        f32x4 wq[2][2][4];
#define CG_LOADW(N) do { _Pragma("unroll") for (int bj = 0; bj < 2; ++bj) { const int ch = 128 * u.pn + 32 * wc + 16 * (N) + 4 * fq + bj * DFF; \
            wq[N][bj][0] = *(const f32x4*)(cw + ch); wq[N][bj][1] = *(const f32x4*)(cw + DUP + ch); wq[N][bj][2] = *(const f32x4*)(cw + 2 * DUP + ch); wq[N][bj][3] = *(const f32x4*)(cbias + ch); } } while (0)
        CG_LOADW(0);
#pragma unroll
        for (int ai = 0; ai < 2; ++ai) {
            const int s = 2 * ai + wr;
            if (fr == 0) {
#pragma unroll
                for (int bj = 0; bj < 2; ++bj)
#pragma unroll
                    for (int n = 0; n < 2; ++n) *(LAS f32x4*)(X + ((s * 2 + 0) * 2 + bj) * 128 + 32 * wc + 16 * n + 4 * fq) = acc[ai][bj][0][n];
            }
            if (fr == 15) {
#pragma unroll
                for (int bj = 0; bj < 2; ++bj)
#pragma unroll
                    for (int n = 0; n < 2; ++n) *(LAS f32x4*)(X + ((s * 2 + 1) * 2 + bj) * 128 + 32 * wc + 16 * n + 4 * fq) = acc[ai][bj][3][n];
            }
        }
        asm volatile("s_waitcnt lgkmcnt(0)" ::: "memory");
        __builtin_amdgcn_s_barrier(); asm volatile("" ::: "memory");
#pragma unroll
        for (int n = 0; n < 2; ++n) {
            const int chg = 128 * u.pn + 32 * wc + 16 * n + 4 * fq;
            if (n == 1) CG_LOADW(1);
            f32x4 w0[2], w1[2], w2[2], bb[2], w0m[2], w2m[2];
#pragma unroll
            for (int bj = 0; bj < 2; ++bj) {
                w0[bj] = wq[n][bj][0]; w1[bj] = wq[n][bj][1]; w2[bj] = wq[n][bj][2]; bb[bj] = wq[n][bj][3];
                w0m[bj] = (fr == 0) ? w0[bj] : (f32x4){0.f, 0.f, 0.f, 0.f}; w2m[bj] = (fr == 15) ? w2[bj] : (f32x4){0.f, 0.f, 0.f, 0.f};
            }
#pragma unroll
            for (int ai = 0; ai < 2; ++ai) {
                const int s = 2 * ai + wr;
                f32x4 xp[2], xn[2];
#pragma unroll
                for (int bj = 0; bj < 2; ++bj) {
                    xp[bj] = *(const LAS f32x4*)(X + ((((s + 3) & 3) * 2 + 1) * 2 + bj) * 128 + 32 * wc + 16 * n + 4 * fq);
                    xn[bj] = *(const LAS f32x4*)(X + ((((s + 1) & 3) * 2 + 0) * 2 + bj) * 128 + 32 * wc + 16 * n + 4 * fq);
                }
                f32x4 cvv[4][2];
#pragma unroll
                for (int bj = 0; bj < 2; ++bj) {
                    const f32x4 a0 = acc[ai][bj][0][n], a1 = acc[ai][bj][1][n], a2 = acc[ai][bj][2][n], a3 = acc[ai][bj][3][n];
                    f32x4 c0 = bb[bj] + w1[bj] * a0 + w2[bj] * a1 + w0m[bj] * xp[bj];
                    f32x4 c1 = bb[bj] + w1[bj] * a1 + w0[bj] * a0 + w2[bj] * a2;
                    f32x4 c2 = bb[bj] + w1[bj] * a2 + w0[bj] * a1 + w2[bj] * a3;
                    f32x4 c3 = bb[bj] + w1[bj] * a3 + w0[bj] * a2 + w2m[bj] * xn[bj];
                    DPP_FMAC4(c0, a3, w0[bj], "row_shr:1");
                    DPP_FMAC4(c3, a0, w2[bj], "row_shl:1");
                    cvv[0][bj] = c0; cvv[1][bj] = c1; cvv[2][bj] = c2; cvv[3][bj] = c3;
                }
#pragma unroll
                for (int m = 0; m < 4; ++m) {
                    const int lr = 128 * ai + 64 * wr + 4 * fr + m;
                    const int R = 254 * u.pm + lr;
                    const int b = R >= (H2_BSTRIDE + 1) ? 1 : 0;
                    const int t = R - 1 - H2_BSTRIDE * b;
                    const bool valid = lr >= 1 && lr <= 254 && t >= 0 && t < S;
                    if (valid) {
                        u32x2 w;
                        w.x = pk2(silu_(cvv[m][0][0]) * cvv[m][1][0], silu_(cvv[m][0][1]) * cvv[m][1][1]);
                        w.y = pk2(silu_(cvv[m][0][2]) * cvv[m][1][2], silu_(cvv[m][0][3]) * cvv[m][1][3]);
                        *(u32x2*)(act + (size_t)(b * S + t) * DFF + chg) = w;
                    }
                }
            }
        }
        asm volatile("" ::: "memory"); if (wr == 1) { __builtin_amdgcn_s_barrier(); }
    }
};

#undef CG_LOADW
__device__ __forceinline__ void transpose_item(const float* W, int N, int k0, int n0, bf16_t* dst, int Kd, float* scr, int lane) {
#pragma unroll 16
    for (int i = 0; i < 32; ++i) { const int kk = 2 * i + (lane >> 5); scr[kk * 33 + (lane & 31)] = __builtin_nontemporal_load(W + (size_t)(k0 + kk) * N + n0 + (lane & 31)); }
    __builtin_amdgcn_wave_barrier();
    const int c = lane & 7;
#pragma unroll
    for (int j = 0; j < 4; ++j) {
        const int n = (lane >> 3) + 8 * j; const float* s = scr + (8 * c) * 33 + n;
        u32x4 o; o.x = pk2(s[0], s[33]); o.y = pk2(s[2 * 33], s[3 * 33]); o.z = pk2(s[4 * 33], s[5 * 33]); o.w = pk2(s[6 * 33], s[7 * 33]);
        *(u32x4*)(dst + (size_t)n * Kd + k0 + 8 * c) = o;
    }
    __builtin_amdgcn_wave_barrier();
}

__device__ __forceinline__ void phase0(PP p, unsigned char* shm, int wv) {
    const int tid = tid_opaque(wv), lane = tid & 63, wave = tid >> 6;
    unsigned char* ws = p->ws;
    if (blockIdx.x < 192) {
        float* sv = (float*)shm;
        float* red = sv + 3 * 1024;
        for (int i = tid; i < 3 * 1024; i += 512) {
            const int j = i >> 10, k = i & 1023;
            const float v = (j < 2) ? p->c[j * 1024 + k] : p->c_ctx[k];
            sv[i] = silu_(v);
        }
        __syncthreads();
        const int n0 = blockIdx.x * 32, col = tid & 31, ks = tid >> 5;
        float a0 = 0.f, a1 = 0.f, a2 = 0.f;
        const float* wp = p->w_mod + (size_t)(ks * 64) * 6144 + n0 + col;
#pragma unroll
        for (int k = 0; k < 64; ++k) {
            const float w = __builtin_nontemporal_load(wp + (size_t)k * 6144);
            a0 += sv[ks * 64 + k] * w; a1 += sv[1024 + ks * 64 + k] * w; a2 += sv[2048 + ks * 64 + k] * w;
        }
        red[(ks * 3 + 0) * 32 + col] = a0; red[(ks * 3 + 1) * 32 + col] = a1; red[(ks * 3 + 2) * 32 + col] = a2;
        __syncthreads();
        if (tid < 96) {
            const int j = tid >> 5, cc = tid & 31; float s = p->b_mod[n0 + cc];
            for (int k = 0; k < 16; ++k) s += red[(k * 3 + j) * 32 + cc];
            ((float*)(ws + WS_MOD))[j * 6144 + n0 + cc] = s;
        }
        __syncthreads();
    }
    if (blockIdx.x == 200) { for (int i = tid; i < 1024; i += 512) ((float*)(ws + WS_SP8))[i] = -8.0f * log1pf(expf(-p->lru_lam[i])); }
    if (blockIdx.x >= 192 && blockIdx.x < 200) {
        const int idx = (blockIdx.x - 192) * 512 + tid;
        const int pos = idx >> 4, i = idx & 15;
        const float inv = powf(10000.0f, -(float)i / 16.0f);
        const float ang = (float)pos * inv;
        ((float*)(ws + WS_ROPE))[idx] = cosf(ang);
        ((float*)(ws + WS_ROPE))[4096 + idx] = sinf(ang);
    }
}
__device__ __forceinline__ void transpose_phase(PP p, unsigned char* shm, int wv, int it_lo, int it_hi, int gw0, int NGW) {
    const int tid = tid_opaque(wv), lane = tid & 63, wave = wv;
    unsigned char* ws = p->ws;
    float* scr = (float*)(shm + 32768) + wave * (64 * 33);
    const int gw = gw0 + wave;
    constexpr int I_IN = (D / 64) * (DIN / 32), I_OUT = (D / 64) * (D / 32), I_UP = (D / 64) * (DUP / 32), I_DN = (DFF / 64) * (D / 32), I_LRU = 2 * 2 * 8 * 2;
    constexpr int NIT = I_IN + I_OUT + I_UP + I_DN + I_LRU;
    (void)NIT;
    for (int it = it_lo + gw; it < it_hi; it += NGW) {
        int r = it;
        if (r >= I_IN + I_OUT + I_UP + I_DN + I_LRU) continue;
        if (r < I_IN) { const int nb = DIN / 32, kb = r / nb, n0 = (r % nb) * 32; transpose_item(p->w_in, DIN, kb * 64, n0, (bf16_t*)(ws + WS_WIN) + (size_t)n0 * D, D, scr, lane); continue; } r -= I_IN;
        if (r < I_OUT) { const int nb = D / 32, kb = r / nb, n0 = (r % nb) * 32; transpose_item(p->w_out, D, kb * 64, n0, (bf16_t*)(ws + WS_WOUT) + (size_t)n0 * D, D, scr, lane); continue; } r -= I_OUT;
        if (r < I_UP) { const int nb = DUP / 32, kb = r / nb, n0 = (r % nb) * 32;
            const int isv = n0 >= DFF, nn = isv ? n0 - DFF : n0, drow = (nn / 128) * 256 + isv * 128 + (nn % 128);
            transpose_item(p->w_up, DUP, kb * 64, n0, (bf16_t*)(ws + WS_WUP) + (size_t)drow * D, D, scr, lane); continue; } r -= I_UP;
        if (r < I_DN) { const int nb = D / 32, kb = r / nb, n0 = (r % nb) * 32; transpose_item(p->w_down, D, kb * 64, n0, (bf16_t*)(ws + WS_WDN) + (size_t)n0 * DFF, DFF, scr, lane); continue; } r -= I_DN;
        {
            const int nh = r & 1, blk = (r >> 1) & 7, type = (r >> 4) & 1, dir = r >> 5;
            const float* src = (type ? p->lru_w_i : p->lru_w_a) + (size_t)(dir * 8 + blk) * 4096;
            bf16_t* dst = (bf16_t*)(ws + WS_LRU) + (size_t)((dir * 2 + type) * 8 + blk) * 4096 + (size_t)(nh * 32) * 64;
            transpose_item(src, 64, 0, nh * 32, dst, 64, scr, lane);
        }
    }
}

__device__ __forceinline__ void row_load_nt(const float* src, int lane, f32x4 (&v)[4]) {
#pragma unroll
    for (int j = 0; j < 4; ++j) v[j] = __builtin_nontemporal_load((const f32x4*)(src + 4 * lane + 256 * j));
}
__device__ __forceinline__ void row_load(const float* src, int lane, f32x4 (&v)[4]) {
#pragma unroll
    for (int j = 0; j < 4; ++j) v[j] = *(const f32x4*)(src + 4 * lane + 256 * j);
}
__device__ __forceinline__ float row_rstd(const f32x4 (&v)[4]) {
    float ss = 0.f;
#pragma unroll
    for (int j = 0; j < 4; ++j) ss += v[j][0] * v[j][0] + v[j][1] * v[j][1] + v[j][2] * v[j][2] + v[j][3] * v[j][3];
    return rsqrtf(wave_sum(ss) * (1.0f / D) + EPS);
}
__device__ __forceinline__ void norm_mod_store(const f32x4 (&v)[4], float rstd, const float* g, const float* sh, const float* sc, bf16_t* dst, int lane) {
#pragma unroll
    for (int j = 0; j < 4; ++j) {
        const int c = 4 * lane + 256 * j;
        const f32x4 gg = *(const f32x4*)(g + c), s1 = *(const f32x4*)(sc + c), s0 = *(const f32x4*)(sh + c);
        const f32x4 o = (v[j] * rstd * gg) * (s1 + 1.0f) + s0;
        u32x2 w; w.x = pk2(o[0], o[1]); w.y = pk2(o[2], o[3]);
        *(u32x2*)(dst + c) = w;
    }
}
__device__ __forceinline__ void phase1(PP p, int wv) {
    const int tid_ = tid_opaque(wv), lane = tid_ & 63, gw = blockIdx.x * 8 + (tid_ >> 6), NGW = gridDim.x * 8;
    const float* mod = (const float*)(p->ws + WS_MOD);
    bf16_t* hb = (bf16_t*)(p->ws + WS_HB);
    int cur = -1; f32x4 gsc[4], gsh[4];
    for (int r0 = gw; r0 < MROWS; r0 += 4 * NGW) {
        f32x4 v[4][4];
#pragma unroll
        for (int q = 0; q < 4; ++q) {
            const int r = (r0 + q * NGW < MROWS) ? r0 + q * NGW : r0;
            row_load_nt(r < NLAT ? p->x + (size_t)r * D : p->ctx + (size_t)(r - NLAT) * D, lane, v[q]);
        }
#pragma unroll
        for (int q = 0; q < 4; ++q) {
            const int r = r0 + q * NGW;
            if (r < MROWS) {
                const int mi = r < NLAT ? (r >> 14) : 2;
                if (mi != cur) {
                    cur = mi;
#pragma unroll
                    for (int j = 0; j < 4; ++j) {
                        const int c = 4 * lane + 256 * j;
                        gsc[j] = *(const f32x4*)(p->norm1_g + c) * (*(const f32x4*)(mod + mi * 6144 + 1024 + c) + 1.0f);
                        gsh[j] = *(const f32x4*)(mod + mi * 6144 + c);
                    }
                }
                const float rstd = row_rstd(v[q]);
#pragma unroll
                for (int j = 0; j < 4; ++j) {
                    const f32x4 o = v[q][j] * rstd * gsc[j] + gsh[j];
                    u32x2 w; w.x = pk2(o[0], o[1]); w.y = pk2(o[2], o[3]);
                    *(u32x2*)(hb + (size_t)r * D + 4 * lane + 256 * j) = w;
                }
            }
        }
    }
}

typedef float f32x16 __attribute__((ext_vector_type(16)));
__device__ __forceinline__ unsigned cvt_pk_bf16(float lo, float hi) { unsigned r; asm("v_cvt_pk_bf16_f32 %0, %1, %2" : "=v"(r) : "v"(lo), "v"(hi)); return r; }
__device__ __forceinline__ void attn_mfma(PP p, unsigned char* shm, int wv) {
    const int tid = tid_opaque(wv);
    const int lane = tid & 63, wave = wv, l31 = lane & 31, hl = lane >> 5;
    const bf16_t* proj = (const bf16_t*)(p->ws + WS_PROJ);
    bf16_t* att = (bf16_t*)(p->ws + WS_ATT);
    const float L2E = 1.4426950408889634f;
    const float SC2 = 0.125f * L2E;
    for (int item = blockIdx.x; item < 512; item += gridDim.x) {
        const int hk = item & 1, qb = (item >> 1) & 127, b = item >> 8;
        const int g = wave >> 1, qh = wave & 1, hq = hk * 4 + g;
        const int qrow0 = b * S + 128 * qb + 64 * qh;
        bf16x8 qf[2][4];
#pragma unroll
        for (int qi = 0; qi < 2; ++qi)
#pragma unroll
            for (int st = 0; st < 4; ++st) qf[qi][st] = *(const bf16x8*)(proj + (size_t)(qrow0 + 32 * qi + l31) * DIN + 1024 + 64 * hq + 16 * st + 8 * hl);
        const float sink2 = p->attn_sink[hq] * L2E;
        float mrun[2] = {sink2, sink2};
        float lrun[2] = {hl == 0 ? 1.f : 0.f, hl == 0 ? 1.f : 0.f};
        f32x16 oacc[2][2];
#pragma unroll
        for (int a = 0; a < 2; ++a)
#pragma unroll
            for (int c = 0; c < 2; ++c)
#pragma unroll
                for (int i = 0; i < 16; ++i) oacc[a][c][i] = 0.f;
        u32x4 kreg[2], vreg[2];
        int ci = (qb == 0) ? 1 : 0;
#define ATT_GLOAD(CI) do { const int _row0 = (CI) < 3 ? b * S + 128 * (qb - 1 + (CI)) : NLAT + b * LC + 128 * ((CI) - 3); \
        _Pragma("unroll") for (int _i = 0; _i < 2; ++_i) { const int _pi = tid + 512 * _i, _key = _pi >> 3, _part = _pi & 7; \
            const bf16_t* _src = proj + (size_t)(_row0 + _key) * DIN + 1536 + 64 * hk + 8 * _part; kreg[_i] = *(const u32x4*)_src; vreg[_i] = *(const u32x4*)(_src + 128); } } while (0)
#define ATT_STAGE(PAR) do { bf16_t* _K = (bf16_t*)(shm + (PAR) * 36864); bf16_t* _V = (bf16_t*)(shm + (PAR) * 36864 + 18432); \
        _Pragma("unroll") for (int i = 0; i < 2; ++i) { const int pi = tid + 512 * i, key = pi >> 3, part = pi & 7; \
            *(u32x4*)(_K + key * 72 + 8 * part) = kreg[i]; \
            _Pragma("unroll") for (int e = 0; e < 8; ++e) { const unsigned w = vreg[i][e >> 1]; _V[(8 * part + e) * 132 + key] = (bf16_t)((e & 1) ? (w >> 16) : (w & 0xFFFFu)); } } } while (0)
#define ATT_NEXT(C) (((C) + 1 == 2 && qb == 127) ? 3 : (C) + 1)
        ATT_GLOAD(ci);
        __syncthreads();
        ATT_STAGE(0);
        { const int c1 = ATT_NEXT(ci); if (c1 < 5) ATT_GLOAD(c1); }
        __syncthreads();
        int par = 0;
        while (ci < 5) {
            const int cn = ATT_NEXT(ci);
            if (cn < 5) { ATT_STAGE(par ^ 1); const int c2 = ATT_NEXT(cn); if (c2 < 5) ATT_GLOAD(c2); }
            const bf16_t* Ks = (const bf16_t*)(shm + par * 36864);
            const bf16_t* Vt = (const bf16_t*)(shm + par * 36864 + 18432);
            const int kt_lo = (ci == 0 && qh == 1) ? 2 : 0, kt_hi = (ci == 2 && qh == 0) ? 2 : 4;
#pragma unroll 1
            for (int kt = kt_lo; kt < kt_hi; ++kt) {
                bf16x8 kf[4];
#pragma unroll
                for (int st = 0; st < 4; ++st) kf[st] = *(const bf16x8*)(Ks + (32 * kt + l31) * 72 + 16 * st + 8 * hl);
                bf16x8 vf[2][2];
#pragma unroll
                for (int db = 0; db < 2; ++db)
#pragma unroll
                    for (int s2 = 0; s2 < 2; ++s2) {
                        const bf16_t* vp = Vt + (32 * db + l31) * 132 + 32 * kt + 16 * s2 + 4 * hl;
                        const u32x2 lo = *(const u32x2*)vp, hi = *(const u32x2*)(vp + 8);
                        u32x4 w; w.x = lo.x; w.y = lo.y; w.z = hi.x; w.w = hi.y;
                        vf[db][s2] = __builtin_bit_cast(bf16x8, w);
                    }
#pragma unroll
                for (int qi = 0; qi < 2; ++qi) {
                    f32x16 s;
#pragma unroll
                    for (int i = 0; i < 16; ++i) s[i] = 0.f;
#pragma unroll
                    for (int st = 0; st < 4; ++st) s = __builtin_amdgcn_mfma_f32_32x32x16_bf16(kf[st], qf[qi][st], s, 0, 0, 0);
                    if (ci == 0 || ci == 2) {
                        asm volatile("");
                        const int dl = (ci == 0) ? (32 * kt + 4 * hl - (64 * qh + 32 * qi + l31)) : ((64 * qh + 32 * qi + l31) - 32 * kt - 4 * hl);
#pragma unroll
                        for (int i = 0; i < 16; ++i) {
                            const int ki = 8 * (i >> 2) + (i & 3);
                            const bool ok = (ci == 0) ? (dl + ki >= 0) : (dl - ki >= 0);
                            s[i] = ok ? s[i] : -1e30f;
                        }
                    }
                    float mx = s[0];
#pragma unroll
                    for (int i = 1; i < 16; ++i) mx = fmaxf(mx, s[i]);
                    mx = fmaxf(mx, __shfl_xor(mx, 32));
                    const float mnew = fmaxf(mrun[qi], mx * SC2);
                    if (__builtin_amdgcn_ballot_w64(mnew > mrun[qi]) != 0ull) {
                        const float alpha = __builtin_amdgcn_exp2f(mrun[qi] - mnew);
                        lrun[qi] *= alpha;
#pragma unroll
                        for (int db = 0; db < 2; ++db)
#pragma unroll
                            for (int i = 0; i < 16; ++i) oacc[db][qi][i] *= alpha;
                        mrun[qi] = mnew;
                    }
                    float ls = 0.f;
#pragma unroll
                    for (int i = 0; i < 16; ++i) { s[i] = __builtin_amdgcn_exp2f(__builtin_fmaf(s[i], SC2, -mnew)); ls += s[i]; }
                    lrun[qi] += ls;
                    bf16x8 pf[2];
#pragma unroll
                    for (int s2 = 0; s2 < 2; ++s2) {
                        u32x4 w; w.x = cvt_pk_bf16(s[8 * s2 + 0], s[8 * s2 + 1]); w.y = cvt_pk_bf16(s[8 * s2 + 2], s[8 * s2 + 3]);
                        w.z = cvt_pk_bf16(s[8 * s2 + 4], s[8 * s2 + 5]); w.w = cvt_pk_bf16(s[8 * s2 + 6], s[8 * s2 + 7]);
                        pf[s2] = __builtin_bit_cast(bf16x8, w);
                    }
#pragma unroll
                    for (int db = 0; db < 2; ++db)
#pragma unroll
                        for (int s2 = 0; s2 < 2; ++s2) oacc[db][qi] = __builtin_amdgcn_mfma_f32_32x32x16_bf16(vf[db][s2], pf[s2], oacc[db][qi], 0, 0, 0);
                }
            }
            __syncthreads();
            ci = cn; par ^= 1;
        }
#undef ATT_STAGE
#undef ATT_NEXT
#undef ATT_GLOAD
#pragma unroll
        for (int qi = 0; qi < 2; ++qi) {
            const float lt = lrun[qi] + __shfl_xor(lrun[qi], 32);
            const float inv = 1.0f / lt;
            bf16_t* orow = att + (size_t)(qrow0 + 32 * qi + l31) * 512 + hq * 64;
#pragma unroll
            for (int db = 0; db < 2; ++db)
#pragma unroll
                for (int g4 = 0; g4 < 4; ++g4) {
                    u32x2 w; w.x = cvt_pk_bf16(oacc[db][qi][4 * g4] * inv, oacc[db][qi][4 * g4 + 1] * inv); w.y = cvt_pk_bf16(oacc[db][qi][4 * g4 + 2] * inv, oacc[db][qi][4 * g4 + 3] * inv);
                    *(u32x2*)(orow + 32 * db + 8 * g4 + 4 * hl) = w;
                }
        }
    }
    __syncthreads();
}


struct ScanW { bf16x8 wfa[4], wfi[4]; float ba, bi, sp8l2; };
__device__ __forceinline__ void scan_loadw(PP p, int dir, int n, int ct, int l31, int hl, ScanW& w) {
    unsigned chv = (unsigned)(32 * ct + l31); asm volatile("" : "+v"(chv));
    const unsigned ch = (unsigned)(dir * 512 + 64 * n) + chv;
    w.ba = p->lru_b_a[ch]; w.bi = p->lru_b_i[ch];
    w.sp8l2 = ((const float*)(p->ws + WS_SP8))[ch] * 1.4426950408889634f;
    const bf16_t* wa_b = (const bf16_t*)(p->ws + WS_LRU) + (size_t)((dir * 2 + 0) * 8 + n) * 4096;
    const bf16_t* wi_b = (const bf16_t*)(p->ws + WS_LRU) + (size_t)((dir * 2 + 1) * 8 + n) * 4096;
    const unsigned lo = chv * 64u + 8u * (unsigned)hl;
#pragma unroll
    for (int st = 0; st < 4; ++st) { w.wfa[st] = *(const bf16x8*)(wa_b + lo + 16 * st); w.wfi[st] = *(const bf16x8*)(wi_b + lo + 16 * st); }
}
template <int DIR>
__device__ __forceinline__ void scan_dir(PP p, const bf16_t* xs, const ScanW& w, ScanW& wn, int ndir, int nct, bool do_next, int n, int ct, int l31, int hl, int id, int rowbase, bool latent, float (&hf)[2][16]) {
    constexpr int XS = 520;
    const int ch = 64 * n + 32 * ct + l31;
    const float ba = w.ba, bi = w.bi, sp8l2 = w.sp8l2;
    const bf16x8 (&wfa)[4] = w.wfa; const bf16x8 (&wfi)[4] = w.wfi;
    float a[2][16], u[2][16];
#pragma unroll
    for (int rt = 0; rt < 2; ++rt) {
        bf16x8 af[4];
#pragma unroll
        for (int st = 0; st < 4; ++st) af[st] = *(const bf16x8*)(xs + (32 * rt + l31) * XS + 64 * n + 16 * st + 8 * hl);
        f32x16 ga, gi;
#pragma unroll
        for (int i = 0; i < 16; ++i) { ga[i] = 0.f; gi[i] = 0.f; }
#pragma unroll
        for (int st = 0; st < 4; ++st) { ga = __builtin_amdgcn_mfma_f32_32x32x16_bf16(af[st], wfa[st], ga, 0, 0, 0); gi = __builtin_amdgcn_mfma_f32_32x32x16_bf16(af[st], wfi[st], gi, 0, 0, 0); }
#pragma unroll
        for (int i = 0; i < 16; ++i) {
            const int token = 32 * rt + 8 * (i >> 2) + 4 * hl + (i & 3);
            const float xv = bf2f(xs[token * XS + ch]);
            const float rr = fast_sigmoid(ga[i] + ba), ii = fast_sigmoid(gi[i] + bi);
            const float la2 = rr * sp8l2;
            const float av = __builtin_amdgcn_exp2f(la2);
            const float t2 = la2 * 1.3862943611f;
            float em1p = t2 * (1.0f + t2 * (0.5f + t2 * (0.16666667f + t2 * (0.041666668f + t2 * 0.0083333333f)))), em1e = __builtin_fmaf(av, av, -1.0f);
            asm volatile("" : "+v"(em1p), "+v"(em1e));
            const float em1 = (t2 > -0.1f) ? em1p : em1e;
            a[rt][i] = av; u[rt][i] = __builtin_amdgcn_sqrtf(-em1) * (ii * xv);
        }
    }
    float Ao[8], Ho[8], Ap[8], Hp[8];
#pragma unroll
    for (int k = 0; k < 8; ++k) {
        const int rt = k >> 2, g = k & 3;
        float H = 0.f, A = 1.f;
#pragma unroll
        for (int jj = 0; jj < 4; ++jj) { const int j = DIR ? 3 - jj : jj; const float av = a[rt][4 * g + j]; H = av * H + u[rt][4 * g + j]; A *= av; }
        Ao[k] = A; Ho[k] = H; Ap[k] = __shfl_xor(A, 32); Hp[k] = __shfl_xor(H, 32);
    }
    float Sin[8], Pin[8]; float Sx = 0.f, Px = 1.f;
#pragma unroll
    for (int kk = 0; kk < 8; ++kk) {
        const int k = DIR ? 7 - kk : kk;
        const float A0 = hl ? Ap[k] : Ao[k], H0 = hl ? Hp[k] : Ho[k], A1 = hl ? Ao[k] : Ap[k], H1 = hl ? Ho[k] : Hp[k];
        float s0, p0, s1, p1;
        if (DIR == 0) { s0 = Sx; p0 = Px; Sx = A0 * Sx + H0; Px *= A0; s1 = Sx; p1 = Px; Sx = A1 * Sx + H1; Px *= A1; }
        else          { s1 = Sx; p1 = Px; Sx = A1 * Sx + H1; Px *= A1; s0 = Sx; p0 = Px; Sx = A0 * Sx + H0; Px *= A0; }
        Sin[k] = hl ? s1 : s0; Pin[k] = hl ? p1 : p0;
    }
    asm volatile("" ::: "memory");
    if (do_next) scan_loadw(p, ndir, n, nct, l31, hl, wn);
    bf16_t* yl = (bf16_t*)(p->ws + WS_YL) + (size_t)rowbase * 512; bf16_t* caf = (bf16_t*)(p->ws + WS_CAF) + (size_t)rowbase * 512; bf16_t* cab = (bf16_t*)(p->ws + WS_CAB) + (size_t)rowbase * 512;
    unsigned lo = (unsigned)ch; asm volatile("" : "+v"(lo));
#pragma unroll
    for (int k = 0; k < 8; ++k) {
        const int rt = k >> 2, g = k & 3;
        float h = Sin[k], P = Pin[k];
#pragma unroll
        for (int jj = 0; jj < 4; ++jj) {
            const int j = DIR ? 3 - jj : jj, idx = 4 * g + j;
            h = a[rt][idx] * h + u[rt][idx]; P *= a[rt][idx];
            const int token = 32 * rt + 8 * g + 4 * hl + j;
            const unsigned o = lo + (unsigned)token * 512u;
            if (DIR == 0) { hf[rt][idx] = h; if (latent) caf[o] = f2bf(P); }
            else if (latent) { yl[o] = f2bf(hf[rt][idx] + h); cab[o] = f2bf(P); }
        }
    }
    if (hl == 0) {
        float* sumb = (float*)(p->ws + WS_SUM);
        sumb[((size_t)(DIR * NCHUNK + id) * 2 + 0) * 512 + ch] = Px;
        sumb[((size_t)(DIR * NCHUNK + id) * 2 + 1) * 512 + ch] = Sx;
    }
}
__device__ __forceinline__ void scan_mfma(PP p, unsigned char* shm, int wv) {
    const int tid_ = tid_opaque(wv); const int tid = tid_;
    const int lane = tid & 63, n = wv, l31 = lane & 31, hl = lane >> 5;
    constexpr int XS = 520;
    bf16_t* xs = (bf16_t*)shm;
    const bf16_t* proj = (const bf16_t*)(p->ws + WS_PROJ);
    for (int item = blockIdx.x; item < 512 + 32; item += gridDim.x) {
        const int id = item < 512 ? item : 512 + ((item - 512) >> 2);
        const int quarter = item < 512 ? -1 : ((item - 512) & 3);
        int rowbase, t0, seqlen; bool latent;
        if (id < 512) { const int b = id >> 8, k = id & 255; t0 = 64 * k; rowbase = b * S + t0; seqlen = S; latent = true; }
        else { const int j = id - 512, b = j >> 2, k = j & 3; t0 = 64 * k; rowbase = NLAT + b * LC + t0; seqlen = LC; latent = false; }
        const int seqbase = rowbase - t0;
        ScanW w0, w1;
        if (quarter < 0) scan_loadw(p, 0, n, 0, l31, hl, w0);
        {
            const int tid = tid_opaque(wv);
            bf16_t* raw = (bf16_t*)(shm + 66560);
#pragma unroll
            for (int i = 0; i < 9; ++i) {
                const int piece = tid + 512 * i;
                if (piece < 67 * 64) {
                    const int row = piece >> 6, c8 = piece & 63, tt = t0 - 2 + row;
                    u32x4 v = {0u, 0u, 0u, 0u};
                    if (tt >= 0 && tt < seqlen) v = *(const u32x4*)(proj + (size_t)(seqbase + tt) * DIN + 8 * c8);
                    *(u32x4*)(raw + row * 512 + 8 * c8) = v;
                }
            }
            __syncthreads();
            const int cq = tid & 127, tq = tid >> 7, c4 = 4 * cq;
            const f32x4 k0 = *(const f32x4*)(p->rnn_conv_w + c4), k1 = *(const f32x4*)(p->rnn_conv_w + 512 + c4), k2 = *(const f32x4*)(p->rnn_conv_w + 1024 + c4),
                        k3 = *(const f32x4*)(p->rnn_conv_w + 1536 + c4), kb = *(const f32x4*)(p->rnn_conv_b + c4);
            auto ld4 = [&](int row) -> f32x4 { const u32x2 w = *(const u32x2*)(raw + row * 512 + c4); f32x4 r; r[0] = bflo(w.x); r[1] = bfhi(w.x); r[2] = bflo(w.y); r[3] = bfhi(w.y); return r; };
            f32x4 xm2 = ld4(16 * tq), xm1 = ld4(16 * tq + 1), x0 = ld4(16 * tq + 2);
#pragma unroll
            for (int t = 0; t < 16; ++t) {
                const f32x4 xp1 = ld4(16 * tq + t + 3);
                const f32x4 o = kb + k0 * xm2 + k1 * xm1 + k2 * x0 + k3 * xp1;
                u32x2 w; w.x = pk2(o[0], o[1]); w.y = pk2(o[2], o[3]);
                *(u32x2*)(xs + (16 * tq + t) * XS + c4) = w;
                xm2 = xm1; xm1 = x0; x0 = xp1;
            }
        }
        __syncthreads();
#pragma unroll 1
        for (int ct = 0; ct < 2; ++ct) {
            float hf[2][16];
            const bool run0 = quarter < 0 || quarter == 2 * ct, run1 = quarter < 0 || quarter == 2 * ct + 1;
            if (quarter >= 0) { if (run0) scan_loadw(p, 0, n, ct, l31, hl, w0); if (run1) scan_loadw(p, 1, n, ct, l31, hl, w1); }
            if (run0) scan_dir<0>(p, xs, w0, w1, 1, ct, quarter < 0, n, ct, l31, hl, id, rowbase, latent, hf);
            if (run1) scan_dir<1>(p, xs, w1, w0, 0, 1, quarter < 0 && ct == 0, n, ct, l31, hl, id, rowbase, latent, hf);
        }
        __syncthreads();
    }
}

__device__ __forceinline__ void carry_phase(PP p, unsigned char* shm, int wv) {
    if (blockIdx.x >= 128) return;
    const int tid = tid_opaque(wv), cl = tid & 15, sg = tid >> 4;
    const int b = blockIdx.x >> 6, dir = (blockIdx.x >> 5) & 1, c = (blockIdx.x & 31) * 16 + cl;
    const float* sumb = (const float*)(p->ws + WS_SUM) + (size_t)dir * NCHUNK * 1024;
    float* car = (float*)(p->ws + WS_CAR) + (size_t)dir * NCHUNK * 512;
    float* segA = (float*)shm; float* segH = segA + 512;
    float A[9], H[9]; int ids[9];
#pragma unroll
    for (int k = 0; k < 9; ++k) {
        const int s = sg * 9 + k;
        int id = -1;
        if (s < 260) { if (dir == 0) id = s < 4 ? 512 + 4 * b + s : 256 * b + (s - 4); else id = s < 4 ? 512 + 4 * b + (3 - s) : 256 * b + (255 - (s - 4)); }
        ids[k] = id;
        A[k] = id >= 0 ? sumb[(size_t)id * 1024 + c] : 1.f;
        H[k] = id >= 0 ? sumb[(size_t)id * 1024 + 512 + c] : 0.f;
    }
    float As = 1.f, Hs = 0.f;
#pragma unroll
    for (int k = 0; k < 9; ++k) { Hs = A[k] * Hs + H[k]; As *= A[k]; }
    segA[sg * 16 + cl] = As; segH[sg * 16 + cl] = Hs;
    __syncthreads();
    float h = 0.f;
    for (int j = 0; j < sg; ++j) h = segA[j * 16 + cl] * h + segH[j * 16 + cl];
#pragma unroll
    for (int k = 0; k < 9; ++k) { if (ids[k] >= 0) car[(size_t)ids[k] * 512 + c] = h; h = A[k] * h + H[k]; }
    __syncthreads();
}

struct MixRow { u32x4 vy, vf, vb, vg, va; f32x4 cf0, cf1, cb0, cb1; };
__device__ __forceinline__ void mix_load(PP p, int r, int c0, MixRow& m) {
    const bf16_t* proj = (const bf16_t*)(p->ws + WS_PROJ);
    const bf16_t* att = (const bf16_t*)(p->ws + WS_ATT);
    const bf16_t* yl = (const bf16_t*)(p->ws + WS_YL); const bf16_t* caf = (const bf16_t*)(p->ws + WS_CAF); const bf16_t* cab = (const bf16_t*)(p->ws + WS_CAB);
    const float* car = (const float*)(p->ws + WS_CAR);
    const int id = r >> 6;
    m.vy = *(const u32x4*)(yl + (size_t)r * 512 + c0); m.vf = *(const u32x4*)(caf + (size_t)r * 512 + c0); m.vb = *(const u32x4*)(cab + (size_t)r * 512 + c0);
    m.vg = *(const u32x4*)(proj + (size_t)r * DIN + 512 + c0); m.va = *(const u32x4*)(att + (size_t)r * 512 + c0);
    const float* cf = car + (size_t)id * 512 + c0; const float* cbk = car + (size_t)(NCHUNK + id) * 512 + c0;
    m.cf0 = *(const f32x4*)cf; m.cf1 = *(const f32x4*)(cf + 4); m.cb0 = *(const f32x4*)cbk; m.cb1 = *(const f32x4*)(cbk + 4);
}
__device__ __forceinline__ void mix_store(PP p, int r, int c0, const MixRow& m, const f32x4 (&gr)[2], const f32x4 (&ga)[2]) {
    bf16_t* mix = (bf16_t*)(p->ws + WS_HB);
    float rn[8], at[8]; float s1 = 0.f, s2 = 0.f;
#pragma unroll
    for (int e = 0; e < 8; ++e) {
        const unsigned wy = m.vy[e >> 1], wf = m.vf[e >> 1], wb = m.vb[e >> 1], wg = m.vg[e >> 1], wa = m.va[e >> 1];
        const float cfe = e < 4 ? m.cf0[e & 3] : m.cf1[e & 3], cbe = e < 4 ? m.cb0[e & 3] : m.cb1[e & 3];
        const float y = ((e & 1) ? bfhi(wy) : bflo(wy)) + ((e & 1) ? bfhi(wf) : bflo(wf)) * cfe + ((e & 1) ? bfhi(wb) : bflo(wb)) * cbe;
        const float xg = (e & 1) ? bfhi(wg) : bflo(wg);
        rn[e] = gelu_tanh_(xg) * y; s1 += rn[e] * rn[e];
        at[e] = (e & 1) ? bfhi(wa) : bflo(wa); s2 += at[e] * at[e];
    }
    const float r1 = rsqrtf(wave_sum(s1) * (1.0f / 512.0f) + EPS), r2 = rsqrtf(wave_sum(s2) * (1.0f / 512.0f) + EPS);
    u32x4 o1, o2;
#pragma unroll
    for (int e2 = 0; e2 < 4; ++e2) {
        o1[e2] = pk2(rn[2 * e2] * r1 * gr[e2 >> 1][(2 * e2) & 3], rn[2 * e2 + 1] * r1 * gr[e2 >> 1][(2 * e2 + 1) & 3]);
        o2[e2] = pk2(at[2 * e2] * r2 * ga[e2 >> 1][(2 * e2) & 3], at[2 * e2 + 1] * r2 * ga[e2 >> 1][(2 * e2 + 1) & 3]);
    }
    *(u32x4*)(mix + (size_t)r * D + c0) = o1; *(u32x4*)(mix + (size_t)r * D + 512 + c0) = o2;
}
__device__ __forceinline__ void mix_phase(PP p, int wv) {
    const int tid_ = tid_opaque(wv), lane = tid_ & 63, gw = blockIdx.x * 8 + (tid_ >> 6), NGW = gridDim.x * 8;
    const int c0 = 8 * lane;
    f32x4 gr[2], ga[2];
    gr[0] = *(const f32x4*)(p->gn_rnn + c0); gr[1] = *(const f32x4*)(p->gn_rnn + c0 + 4); ga[0] = *(const f32x4*)(p->gn_attn + c0); ga[1] = *(const f32x4*)(p->gn_attn + c0 + 4);
    for (int r = gw; r < NLAT; r += 2 * NGW) {
        const int rb = (r + NGW < NLAT) ? r + NGW : r;
        MixRow ma, mb;
        mix_load(p, r, c0, ma); mix_load(p, rb, c0, mb);
        mix_store(p, r, c0, ma, gr, ga);
        if (rb != r) mix_store(p, rb, c0, mb, gr, ga);
    }
}

__device__ __forceinline__ void phase7(PP p, int wv) {
    const int tid_ = tid_opaque(wv), lane = tid_ & 63, gw = blockIdx.x * 8 + (tid_ >> 6), NGW = gridDim.x * 8;
    const float* mod = (const float*)(p->ws + WS_MOD);
    bf16_t* hb = (bf16_t*)(p->ws + WS_HB);
    const bf16_t* o1 = (const bf16_t*)(p->ws + WS_O1);
    int cur = -1; f32x4 gsc[4], gsh[4];
    for (int r = gw; r < NLAT; r += 2 * NGW) {
        const int rb = r + NGW;
        f32x4 va[4], vb[4]; u32x2 da[4], db[4];
        row_load_nt(p->x + (size_t)r * D, lane, va); row_load_nt(p->x + (size_t)rb * D, lane, vb);
#pragma unroll
        for (int j = 0; j < 4; ++j) { da[j] = *(const u32x2*)(o1 + (size_t)r * D + 4 * lane + 256 * j); db[j] = *(const u32x2*)(o1 + (size_t)rb * D + 4 * lane + 256 * j); }
#pragma unroll
        for (int j = 0; j < 4; ++j) {
            va[j][0] += bflo(da[j].x); va[j][1] += bfhi(da[j].x); va[j][2] += bflo(da[j].y); va[j][3] += bfhi(da[j].y);
            vb[j][0] += bflo(db[j].x); vb[j][1] += bfhi(db[j].x); vb[j][2] += bflo(db[j].y); vb[j][3] += bfhi(db[j].y);
        }
        const float sa = row_rstd(va), sb = row_rstd(vb);
        const int ma = r >> 14;
        if (ma != cur) {
            cur = ma;
#pragma unroll
            for (int j = 0; j < 4; ++j) {
                const int c = 4 * lane + 256 * j;
                gsc[j] = *(const f32x4*)(p->norm2_g + c) * (*(const f32x4*)(mod + ma * 6144 + 4096 + c) + 1.0f);
                gsh[j] = *(const f32x4*)(mod + ma * 6144 + 3072 + c);
            }
        }
        bf16_t* da_ = hb + (size_t)(ma * H2_BSTRIDE + 1 + (r & (S - 1))) * D; bf16_t* db_ = hb + (size_t)((rb >> 14) * H2_BSTRIDE + 1 + (rb & (S - 1))) * D;
#pragma unroll
        for (int j = 0; j < 4; ++j) {
            const f32x4 oa = va[j] * sa * gsc[j] + gsh[j], ob = vb[j] * sb * gsc[j] + gsh[j];
            u32x2 wa; wa.x = pk2(oa[0], oa[1]); wa.y = pk2(oa[2], oa[3]); u32x2 wb; wb.x = pk2(ob[0], ob[1]); wb.y = pk2(ob[2], ob[3]);
            *(u32x2*)(da_ + 4 * lane + 256 * j) = wa; if ((rb >> 14) == ma) *(u32x2*)(db_ + 4 * lane + 256 * j) = wb;
        }
        if ((rb >> 14) != ma) { const int mb = rb >> 14; norm_mod_store(vb, sb, p->norm2_g, mod + mb * 6144 + 3072, mod + mb * 6144 + 4096, db_, lane); }
    }
    for (int z = gw; z < 254; z += NGW) {
        const int R = z == 0 ? 0 : (z <= 126 ? S + z : 32895 + (z - 127));
        const u32x4 zz = {0u, 0u, 0u, 0u};
        *(u32x4*)(hb + (size_t)R * D + 8 * lane) = zz; *(u32x4*)(hb + (size_t)R * D + 512 + 8 * lane) = zz;
    }
}

__device__ __forceinline__ void final_phase(PP p, int wv) {
    const int tid_ = tid_opaque(wv), lane = tid_ & 63, gw = blockIdx.x * 8 + (tid_ >> 6), NGW = gridDim.x * 8;
    const bf16_t* o1 = (const bf16_t*)(p->ws + WS_O1); const bf16_t* o2 = (const bf16_t*)(p->ws + WS_O2);
    f32x4 fg[4];
#pragma unroll
    for (int j = 0; j < 4; ++j) fg[j] = *(const f32x4*)(p->final_g + 4 * lane + 256 * j);
    for (int r = gw; r < NLAT; r += 2 * NGW) {
        const int rb = r + NGW;
        f32x4 va[4], vb[4]; u32x2 da[4], db[4], ea[4], eb[4];
        row_load_nt(p->x + (size_t)r * D, lane, va); row_load_nt(p->x + (size_t)rb * D, lane, vb);
#pragma unroll
        for (int j = 0; j < 4; ++j) {
            da[j] = *(const u32x2*)(o1 + (size_t)r * D + 4 * lane + 256 * j); db[j] = *(const u32x2*)(o1 + (size_t)rb * D + 4 * lane + 256 * j);
            ea[j] = *(const u32x2*)(o2 + (size_t)r * D + 4 * lane + 256 * j); eb[j] = *(const u32x2*)(o2 + (size_t)rb * D + 4 * lane + 256 * j);
        }
#pragma unroll
        for (int j = 0; j < 4; ++j) {
            va[j][0] += bflo(da[j].x) + bflo(ea[j].x); va[j][1] += bfhi(da[j].x) + bfhi(ea[j].x); va[j][2] += bflo(da[j].y) + bflo(ea[j].y); va[j][3] += bfhi(da[j].y) + bfhi(ea[j].y);
            vb[j][0] += bflo(db[j].x) + bflo(eb[j].x); vb[j][1] += bfhi(db[j].x) + bfhi(eb[j].x); vb[j][2] += bflo(db[j].y) + bflo(eb[j].y); vb[j][3] += bfhi(db[j].y) + bfhi(eb[j].y);
        }
        const float sa = row_rstd(va), sb = row_rstd(vb);
        float* rowa = p->out + (size_t)r * D; float* rowb = p->out + (size_t)rb * D;
#pragma unroll
        for (int j = 0; j < 4; ++j) { const f32x4 gg = fg[j]; *(f32x4*)(rowa + 4 * lane + 256 * j) = va[j] * sa * gg; *(f32x4*)(rowb + 4 * lane + 256 * j) = vb[j] * sb * gg; }
    }
}

__global__ void __launch_bounds__(512, 2) fwd_megakernel(Params p_arg) {
    extern __shared__ __attribute__((aligned(16))) unsigned char shm[];
    cg::grid_group grid = cg::this_grid();
    LAS unsigned char* lds = (LAS unsigned char*)shm;
    pg8::StaticOrder so;
    const int wv = __builtin_amdgcn_readfirstlane((int)(threadIdx.x >> 6));
    volatile LAS unsigned* xst = (volatile LAS unsigned*)(lds + LDS_XB);
    if (tid_opaque(wv) == 0) { xst[0] = 0u; xst[1] = 0u; }
    __syncthreads();
    (void)xcd_barrier_post((unsigned*)(kparams()->ws + WS_BAR), xst, wv);
#define XBAR() do { XcdBarrier _b; _b.bar = (unsigned*)(kparams()->ws + WS_BAR); _b.x = xb_xcc_id(); _b.st = (volatile LAS unsigned*)(lds + LDS_XB); xcd_barrier(_b, wv); } while (0)
    if (kparams()->out == nullptr) grid.sync();

    phase0(kparams(), shm, wv);
    {
        constexpr int T_IN = (D / 64) * (DIN / 32), T_B = (D / 64) * (D / 32) + (D / 64) * (DUP / 32) + (DFF / 64) * (D / 32), T_LRU = 64;
        const int nfree = (int)gridDim.x > 192 ? (int)gridDim.x - 192 : 0;
        const int first = nfree ? 192 : 0, nblk = nfree ? nfree : (int)gridDim.x;
        if ((int)blockIdx.x >= first) {
            transpose_phase(kparams(), shm, wv, 0, T_IN, ((int)blockIdx.x - first) * 8, nblk * 8);
            transpose_phase(kparams(), shm, wv, T_IN + T_B, T_IN + T_B + T_LRU, ((int)blockIdx.x - first) * 8, nblk * 8);
        }
    }
    XBAR();
    phase1(kparams(), wv);
    XBAR();
    {
        PP p = kparams(); unsigned char* ws = p->ws;
        pg8::Gemm g{(const bf16_t*)(ws + WS_HB), (const bf16_t*)(ws + WS_WIN), MROWS / 256, DIN / 256, D, 256};
        so.init(g.nM, g.nN, gridDim.x, blockIdx.x);
        EpiProj e{(bf16_t*)(ws + WS_PROJ), (const float*)(ws + WS_ROPE), (const float*)(ws + WS_ROPE) + 4096};
        pg8::gemm_phase(lds, g, so, e, wv);
        {
            constexpr int T_IN = (D / 64) * (DIN / 32), T_B = (D / 64) * (D / 32) + (D / 64) * (DUP / 32) + (DFF / 64) * (D / 32);
            const int G = (int)gridDim.x, rem = (g.nM * g.nN) % G;
            const int first = rem ? rem : 0, nblk = G - first;
            if ((int)blockIdx.x >= first) transpose_phase(p, shm, wv, T_IN, T_IN + T_B, ((int)blockIdx.x - first) * 8, nblk * 8);
        }
    }
    XBAR();
    scan_mfma(kparams(), shm, wv);
    attn_mfma(kparams(), shm, wv);
    XBAR();
    carry_phase(kparams(), shm, wv);
    XBAR();
    mix_phase(kparams(), wv);
    XBAR();
    {
        PP p = kparams(); unsigned char* ws = p->ws; const float* mod = (const float*)(ws + WS_MOD);
        pg8::Gemm g{(const bf16_t*)(ws + WS_HB), (const bf16_t*)(ws + WS_WOUT), NLAT / 256, D / 256, D, 256};
        so.init(g.nM, g.nN, gridDim.x, blockIdx.x);
        EpiDelta e{(bf16_t*)(ws + WS_O1), mod + 2048, mod + 6144 + 2048};
        pg8::gemm_phase(lds, g, so, e, wv);
    }
    XBAR();
    phase7(kparams(), wv);
    XBAR();
    {
        PP p = kparams(); unsigned char* ws = p->ws;
        pg8::Gemm g{(const bf16_t*)(ws + WS_HB), (const bf16_t*)(ws + WS_WUP), 130, DUP / 256, D, 254};
        so.init(g.nM, g.nN, gridDim.x, blockIdx.x);
        EpiConvGate e{(bf16_t*)(ws + WS_ACT), p->ffn_conv_w, p->ffn_conv_b, lds + 131072};
        pg8::gemm_phase(lds, g, so, e, wv);
    }
    XBAR();
    {
        PP p = kparams(); unsigned char* ws = p->ws; const float* mod = (const float*)(ws + WS_MOD);
        pg8::Gemm g{(const bf16_t*)(ws + WS_ACT), (const bf16_t*)(ws + WS_WDN), NLAT / 256, D / 256, DFF, 256};
        so.init(g.nM, g.nN, gridDim.x, blockIdx.x);
        EpiDelta e{(bf16_t*)(ws + WS_O2), mod + 5120, mod + 6144 + 5120};
        pg8::gemm_phase(lds, g, so, e, wv);
    }
    XBAR();
    final_phase(kparams(), wv);
}

extern "C" void kernel_launch(void* const* d_in, const int* in_sizes, int n_in, void* d_out, int out_size, void* d_ws, size_t ws_size, hipStream_t stream) {
    static int grid_blocks = 0;
    if (!grid_blocks) {
        int dev = 0, cus = 0, per_cu = 0;
        hipGetDevice(&dev);
        hipDeviceGetAttribute(&cus, hipDeviceAttributeMultiprocessorCount, dev);
        hipFuncSetAttribute((const void*)fwd_megakernel, hipFuncAttributeMaxDynamicSharedMemorySize, LDS_BYTES);
        hipOccupancyMaxActiveBlocksPerMultiprocessor(&per_cu, (const void*)fwd_megakernel, 512, LDS_BYTES);
        if (per_cu < 1) per_cu = 1;
        grid_blocks = cus * per_cu;
        if (ws_size < WS_END) fprintf(stderr, "kernel_launch: workspace too small: %zu < %zu\n", ws_size, (size_t)WS_END);
    }
    Params p{};
    const float** pp = (const float**)&p;
    for (int i = 0; i < 25; ++i) pp[i] = (const float*)d_in[i];
    const size_t ws_off = ws_size > WS_END ? ((ws_size - WS_END) & ~(size_t)4095) : 0;
    p.out = (float*)d_out; p.ws = (unsigned char*)d_ws + ws_off;
    hipMemsetAsync((unsigned char*)d_ws + ws_off + WS_BAR, 0, 16384, stream);
    void* args[] = {&p};
    hipError_t e = hipLaunchCooperativeKernel((const void*)fwd_megakernel, dim3(grid_blocks), dim3(512), args, LDS_BYTES, stream);
    if (e != hipSuccess) fprintf(stderr, "cooperative launch failed: %s (grid %d)\n", hipGetErrorString(e), grid_blocks);
}
```

```cpp
#include <hip/hip_runtime.h>
#include <hip/hip_cooperative_groups.h>
#include <cstdio>
namespace cg = cooperative_groups;

#define LAS __attribute__((address_space(3)))
typedef unsigned short bf16_t;
typedef short bf16x8 __attribute__((ext_vector_type(8)));
typedef float f32x4 __attribute__((ext_vector_type(4)));
typedef unsigned u32x4 __attribute__((ext_vector_type(4)));
typedef unsigned u32x2 __attribute__((ext_vector_type(2)));

constexpr int D = 1024, NB = 2, S = 16384, LC = 256;
constexpr int NLAT = NB * S;
constexpr int NCTX = NB * LC;
constexpr int MROWS = NLAT + NCTX;
constexpr int DIN = 1792, DFF = 2816, DUP = 5632, DRNN = 512;
constexpr int NCHUNK = MROWS / 64;
constexpr float EPS = 1e-6f;

constexpr size_t AL(size_t x) { return (x + 255) & ~(size_t)255; }
constexpr size_t WS_WIN  = 0;
constexpr size_t WS_WOUT = WS_WIN  + AL((size_t)DIN * D * 2);
constexpr size_t WS_WUP  = WS_WOUT + AL((size_t)D * D * 2);
constexpr size_t WS_WDN  = WS_WUP  + AL((size_t)DUP * D * 2);
constexpr size_t WS_LRU  = WS_WDN  + AL((size_t)D * DFF * 2);
constexpr size_t WS_MOD  = WS_LRU  + AL((size_t)4 * 8 * 64 * 64 * 2);
constexpr size_t WS_ROPE = WS_MOD  + AL((size_t)3 * 6144 * 4);
constexpr size_t WS_SUM  = WS_ROPE + AL((size_t)2 * 256 * 16 * 4);
constexpr size_t WS_CAR  = WS_SUM  + AL((size_t)2 * NCHUNK * 2 * 512 * 4);
constexpr size_t WS_SP8  = WS_CAR  + AL((size_t)2 * NCHUNK * 512 * 4);
constexpr size_t WS_BAR  = WS_SP8  + 4096;
constexpr size_t WS_R1   = WS_BAR  + 16384;
constexpr size_t WS_ATT  = WS_R1;
constexpr size_t WS_YL   = WS_ATT  + AL((size_t)NLAT * 512 * 2);
constexpr size_t WS_CAF  = WS_YL   + AL((size_t)NLAT * 512 * 2);
constexpr size_t WS_CAB  = WS_CAF  + AL((size_t)NLAT * 512 * 2);
constexpr size_t WS_PROJ = WS_CAB  + AL((size_t)NLAT * 512 * 2);
constexpr size_t WS_R1END = WS_PROJ + AL((size_t)MROWS * DIN * 2);
constexpr size_t WS_HB   = WS_R1END;
constexpr size_t WS_HBEND = WS_HB + AL((size_t)MROWS * D * 2);
constexpr size_t WS_ACT  = WS_R1;
constexpr size_t WS_O1   = WS_ACT + AL((size_t)NLAT * DFF * 2);
constexpr size_t WS_O2   = WS_HB;
constexpr size_t WS_END  = WS_HBEND;
static_assert(WS_O1 + (size_t)NLAT * D * 2 <= WS_R1END, "o1");
static_assert(WS_ACT + (size_t)NLAT * DFF * 2 <= WS_R1END, "act");
constexpr int H2_BSTRIDE = 65 * 254;
constexpr int H2_ROWS = 130 * 254 + 2;
static_assert((size_t)H2_ROWS * D * 2 <= (size_t)MROWS * D * 2, "h2");

constexpr int LDS_BYTES = 131072 + 8192 + 256;
constexpr int LDS_XB = 131072 + 8192;

struct Params {
    const float *x, *c, *ctx, *c_ctx, *w_mod, *b_mod, *norm1_g, *w_in, *rnn_conv_w, *rnn_conv_b, *lru_w_a, *lru_b_a,
        *lru_w_i, *lru_b_i, *lru_lam, *attn_sink, *gn_rnn, *gn_attn, *w_out, *norm2_g, *w_up, *ffn_conv_w, *ffn_conv_b,
        *w_down, *final_g;
    float* out;
    unsigned char* ws;
};

typedef const Params __attribute__((address_space(4)))* PP;
__device__ __forceinline__ PP kparams() { PP k = (PP)__builtin_amdgcn_kernarg_segment_ptr(); asm volatile("" : "+s"(k)); return k; }
__device__ __forceinline__ int lane_fresh() { unsigned m = ~0u; asm volatile("" : "+s"(m)); return (int)__builtin_amdgcn_mbcnt_hi(m, __builtin_amdgcn_mbcnt_lo(m, 0u)); }
__device__ __forceinline__ int tid_opaque(int wv) { return wv * 64 + lane_fresh(); }
__device__ __forceinline__ bf16_t f2bf(float f) { unsigned u = __float_as_uint(f); u += 0x7FFFu + ((u >> 16) & 1u); return (bf16_t)(u >> 16); }
__device__ __forceinline__ float bf2f(bf16_t b) { return __uint_as_float(((unsigned)b) << 16); }
__device__ __forceinline__ unsigned pk2(float lo, float hi) { unsigned r; asm("v_cvt_pk_bf16_f32 %0, %1, %2" : "=v"(r) : "v"(lo), "v"(hi)); return r; }
__device__ __forceinline__ float bflo(unsigned w) { return __uint_as_float(w << 16); }
__device__ __forceinline__ float bfhi(unsigned w) { return __uint_as_float(w & 0xFFFF0000u); }
__device__ __forceinline__ float wave_sum(float v) {
#pragma unroll
    for (int o = 32; o >= 1; o >>= 1) v += __shfl_xor(v, o);
    return v;
}
__device__ __forceinline__ float wave_max(float v) {
#pragma unroll
    for (int o = 32; o >= 1; o >>= 1) v = fmaxf(v, __shfl_xor(v, o));
    return v;
}
__device__ __forceinline__ float sigmoidf_(float x) { return 1.0f / (1.0f + __expf(-x)); }
__device__ __forceinline__ float fast_sigmoid(float x) { return __builtin_amdgcn_rcpf(1.0f + __builtin_amdgcn_exp2f(-1.4426950408889634f * x)); }
__device__ __forceinline__ float silu_(float x) { return x * fast_sigmoid(x); }
__device__ __forceinline__ float gelu_tanh_(float x) {
    const float u = 0.7978845608028654f * (x + 0.044715f * x * x * x);
    const float e = __builtin_amdgcn_exp2f(2.8853900817779268f * u);
    const float th = 1.0f - 2.0f * __builtin_amdgcn_rcpf(e + 1.0f);
    return 0.5f * x * (1.0f + th);
}


#define XB_TMO      128
#define XB_XCNT(j)  (256  + 64 * (j))
#define XB_XSUB(j)  (1280 + 64 * (j))
#define XB_XGEN(j)  (2304 + 64 * (j))
#define XB_TOP      3328
#define XB_TOPGEN   3392
#define XCD_BAR_WORDS 3456
#define XB_SPIN_CAP (1u << 20)
__device__ __forceinline__ unsigned xb_ld(unsigned* p)              { return __hip_atomic_load(p, __ATOMIC_RELAXED, __HIP_MEMORY_SCOPE_AGENT); }
__device__ __forceinline__ unsigned xb_add(unsigned* p, unsigned v) { return __hip_atomic_fetch_add(p, v, __ATOMIC_RELAXED, __HIP_MEMORY_SCOPE_AGENT); }
__device__ __forceinline__ unsigned xb_xcc_id() { return (unsigned)__builtin_amdgcn_s_getreg((3 << 11) | 20) & 0xFu; }
#define XB_SPIN(cond, bar) do { unsigned _sp = 0; while (cond) { __builtin_amdgcn_s_sleep(1); \
    if ((++_sp & 255u) == 0u) { if (xb_ld(&(bar)[XB_TMO])) break; if (_sp > XB_SPIN_CAP) { atomicAdd(&(bar)[XB_TMO], 1u); break; } } } } while (0)
struct XcdBarrier { unsigned* bar; unsigned x; volatile LAS unsigned* st; };
__device__ __forceinline__ XcdBarrier xcd_barrier_post(unsigned* bar, volatile LAS unsigned* st, int wv) {
    XcdBarrier b; b.bar = bar; b.x = xb_xcc_id(); b.st = st;
    if (tid_opaque(wv) == 0) (void)xb_add(&bar[XB_XCNT(b.x)], 1u);
    return b;
}
__device__ __forceinline__ void xcd_barrier_complete(unsigned* bar, unsigned x, unsigned& nloc, unsigned& nx) {
    const unsigned G = gridDim.x * gridDim.y * gridDim.z;
    unsigned sum, cnt, mine, sp = 0u;
    for (;;) {
        sum = 0u; cnt = 0u; mine = 0u;
#pragma unroll
        for (unsigned j = 0; j < 16; ++j) { const unsigned c = xb_ld(&bar[XB_XCNT(j)]); sum += c; cnt += (c > 0u) ? 1u : 0u; mine = (j == x) ? c : mine; }
        if (sum == G) break;
        __builtin_amdgcn_s_sleep(1);
        if ((++sp & 255u) == 0u) { if (xb_ld(&bar[XB_TMO])) break; if (sp > XB_SPIN_CAP) { atomicAdd(&bar[XB_TMO], 1u); break; } }
    }
    nloc = mine > 0u ? mine : 1u; nx = cnt > 0u ? cnt : 1u;
}
__device__ __forceinline__ void xcd_barrier(const XcdBarrier& b, int wv) {
    asm volatile("s_waitcnt vmcnt(0)" ::: "memory");
    __syncthreads();
    if (tid_opaque(wv) == 0) {
        unsigned* bar = b.bar;
        __builtin_amdgcn_s_waitcnt(0);
        unsigned nloc = b.st[0], nx = b.st[1];
        if (nloc == 0u) { xcd_barrier_complete(bar, b.x, nloc, nx); b.st[0] = nloc; b.st[1] = nx; }
        const unsigned old = xb_add(&bar[XB_XSUB(b.x)], 1u);
        const unsigned gen = old / nloc;
        if (old + 1u == (gen + 1u) * nloc) {
            __builtin_amdgcn_fence(__ATOMIC_RELEASE, "agent");
            asm volatile("s_waitcnt vmcnt(0)" ::: "memory");
            const unsigned og = xb_add(&bar[XB_TOP], 1u);
            const unsigned tg = og / nx;
            if (og + 1u == (tg + 1u) * nx) xb_add(&bar[XB_TOPGEN], 1u);
            else XB_SPIN(xb_ld(&bar[XB_TOPGEN]) == tg, bar);
            __builtin_amdgcn_fence(__ATOMIC_ACQUIRE, "agent");
            xb_add(&bar[XB_XGEN(b.x)], 1u);
            asm volatile("s_waitcnt vmcnt(0)" ::: "memory");
        } else {
            XB_SPIN(xb_ld(&bar[XB_XGEN(b.x)]) == gen, bar);
            __builtin_amdgcn_fence(__ATOMIC_ACQUIRE, "agent");
            asm volatile("s_waitcnt vmcnt(0)" ::: "memory");
        }
    }
    __syncthreads();
}

namespace pg8 {
constexpr int BM = 256, BK = 64, HALF = 128, HTB = HALF * BK * 2, NXCD = 8, WGM = 4;
__host__ __device__ __forceinline__ int lds_byte(int r, int c) { const int st = (r >> 4) * 2 + (c >> 5), rr = r & 15, cc = c & 31, ob = rr * 64 + cc * 2; return st * 1024 + (ob ^ (((ob >> 9) & 1) << 5)); }
__host__ __device__ __forceinline__ void stage_rc(int b, int& R, int& C) { const int st = b / 1024, sb = b % 1024, swz = sb ^ (((sb >> 9) & 1) << 5); R = (st >> 1) * 16 + swz / 64; C = (st & 1) * 32 + (swz % 64) / 2; }
struct Unit { int pm, pn; };
struct Gemm { const bf16_t* A; const bf16_t* Bt; int nM, nN, K, a_tile_rows; };
struct StaticOrder {
    int nM, nN, nwg, G, c;
    __device__ void init(int nM_, int nN_, int G_, int c_) { nM = nM_; nN = nN_; nwg = nM * nN; G = G_; c = c_; }
    __device__ bool next(int i, Unit& u) const {
        const long L = (long)i * G + c; if (L >= nwg) return false;
        int wgid = (int)L; { const int q = nwg / NXCD, r = nwg % NXCD, xcd = wgid % NXCD, off = wgid / NXCD; wgid = (xcd < r ? xcd * (q + 1) : r * (q + 1) + (xcd - r) * q) + off; }
        const int nig = WGM * nN, gid = wgid / nig, fm = gid * WGM, gsz = (nM - fm) < WGM ? (nM - fm) : WGM;
        u.pm = fm + ((wgid % nig) % gsz); u.pn = (wgid % nig) / gsz; return true;
    }
};
template <class Epi>
__device__ __forceinline__ void gemm_phase(LAS unsigned char* lds, const Gemm g, const StaticOrder& S, const Epi& E, int wv) {
    const int tid = tid_opaque(wv);
    const int wid = __builtin_amdgcn_readfirstlane(tid >> 6), lane = tid & 63, wr = wid >> 2, wc = wid & 3, fr = lane & 15, fq = lane >> 4;
    const int K = g.K, nt = K / BK;
    unsigned voffA[2], voffB[2];
#pragma unroll
    for (int i = 0; i < 2; ++i) { int R, C; stage_rc(tid * 16 + i * 8192, R, C);
        const int Ra = (R & ~63) + 4 * (R & 15) + ((R >> 4) & 3);
        voffA[i] = (unsigned)(Ra * K + C) * 2u; voffB[i] = (unsigned)(R * K + C) * 2u; }
    const size_t kstep = (size_t)(BK * 2);
    const size_t hstep = (size_t)HALF * K * 2;
    const size_t tstepA = (size_t)g.a_tile_rows * K * 2;
    const size_t tstepB = 2 * hstep;
    const unsigned ldsw = (unsigned)wid * 1024u;
    const int aoff = lds_byte(wr * 64 + fr, fq * 8), boff = lds_byte(wc * 32 + fr, fq * 8);
#define PG8_SA(b, h) (((b) * 2 + (h)) * HTB)
#define PG8_SB(b, h) ((4 + (b) * 2 + (h)) * HTB)
#define PG8_STAGE(bufoff, gbase, voff) do { _Pragma("unroll") for (int _i = 0; _i < 2; ++_i) \
        __builtin_amdgcn_global_load_lds((const unsigned*)((const char*)(gbase) + (voff)[_i]), (LAS unsigned*)(lds + (bufoff) + ldsw + _i * 8192), 16, 0, 0); } while (0)
#define PG8_LDA(dst, b, h) do { _Pragma("unroll") for (int m = 0; m < 4; ++m) _Pragma("unroll") for (int k = 0; k < 2; ++k) dst[m][k] = *(const LAS bf16x8*)(lds + PG8_SA(b, h) + aoff + m * 2048 + k * 1024); } while (0)
#define PG8_LDB(dst, b, h) do { _Pragma("unroll") for (int n = 0; n < 2; ++n) _Pragma("unroll") for (int k = 0; k < 2; ++k) dst[n][k] = *(const LAS bf16x8*)(lds + PG8_SB(b, h) + boff + n * 2048 + k * 1024); } while (0)
#define PG8_MMA(ai, bj, At, Bt) do { __builtin_amdgcn_s_setprio(1); _Pragma("unroll") for (int m = 0; m < 4; ++m) _Pragma("unroll") for (int n = 0; n < 2; ++n) _Pragma("unroll") for (int k = 0; k < 2; ++k) \
        acc[ai][bj][m][n] = __builtin_amdgcn_mfma_f32_16x16x32_bf16(Bt[n][k], At[m][k], acc[ai][bj][m][n], 0, 0, 0); __builtin_amdgcn_s_setprio(0); } while (0)
#define PG8_WAIT_V(n) asm volatile("s_waitcnt vmcnt(" #n ")" ::: "memory")
#define PG8_WAIT_L(n) asm volatile("s_waitcnt lgkmcnt(" #n ")" ::: "memory")
#define PG8_BAR __builtin_amdgcn_s_barrier()
#define PG8_SCHED __builtin_amdgcn_sched_barrier(0)
    Unit cur, nxt; int ui = 0;
    if (!S.next(0, cur)) return;
    f32x4 acc[2][2][4][2];
#pragma unroll
    for (int a = 0; a < 2; ++a)
#pragma unroll
        for (int b = 0; b < 2; ++b)
#pragma unroll
            for (int m = 0; m < 4; ++m)
#pragma unroll
                for (int n = 0; n < 2; ++n) acc[a][b][m][n] = (f32x4){0.f, 0.f, 0.f, 0.f};
    bf16x8 At[4][2], B0[2][2], B1[2][2];
    const char* cA = (const char*)g.A + (size_t)cur.pm * tstepA; const char* cB = (const char*)g.Bt + (size_t)cur.pn * tstepB;
    PG8_STAGE(PG8_SB(0, 0), cB, voffB); PG8_STAGE(PG8_SA(0, 0), cA, voffA); PG8_STAGE(PG8_SB(0, 1), cB + hstep, voffB); PG8_STAGE(PG8_SA(0, 1), cA + hstep, voffA);
    if (wr == 1) PG8_BAR;
    PG8_WAIT_V(4); PG8_BAR;
    PG8_STAGE(PG8_SB(1, 0), cB + kstep, voffB); PG8_STAGE(PG8_SA(1, 0), cA + kstep, voffA); PG8_STAGE(PG8_SB(1, 1), cB + hstep + kstep, voffB);
    PG8_WAIT_V(6); PG8_BAR;
    for (;;) {
        const bool has_next = S.next(ui + 1, nxt);
        const char* nA = has_next ? (const char*)g.A + (size_t)nxt.pm * tstepA : cA; const char* nB = has_next ? (const char*)g.Bt + (size_t)nxt.pn * tstepB : cB;
        for (int t = 0; t < nt; t += 2) {
            const bool last = (t == nt - 2);
            const char* a1 = cA + (size_t)(t + 1) * kstep;
            const char* a2 = last ? nA : cA + (size_t)(t + 2) * kstep; const char* b2 = last ? nB : cB + (size_t)(t + 2) * kstep;
            const char* a3 = a2 + kstep; const char* b3 = b2 + kstep;
            PG8_LDB(B0, 0, 0); PG8_SCHED; PG8_LDA(At, 0, 0); PG8_STAGE(PG8_SA(1, 1), a1 + hstep, voffA);
            PG8_WAIT_L(8); PG8_BAR; PG8_WAIT_L(0); PG8_MMA(0, 0, At, B0); PG8_BAR; PG8_SCHED;
            PG8_LDB(B1, 0, 1); PG8_STAGE(PG8_SB(0, 0), b2, voffB);
            PG8_BAR; PG8_WAIT_L(0); PG8_MMA(0, 1, At, B1); PG8_BAR;
            PG8_LDA(At, 0, 1); PG8_STAGE(PG8_SA(0, 0), a2, voffA);
            PG8_BAR; PG8_WAIT_L(0); PG8_MMA(1, 0, At, B0); PG8_BAR; PG8_SCHED;
            PG8_STAGE(PG8_SB(0, 1), b2 + hstep, voffB);
            PG8_WAIT_V(6); PG8_BAR; PG8_MMA(1, 1, At, B1); PG8_BAR;
            PG8_LDB(B0, 1, 0); PG8_SCHED; PG8_LDA(At, 1, 0); PG8_STAGE(PG8_SA(0, 1), a2 + hstep, voffA);
            PG8_WAIT_L(8); PG8_BAR; PG8_WAIT_L(0); PG8_MMA(0, 0, At, B0); PG8_BAR; PG8_SCHED;
            PG8_LDB(B1, 1, 1); PG8_STAGE(PG8_SB(1, 0), b3, voffB);
            PG8_BAR; PG8_WAIT_L(0); PG8_MMA(0, 1, At, B1); PG8_BAR;
            PG8_LDA(At, 1, 1); PG8_STAGE(PG8_SA(1, 0), a3, voffA);
            PG8_BAR; PG8_WAIT_L(0); PG8_MMA(1, 0, At, B0); PG8_BAR; PG8_SCHED;
            PG8_STAGE(PG8_SB(1, 1), b3 + hstep, voffB);
            PG8_WAIT_V(6); PG8_BAR; PG8_MMA(1, 1, At, B1); PG8_BAR;
        }
        { const int ln2 = lane_fresh();
          E(acc, cur, wr, wc, ln2 & 15, ln2 >> 4); }
        if (!has_next) break;
#pragma unroll
        for (int a = 0; a < 2; ++a)
#pragma unroll
            for (int b = 0; b < 2; ++b)
#pragma unroll
                for (int m = 0; m < 4; ++m)
#pragma unroll
                    for (int n = 0; n < 2; ++n) acc[a][b][m][n] = (f32x4){0.f, 0.f, 0.f, 0.f};
        cur = nxt; cA = nA; cB = nB; ++ui;
    }
    PG8_WAIT_V(0);
    if (wr == 0) PG8_BAR;
    PG8_BAR;
#undef PG8_SA
#undef PG8_SB
#undef PG8_STAGE
#undef PG8_LDA
#undef PG8_LDB
#undef PG8_MMA
#undef PG8_WAIT_V
#undef PG8_WAIT_L
#undef PG8_BAR
#undef PG8_SCHED
}
}
using pg8::Unit;

struct EpiProj {
    bf16_t* O; const float* cosT; const float* sinT;
    __device__ __forceinline__ void operator()(const f32x4 (&acc)[2][2][4][2], const Unit& u, int wr, int wc, int fr, int fq) const {
        const bool latent = u.pm < 128;
#pragma unroll
        for (int ai = 0; ai < 2; ++ai)
#pragma unroll
            for (int m = 0; m < 4; ++m) {
                const int row = u.pm * 256 + ai * 128 + wr * 64 + 4 * fr + m;
                const int t = row & (S - 1);
                const int pos = (wc & 1) ? (t & 63) : (t >> 6);
#pragma unroll
                for (int bj = 0; bj < 2; ++bj) {
                    const int col = u.pn * 256 + bj * 128 + wc * 32 + 4 * fq;
                    f32x4 v0 = acc[ai][bj][m][0], v1 = acc[ai][bj][m][1];
                    const bool rope = latent && (u.pn == 4 || u.pn == 5 || (u.pn == 6 && bj == 0));
                    if (rope) {
                        const f32x4 cs = *(const f32x4*)(cosT + pos * 16 + 4 * fq), sn = *(const f32x4*)(sinT + pos * 16 + 4 * fq);
                        const f32x4 n0 = v0 * cs - v1 * sn, n1 = v1 * cs + v0 * sn; v0 = n0; v1 = n1;
                    }
                    bf16_t* p = O + (size_t)row * DIN + col;
                    u32x2 w0, w1; w0.x = pk2(v0[0], v0[1]); w0.y = pk2(v0[2], v0[3]); w1.x = pk2(v1[0], v1[1]); w1.y = pk2(v1[2], v1[3]);
                    *(u32x2*)p = w0; *(u32x2*)(p + 16) = w1;
                }
            }
    }
};
struct EpiDelta {
    bf16_t* O; const float* gate0; const float* gate1;
    __device__ __forceinline__ void operator()(const f32x4 (&acc)[2][2][4][2], const Unit& u, int wr, int wc, int fr, int fq) const {
        const float* gate = (u.pm >= 64) ? gate1 : gate0;
        f32x4 gv[2][2];
#pragma unroll
        for (int bj = 0; bj < 2; ++bj)
#pragma unroll
            for (int n = 0; n < 2; ++n) gv[bj][n] = *(const f32x4*)(gate + u.pn * 256 + bj * 128 + wc * 32 + n * 16 + 4 * fq);
#pragma unroll
        for (int ai = 0; ai < 2; ++ai)
#pragma unroll
            for (int m = 0; m < 4; ++m) {
                const size_t row = (size_t)u.pm * 256 + ai * 128 + wr * 64 + 4 * fr + m;
#pragma unroll
                for (int bj = 0; bj < 2; ++bj)
#pragma unroll
                    for (int n = 0; n < 2; ++n) {
                        const f32x4 v = gv[bj][n] * acc[ai][bj][m][n];
                        u32x2 w; w.x = pk2(v[0], v[1]); w.y = pk2(v[2], v[3]);
                        *(u32x2*)(O + row * D + u.pn * 256 + bj * 128 + wc * 32 + n * 16 + 4 * fq) = w;
                    }
            }
    }
};

__device__ __forceinline__ float dpp_ror1(float v)  { return __int_as_float(__builtin_amdgcn_update_dpp(0, __float_as_int(v), 0x121, 0xF, 0xF, true)); }
__device__ __forceinline__ float dpp_ror15(float v) { return __int_as_float(__builtin_amdgcn_update_dpp(0, __float_as_int(v), 0x12F, 0xF, 0xF, true)); }
__device__ __forceinline__ float dpp_shr1(float v)  { return __int_as_float(__builtin_amdgcn_update_dpp(0, __float_as_int(v), 0x111, 0xF, 0xF, true)); }
__device__ __forceinline__ float dpp_shl1(float v)  { return __int_as_float(__builtin_amdgcn_update_dpp(0, __float_as_int(v), 0x101, 0xF, 0xF, true)); }

#define DPP_FMAC4X2(C, SA, WA, CTRLA, SB, WB, CTRLB) do { float _c0 = (C)[0], _c1 = (C)[1], _c2 = (C)[2], _c3 = (C)[3]; \
    asm("s_nop 1\n\t" \
        "v_fmac_f32_dpp %0, %4, %8 " CTRLA " row_mask:0xf bank_mask:0xf bound_ctrl:1\n\t" \
        "v_fmac_f32_dpp %1, %5, %9 " CTRLA " row_mask:0xf bank_mask:0xf bound_ctrl:1\n\t" \
        "v_fmac_f32_dpp %2, %6, %10 " CTRLA " row_mask:0xf bank_mask:0xf bound_ctrl:1\n\t" \
        "v_fmac_f32_dpp %3, %7, %11 " CTRLA " row_mask:0xf bank_mask:0xf bound_ctrl:1\n\t" \
        "v_fmac_f32_dpp %0, %12, %16 " CTRLB " row_mask:0xf bank_mask:0xf bound_ctrl:1\n\t" \
        "v_fmac_f32_dpp %1, %13, %17 " CTRLB " row_mask:0xf bank_mask:0xf bound_ctrl:1\n\t" \
        "v_fmac_f32_dpp %2, %14, %18 " CTRLB " row_mask:0xf bank_mask:0xf bound_ctrl:1\n\t" \
        "v_fmac_f32_dpp %3, %15, %19 " CTRLB " row_mask:0xf bank_mask:0xf bound_ctrl:1" \
        : "+v"(_c0), "+v"(_c1), "+v"(_c2), "+v"(_c3) \
        : "v"((SA)[0]), "v"((SA)[1]), "v"((SA)[2]), "v"((SA)[3]), "v"((WA)[0]), "v"((WA)[1]), "v"((WA)[2]), "v"((WA)[3]), \
          "v"((SB)[0]), "v"((SB)[1]), "v"((SB)[2]), "v"((SB)[3]), "v"((WB)[0]), "v"((WB)[1]), "v"((WB)[2]), "v"((WB)[3])); \
    (C)[0] = _c0; (C)[1] = _c1; (C)[2] = _c2; (C)[3] = _c3; } while (0)
#define DPP_FMAC4(C, SA, WA, CTRLA) do { float _c0 = (C)[0], _c1 = (C)[1], _c2 = (C)[2], _c3 = (C)[3]; \
    asm("s_nop 1\n\t" \
        "v_fmac_f32_dpp %0, %4, %8 " CTRLA " row_mask:0xf bank_mask:0xf bound_ctrl:1\n\t" \
        "v_fmac_f32_dpp %1, %5, %9 " CTRLA " row_mask:0xf bank_mask:0xf bound_ctrl:1\n\t" \
        "v_fmac_f32_dpp %2, %6, %10 " CTRLA " row_mask:0xf bank_mask:0xf bound_ctrl:1\n\t" \
        "v_fmac_f32_dpp %3, %7, %11 " CTRLA " row_mask:0xf bank_mask:0xf bound_ctrl:1" \
        : "+v"(_c0), "+v"(_c1), "+v"(_c2), "+v"(_c3) \
        : "v"((SA)[0]), "v"((SA)[1]), "v"((SA)[2]), "v"((SA)[3]), "v"((WA)[0]), "v"((WA)[1]), "v"((WA)[2]), "v"((WA)[3])); \
    (C)[0] = _c0; (C)[1] = _c1; (C)[2] = _c2; (C)[3] = _c3; } while (0)
struct EpiConvGate {
    bf16_t* act; const float* cw; const float* cbias; LAS unsigned char* xl;
    __device__ __forceinline__ void operator()(const f32x4 (&acc)[2][2][4][2], const Unit& u, int wr, int wc, int fr, int fq) const {
        if (wr == 0) { __builtin_amdgcn_s_barrier(); } asm volatile("" ::: "memory");
        LAS float* X = (LAS float*)xl;
        f32x4 wq[2][2][4];
#define CG_LOADW(N) do { _Pragma("unroll") for (int bj = 0; bj < 2; ++bj) { const int ch = 128 * u.pn + 32 * wc + 16 * (N) + 4 * fq + bj * DFF; \
            wq[N][bj][0] = *(const f32x4*)(cw + ch); wq[N][bj][1] = *(const f32x4*)(cw + DUP + ch); wq[N][bj][2] = *(const f32x4*)(cw + 2 * DUP + ch); wq[N][bj][3] = *(const f32x4*)(cbias + ch); } } while (0)
        CG_LOADW(0);
#pragma unroll
        for (int ai = 0; ai < 2; ++ai) {
            const int s = 2 * ai + wr;
            if (fr == 0) {
#pragma unroll
                for (int bj = 0; bj < 2; ++bj)
#pragma unroll
                    for (int n = 0; n < 2; ++n) *(LAS f32x4*)(X + ((s * 2 + 0) * 2 + bj) * 128 + 32 * wc + 16 * n + 4 * fq) = acc[ai][bj][0][n];
            }
            if (fr == 15) {
#pragma unroll
                for (int bj = 0; bj < 2; ++bj)
#pragma unroll
                    for (int n = 0; n < 2; ++n) *(LAS f32x4*)(X + ((s * 2 + 1) * 2 + bj) * 128 + 32 * wc + 16 * n + 4 * fq) = acc[ai][bj][3][n];
            }
        }
        asm volatile("s_waitcnt lgkmcnt(0)" ::: "memory");
        __builtin_amdgcn_s_barrier(); asm volatile("" ::: "memory");
#pragma unroll
        for (int n = 0; n < 2; ++n) {
            const int chg = 128 * u.pn + 32 * wc + 16 * n + 4 * fq;
            if (n == 1) CG_LOADW(1);
            f32x4 w0[2], w1[2], w2[2], bb[2], w0m[2], w2m[2];
#pragma unroll
            for (int bj = 0; bj < 2; ++bj) {
                w0[bj] = wq[n][bj][0]; w1[bj] = wq[n][bj][1]; w2[bj] = wq[n][bj][2]; bb[bj] = wq[n][bj][3];
                w0m[bj] = (fr == 0) ? w0[bj] : (f32x4){0.f, 0.f, 0.f, 0.f}; w2m[bj] = (fr == 15) ? w2[bj] : (f32x4){0.f, 0.f, 0.f, 0.f};
            }
#pragma unroll
            for (int ai = 0; ai < 2; ++ai) {
                const int s = 2 * ai + wr;
                f32x4 xp[2], xn[2];
#pragma unroll
                for (int bj = 0; bj < 2; ++bj) {
                    xp[bj] = *(const LAS f32x4*)(X + ((((s + 3) & 3) * 2 + 1) * 2 + bj) * 128 + 32 * wc + 16 * n + 4 * fq);
                    xn[bj] = *(const LAS f32x4*)(X + ((((s + 1) & 3) * 2 + 0) * 2 + bj) * 128 + 32 * wc + 16 * n + 4 * fq);
                }
                f32x4 cvv[4][2];
#pragma unroll
                for (int bj = 0; bj < 2; ++bj) {
                    const f32x4 a0 = acc[ai][bj][0][n], a1 = acc[ai][bj][1][n], a2 = acc[ai][bj][2][n], a3 = acc[ai][bj][3][n];
                    f32x4 c0 = bb[bj] + w1[bj] * a0 + w2[bj] * a1 + w0m[bj] * xp[bj];
                    f32x4 c1 = bb[bj] + w1[bj] * a1 + w0[bj] * a0 + w2[bj] * a2;
                    f32x4 c2 = bb[bj] + w1[bj] * a2 + w0[bj] * a1 + w2[bj] * a3;
                    f32x4 c3 = bb[bj] + w1[bj] * a3 + w0[bj] * a2 + w2m[bj] * xn[bj];
                    DPP_FMAC4(c0, a3, w0[bj], "row_shr:1");
                    DPP_FMAC4(c3, a0, w2[bj], "row_shl:1");
                    cvv[0][bj] = c0; cvv[1][bj] = c1; cvv[2][bj] = c2; cvv[3][bj] = c3;
                }
#pragma unroll
                for (int m = 0; m < 4; ++m) {
                    const int lr = 128 * ai + 64 * wr + 4 * fr + m;
                    const int R = 254 * u.pm + lr;
                    const int b = R >= (H2_BSTRIDE + 1) ? 1 : 0;
                    const int t = R - 1 - H2_BSTRIDE * b;
                    const bool valid = lr >= 1 && lr <= 254 && t >= 0 && t < S;
                    if (valid) {
                        u32x2 w;
                        w.x = pk2(silu_(cvv[m][0][0]) * cvv[m][1][0], silu_(cvv[m][0][1]) * cvv[m][1][1]);
                        w.y = pk2(silu_(cvv[m][0][2]) * cvv[m][1][2], silu_(cvv[m][0][3]) * cvv[m][1][3]);
                        *(u32x2*)(act + (size_t)(b * S + t) * DFF + chg) = w;
                    }
                }
            }
        }
        asm volatile("" ::: "memory"); if (wr == 1) { __builtin_amdgcn_s_barrier(); }
    }
};

#undef CG_LOADW
__device__ __forceinline__ void transpose_item(const float* W, int N, int k0, int n0, bf16_t* dst, int Kd, float* scr, int lane) {
#pragma unroll 16
    for (int i = 0; i < 32; ++i) { const int kk = 2 * i + (lane >> 5); scr[kk * 33 + (lane & 31)] = __builtin_nontemporal_load(W + (size_t)(k0 + kk) * N + n0 + (lane & 31)); }
    __builtin_amdgcn_wave_barrier();
    const int c = lane & 7;
#pragma unroll
    for (int j = 0; j < 4; ++j) {
        const int n = (lane >> 3) + 8 * j; const float* s = scr + (8 * c) * 33 + n;
        u32x4 o; o.x = pk2(s[0], s[33]); o.y = pk2(s[2 * 33], s[3 * 33]); o.z = pk2(s[4 * 33], s[5 * 33]); o.w = pk2(s[6 * 33], s[7 * 33]);
        *(u32x4*)(dst + (size_t)n * Kd + k0 + 8 * c) = o;
    }
    __builtin_amdgcn_wave_barrier();
}

__device__ __forceinline__ void phase0(PP p, unsigned char* shm, int wv) {
    const int tid = tid_opaque(wv), lane = tid & 63, wave = tid >> 6;
    unsigned char* ws = p->ws;
    if (blockIdx.x < 192) {
        float* sv = (float*)shm;
        float* red = sv + 3 * 1024;
        for (int i = tid; i < 3 * 1024; i += 512) {
            const int j = i >> 10, k = i & 1023;
            const float v = (j < 2) ? p->c[j * 1024 + k] : p->c_ctx[k];
            sv[i] = silu_(v);
        }
        __syncthreads();
        const int n0 = blockIdx.x * 32, col = tid & 31, ks = tid >> 5;
        float a0 = 0.f, a1 = 0.f, a2 = 0.f;
        const float* wp = p->w_mod + (size_t)(ks * 64) * 6144 + n0 + col;
#pragma unroll
        for (int k = 0; k < 64; ++k) {
            const float w = __builtin_nontemporal_load(wp + (size_t)k * 6144);
            a0 += sv[ks * 64 + k] * w; a1 += sv[1024 + ks * 64 + k] * w; a2 += sv[2048 + ks * 64 + k] * w;
        }
        red[(ks * 3 + 0) * 32 + col] = a0; red[(ks * 3 + 1) * 32 + col] = a1; red[(ks * 3 + 2) * 32 + col] = a2;
        __syncthreads();
        if (tid < 96) {
            const int j = tid >> 5, cc = tid & 31; float s = p->b_mod[n0 + cc];
            for (int k = 0; k < 16; ++k) s += red[(k * 3 + j) * 32 + cc];
            ((float*)(ws + WS_MOD))[j * 6144 + n0 + cc] = s;
        }
        __syncthreads();
    }
    if (blockIdx.x == 200) { for (int i = tid; i < 1024; i += 512) ((float*)(ws + WS_SP8))[i] = -8.0f * log1pf(expf(-p->lru_lam[i])); }
    if (blockIdx.x >= 192 && blockIdx.x < 200) {
        const int idx = (blockIdx.x - 192) * 512 + tid;
        const int pos = idx >> 4, i = idx & 15;
        const float inv = powf(10000.0f, -(float)i / 16.0f);
        const float ang = (float)pos * inv;
        ((float*)(ws + WS_ROPE))[idx] = cosf(ang);
        ((float*)(ws + WS_ROPE))[4096 + idx] = sinf(ang);
    }
}
__device__ __forceinline__ void transpose_phase(PP p, unsigned char* shm, int wv, int it_lo, int it_hi, int gw0, int NGW) {
    const int tid = tid_opaque(wv), lane = tid & 63, wave = wv;
    unsigned char* ws = p->ws;
    float* scr = (float*)(shm + 32768) + wave * (64 * 33);
    const int gw = gw0 + wave;
    constexpr int I_IN = (D / 64) * (DIN / 32), I_OUT = (D / 64) * (D / 32), I_UP = (D / 64) * (DUP / 32), I_DN = (DFF / 64) * (D / 32), I_LRU = 2 * 2 * 8 * 2;
    constexpr int NIT = I_IN + I_OUT + I_UP + I_DN + I_LRU;
    (void)NIT;
    for (int it = it_lo + gw; it < it_hi; it += NGW) {
        int r = it;
        if (r >= I_IN + I_OUT + I_UP + I_DN + I_LRU) continue;
        if (r < I_IN) { const int nb = DIN / 32, kb = r / nb, n0 = (r % nb) * 32; transpose_item(p->w_in, DIN, kb * 64, n0, (bf16_t*)(ws + WS_WIN) + (size_t)n0 * D, D, scr, lane); continue; } r -= I_IN;
        if (r < I_OUT) { const int nb = D / 32, kb = r / nb, n0 = (r % nb) * 32; transpose_item(p->w_out, D, kb * 64, n0, (bf16_t*)(ws + WS_WOUT) + (size_t)n0 * D, D, scr, lane); continue; } r -= I_OUT;
        if (r < I_UP) { const int nb = DUP / 32, kb = r / nb, n0 = (r % nb) * 32;
            const int isv = n0 >= DFF, nn = isv ? n0 - DFF : n0, drow = (nn / 128) * 256 + isv * 128 + (nn % 128);
            transpose_item(p->w_up, DUP, kb * 64, n0, (bf16_t*)(ws + WS_WUP) + (size_t)drow * D, D, scr, lane); continue; } r -= I_UP;
        if (r < I_DN) { const int nb = D / 32, kb = r / nb, n0 = (r % nb) * 32; transpose_item(p->w_down, D, kb * 64, n0, (bf16_t*)(ws + WS_WDN) + (size_t)n0 * DFF, DFF, scr, lane); continue; } r -= I_DN;
        {
            const int nh = r & 1, blk = (r >> 1) & 7, type = (r >> 4) & 1, dir = r >> 5;
            const float* src = (type ? p->lru_w_i : p->lru_w_a) + (size_t)(dir * 8 + blk) * 4096;
            bf16_t* dst = (bf16_t*)(ws + WS_LRU) + (size_t)((dir * 2 + type) * 8 + blk) * 4096 + (size_t)(nh * 32) * 64;
            transpose_item(src, 64, 0, nh * 32, dst, 64, scr, lane);
        }
    }
}

__device__ __forceinline__ void row_load_nt(const float* src, int lane, f32x4 (&v)[4]) {
#pragma unroll
    for (int j = 0; j < 4; ++j) v[j] = __builtin_nontemporal_load((const f32x4*)(src + 4 * lane + 256 * j));
}
__device__ __forceinline__ void row_load(const float* src, int lane, f32x4 (&v)[4]) {
#pragma unroll
    for (int j = 0; j < 4; ++j) v[j] = *(const f32x4*)(src + 4 * lane + 256 * j);
}
__device__ __forceinline__ float row_rstd(const f32x4 (&v)[4]) {
    float ss = 0.f;
#pragma unroll
    for (int j = 0; j < 4; ++j) ss += v[j][0] * v[j][0] + v[j][1] * v[j][1] + v[j][2] * v[j][2] + v[j][3] * v[j][3];
    return rsqrtf(wave_sum(ss) * (1.0f / D) + EPS);
}
__device__ __forceinline__ void norm_mod_store(const f32x4 (&v)[4], float rstd, const float* g, const float* sh, const float* sc, bf16_t* dst, int lane) {
#pragma unroll
    for (int j = 0; j < 4; ++j) {
        const int c = 4 * lane + 256 * j;
        const f32x4 gg = *(const f32x4*)(g + c), s1 = *(const f32x4*)(sc + c), s0 = *(const f32x4*)(sh + c);
        const f32x4 o = (v[j] * rstd * gg) * (s1 + 1.0f) + s0;
        u32x2 w; w.x = pk2(o[0], o[1]); w.y = pk2(o[2], o[3]);
        *(u32x2*)(dst + c) = w;
    }
}
__device__ __forceinline__ void phase1(PP p, int wv) {
    const int tid_ = tid_opaque(wv), lane = tid_ & 63, gw = blockIdx.x * 8 + (tid_ >> 6), NGW = gridDim.x * 8;
    const float* mod = (const float*)(p->ws + WS_MOD);
    bf16_t* hb = (bf16_t*)(p->ws + WS_HB);
    int cur = -1; f32x4 gsc[4], gsh[4];
    for (int r0 = gw; r0 < MROWS; r0 += 4 * NGW) {
        f32x4 v[4][4];
#pragma unroll
        for (int q = 0; q < 4; ++q) {
            const int r = (r0 + q * NGW < MROWS) ? r0 + q * NGW : r0;
            row_load_nt(r < NLAT ? p->x + (size_t)r * D : p->ctx + (size_t)(r - NLAT) * D, lane, v[q]);
        }
#pragma unroll
        for (int q = 0; q < 4; ++q) {
            const int r = r0 + q * NGW;
            if (r < MROWS) {
                const int mi = r < NLAT ? (r >> 14) : 2;
                if (mi != cur) {
                    cur = mi;
#pragma unroll
                    for (int j = 0; j < 4; ++j) {
                        const int c = 4 * lane + 256 * j;
                        gsc[j] = *(const f32x4*)(p->norm1_g + c) * (*(const f32x4*)(mod + mi * 6144 + 1024 + c) + 1.0f);
                        gsh[j] = *(const f32x4*)(mod + mi * 6144 + c);
                    }
                }
                const float rstd = row_rstd(v[q]);
#pragma unroll
                for (int j = 0; j < 4; ++j) {
                    const f32x4 o = v[q][j] * rstd * gsc[j] + gsh[j];
                    u32x2 w; w.x = pk2(o[0], o[1]); w.y = pk2(o[2], o[3]);
                    *(u32x2*)(hb + (size_t)r * D + 4 * lane + 256 * j) = w;
                }
            }
        }
    }
}

typedef float f32x16 __attribute__((ext_vector_type(16)));
__device__ __forceinline__ unsigned cvt_pk_bf16(float lo, float hi) { unsigned r; asm("v_cvt_pk_bf16_f32 %0, %1, %2" : "=v"(r) : "v"(lo), "v"(hi)); return r; }
__device__ __forceinline__ void attn_mfma(PP p, unsigned char* shm, int wv) {
    const int tid = tid_opaque(wv);
    const int lane = tid & 63, wave = wv, l31 = lane & 31, hl = lane >> 5;
    const bf16_t* proj = (const bf16_t*)(p->ws + WS_PROJ);
    bf16_t* att = (bf16_t*)(p->ws + WS_ATT);
    const float L2E = 1.4426950408889634f;
    const float SC2 = 0.125f * L2E;
    for (int item = blockIdx.x; item < 512; item += gridDim.x) {
        const int hk = item & 1, qb = (item >> 1) & 127, b = item >> 8;
        const int g = wave >> 1, qh = wave & 1, hq = hk * 4 + g;
        const int qrow0 = b * S + 128 * qb + 64 * qh;
        bf16x8 qf[2][4];
#pragma unroll
        for (int qi = 0; qi < 2; ++qi)
#pragma unroll
            for (int st = 0; st < 4; ++st) qf[qi][st] = *(const bf16x8*)(proj + (size_t)(qrow0 + 32 * qi + l31) * DIN + 1024 + 64 * hq + 16 * st + 8 * hl);
        const float sink2 = p->attn_sink[hq] * L2E;
        float mrun[2] = {sink2, sink2};
        float lrun[2] = {hl == 0 ? 1.f : 0.f, hl == 0 ? 1.f : 0.f};
        f32x16 oacc[2][2];
#pragma unroll
        for (int a = 0; a < 2; ++a)
#pragma unroll
            for (int c = 0; c < 2; ++c)
#pragma unroll
                for (int i = 0; i < 16; ++i) oacc[a][c][i] = 0.f;
        u32x4 kreg[2], vreg[2];
        int ci = (qb == 0) ? 1 : 0;
#define ATT_GLOAD(CI) do { const int _row0 = (CI) < 3 ? b * S + 128 * (qb - 1 + (CI)) : NLAT + b * LC + 128 * ((CI) - 3); \
        _Pragma("unroll") for (int _i = 0; _i < 2; ++_i) { const int _pi = tid + 512 * _i, _key = _pi >> 3, _part = _pi & 7; \
            const bf16_t* _src = proj + (size_t)(_row0 + _key) * DIN + 1536 + 64 * hk + 8 * _part; kreg[_i] = *(const u32x4*)_src; vreg[_i] = *(const u32x4*)(_src + 128); } } while (0)
#define ATT_STAGE(PAR) do { bf16_t* _K = (bf16_t*)(shm + (PAR) * 36864); bf16_t* _V = (bf16_t*)(shm + (PAR) * 36864 + 18432); \
        _Pragma("unroll") for (int i = 0; i < 2; ++i) { const int pi = tid + 512 * i, key = pi >> 3, part = pi & 7; \
            *(u32x4*)(_K + key * 72 + 8 * part) = kreg[i]; \
            _Pragma("unroll") for (int e = 0; e < 8; ++e) { const unsigned w = vreg[i][e >> 1]; _V[(8 * part + e) * 132 + key] = (bf16_t)((e & 1) ? (w >> 16) : (w & 0xFFFFu)); } } } while (0)
#define ATT_NEXT(C) (((C) + 1 == 2 && qb == 127) ? 3 : (C) + 1)
        ATT_GLOAD(ci);
        __syncthreads();
        ATT_STAGE(0);
        { const int c1 = ATT_NEXT(ci); if (c1 < 5) ATT_GLOAD(c1); }
        __syncthreads();
        int par = 0;
        while (ci < 5) {
            const int cn = ATT_NEXT(ci);
            if (cn < 5) { ATT_STAGE(par ^ 1); const int c2 = ATT_NEXT(cn); if (c2 < 5) ATT_GLOAD(c2); }
            const bf16_t* Ks = (const bf16_t*)(shm + par * 36864);
            const bf16_t* Vt = (const bf16_t*)(shm + par * 36864 + 18432);
            const int kt_lo = (ci == 0 && qh == 1) ? 2 : 0, kt_hi = (ci == 2 && qh == 0) ? 2 : 4;
#pragma unroll 1
            for (int kt = kt_lo; kt < kt_hi; ++kt) {
                bf16x8 kf[4];
#pragma unroll
                for (int st = 0; st < 4; ++st) kf[st] = *(const bf16x8*)(Ks + (32 * kt + l31) * 72 + 16 * st + 8 * hl);
                bf16x8 vf[2][2];
#pragma unroll
                for (int db = 0; db < 2; ++db)
#pragma unroll
                    for (int s2 = 0; s2 < 2; ++s2) {
                        const bf16_t* vp = Vt + (32 * db + l31) * 132 + 32 * kt + 16 * s2 + 4 * hl;
                        const u32x2 lo = *(const u32x2*)vp, hi = *(const u32x2*)(vp + 8);
                        u32x4 w; w.x = lo.x; w.y = lo.y; w.z = hi.x; w.w = hi.y;
                        vf[db][s2] = __builtin_bit_cast(bf16x8, w);
                    }
#pragma unroll
                for (int qi = 0; qi < 2; ++qi) {
                    f32x16 s;
#pragma unroll
                    for (int i = 0; i < 16; ++i) s[i] = 0.f;
#pragma unroll
                    for (int st = 0; st < 4; ++st) s = __builtin_amdgcn_mfma_f32_32x32x16_bf16(kf[st], qf[qi][st], s, 0, 0, 0);
                    if (ci == 0 || ci == 2) {
                        asm volatile("");
                        const int dl = (ci == 0) ? (32 * kt + 4 * hl - (64 * qh + 32 * qi + l31)) : ((64 * qh + 32 * qi + l31) - 32 * kt - 4 * hl);
#pragma unroll
                        for (int i = 0; i < 16; ++i) {
                            const int ki = 8 * (i >> 2) + (i & 3);
                            const bool ok = (ci == 0) ? (dl + ki >= 0) : (dl - ki >= 0);
                            s[i] = ok ? s[i] : -1e30f;
                        }
                    }
                    float mx = s[0];
#pragma unroll
                    for (int i = 1; i < 16; ++i) mx = fmaxf(mx, s[i]);
                    mx = fmaxf(mx, __shfl_xor(mx, 32));
                    const float mnew = fmaxf(mrun[qi], mx * SC2);
                    if (__builtin_amdgcn_ballot_w64(mnew > mrun[qi]) != 0ull) {
                        const float alpha = __builtin_amdgcn_exp2f(mrun[qi] - mnew);
                        lrun[qi] *= alpha;
#pragma unroll
                        for (int db = 0; db < 2; ++db)
#pragma unroll
                            for (int i = 0; i < 16; ++i) oacc[db][qi][i] *= alpha;
                        mrun[qi] = mnew;
                    }
                    float ls = 0.f;
#pragma unroll
                    for (int i = 0; i < 16; ++i) { s[i] = __builtin_amdgcn_exp2f(__builtin_fmaf(s[i], SC2, -mnew)); ls += s[i]; }
                    lrun[qi] += ls;
                    bf16x8 pf[2];
#pragma unroll
                    for (int s2 = 0; s2 < 2; ++s2) {
                        u32x4 w; w.x = cvt_pk_bf16(s[8 * s2 + 0], s[8 * s2 + 1]); w.y = cvt_pk_bf16(s[8 * s2 + 2], s[8 * s2 + 3]);
                        w.z = cvt_pk_bf16(s[8 * s2 + 4], s[8 * s2 + 5]); w.w = cvt_pk_bf16(s[8 * s2 + 6], s[8 * s2 + 7]);
                        pf[s2] = __builtin_bit_cast(bf16x8, w);
                    }
#pragma unroll
                    for (int db = 0; db < 2; ++db)
#pragma unroll
                        for (int s2 = 0; s2 < 2; ++s2) oacc[db][qi] = __builtin_amdgcn_mfma_f32_32x32x16_bf16(vf[db][s2], pf[s2], oacc[db][qi], 0, 0, 0);
                }
            }
            __syncthreads();
            ci = cn; par ^= 1;
        }
#undef ATT_STAGE
#undef ATT_NEXT
#undef ATT_GLOAD
#pragma unroll
        for (int qi = 0; qi < 2; ++qi) {
            const float lt = lrun[qi] + __shfl_xor(lrun[qi], 32);
            const float inv = 1.0f / lt;
            bf16_t* orow = att + (size_t)(qrow0 + 32 * qi + l31) * 512 + hq * 64;
#pragma unroll
            for (int db = 0; db < 2; ++db)
#pragma unroll
                for (int g4 = 0; g4 < 4; ++g4) {
                    u32x2 w; w.x = cvt_pk_bf16(oacc[db][qi][4 * g4] * inv, oacc[db][qi][4 * g4 + 1] * inv); w.y = cvt_pk_bf16(oacc[db][qi][4 * g4 + 2] * inv, oacc[db][qi][4 * g4 + 3] * inv);
                    *(u32x2*)(orow + 32 * db + 8 * g4 + 4 * hl) = w;
                }
        }
    }
    __syncthreads();
}


struct ScanW { bf16x8 wfa[4], wfi[4]; float ba, bi, sp8l2; };
__device__ __forceinline__ void scan_loadw(PP p, int dir, int n, int ct, int l31, int hl, ScanW& w) {
    unsigned chv = (unsigned)(32 * ct + l31); asm volatile("" : "+v"(chv));
    const unsigned ch = (unsigned)(dir * 512 + 64 * n) + chv;
    w.ba = p->lru_b_a[ch]; w.bi = p->lru_b_i[ch];
    w.sp8l2 = ((const float*)(p->ws + WS_SP8))[ch] * 1.4426950408889634f;
    const bf16_t* wa_b = (const bf16_t*)(p->ws + WS_LRU) + (size_t)((dir * 2 + 0) * 8 + n) * 4096;
    const bf16_t* wi_b = (const bf16_t*)(p->ws + WS_LRU) + (size_t)((dir * 2 + 1) * 8 + n) * 4096;
    const unsigned lo = chv * 64u + 8u * (unsigned)hl;
#pragma unroll
    for (int st = 0; st < 4; ++st) { w.wfa[st] = *(const bf16x8*)(wa_b + lo + 16 * st); w.wfi[st] = *(const bf16x8*)(wi_b + lo + 16 * st); }
}
template <int DIR>
__device__ __forceinline__ void scan_dir(PP p, const bf16_t* xs, const ScanW& w, ScanW& wn, int ndir, int nct, bool do_next, int n, int ct, int l31, int hl, int id, int rowbase, bool latent, float (&hf)[2][16]) {
    constexpr int XS = 520;
    const int ch = 64 * n + 32 * ct + l31;
    const float ba = w.ba, bi = w.bi, sp8l2 = w.sp8l2;
    const bf16x8 (&wfa)[4] = w.wfa; const bf16x8 (&wfi)[4] = w.wfi;
    float a[2][16], u[2][16];
#pragma unroll
    for (int rt = 0; rt < 2; ++rt) {
        bf16x8 af[4];
#pragma unroll
        for (int st = 0; st < 4; ++st) af[st] = *(const bf16x8*)(xs + (32 * rt + l31) * XS + 64 * n + 16 * st + 8 * hl);
        f32x16 ga, gi;
#pragma unroll
        for (int i = 0; i < 16; ++i) { ga[i] = 0.f; gi[i] = 0.f; }
#pragma unroll
        for (int st = 0; st < 4; ++st) { ga = __builtin_amdgcn_mfma_f32_32x32x16_bf16(af[st], wfa[st], ga, 0, 0, 0); gi = __builtin_amdgcn_mfma_f32_32x32x16_bf16(af[st], wfi[st], gi, 0, 0, 0); }
#pragma unroll
        for (int i = 0; i < 16; ++i) {
            const int token = 32 * rt + 8 * (i >> 2) + 4 * hl + (i & 3);
            const float xv = bf2f(xs[token * XS + ch]);
            const float rr = fast_sigmoid(ga[i] + ba), ii = fast_sigmoid(gi[i] + bi);
            const float la2 = rr * sp8l2;
            const float av = __builtin_amdgcn_exp2f(la2);
            const float t2 = la2 * 1.3862943611f;
            float em1p = t2 * (1.0f + t2 * (0.5f + t2 * (0.16666667f + t2 * (0.041666668f + t2 * 0.0083333333f)))), em1e = __builtin_fmaf(av, av, -1.0f);
            asm volatile("" : "+v"(em1p), "+v"(em1e));
            const float em1 = (t2 > -0.1f) ? em1p : em1e;
            a[rt][i] = av; u[rt][i] = __builtin_amdgcn_sqrtf(-em1) * (ii * xv);
        }
    }
    float Ao[8], Ho[8], Ap[8], Hp[8];
#pragma unroll
    for (int k = 0; k < 8; ++k) {
        const int rt = k >> 2, g = k & 3;
        float H = 0.f, A = 1.f;
#pragma unroll
        for (int jj = 0; jj < 4; ++jj) { const int j = DIR ? 3 - jj : jj; const float av = a[rt][4 * g + j]; H = av * H + u[rt][4 * g + j]; A *= av; }
        Ao[k] = A; Ho[k] = H; Ap[k] = __shfl_xor(A, 32); Hp[k] = __shfl_xor(H, 32);
    }
    float Sin[8], Pin[8]; float Sx = 0.f, Px = 1.f;
#pragma unroll
    for (int kk = 0; kk < 8; ++kk) {
        const int k = DIR ? 7 - kk : kk;
        const float A0 = hl ? Ap[k] : Ao[k], H0 = hl ? Hp[k] : Ho[k], A1 = hl ? Ao[k] : Ap[k], H1 = hl ? Ho[k] : Hp[k];
        float s0, p0, s1, p1;
        if (DIR == 0) { s0 = Sx; p0 = Px; Sx = A0 * Sx + H0; Px *= A0; s1 = Sx; p1 = Px; Sx = A1 * Sx + H1; Px *= A1; }
        else          { s1 = Sx; p1 = Px; Sx = A1 * Sx + H1; Px *= A1; s0 = Sx; p0 = Px; Sx = A0 * Sx + H0; Px *= A0; }
        Sin[k] = hl ? s1 : s0; Pin[k] = hl ? p1 : p0;
    }
    asm volatile("" ::: "memory");
    if (do_next) scan_loadw(p, ndir, n, nct, l31, hl, wn);
    bf16_t* yl = (bf16_t*)(p->ws + WS_YL) + (size_t)rowbase * 512; bf16_t* caf = (bf16_t*)(p->ws + WS_CAF) + (size_t)rowbase * 512; bf16_t* cab = (bf16_t*)(p->ws + WS_CAB) + (size_t)rowbase * 512;
    unsigned lo = (unsigned)ch; asm volatile("" : "+v"(lo));
#pragma unroll
    for (int k = 0; k < 8; ++k) {
        const int rt = k >> 2, g = k & 3;
        float h = Sin[k], P = Pin[k];
#pragma unroll
        for (int jj = 0; jj < 4; ++jj) {
            const int j = DIR ? 3 - jj : jj, idx = 4 * g + j;
            h = a[rt][idx] * h + u[rt][idx]; P *= a[rt][idx];
            const int token = 32 * rt + 8 * g + 4 * hl + j;
            const unsigned o = lo + (unsigned)token * 512u;
            if (DIR == 0) { hf[rt][idx] = h; if (latent) caf[o] = f2bf(P); }
            else if (latent) { yl[o] = f2bf(hf[rt][idx] + h); cab[o] = f2bf(P); }
        }
    }
    if (hl == 0) {
        float* sumb = (float*)(p->ws + WS_SUM);
        sumb[((size_t)(DIR * NCHUNK + id) * 2 + 0) * 512 + ch] = Px;
        sumb[((size_t)(DIR * NCHUNK + id) * 2 + 1) * 512 + ch] = Sx;
    }
}
__device__ __forceinline__ void scan_mfma(PP p, unsigned char* shm, int wv) {
    const int tid_ = tid_opaque(wv); const int tid = tid_;
    const int lane = tid & 63, n = wv, l31 = lane & 31, hl = lane >> 5;
    constexpr int XS = 520;
    bf16_t* xs = (bf16_t*)shm;
    const bf16_t* proj = (const bf16_t*)(p->ws + WS_PROJ);
    for (int item = blockIdx.x; item < 512 + 32; item += gridDim.x) {
        const int id = item < 512 ? item : 512 + ((item - 512) >> 2);
        const int quarter = item < 512 ? -1 : ((item - 512) & 3);
        int rowbase, t0, seqlen; bool latent;
        if (id < 512) { const int b = id >> 8, k = id & 255; t0 = 64 * k; rowbase = b * S + t0; seqlen = S; latent = true; }
        else { const int j = id - 512, b = j >> 2, k = j & 3; t0 = 64 * k; rowbase = NLAT + b * LC + t0; seqlen = LC; latent = false; }
        const int seqbase = rowbase - t0;
        ScanW w0, w1;
        if (quarter < 0) scan_loadw(p, 0, n, 0, l31, hl, w0);
        {
            const int tid = tid_opaque(wv);
            bf16_t* raw = (bf16_t*)(shm + 66560);
#pragma unroll
            for (int i = 0; i < 9; ++i) {
                const int piece = tid + 512 * i;
                if (piece < 67 * 64) {
                    const int row = piece >> 6, c8 = piece & 63, tt = t0 - 2 + row;
                    u32x4 v = {0u, 0u, 0u, 0u};
                    if (tt >= 0 && tt < seqlen) v = *(const u32x4*)(proj + (size_t)(seqbase + tt) * DIN + 8 * c8);
                    *(u32x4*)(raw + row * 512 + 8 * c8) = v;
                }
            }
            __syncthreads();
            const int cq = tid & 127, tq = tid >> 7, c4 = 4 * cq;
            const f32x4 k0 = *(const f32x4*)(p->rnn_conv_w + c4), k1 = *(const f32x4*)(p->rnn_conv_w + 512 + c4), k2 = *(const f32x4*)(p->rnn_conv_w + 1024 + c4),
                        k3 = *(const f32x4*)(p->rnn_conv_w + 1536 + c4), kb = *(const f32x4*)(p->rnn_conv_b + c4);
            auto ld4 = [&](int row) -> f32x4 { const u32x2 w = *(const u32x2*)(raw + row * 512 + c4); f32x4 r; r[0] = bflo(w.x); r[1] = bfhi(w.x); r[2] = bflo(w.y); r[3] = bfhi(w.y); return r; };
            f32x4 xm2 = ld4(16 * tq), xm1 = ld4(16 * tq + 1), x0 = ld4(16 * tq + 2);
#pragma unroll
            for (int t = 0; t < 16; ++t) {
                const f32x4 xp1 = ld4(16 * tq + t + 3);
                const f32x4 o = kb + k0 * xm2 + k1 * xm1 + k2 * x0 + k3 * xp1;
                u32x2 w; w.x = pk2(o[0], o[1]); w.y = pk2(o[2], o[3]);
                *(u32x2*)(xs + (16 * tq + t) * XS + c4) = w;
                xm2 = xm1; xm1 = x0; x0 = xp1;
            }
        }
        __syncthreads();
#pragma unroll 1
        for (int ct = 0; ct < 2; ++ct) {
            float hf[2][16];
            const bool run0 = quarter < 0 || quarter == 2 * ct, run1 = quarter < 0 || quarter == 2 * ct + 1;
            if (quarter >= 0) { if (run0) scan_loadw(p, 0, n, ct, l31, hl, w0); if (run1) scan_loadw(p, 1, n, ct, l31, hl, w1); }
            if (run0) scan_dir<0>(p, xs, w0, w1, 1, ct, quarter < 0, n, ct, l31, hl, id, rowbase, latent, hf);
            if (run1) scan_dir<1>(p, xs, w1, w0, 0, 1, quarter < 0 && ct == 0, n, ct, l31, hl, id, rowbase, latent, hf);
        }
        __syncthreads();
    }
}

__device__ __forceinline__ void carry_phase(PP p, unsigned char* shm, int wv) {
    if (blockIdx.x >= 128) return;
    const int tid = tid_opaque(wv), cl = tid & 15, sg = tid >> 4;
    const int b = blockIdx.x >> 6, dir = (blockIdx.x >> 5) & 1, c = (blockIdx.x & 31) * 16 + cl;
    const float* sumb = (const float*)(p->ws + WS_SUM) + (size_t)dir * NCHUNK * 1024;
    float* car = (float*)(p->ws + WS_CAR) + (size_t)dir * NCHUNK * 512;
    float* segA = (float*)shm; float* segH = segA + 512;
    float A[9], H[9]; int ids[9];
#pragma unroll
    for (int k = 0; k < 9; ++k) {
        const int s = sg * 9 + k;
        int id = -1;
        if (s < 260) { if (dir == 0) id = s < 4 ? 512 + 4 * b + s : 256 * b + (s - 4); else id = s < 4 ? 512 + 4 * b + (3 - s) : 256 * b + (255 - (s - 4)); }
        ids[k] = id;
        A[k] = id >= 0 ? sumb[(size_t)id * 1024 + c] : 1.f;
        H[k] = id >= 0 ? sumb[(size_t)id * 1024 + 512 + c] : 0.f;
    }
    float As = 1.f, Hs = 0.f;
#pragma unroll
    for (int k = 0; k < 9; ++k) { Hs = A[k] * Hs + H[k]; As *= A[k]; }
    segA[sg * 16 + cl] = As; segH[sg * 16 + cl] = Hs;
    __syncthreads();
    float h = 0.f;
    for (int j = 0; j < sg; ++j) h = segA[j * 16 + cl] * h + segH[j * 16 + cl];
#pragma unroll
    for (int k = 0; k < 9; ++k) { if (ids[k] >= 0) car[(size_t)ids[k] * 512 + c] = h; h = A[k] * h + H[k]; }
    __syncthreads();
}

struct MixRow { u32x4 vy, vf, vb, vg, va; f32x4 cf0, cf1, cb0, cb1; };
__device__ __forceinline__ void mix_load(PP p, int r, int c0, MixRow& m) {
    const bf16_t* proj = (const bf16_t*)(p->ws + WS_PROJ);
    const bf16_t* att = (const bf16_t*)(p->ws + WS_ATT);
    const bf16_t* yl = (const bf16_t*)(p->ws + WS_YL); const bf16_t* caf = (const bf16_t*)(p->ws + WS_CAF); const bf16_t* cab = (const bf16_t*)(p->ws + WS_CAB);
    const float* car = (const float*)(p->ws + WS_CAR);
    const int id = r >> 6;
    m.vy = *(const u32x4*)(yl + (size_t)r * 512 + c0); m.vf = *(const u32x4*)(caf + (size_t)r * 512 + c0); m.vb = *(const u32x4*)(cab + (size_t)r * 512 + c0);
    m.vg = *(const u32x4*)(proj + (size_t)r * DIN + 512 + c0); m.va = *(const u32x4*)(att + (size_t)r * 512 + c0);
    const float* cf = car + (size_t)id * 512 + c0; const float* cbk = car + (size_t)(NCHUNK + id) * 512 + c0;
    m.cf0 = *(const f32x4*)cf; m.cf1 = *(const f32x4*)(cf + 4); m.cb0 = *(const f32x4*)cbk; m.cb1 = *(const f32x4*)(cbk + 4);
}
__device__ __forceinline__ void mix_store(PP p, int r, int c0, const MixRow& m, const f32x4 (&gr)[2], const f32x4 (&ga)[2]) {
    bf16_t* mix = (bf16_t*)(p->ws + WS_HB);
    float rn[8], at[8]; float s1 = 0.f, s2 = 0.f;
#pragma unroll
    for (int e = 0; e < 8; ++e) {
        const unsigned wy = m.vy[e >> 1], wf = m.vf[e >> 1], wb = m.vb[e >> 1], wg = m.vg[e >> 1], wa = m.va[e >> 1];
        const float cfe = e < 4 ? m.cf0[e & 3] : m.cf1[e & 3], cbe = e < 4 ? m.cb0[e & 3] : m.cb1[e & 3];
        const float y = ((e & 1) ? bfhi(wy) : bflo(wy)) + ((e & 1) ? bfhi(wf) : bflo(wf)) * cfe + ((e & 1) ? bfhi(wb) : bflo(wb)) * cbe;
        const float xg = (e & 1) ? bfhi(wg) : bflo(wg);
        rn[e] = gelu_tanh_(xg) * y; s1 += rn[e] * rn[e];
        at[e] = (e & 1) ? bfhi(wa) : bflo(wa); s2 += at[e] * at[e];
    }
    const float r1 = rsqrtf(wave_sum(s1) * (1.0f / 512.0f) + EPS), r2 = rsqrtf(wave_sum(s2) * (1.0f / 512.0f) + EPS);
    u32x4 o1, o2;
#pragma unroll
    for (int e2 = 0; e2 < 4; ++e2) {
        o1[e2] = pk2(rn[2 * e2] * r1 * gr[e2 >> 1][(2 * e2) & 3], rn[2 * e2 + 1] * r1 * gr[e2 >> 1][(2 * e2 + 1) & 3]);
        o2[e2] = pk2(at[2 * e2] * r2 * ga[e2 >> 1][(2 * e2) & 3], at[2 * e2 + 1] * r2 * ga[e2 >> 1][(2 * e2 + 1) & 3]);
    }
    *(u32x4*)(mix + (size_t)r * D + c0) = o1; *(u32x4*)(mix + (size_t)r * D + 512 + c0) = o2;
}
__device__ __forceinline__ void mix_phase(PP p, int wv) {
    const int tid_ = tid_opaque(wv), lane = tid_ & 63, gw = blockIdx.x * 8 + (tid_ >> 6), NGW = gridDim.x * 8;
    const int c0 = 8 * lane;
    f32x4 gr[2], ga[2];
    gr[0] = *(const f32x4*)(p->gn_rnn + c0); gr[1] = *(const f32x4*)(p->gn_rnn + c0 + 4); ga[0] = *(const f32x4*)(p->gn_attn + c0); ga[1] = *(const f32x4*)(p->gn_attn + c0 + 4);
    for (int r = gw; r < NLAT; r += 2 * NGW) {
        const int rb = (r + NGW < NLAT) ? r + NGW : r;
        MixRow ma, mb;
        mix_load(p, r, c0, ma); mix_load(p, rb, c0, mb);
        mix_store(p, r, c0, ma, gr, ga);
        if (rb != r) mix_store(p, rb, c0, mb, gr, ga);
    }
}

__device__ __forceinline__ void phase7(PP p, int wv) {
    const int tid_ = tid_opaque(wv), lane = tid_ & 63, gw = blockIdx.x * 8 + (tid_ >> 6), NGW = gridDim.x * 8;
    const float* mod = (const float*)(p->ws + WS_MOD);
    bf16_t* hb = (bf16_t*)(p->ws + WS_HB);
    const bf16_t* o1 = (const bf16_t*)(p->ws + WS_O1);
    int cur = -1; f32x4 gsc[4], gsh[4];
    for (int r = gw; r < NLAT; r += 2 * NGW) {
        const int rb = r + NGW;
        f32x4 va[4], vb[4]; u32x2 da[4], db[4];
        row_load_nt(p->x + (size_t)r * D, lane, va); row_load_nt(p->x + (size_t)rb * D, lane, vb);
#pragma unroll
        for (int j = 0; j < 4; ++j) { da[j] = *(const u32x2*)(o1 + (size_t)r * D + 4 * lane + 256 * j); db[j] = *(const u32x2*)(o1 + (size_t)rb * D + 4 * lane + 256 * j); }
#pragma unroll
        for (int j = 0; j < 4; ++j) {
            va[j][0] += bflo(da[j].x); va[j][1] += bfhi(da[j].x); va[j][2] += bflo(da[j].y); va[j][3] += bfhi(da[j].y);
            vb[j][0] += bflo(db[j].x); vb[j][1] += bfhi(db[j].x); vb[j][2] += bflo(db[j].y); vb[j][3] += bfhi(db[j].y);
        }
        const float sa = row_rstd(va), sb = row_rstd(vb);
        const int ma = r >> 14;
        if (ma != cur) {
            cur = ma;
#pragma unroll
            for (int j = 0; j < 4; ++j) {
                const int c = 4 * lane + 256 * j;
                gsc[j] = *(const f32x4*)(p->norm2_g + c) * (*(const f32x4*)(mod + ma * 6144 + 4096 + c) + 1.0f);
                gsh[j] = *(const f32x4*)(mod + ma * 6144 + 3072 + c);
            }
        }
        bf16_t* da_ = hb + (size_t)(ma * H2_BSTRIDE + 1 + (r & (S - 1))) * D; bf16_t* db_ = hb + (size_t)((rb >> 14) * H2_BSTRIDE + 1 + (rb & (S - 1))) * D;
#pragma unroll
        for (int j = 0; j < 4; ++j) {
            const f32x4 oa = va[j] * sa * gsc[j] + gsh[j], ob = vb[j] * sb * gsc[j] + gsh[j];
            u32x2 wa; wa.x = pk2(oa[0], oa[1]); wa.y = pk2(oa[2], oa[3]); u32x2 wb; wb.x = pk2(ob[0], ob[1]); wb.y = pk2(ob[2], ob[3]);
            *(u32x2*)(da_ + 4 * lane + 256 * j) = wa; if ((rb >> 14) == ma) *(u32x2*)(db_ + 4 * lane + 256 * j) = wb;
        }
        if ((rb >> 14) != ma) { const int mb = rb >> 14; norm_mod_store(vb, sb, p->norm2_g, mod + mb * 6144 + 3072, mod + mb * 6144 + 4096, db_, lane); }
    }
    for (int z = gw; z < 254; z += NGW) {
        const int R = z == 0 ? 0 : (z <= 126 ? S + z : 32895 + (z - 127));
        const u32x4 zz = {0u, 0u, 0u, 0u};
        *(u32x4*)(hb + (size_t)R * D + 8 * lane) = zz; *(u32x4*)(hb + (size_t)R * D + 512 + 8 * lane) = zz;
    }
}

__device__ __forceinline__ void final_phase(PP p, int wv) {
    const int tid_ = tid_opaque(wv), lane = tid_ & 63, gw = blockIdx.x * 8 + (tid_ >> 6), NGW = gridDim.x * 8;
    const bf16_t* o1 = (const bf16_t*)(p->ws + WS_O1); const bf16_t* o2 = (const bf16_t*)(p->ws + WS_O2);
    f32x4 fg[4];
#pragma unroll
    for (int j = 0; j < 4; ++j) fg[j] = *(const f32x4*)(p->final_g + 4 * lane + 256 * j);
    for (int r = gw; r < NLAT; r += 2 * NGW) {
        const int rb = r + NGW;
        f32x4 va[4], vb[4]; u32x2 da[4], db[4], ea[4], eb[4];
        row_load_nt(p->x + (size_t)r * D, lane, va); row_load_nt(p->x + (size_t)rb * D, lane, vb);
#pragma unroll
        for (int j = 0; j < 4; ++j) {
            da[j] = *(const u32x2*)(o1 + (size_t)r * D + 4 * lane + 256 * j); db[j] = *(const u32x2*)(o1 + (size_t)rb * D + 4 * lane + 256 * j);
            ea[j] = *(const u32x2*)(o2 + (size_t)r * D + 4 * lane + 256 * j); eb[j] = *(const u32x2*)(o2 + (size_t)rb * D + 4 * lane + 256 * j);
        }
#pragma unroll
        for (int j = 0; j < 4; ++j) {
            va[j][0] += bflo(da[j].x) + bflo(ea[j].x); va[j][1] += bfhi(da[j].x) + bfhi(ea[j].x); va[j][2] += bflo(da[j].y) + bflo(ea[j].y); va[j][3] += bfhi(da[j].y) + bfhi(ea[j].y);
            vb[j][0] += bflo(db[j].x) + bflo(eb[j].x); vb[j][1] += bfhi(db[j].x) + bfhi(eb[j].x); vb[j][2] += bflo(db[j].y) + bflo(eb[j].y); vb[j][3] += bfhi(db[j].y) + bfhi(eb[j].y);
        }
        const float sa = row_rstd(va), sb = row_rstd(vb);
        float* rowa = p->out + (size_t)r * D; float* rowb = p->out + (size_t)rb * D;
#pragma unroll
        for (int j = 0; j < 4; ++j) { const f32x4 gg = fg[j]; *(f32x4*)(rowa + 4 * lane + 256 * j) = va[j] * sa * gg; *(f32x4*)(rowb + 4 * lane + 256 * j) = vb[j] * sb * gg; }
    }
}

__global__ void __launch_bounds__(512, 2) fwd_megakernel(Params p_arg) {
    extern __shared__ __attribute__((aligned(16))) unsigned char shm[];
    cg::grid_group grid = cg::this_grid();
    LAS unsigned char* lds = (LAS unsigned char*)shm;
    pg8::StaticOrder so;
    const int wv = __builtin_amdgcn_readfirstlane((int)(threadIdx.x >> 6));
    volatile LAS unsigned* xst = (volatile LAS unsigned*)(lds + LDS_XB);
    if (tid_opaque(wv) == 0) { xst[0] = 0u; xst[1] = 0u; }
    __syncthreads();
    (void)xcd_barrier_post((unsigned*)(kparams()->ws + WS_BAR), xst, wv);
#define XBAR() do { XcdBarrier _b; _b.bar = (unsigned*)(kparams()->ws + WS_BAR); _b.x = xb_xcc_id(); _b.st = (volatile LAS unsigned*)(lds + LDS_XB); xcd_barrier(_b, wv); } while (0)
    if (kparams()->out == nullptr) grid.sync();

    phase0(kparams(), shm, wv);
    {
        constexpr int T_IN = (D / 64) * (DIN / 32), T_B = (D / 64) * (D / 32) + (D / 64) * (DUP / 32) + (DFF / 64) * (D / 32), T_LRU = 64;
        const int nfree = (int)gridDim.x > 192 ? (int)gridDim.x - 192 : 0;
        const int first = nfree ? 192 : 0, nblk = nfree ? nfree : (int)gridDim.x;
        if ((int)blockIdx.x >= first) {
            transpose_phase(kparams(), shm, wv, 0, T_IN, ((int)blockIdx.x - first) * 8, nblk * 8);
            transpose_phase(kparams(), shm, wv, T_IN + T_B, T_IN + T_B + T_LRU, ((int)blockIdx.x - first) * 8, nblk * 8);
        }
    }
    XBAR();
    phase1(kparams(), wv);
    XBAR();
    {
        PP p = kparams(); unsigned char* ws = p->ws;
        pg8::Gemm g{(const bf16_t*)(ws + WS_HB), (const bf16_t*)(ws + WS_WIN), MROWS / 256, DIN / 256, D, 256};
        so.init(g.nM, g.nN, gridDim.x, blockIdx.x);
        EpiProj e{(bf16_t*)(ws + WS_PROJ), (const float*)(ws + WS_ROPE), (const float*)(ws + WS_ROPE) + 4096};
        pg8::gemm_phase(lds, g, so, e, wv);
        {
            constexpr int T_IN = (D / 64) * (DIN / 32), T_B = (D / 64) * (D / 32) + (D / 64) * (DUP / 32) + (DFF / 64) * (D / 32);
            const int G = (int)gridDim.x, rem = (g.nM * g.nN) % G;
            const int first = rem ? rem : 0, nblk = G - first;
            if ((int)blockIdx.x >= first) transpose_phase(p, shm, wv, T_IN, T_IN + T_B, ((int)blockIdx.x - first) * 8, nblk * 8);
        }
    }
    XBAR();
    scan_mfma(kparams(), shm, wv);
    attn_mfma(kparams(), shm, wv);
    XBAR();
    carry_phase(kparams(), shm, wv);
    XBAR();
    mix_phase(kparams(), wv);
    XBAR();
    {
        PP p = kparams(); unsigned char* ws = p->ws; const float* mod = (const float*)(ws + WS_MOD);
        pg8::Gemm g{(const bf16_t*)(ws + WS_HB), (const bf16_t*)(ws + WS_WOUT), NLAT / 256, D / 256, D, 256};
        so.init(g.nM, g.nN, gridDim.x, blockIdx.x);
        EpiDelta e{(bf16_t*)(ws + WS_O1), mod + 2048, mod + 6144 + 2048};
        pg8::gemm_phase(lds, g, so, e, wv);
    }
    XBAR();
    phase7(kparams(), wv);
    XBAR();
    {
        PP p = kparams(); unsigned char* ws = p->ws;
        pg8::Gemm g{(const bf16_t*)(ws + WS_HB), (const bf16_t*)(ws + WS_WUP), 130, DUP / 256, D, 254};
        so.init(g.nM, g.nN, gridDim.x, blockIdx.x);
        EpiConvGate e{(bf16_t*)(ws + WS_ACT), p->ffn_conv_w, p->ffn_conv_b, lds + 131072};
        pg8::gemm_phase(lds, g, so, e, wv);
    }
    XBAR();
    {
        PP p = kparams(); unsigned char* ws = p->ws; const float* mod = (const float*)(ws + WS_MOD);
        pg8::Gemm g{(const bf16_t*)(ws + WS_ACT), (const bf16_t*)(ws + WS_WDN), NLAT / 256, D / 256, DFF, 256};
        so.init(g.nM, g.nN, gridDim.x, blockIdx.x);
        EpiDelta e{(bf16_t*)(ws + WS_O2), mod + 5120, mod + 6144 + 5120};
        pg8::gemm_phase(lds, g, so, e, wv);
    }
    XBAR();
    final_phase(kparams(), wv);
}

extern "C" void kernel_launch(void* const* d_in, const int* in_sizes, int n_in, void* d_out, int out_size, void* d_ws, size_t ws_size, hipStream_t stream) {
    static int grid_blocks = 0;
    if (!grid_blocks) {
        int dev = 0, cus = 0, per_cu = 0;
        hipGetDevice(&dev);
        hipDeviceGetAttribute(&cus, hipDeviceAttributeMultiprocessorCount, dev);
        hipFuncSetAttribute((const void*)fwd_megakernel, hipFuncAttributeMaxDynamicSharedMemorySize, LDS_BYTES);
        hipOccupancyMaxActiveBlocksPerMultiprocessor(&per_cu, (const void*)fwd_megakernel, 512, LDS_BYTES);
        if (per_cu < 1) per_cu = 1;
        grid_blocks = cus * per_cu;
        if (ws_size < WS_END) fprintf(stderr, "kernel_launch: workspace too small: %zu < %zu\n", ws_size, (size_t)WS_END);
    }
    Params p{};
    const float** pp = (const float**)&p;
    for (int i = 0; i < 25; ++i) pp[i] = (const float*)d_in[i];
    const size_t ws_off = ws_size > WS_END ? ((ws_size - WS_END) & ~(size_t)4095) : 0;
    p.out = (float*)d_out; p.ws = (unsigned char*)d_ws + ws_off;
    hipMemsetAsync((unsigned char*)d_ws + ws_off + WS_BAR, 0, 16384, stream);
    void* args[] = {&p};
    hipError_t e = hipLaunchCooperativeKernel((const void*)fwd_megakernel, dim3(grid_blocks), dim3(512), args, LDS_BYTES, stream);
    if (e != hipSuccess) fprintf(stderr, "cooperative launch failed: %s (grid %d)\n", hipGetErrorString(e), grid_blocks);
}
```
